# Optimizing an MI355X kernel written in HIP

```python
import math
import jax, jax.numpy as jnp
from jax import lax
import numpy as np

D_MODEL = 1024
BATCH = 2
SEQ = 8192
DEPTH = 2

N_MIXERS = 2
N_A_LAYERS = (DEPTH + 1) // 2
N_B_LAYERS = DEPTH // 2

HGRN_EXPAND = 128
HGRN_HEADS = D_MODEL // HGRN_EXPAND
HGRN_FDIM = HGRN_HEADS * HGRN_EXPAND
HGRN_IDIM = D_MODEL // HGRN_HEADS
HGRN_CHUNK = 64

ATTN_HEADS = 8
ATTN_HEAD_DIM = D_MODEL // ATTN_HEADS
MOBA_BLOCK = 256
MOBA_TOPK = 3
MOBA_QCHUNK = 32

REL_BUCKETS = 32
REL_MAX_DISTANCE = 1024

D_FF = -(-(8 * D_MODEL) // (3 * 256)) * 256
RMS_EPS = 1e-6

kernel_name = "hgrn2_moba_interleaved_hybrid"


def rms_norm(x, g):
    xf = x.astype(jnp.float32)
    y = xf * lax.rsqrt(jnp.mean(xf * xf, axis=-1, keepdims=True) + RMS_EPS)
    return (y * g.astype(jnp.float32)).astype(x.dtype)


def t5_bucket(dist):
    n = jnp.maximum(dist, 0)
    max_exact = REL_BUCKETS // 2
    nf = jnp.maximum(n, max_exact).astype(jnp.float32)
    large = max_exact + (jnp.log(nf / max_exact) / math.log(REL_MAX_DISTANCE / max_exact)
                         * (REL_BUCKETS - max_exact)).astype(jnp.int32)
    large = jnp.minimum(large, REL_BUCKETS - 1)
    return jnp.where(n < max_exact, n, large)


def hgrn2_mixer(h, w_in, w_out, lb, out_norm):
    b_, s_, _ = h.shape
    f32 = jnp.float32
    proj = h @ w_in
    q, fz, inp, og = jnp.split(proj, [HGRN_FDIM, 2 * HGRN_FDIM, 2 * HGRN_FDIM + D_MODEL], axis=-1)
    q = jax.nn.silu(q.astype(f32))
    lbf = lb.astype(f32)
    f = lbf + (1.0 - lbf) * jax.nn.sigmoid(fz.astype(f32))
    k = 1.0 - f
    logf = jnp.log(f)
    nc = s_ // HGRN_CHUNK

    def to_chunks(t, d):
        return t.reshape(b_, nc, HGRN_CHUNK, HGRN_HEADS, d).transpose(1, 0, 3, 2, 4)

    qc = to_chunks(q, HGRN_EXPAND)
    kc = to_chunks(k, HGRN_EXPAND)
    gc = to_chunks(logf, HGRN_EXPAND)
    ic = to_chunks(inp.astype(f32), HGRN_IDIM)
    causal = jnp.tril(jnp.ones((HGRN_CHUNK, HGRN_CHUNK), dtype=bool))

    def step(state, xs):
        qb, kb, gb, ib = xs
        cum = jnp.cumsum(gb, axis=2)
        diff = cum[:, :, :, None, :] - cum[:, :, None, :, :]
        decay = jnp.exp(jnp.where(causal[:, :, None], diff, -jnp.inf))
        scores = jnp.einsum('bhtn,bhsn,bhtsn->bhts', qb, kb, decay)
        o = (jnp.einsum('bhts,bhsd->bhtd', scores, ib)
             + jnp.einsum('bhtn,bhnd->bhtd', qb * jnp.exp(cum), state))
        last = cum[:, :, -1:, :]
        state = (state * jnp.exp(last[:, :, 0, :, None])
                 + jnp.einsum('bhsn,bhsd->bhnd', kb * jnp.exp(last - cum), ib))
        return state, o

    s0 = jnp.zeros((b_, HGRN_HEADS, HGRN_EXPAND, HGRN_IDIM), f32)
    _, o = lax.scan(step, s0, (qc, kc, gc, ic))
    o = o.transpose(1, 0, 3, 2, 4).reshape(b_, s_, D_MODEL)
    o = rms_norm(o, out_norm) * jax.nn.sigmoid(og.astype(f32))
    return (o.astype(h.dtype) @ w_out).astype(h.dtype)


def moba_mixer(h, w_in, w_out, rel_table):
    b_, s_, _ = h.shape
    f32 = jnp.float32
    nh, dh = ATTN_HEADS, ATTN_HEAD_DIM
    q, k, v = jnp.split(h @ w_in, 3, axis=-1)
    heads = lambda t: t.reshape(b_, s_, nh, dh).transpose(0, 2, 1, 3)
    q, k, v = heads(q), heads(k), heads(v)
    nb = -(-s_ // MOBA_BLOCK)
    pad = nb * MOBA_BLOCK - s_
    kp = jnp.pad(k, ((0, 0), (0, 0), (0, pad), (0, 0)))
    vp = jnp.pad(v, ((0, 0), (0, 0), (0, pad), (0, 0)))
    kb = kp.reshape(b_, nh, nb, MOBA_BLOCK, dh)
    vb = vp.reshape(b_, nh, nb, MOBA_BLOCK, dh)
    kmean = jnp.mean(kb.astype(f32), axis=3)
    scale = dh ** -0.5
    nqc = s_ // MOBA_QCHUNK
    qch = q.reshape(b_, nh, nqc, MOBA_QCHUNK, dh).transpose(2, 0, 1, 3, 4)
    bi = jnp.arange(b_)[:, None, None, None]
    hi = jnp.arange(nh)[None, :, None, None]
    table_t = rel_table.T
    topk = min(MOBA_TOPK, nb)
    kk = topk * MOBA_BLOCK

    def chunk(args):
        c, qb = args
        q0 = c * MOBA_QCHUNK
        qpos = q0 + jnp.arange(MOBA_QCHUNK)
        j = q0 // MOBA_BLOCK
        gate = jnp.einsum('bhqd,bhnd->bhqn', qb.astype(f32), kmean)
        gate = jnp.where(jnp.arange(nb) < j, gate, -jnp.inf)
        _, sel = lax.top_k(gate, topk)
        sel_ok = jnp.arange(topk) < j
        ks = kb[bi, hi, sel]
        vs = vb[bi, hi, sel]
        s_sel = jnp.einsum('bhqd,bhqkpd->bhqkp', qb, ks).astype(f32) * scale
        kpos_sel = sel[..., None] * MOBA_BLOCK + jnp.arange(MOBA_BLOCK)
        bias_sel = table_t[hi[..., None], t5_bucket(qpos[:, None, None] - kpos_sel)]
        s_sel = jnp.where(sel_ok[:, None], s_sel + bias_sel.astype(f32), -jnp.inf)
        kown = lax.dynamic_slice_in_dim(kp, j * MOBA_BLOCK, MOBA_BLOCK, axis=2)
        vown = lax.dynamic_slice_in_dim(vp, j * MOBA_BLOCK, MOBA_BLOCK, axis=2)
        dist_own = qpos[:, None] - (j * MOBA_BLOCK + jnp.arange(MOBA_BLOCK))[None, :]
        bias_own = rel_table[t5_bucket(dist_own)].transpose(2, 0, 1).astype(f32)
        s_own = jnp.einsum('bhqd,bhpd->bhqp', qb, kown).astype(f32) * scale + bias_own
        s_own = jnp.where(dist_own >= 0, s_own, -jnp.inf)
        logits = jnp.concatenate([s_sel.reshape(b_, nh, MOBA_QCHUNK, kk), s_own], axis=-1)
        p = jax.nn.softmax(logits, axis=-1).astype(vb.dtype)
        p_sel = p[..., :kk].reshape(b_, nh, MOBA_QCHUNK, topk, MOBA_BLOCK)
        p_own = p[..., kk:]
        return (jnp.einsum('bhqkp,bhqkpd->bhqd', p_sel, vs)
                + jnp.einsum('bhqp,bhpd->bhqd', p_own, vown))

    o = lax.map(chunk, (jnp.arange(nqc), qch))
    o = o.transpose(1, 0, 3, 2, 4).reshape(b_, s_, D_MODEL)
    return (o @ w_out).astype(h.dtype)


def swiglu(h, w13, w2):
    g, u = jnp.split(h @ w13, 2, axis=-1)
    return ((jax.nn.silu(g) * u) @ w2).astype(h.dtype)


def setup_inputs(seed: int = 0) -> dict:
    key = jax.random.key(seed)
    ks = jax.random.split(key, 14)
    nrm = lambda k, shape, fan_in: jax.random.normal(k, shape, jnp.float32) * (fan_in ** -0.5)
    gain = lambda k, shape: 1.0 + 0.02 * jax.random.normal(k, shape, jnp.float32)
    return {
        "x": jax.random.normal(ks[0], (BATCH, SEQ, D_MODEL), jnp.float32),
        "norm_mix": gain(ks[1], (DEPTH, D_MODEL)),
        "norm_ffn": gain(ks[2], (DEPTH, D_MODEL)),
        "hgrn_w_in": nrm(ks[3], (N_A_LAYERS, D_MODEL, 2 * HGRN_FDIM + 2 * D_MODEL), D_MODEL),
        "hgrn_lb_logits": 1.0 + 0.1 * jax.random.normal(ks[4], (N_A_LAYERS + 1, HGRN_FDIM), jnp.float32),
        "hgrn_out_norm": gain(ks[5], (N_A_LAYERS, D_MODEL)),
        "hgrn_w_out": nrm(ks[6], (N_A_LAYERS, D_MODEL, D_MODEL), D_MODEL),
        "moba_w_in": nrm(ks[7], (N_B_LAYERS, D_MODEL, 3 * D_MODEL), D_MODEL),
        "moba_w_out": nrm(ks[8], (N_B_LAYERS, D_MODEL, D_MODEL), D_MODEL),
        "rel_bias_table": 0.5 * jax.random.normal(ks[9], (REL_BUCKETS, ATTN_HEADS), jnp.float32),
        "ffn_w13": nrm(ks[10], (DEPTH, D_MODEL, 2 * D_FF), D_MODEL),
        "ffn_w2": nrm(ks[11], (DEPTH, D_FF, D_MODEL), D_FF),
        "final_norm": gain(ks[12], (D_MODEL,)),
    }


def reference(x, norm_mix, norm_ffn, hgrn_w_in, hgrn_lb_logits, hgrn_out_norm, hgrn_w_out,
              moba_w_in, moba_w_out, rel_bias_table, ffn_w13, ffn_w2, final_norm):
    lb_all = jnp.cumsum(jax.nn.softmax(hgrn_lb_logits.astype(jnp.float32), axis=0), axis=0)[:N_A_LAYERS]
    h = x
    for layer in range(DEPTH):
        y = rms_norm(h, norm_mix[layer])
        idx = layer // N_MIXERS
        if layer % N_MIXERS == 0:
            y = hgrn2_mixer(y, hgrn_w_in[idx], hgrn_w_out[idx], lb_all[idx], hgrn_out_norm[idx])
        else:
            y = moba_mixer(y, moba_w_in[idx], moba_w_out[idx], rel_bias_table)
        h = h + y
        h = h + swiglu(rms_norm(h, norm_ffn[layer]), ffn_w13[layer], ffn_w2[layer])
    return rms_norm(h, final_norm)
```

```cpp
#include <hip/hip_runtime.h>
#include <cstdio>
#include <cstdint>
#include <cmath>

namespace {
constexpr int D = 1024, B = 2, S = 8192, H = 8, DH = 128, DFF = 2816;
constexpr int NB = 32, BLK = 256;
constexpr float EPS = 1e-6f;

__device__ __forceinline__ float sigmoidf_(float x) { return 1.f / (1.f + __expf(-x)); }

__device__ __forceinline__ float block_sum_256(float v, float* red) {
    for (int o = 32; o > 0; o >>= 1) v += __shfl_xor(v, o);
    __syncthreads();
    if ((threadIdx.x & 63) == 0) red[threadIdx.x >> 6] = v;
    __syncthreads();
    return red[0] + red[1] + red[2] + red[3];
}
__device__ __forceinline__ float block_max_256(float v, float* red) {
    for (int o = 32; o > 0; o >>= 1) v = fmaxf(v, __shfl_xor(v, o));
    __syncthreads();
    if ((threadIdx.x & 63) == 0) red[threadIdx.x >> 6] = v;
    __syncthreads();
    return fmaxf(fmaxf(red[0], red[1]), fmaxf(red[2], red[3]));
}

__global__ void __launch_bounds__(256) rmsnorm_k(const float* x, const float* __restrict__ g, float* y, const float* gate, int ldgate) {
    __shared__ float red[4];
    const int row = blockIdx.x, t = threadIdx.x;
    const float4 v = *(const float4*)(x + (size_t)row * D + t * 4);
    float s = v.x * v.x + v.y * v.y + v.z * v.z + v.w * v.w;
    s = block_sum_256(s, red);
    const float r = rsqrtf(s * (1.f / D) + EPS);
    const float4 gg = *(const float4*)(g + t * 4);
    float4 o; o.x = v.x * r * gg.x; o.y = v.y * r * gg.y; o.z = v.z * r * gg.z; o.w = v.w * r * gg.w;
    if (gate) {
        const float4 q = *(const float4*)(gate + (size_t)row * ldgate + t * 4);
        o.x *= sigmoidf_(q.x); o.y *= sigmoidf_(q.y); o.z *= sigmoidf_(q.z); o.w *= sigmoidf_(q.w);
    }
    *(float4*)(y + (size_t)row * D + t * 4) = o;
}

template <int MODE>
__global__ void __launch_bounds__(256) gemm_f32(const float* __restrict__ A, int lda, const float* __restrict__ W, int ldw, float* C, int ldc,
                                                const float* R, int ldr, int K) {
    __shared__ float As[8][128];
    __shared__ float Ws[8][128];
    const int tid = threadIdx.x, tx = tid & 15, ty = tid >> 4;
    const int m0 = blockIdx.y * 128, n0 = blockIdx.x * 128;
    float acc[8][8];
#pragma unroll
    for (int i = 0; i < 8; ++i)
#pragma unroll
        for (int j = 0; j < 8; ++j) acc[i][j] = 0.f;
    const float* ap = A + (size_t)(m0 + (tid >> 1)) * lda + (tid & 1) * 4;
    const float* wp = W + (size_t)(tid >> 5) * ldw + n0 + (tid & 31) * 4;
    for (int k0 = 0; k0 < K; k0 += 8) {
        const float4 av = *(const float4*)(ap + k0);
        const float4 wv = *(const float4*)(wp + (size_t)k0 * ldw);
        __syncthreads();
        As[(tid & 1) * 4 + 0][tid >> 1] = av.x; As[(tid & 1) * 4 + 1][tid >> 1] = av.y;
        As[(tid & 1) * 4 + 2][tid >> 1] = av.z; As[(tid & 1) * 4 + 3][tid >> 1] = av.w;
        *(float4*)&Ws[tid >> 5][(tid & 31) * 4] = wv;
        __syncthreads();
#pragma unroll
        for (int k = 0; k < 8; ++k) {
            const float4 a0 = *(const float4*)&As[k][ty * 4], a1 = *(const float4*)&As[k][64 + ty * 4];
            const float4 w0 = *(const float4*)&Ws[k][tx * 4], w1 = *(const float4*)&Ws[k][64 + tx * 4];
            const float a[8] = {a0.x, a0.y, a0.z, a0.w, a1.x, a1.y, a1.z, a1.w};
            const float w[8] = {w0.x, w0.y, w0.z, w0.w, w1.x, w1.y, w1.z, w1.w};
#pragma unroll
            for (int i = 0; i < 8; ++i)
#pragma unroll
                for (int j = 0; j < 8; ++j) acc[i][j] = fmaf(a[i], w[j], acc[i][j]);
        }
    }
#pragma unroll
    for (int i = 0; i < 8; ++i) {
        const int r = m0 + (i < 4 ? ty * 4 + i : 64 + ty * 4 + (i - 4));
#pragma unroll
        for (int jh = 0; jh < 2; ++jh) {
            const int c = n0 + jh * 64 + tx * 4;
            float4 o; o.x = acc[i][jh * 4 + 0]; o.y = acc[i][jh * 4 + 1]; o.z = acc[i][jh * 4 + 2]; o.w = acc[i][jh * 4 + 3];
            if (MODE == 1) { const float4 rr = *(const float4*)(R + (size_t)r * ldr + c); o.x += rr.x; o.y += rr.y; o.z += rr.z; o.w += rr.w; }
            *(float4*)(C + (size_t)r * ldc + c) = o;
        }
    }
}

__global__ void __launch_bounds__(256) swiglu_act_k(const float* __restrict__ P, float* Hd, int rows) {
    const size_t idx = (size_t)blockIdx.x * 256 + threadIdx.x;
    const size_t total = (size_t)rows * DFF;
    if (idx >= total) return;
    const size_t m = idx / DFF; const int j = (int)(idx % DFF);
    const float g = P[m * (2 * DFF) + j], u = P[m * (2 * DFF) + DFF + j];
    Hd[idx] = g * sigmoidf_(g) * u;
}

__global__ void small_setup_k(const float* __restrict__ lb_logits, float* lb, int* bucket) {
    const int i = blockIdx.x * 256 + threadIdx.x;
    if (i < 1024) { const float l0 = lb_logits[i], l1 = lb_logits[1024 + i]; const float m = fmaxf(l0, l1); const float e0 = expf(l0 - m), e1 = expf(l1 - m); lb[i] = e0 / (e0 + e1); }
    if (i < S) {
        int bk;
        if (i < 16) bk = i;
        else { const float nf = (float)i; const float v = logf(nf / 16.f) / 4.1588830833596715f * 16.f; bk = 16 + (int)v; if (bk > 31) bk = 31; }
        bucket[i] = bk;
    }
}

__global__ void __launch_bounds__(512) hgrn_naive_k(const float* __restrict__ P, const float* __restrict__ lb, float* O) {
    constexpr int T = 8;
    __shared__ float sq[T][128], sf[T][128], sk[T][128], si[T][128];
    __shared__ float part[T][4][128];
    const int h = blockIdx.x, tid = threadIdx.x, d = tid & 127, ng = tid >> 7;
    float St[32];
#pragma unroll
    for (int n = 0; n < 32; ++n) St[n] = 0.f;
    for (int t0 = 0; t0 < S; t0 += T) {
        __syncthreads();
        for (int e = tid; e < T * 128; e += 512) {
            const int tt = e >> 7, n = e & 127; const float* row = P + (size_t)(t0 + tt) * 4096;
            const float qv = row[h * 128 + n], fz = row[1024 + h * 128 + n], iv = row[2048 + h * 128 + n];
            const float l = lb[h * 128 + n];
            const float f = l + (1.f - l) * sigmoidf_(fz);
            sq[tt][n] = qv * sigmoidf_(qv); sf[tt][n] = f; sk[tt][n] = 1.f - f; si[tt][n] = iv;
        }
        __syncthreads();
#pragma unroll
        for (int tt = 0; tt < T; ++tt) {
            const float iv = si[tt][d]; float o = 0.f;
#pragma unroll
            for (int n = 0; n < 32; ++n) {
                const int nn = ng * 32 + n;
                St[n] = fmaf(sf[tt][nn], St[n], sk[tt][nn] * iv);
                o = fmaf(sq[tt][nn], St[n], o);
            }
            part[tt][ng][d] = o;
        }
        __syncthreads();
        for (int e = tid; e < T * 128; e += 512) {
            const int tt = e >> 7, dd = e & 127;
            O[(size_t)(t0 + tt) * D + h * 128 + dd] = (part[tt][0][dd] + part[tt][1][dd]) + (part[tt][2][dd] + part[tt][3][dd]);
        }
    }
}

__global__ void __launch_bounds__(128) kmean_k(const float* __restrict__ P, float* km) {
    const int n = blockIdx.x, h = blockIdx.y, d = threadIdx.x;
    float s = 0.f;
    for (int r = 0; r < BLK; ++r) s += P[(size_t)(n * BLK + r) * 3072 + 1024 + h * 128 + d];
    km[(h * NB + n) * 128 + d] = s * (1.f / BLK);
}

__global__ void __launch_bounds__(256) moba_naive_k(const float* __restrict__ P, const float* __restrict__ km, const float* __restrict__ table,
                                                    const int* __restrict__ bucket, float* O) {
    __shared__ float q[128]; __shared__ float gate[32]; __shared__ int sel[4]; __shared__ float p[1024]; __shared__ float red[4]; __shared__ float oacc[2][128];
    const int qpos = blockIdx.x, h = blockIdx.y, tid = threadIdx.x;
    const int j = qpos / BLK;
    if (tid < 128) q[tid] = P[(size_t)qpos * 3072 + h * 128 + tid];
    __syncthreads();
    if (tid < 32) {
        float g = -INFINITY;
        if (tid < j) { g = 0.f; const float* kp = km + (h * NB + tid) * 128; for (int d = 0; d < 128; ++d) g = fmaf(q[d], kp[d], g); }
        gate[tid] = g;
    }
    __syncthreads();
    if (tid == 0) {
        unsigned used = 0u;
        for (int s = 0; s < 3; ++s) { int best = -1; float bv = 0.f;
            for (int n = 0; n < 32; ++n) if (!((used >> n) & 1u) && (best < 0 || gate[n] > bv)) { best = n; bv = gate[n]; }
            used |= 1u << best; sel[s] = best; }
        sel[3] = j;
    }
    __syncthreads();
    const float scale = 0.08838834764831845f;
    float lmax = -INFINITY; float lg[4];
#pragma unroll
    for (int pp = 0; pp < 4; ++pp) {
        const int bsel = sel[pp]; const bool valid = (pp < 3) ? (pp < j) : true;
        const int kpos = bsel * BLK + tid;
        float v = -INFINITY;
        if (valid && kpos <= qpos) {
            const float* kr = P + (size_t)kpos * 3072 + 1024 + h * 128; float dot = 0.f;
            for (int d = 0; d < 128; d += 4) { const float4 kk = *(const float4*)(kr + d); dot = fmaf(q[d], kk.x, dot); dot = fmaf(q[d + 1], kk.y, dot); dot = fmaf(q[d + 2], kk.z, dot); dot = fmaf(q[d + 3], kk.w, dot); }
            v = dot * scale + table[bucket[qpos - kpos] * H + h];
        }
        lg[pp] = v; lmax = fmaxf(lmax, v);
    }
    lmax = block_max_256(lmax, red);
    float ls = 0.f;
#pragma unroll
    for (int pp = 0; pp < 4; ++pp) { const float e = (lg[pp] == -INFINITY) ? 0.f : __expf(lg[pp] - lmax); lg[pp] = e; ls += e; }
    ls = block_sum_256(ls, red);
    const float inv = 1.f / ls;
#pragma unroll
    for (int pp = 0; pp < 4; ++pp) p[pp * 256 + tid] = lg[pp] * inv;
    __syncthreads();
    {
        const int d = tid & 127, half = tid >> 7; float o = 0.f;
        for (int pp = 0; pp < 4; ++pp) {
            const int bsel = sel[pp];
            for (int r = half * 128; r < half * 128 + 128; ++r) { const float pv = p[pp * 256 + r]; if (pv != 0.f) o = fmaf(pv, P[(size_t)(bsel * BLK + r) * 3072 + 2048 + h * 128 + d], o); }
        }
        oacc[half][d] = o;
    }
    __syncthreads();
    if (tid < 128) O[(size_t)qpos * D + h * 128 + tid] = oacc[0][tid] + oacc[1][tid];
}
}

extern "C" void kernel_launch(void* const* d_in, const int* in_sizes, int n_in, void* d_out, int out_size, void* d_ws, size_t ws_size, hipStream_t stream) {
    const float* x = (const float*)d_in[0];
    const float* norm_mix = (const float*)d_in[1];
    const float* norm_ffn = (const float*)d_in[2];
    const float* hgrn_w_in = (const float*)d_in[3];
    const float* lb_logits = (const float*)d_in[4];
    const float* hgrn_out_norm = (const float*)d_in[5];
    const float* hgrn_w_out = (const float*)d_in[6];
    const float* moba_w_in = (const float*)d_in[7];
    const float* moba_w_out = (const float*)d_in[8];
    const float* rel_table = (const float*)d_in[9];
    const float* ffn_w13 = (const float*)d_in[10];
    const float* ffn_w2 = (const float*)d_in[11];
    const float* final_norm = (const float*)d_in[12];
    float* out = (float*)d_out;
    char* ws = (char*)d_ws;
    constexpr size_t MiB = 1u << 20;
    float* Y = (float*)(ws);
    float* Pj = (float*)(ws + 32 * MiB);
    float* Ob = (float*)(ws + 160 * MiB);
    float* Hd = (float*)(ws + 192 * MiB);
    float* lb = (float*)(ws + 240 * MiB);
    int* bucket = (int*)(ws + 240 * MiB + 65536);
    float* km = (float*)(ws + 240 * MiB + 131072);

    small_setup_k<<<32, 256, 0, stream>>>(lb_logits, lb, bucket);
    for (int b = 0; b < B; ++b) {
        const float* xb = x + (size_t)b * S * D;
        float* hb = out + (size_t)b * S * D;
        rmsnorm_k<<<S, 256, 0, stream>>>(xb, norm_mix, Y, nullptr, 0);
        gemm_f32<0><<<dim3(4096 / 128, S / 128), 256, 0, stream>>>(Y, D, hgrn_w_in, 4096, Pj, 4096, nullptr, 0, D);
        hgrn_naive_k<<<H, 512, 0, stream>>>(Pj, lb, Ob);
        rmsnorm_k<<<S, 256, 0, stream>>>(Ob, hgrn_out_norm, Y, Pj + 3072, 4096);
        gemm_f32<1><<<dim3(D / 128, S / 128), 256, 0, stream>>>(Y, D, hgrn_w_out, D, hb, D, xb, D, D);
        rmsnorm_k<<<S, 256, 0, stream>>>(hb, norm_ffn, Y, nullptr, 0);
        for (int c = 0; c < 2; ++c) {
            const int r0 = c * 4096;
            gemm_f32<0><<<dim3(2 * DFF / 128, 4096 / 128), 256, 0, stream>>>(Y + (size_t)r0 * D, D, ffn_w13, 2 * DFF, Pj, 2 * DFF, nullptr, 0, D);
            swiglu_act_k<<<(4096 * DFF + 255) / 256, 256, 0, stream>>>(Pj, Hd, 4096);
            gemm_f32<1><<<dim3(D / 128, 4096 / 128), 256, 0, stream>>>(Hd, DFF, ffn_w2, D, hb + (size_t)r0 * D, D, hb + (size_t)r0 * D, D, DFF);
        }
        rmsnorm_k<<<S, 256, 0, stream>>>(hb, norm_mix + D, Y, nullptr, 0);
        gemm_f32<0><<<dim3(3072 / 128, S / 128), 256, 0, stream>>>(Y, D, moba_w_in, 3072, Pj, 3072, nullptr, 0, D);
        kmean_k<<<dim3(NB, H), 128, 0, stream>>>(Pj, km);
        moba_naive_k<<<dim3(S, H), 256, 0, stream>>>(Pj, km, rel_table, bucket, Ob);
        gemm_f32<1><<<dim3(D / 128, S / 128), 256, 0, stream>>>(Ob, D, moba_w_out, D, hb, D, hb, D, D);
        rmsnorm_k<<<S, 256, 0, stream>>>(hb, norm_ffn + D, Y, nullptr, 0);
        for (int c = 0; c < 2; ++c) {
            const int r0 = c * 4096;
            gemm_f32<0><<<dim3(2 * DFF / 128, 4096 / 128), 256, 0, stream>>>(Y + (size_t)r0 * D, D, ffn_w13 + (size_t)D * 2 * DFF, 2 * DFF, Pj, 2 * DFF, nullptr, 0, D);
            swiglu_act_k<<<(4096 * DFF + 255) / 256, 256, 0, stream>>>(Pj, Hd, 4096);
            gemm_f32<1><<<dim3(D / 128, 4096 / 128), 256, 0, stream>>>(Hd, DFF, ffn_w2 + (size_t)DFF * D, D, hb + (size_t)r0 * D, D, hb + (size_t)r0 * D, D, DFF);
        }
        rmsnorm_k<<<S, 256, 0, stream>>>(hb, final_norm, hb, nullptr, 0);
    }
}
```

```cpp
#include <hip/hip_runtime.h>
#include <hip/hip_cooperative_groups.h>
#include <cstdio>
#include <cstdint>
#include <cmath>
namespace pg8 {
#define PG8_LAS __attribute__((address_space(3)))
typedef unsigned short bf16_t;
typedef short bf16x8 __attribute__((ext_vector_type(8)));
typedef float f32x4 __attribute__((ext_vector_type(4)));
typedef unsigned u32x4 __attribute__((ext_vector_type(4)));
constexpr int BM = 256, BK = 64, HALF = 128, HTB = HALF * BK * 2  , STAGE_BYTES = 8 * HTB, NXCD = 8, WGM = 8;

__host__ __device__ __forceinline__ int lds_byte(int r, int c) { const int st = (r >> 4) * 2 + (c >> 5), rr = r & 15, cc = c & 31, ob = rr * 64 + cc * 2; return st * 1024 + (ob ^ (((ob >> 9) & 1) << 5)); }
__host__ __device__ __forceinline__ void stage_rc(int b, int& R, int& C) { const int st = b / 1024, sb = b % 1024, swz = sb ^ (((sb >> 9) & 1) << 5); R = (st >> 1) * 16 + swz / 64; C = (st & 1) * 32 + (swz % 64) / 2; }
__host__ __device__ __forceinline__ int perm32(int rho) { const int n = rho >> 4, i = rho & 15; return 8 * (i >> 2) + 4 * n + (i & 3); }

struct Unit { int pm, pn; };
struct Gemm { const bf16_t* A; const bf16_t* Bt; int M, N, K; };

struct StaticOrder {
    int nM, nN, nwg, G, c;
    __host__ __device__ void init(int M, int N, int G_, int c_) { nM = M / BM; nN = N / BM; nwg = nM * nN; G = G_; c = c_; }
    __host__ __device__ bool next(int i, Unit& u) const {
        const long L = (long)i * G + c; if (L >= nwg) return false;
        int wgid = (int)L; { const int q = nwg / NXCD, r = nwg % NXCD, xcd = wgid % NXCD, off = wgid / NXCD; wgid = (xcd < r ? xcd * (q + 1) : r * (q + 1) + (xcd - r) * q) + off; }
        const int nig = WGM * nN, gid = wgid / nig, fm = gid * WGM, gsz = (nM - fm) < WGM ? (nM - fm) : WGM;
        u.pm = fm + ((wgid % nig) % gsz); u.pn = (wgid % nig) / gsz; return true;
    }
    __device__ __forceinline__ void a_ready(const Unit&) const {}
    __device__ __forceinline__ void done(const Unit&) const {}
};
__device__ __forceinline__ unsigned cvt_pk_bf16(float lo, float hi) { unsigned r; asm volatile("v_cvt_pk_bf16_f32 %0, %1, %2" : "=v"(r) : "v"(lo), "v"(hi)); return r; }
typedef float f32x2 __attribute__((ext_vector_type(2)));
typedef unsigned u32x2 __attribute__((ext_vector_type(2)));
__device__ __forceinline__ float sigm(float x) { return __builtin_amdgcn_rcpf(1.f + __expf(-x)); }
__device__ __forceinline__ float bf2f_lo(unsigned w) { return __uint_as_float(w << 16); }
__device__ __forceinline__ float bf2f_hi(unsigned w) { return __uint_as_float(w & 0xffff0000u); }
__device__ __forceinline__ float rstd_from16(const float* p) {
    const f32x4 a = *(const f32x4*)p, b = *(const f32x4*)(p + 4), c = *(const f32x4*)(p + 8), d = *(const f32x4*)(p + 12);
    const float s = ((a[0] + a[1]) + (a[2] + a[3])) + ((b[0] + b[1]) + (b[2] + b[3])) + ((c[0] + c[1]) + (c[2] + c[3])) + ((d[0] + d[1]) + (d[2] + d[3]));
    return rsqrtf(s * (1.f / 1024.f) + 1e-6f);
}
__device__ __forceinline__ float rstd_from8(const float* p) {
    const f32x4 a = *(const f32x4*)p, b = *(const f32x4*)(p + 4);
    const float s = ((a[0] + a[1]) + (a[2] + a[3])) + ((b[0] + b[1]) + (b[2] + b[3]));
    return rsqrtf(s * (1.f / 1024.f) + 1e-6f);
}

struct EpiHgrnIn {
    static constexpr bool PERM = true, AFTER_DRAIN = false;
    bf16_t* QS; float* LF; bf16_t* IN; bf16_t* OG; const float* lb;
    __device__ __forceinline__ void operator()(const f32x4 (&acc)[2][2][4][2], const Unit& u, int wr, int wc, int fr, int fq) const {
        const int type = u.pn >> 2;
        const int row0 = u.pm * BM + wr * 64 + fr;
        const int col0 = (u.pn & 3) * BM + wc * 32 + 8 * fq;
#pragma unroll
        for (int bj = 0; bj < 2; ++bj) {
            const int c = col0 + bj * HALF;
            f32x4 l0 = (f32x4){0.f, 0.f, 0.f, 0.f}, l1 = l0;
            if (type == 1) { l0 = *(const f32x4*)(lb + c); l1 = *(const f32x4*)(lb + c + 4); }
#pragma unroll
            for (int ai = 0; ai < 2; ++ai)
#pragma unroll
                for (int m = 0; m < 4; ++m) {
                    const size_t off = (size_t)(row0 + ai * HALF + m * 16) * 1024 + c;
                    f32x4 v0 = acc[ai][bj][m][0], v1 = acc[ai][bj][m][1];
                    if (type == 1) {
#pragma unroll
                        for (int i = 0; i < 4; ++i) { v0[i] = logf(l0[i] + (1.f - l0[i]) * sigm(v0[i])); v1[i] = logf(l1[i] + (1.f - l1[i]) * sigm(v1[i])); }
                        *(f32x4*)(LF + off) = v0; *(f32x4*)(LF + off + 4) = v1;
                    } else {
                        if (type == 0) {
#pragma unroll
                            for (int i = 0; i < 4; ++i) { v0[i] = v0[i] * sigm(v0[i]); v1[i] = v1[i] * sigm(v1[i]); }
                        } else if (type == 3) {
#pragma unroll
                            for (int i = 0; i < 4; ++i) { v0[i] = sigm(v0[i]); v1[i] = sigm(v1[i]); }
                        }
                        u32x4 w; w.x = cvt_pk_bf16(v0[0], v0[1]); w.y = cvt_pk_bf16(v0[2], v0[3]); w.z = cvt_pk_bf16(v1[0], v1[1]); w.w = cvt_pk_bf16(v1[2], v1[3]);
                        if (type == 0) *(u32x4*)(QS + off) = w;
                        else if (type == 2) *(u32x4*)(IN + off) = w;
                        else *(u32x4*)(OG + off) = w;
                    }
                }
        }
    }
};

template <int SCALE, bool WRITE_LO>
struct EpiResid {
    static constexpr bool PERM = false, AFTER_DRAIN = false;
    const float* R; float* Hout; bf16_t* HB; bf16_t* HBL; float* SSQ; const float* SSQIN;
    __device__ __forceinline__ void operator()(const f32x4 (&acc)[2][2][4][2], const Unit& u, int wr, int wc, int fr, int fq) const {
        const int col0 = u.pn * BM + wc * 32 + 4 * fq;
#pragma unroll
        for (int ai = 0; ai < 2; ++ai)
#pragma unroll
            for (int m = 0; m < 4; ++m) {
                const int row = u.pm * BM + ai * HALF + wr * 64 + m * 16 + fr;
                float sc = 1.f;
                if (SCALE == 1) sc = rstd_from8(SSQIN + (size_t)row * 8);
                const size_t off = (size_t)row * 1024 + col0;
                float ss = 0.f;
#pragma unroll
                for (int bj = 0; bj < 2; ++bj)
#pragma unroll
                    for (int n = 0; n < 2; ++n) {
                        const size_t o2 = off + bj * HALF + n * 16;
                        const f32x4 r = *(const f32x4*)(R + o2);
                        const f32x4 v = r + acc[ai][bj][m][n] * sc;
                        *(f32x4*)(Hout + o2) = v;
                        ss += (v[0] * v[0] + v[1] * v[1]) + (v[2] * v[2] + v[3] * v[3]);
                        u32x2 w; w.x = cvt_pk_bf16(v[0], v[1]); w.y = cvt_pk_bf16(v[2], v[3]);
                        *(u32x2*)(HB + o2) = w;
                        if (WRITE_LO) {
                            u32x2 l; l.x = cvt_pk_bf16(v[0] - bf2f_lo(w.x), v[1] - bf2f_hi(w.x)); l.y = cvt_pk_bf16(v[2] - bf2f_lo(w.y), v[3] - bf2f_hi(w.y));
                            *(u32x2*)(HBL + o2) = l;
                        }
                    }
                ss += __shfl_xor(ss, 16); ss += __shfl_xor(ss, 32);
                if (fq == 0) SSQ[(size_t)row * 16 + u.pn * 4 + wc] = ss;
                if (m & 1) asm volatile("" ::: "memory");
            }
    }
};

struct EpiSwiglu {
    static constexpr bool PERM = true, AFTER_DRAIN = false;
    bf16_t* HID; int ldh; const float* SSQIN;
    __device__ __forceinline__ void operator()(const f32x4 (&acc)[2][2][4][2], const Unit& u, int wr, int wc, int fr, int fq) const {
        const int col0 = u.pn * HALF + wc * 32 + 8 * fq;
#pragma unroll
        for (int ai = 0; ai < 2; ++ai)
#pragma unroll
            for (int m = 0; m < 4; ++m) {
                const int row = u.pm * BM + ai * HALF + wr * 64 + m * 16 + fr;
                const float sc = rstd_from16(SSQIN + (size_t)row * 16);
                f32x4 g0 = acc[ai][0][m][0] * sc, g1 = acc[ai][0][m][1] * sc, u0 = acc[ai][1][m][0] * sc, u1 = acc[ai][1][m][1] * sc;
#pragma unroll
                for (int i = 0; i < 4; ++i) { g0[i] = g0[i] * sigm(g0[i]) * u0[i]; g1[i] = g1[i] * sigm(g1[i]) * u1[i]; }
                u32x4 w; w.x = cvt_pk_bf16(g0[0], g0[1]); w.y = cvt_pk_bf16(g0[2], g0[3]); w.z = cvt_pk_bf16(g1[0], g1[1]); w.w = cvt_pk_bf16(g1[2], g1[3]);
                *(u32x4*)(HID + (size_t)row * ldh + col0) = w;
            }
    }
};

struct EpiQKV {
    static constexpr bool PERM = true, AFTER_DRAIN = false;
    bf16_t* O; size_t split_stride; const float* SSQIN;
    __device__ __forceinline__ void operator()(const f32x4 (&acc)[2][2][4][2], const Unit& u, int wr, int wc, int fr, int fq) const {
        const int t = u.pn >> 2;
        bf16_t* base = O + (size_t)t * split_stride;
        const int col0 = (u.pn & 3) * BM + wc * 32 + 8 * fq;
#pragma unroll
        for (int ai = 0; ai < 2; ++ai)
#pragma unroll
            for (int m = 0; m < 4; ++m) {
                const int row = u.pm * BM + ai * HALF + wr * 64 + m * 16 + fr;
                const float sc = rstd_from16(SSQIN + (size_t)row * 16);
#pragma unroll
                for (int bj = 0; bj < 2; ++bj) {
                    const f32x4 v0 = acc[ai][bj][m][0] * sc, v1 = acc[ai][bj][m][1] * sc;
                    u32x4 w; w.x = cvt_pk_bf16(v0[0], v0[1]); w.y = cvt_pk_bf16(v0[2], v0[3]); w.z = cvt_pk_bf16(v1[0], v1[1]); w.w = cvt_pk_bf16(v1[2], v1[3]);
                    *(u32x4*)(base + (size_t)row * 1024 + col0 + bj * HALF) = w;
                }
            }
    }
};

template <class Epi, class Sched, bool ALIGN_EPI = false, bool SP2 = false>
__device__ __forceinline__ void gemm_phase(PG8_LAS unsigned char* lds, const Gemm g, const Sched& S, const Epi& E) {
    const int tid = threadIdx.x, wid = __builtin_amdgcn_readfirstlane(tid >> 6), lane = tid & 63, wr = wid >> 2, wc = wid & 3, fr = lane & 15, fq = lane >> 4;
    const int K = g.K, nt = K / BK;
    unsigned voffA[2], voffB[2];
#pragma unroll
    for (int i = 0; i < 2; ++i) { int R, C; stage_rc(tid * 16 + i * 8192, R, C); const int Rb = Epi::PERM ? ((R & ~31) + perm32(R & 31)) : R;
        voffA[i] = (unsigned)(R * K + C) * 2u; voffB[i] = (unsigned)(Rb * K + C) * 2u; }
    const size_t kstep = (size_t)(BK * 2);
    const size_t hstep = (size_t)HALF * K * 2;
    const size_t tstep = 2 * hstep;
    const unsigned ldsw = (unsigned)wid * 1024u;
    const int aoff = lds_byte(wr * 64 + fr, fq * 8), boff = lds_byte(wc * 32 + fr, fq * 8);
#define PG8_SA(b, h) (((b) * 2 + (h)) * HTB)
#define PG8_SB(b, h) ((4 + (b) * 2 + (h)) * HTB)
#define PG8_STAGE(bufoff, gbase, voff) do { _Pragma("unroll") for (int _i = 0; _i < 2; ++_i) \
        __builtin_amdgcn_global_load_lds((const unsigned*)((const char*)(gbase) + (voff)[_i]), (PG8_LAS unsigned*)(lds + (bufoff) + ldsw + _i * 8192), 16, 0, 0); } while (0)
#define PG8_LDA(dst, b, h) do { _Pragma("unroll") for (int m = 0; m < 4; ++m) _Pragma("unroll") for (int k = 0; k < 2; ++k) dst[m][k] = *(const PG8_LAS bf16x8*)(lds + PG8_SA(b, h) + aoff + m * 2048 + k * 1024); } while (0)
#define PG8_LDB(dst, b, h) do { _Pragma("unroll") for (int n = 0; n < 2; ++n) _Pragma("unroll") for (int k = 0; k < 2; ++k) dst[n][k] = *(const PG8_LAS bf16x8*)(lds + PG8_SB(b, h) + boff + n * 2048 + k * 1024); } while (0)
#define PG8_MMA(ai, bj, At, Bt) do { __builtin_amdgcn_s_setprio(1); _Pragma("unroll") for (int m = 0; m < 4; ++m) _Pragma("unroll") for (int n = 0; n < 2; ++n) _Pragma("unroll") for (int k = 0; k < 2; ++k) \
        acc[ai][bj][m][n] = __builtin_amdgcn_mfma_f32_16x16x32_bf16(Bt[n][k], At[m][k], acc[ai][bj][m][n], 0, 0, 0); __builtin_amdgcn_s_setprio(0); } while (0)
#define PG8_WAIT_V(n) asm volatile("s_waitcnt vmcnt(" #n ")" ::: "memory")
#define PG8_WAIT_L(n) asm volatile("s_waitcnt lgkmcnt(" #n ")" ::: "memory")
#define PG8_BAR __builtin_amdgcn_s_barrier()
#define PG8_SCHED __builtin_amdgcn_sched_barrier(0)
    Unit cur, nxt; int ui = 0;
    if (!S.next(0, cur)) return;
    f32x4 acc[2][2][4][2];
#pragma unroll
    for (int a = 0; a < 2; ++a)
#pragma unroll
        for (int b = 0; b < 2; ++b)
#pragma unroll
            for (int m = 0; m < 4; ++m)
#pragma unroll
                for (int n = 0; n < 2; ++n) acc[a][b][m][n] = (f32x4){0.f, 0.f, 0.f, 0.f};
    bf16x8 At[4][2], B0[2][2], B1[2][2];
    const char* cA = (const char*)g.A + (size_t)cur.pm * tstep; const char* cB = (const char*)g.Bt + (size_t)cur.pn * tstep;
    S.a_ready(cur);
    if constexpr (SP2) {
        PG8_STAGE(PG8_SB(0, 0), cB, voffB); PG8_STAGE(PG8_SB(0, 1), cB + hstep, voffB); PG8_STAGE(PG8_SA(0, 0), cA, voffA); PG8_STAGE(PG8_SA(0, 1), cA + hstep, voffA);
        if (wr == 1) PG8_BAR;
        PG8_WAIT_V(2); PG8_BAR;
        PG8_STAGE(PG8_SB(1, 0), cB + kstep, voffB); PG8_STAGE(PG8_SA(1, 0), cA + kstep, voffA); PG8_STAGE(PG8_SB(1, 1), cB + hstep + kstep, voffB);
        PG8_WAIT_V(6); PG8_BAR;
    } else {
        PG8_STAGE(PG8_SB(0, 0), cB, voffB); PG8_STAGE(PG8_SA(0, 0), cA, voffA); PG8_STAGE(PG8_SB(0, 1), cB + hstep, voffB); PG8_STAGE(PG8_SA(0, 1), cA + hstep, voffA);
        if (wr == 1) PG8_BAR;
        PG8_WAIT_V(4); PG8_BAR;
        PG8_STAGE(PG8_SB(1, 0), cB + kstep, voffB); PG8_STAGE(PG8_SA(1, 0), cA + kstep, voffA); PG8_STAGE(PG8_SB(1, 1), cB + hstep + kstep, voffB);
        PG8_WAIT_V(6); PG8_BAR;
    }
    for (;;) {
        const bool has_next = S.next(ui + 1, nxt);
        const char* nA = has_next ? (const char*)g.A + (size_t)nxt.pm * tstep : cA; const char* nB = has_next ? (const char*)g.Bt + (size_t)nxt.pn * tstep : cB;
        for (int t = 0; t < nt; t += 2) {
            const bool last = (t == nt - 2);
            const char* a1 = cA + (size_t)(t + 1) * kstep;
            const char* a2 = last ? nA : cA + (size_t)(t + 2) * kstep; const char* b2 = last ? nB : cB + (size_t)(t + 2) * kstep;
            const char* a3 = a2 + kstep; const char* b3 = b2 + kstep;
            if (last && has_next) S.a_ready(nxt);
            if constexpr (SP2) {
            PG8_LDB(B0, 0, 0); PG8_LDB(B1, 0, 1); PG8_SCHED; PG8_LDA(At, 0, 0); PG8_STAGE(PG8_SA(1, 1), a1 + hstep, voffA);
            PG8_WAIT_V(8); PG8_WAIT_L(0); PG8_BAR; PG8_MMA(0, 0, At, B0); PG8_MMA(0, 1, At, B1); PG8_BAR; PG8_SCHED;
            PG8_LDA(At, 0, 1); PG8_STAGE(PG8_SB(0, 0), b2, voffB); PG8_STAGE(PG8_SB(0, 1), b2 + hstep, voffB); PG8_STAGE(PG8_SA(0, 0), a2, voffA);
            PG8_WAIT_V(8); PG8_WAIT_L(0); PG8_BAR; PG8_MMA(1, 0, At, B0); PG8_MMA(1, 1, At, B1); PG8_BAR; PG8_SCHED;
            PG8_LDB(B0, 1, 0); PG8_LDB(B1, 1, 1); PG8_SCHED; PG8_LDA(At, 1, 0); PG8_STAGE(PG8_SA(0, 1), a2 + hstep, voffA);
            PG8_WAIT_V(8); PG8_WAIT_L(0); PG8_BAR; PG8_MMA(0, 0, At, B0); PG8_MMA(0, 1, At, B1); PG8_BAR; PG8_SCHED;
            PG8_LDA(At, 1, 1); PG8_STAGE(PG8_SB(1, 0), b3, voffB); PG8_STAGE(PG8_SB(1, 1), b3 + hstep, voffB); PG8_STAGE(PG8_SA(1, 0), a3, voffA);
            PG8_WAIT_V(8); PG8_WAIT_L(0); PG8_BAR; PG8_MMA(1, 0, At, B0); PG8_MMA(1, 1, At, B1); PG8_BAR; PG8_SCHED;
            } else {
            PG8_LDB(B0, 0, 0); PG8_SCHED; PG8_LDA(At, 0, 0); PG8_STAGE(PG8_SA(1, 1), a1 + hstep, voffA);
            PG8_WAIT_L(8); PG8_BAR; PG8_WAIT_L(0); PG8_MMA(0, 0, At, B0); PG8_BAR; PG8_SCHED;
            PG8_LDB(B1, 0, 1); PG8_STAGE(PG8_SB(0, 0), b2, voffB);
            PG8_BAR; PG8_WAIT_L(0); PG8_MMA(0, 1, At, B1); PG8_BAR;
            PG8_LDA(At, 0, 1); PG8_STAGE(PG8_SA(0, 0), a2, voffA);
            PG8_BAR; PG8_WAIT_L(0); PG8_MMA(1, 0, At, B0); PG8_BAR; PG8_SCHED;
            PG8_STAGE(PG8_SB(0, 1), b2 + hstep, voffB);
            PG8_WAIT_V(6); PG8_BAR; PG8_MMA(1, 1, At, B1); PG8_BAR;
            PG8_LDB(B0, 1, 0); PG8_SCHED; PG8_LDA(At, 1, 0); PG8_STAGE(PG8_SA(0, 1), a2 + hstep, voffA);
            PG8_WAIT_L(8); PG8_BAR; PG8_WAIT_L(0); PG8_MMA(0, 0, At, B0); PG8_BAR; PG8_SCHED;
            PG8_LDB(B1, 1, 1); PG8_STAGE(PG8_SB(1, 0), b3, voffB);
            PG8_BAR; PG8_WAIT_L(0); PG8_MMA(0, 1, At, B1); PG8_BAR;
            PG8_LDA(At, 1, 1); PG8_STAGE(PG8_SA(1, 0), a3, voffA);
            PG8_BAR; PG8_WAIT_L(0); PG8_MMA(1, 0, At, B0); PG8_BAR; PG8_SCHED;
            PG8_STAGE(PG8_SB(1, 1), b3 + hstep, voffB);
            PG8_WAIT_V(6); PG8_BAR; PG8_MMA(1, 1, At, B1); PG8_BAR;
            }
        }
        if constexpr (ALIGN_EPI) { if (wr == 0) PG8_BAR; }
        if constexpr (!Epi::AFTER_DRAIN) { E(acc, cur, wr, wc, fr, fq); S.done(cur); }
        if (!has_next) break;
#pragma unroll
        for (int a = 0; a < 2; ++a)
#pragma unroll
            for (int b = 0; b < 2; ++b)
#pragma unroll
                for (int m = 0; m < 4; ++m)
#pragma unroll
                    for (int n = 0; n < 2; ++n) acc[a][b][m][n] = (f32x4){0.f, 0.f, 0.f, 0.f};
        cur = nxt; cA = nA; cB = nB; ++ui;
        if constexpr (ALIGN_EPI) { if (wr == 1) PG8_BAR; }
    }
    PG8_WAIT_V(0);
    if constexpr (!ALIGN_EPI) { if (wr == 0) PG8_BAR; }
    PG8_BAR;
    if constexpr (Epi::AFTER_DRAIN) { E.fused(acc, cur, wr, wc, fr, fq, lds, wid, lane); S.done(cur); }
#undef PG8_SA
#undef PG8_SB
#undef PG8_STAGE
#undef PG8_LDA
#undef PG8_LDB
#undef PG8_MMA
#undef PG8_WAIT_V
#undef PG8_WAIT_L
#undef PG8_BAR
#undef PG8_SCHED
}
}

namespace cg = cooperative_groups;
constexpr int NWAVES = 8;
constexpr int BATCH = 2, T = 8192, D = 1024, H = 8, DH = 128, DFF = 2816, NB = 32, BLK = 256;
constexpr int M = BATCH * T;
constexpr float EPS = 1e-6f;
constexpr size_t MiB = 1u << 20;
constexpr size_t WS_CTL = 0;
constexpr size_t WS_WQKV = 1 * MiB, WS_WOUT1 = 7 * MiB, WS_W13_1 = 9 * MiB, WS_W2_1 = 20 * MiB;
constexpr size_t WS_WIN0 = 26 * MiB, WS_WOUT0 = 34 * MiB, WS_W13_0 = 36 * MiB, WS_W2_0 = 47 * MiB;
constexpr size_t WS_SSQ = 53 * MiB;
constexpr size_t WS_SSQH = 54 * MiB;
constexpr size_t WS_LB = 54 * MiB + 512 * 1024;
constexpr size_t WS_BKT = WS_LB + 4096;
constexpr size_t WS_YMEAN = WS_BKT + 32768;
constexpr size_t WS_KMEAN = WS_YMEAN + 262144;
constexpr size_t WS_SEL = 55 * MiB + 512 * 1024;
constexpr size_t WS_G = 56 * MiB;
constexpr size_t WS_A0 = 60 * MiB;
constexpr size_t WS_A1 = 92 * MiB;
constexpr size_t WS_A2 = 124 * MiB;
constexpr size_t WS_A3 = 188 * MiB;
constexpr size_t WS_A4 = 220 * MiB;
constexpr size_t WS_END = 256 * MiB;
static_assert(WS_W2_0 + (size_t)D * DFF * 2 <= WS_SSQ && WS_G + 2 * MiB <= WS_A0 && WS_A4 + 32 * MiB <= WS_END, "ws map");

constexpr int LDS_BYTES = 147456;

#define GAS __attribute__((address_space(1)))
#define LAS __attribute__((address_space(3)))
typedef unsigned short bf16;
typedef unsigned v4u __attribute__((ext_vector_type(4)));
typedef float f32x4 __attribute__((ext_vector_type(4)));
#define LDS_WAIT() asm volatile("s_waitcnt lgkmcnt(0)" ::: "memory")
__device__ __forceinline__ unsigned f2bf(float f) { unsigned u = __builtin_bit_cast(unsigned, f); return (u + 0x7fffu + ((u >> 16) & 1u)) >> 16; }
__device__ __forceinline__ unsigned pk2(float lo, float hi) { return f2bf(lo) | (f2bf(hi) << 16); }
__device__ __forceinline__ float bf2f(unsigned short b) { return __uint_as_float((unsigned)b << 16); }
__device__ __forceinline__ float wave_sum(float v) {
#pragma unroll
    for (int o = 1; o < 64; o <<= 1) v += __shfl_xor(v, o);
    return v;
}

struct Args {
    const float* x; const float* norm_mix; const float* norm_ffn; const float* hgrn_w_in; const float* lb_logits; const float* hgrn_out_norm; const float* hgrn_w_out;
    const float* moba_w_in; const float* moba_w_out; const float* rel_table; const float* ffn_w13; const float* ffn_w2; const float* final_norm;
    float* out; unsigned char* ws; int ph_lo, ph_hi;
};

__device__ __forceinline__ void tr_item(const float* W, int ldw, int K, bf16* WT, int Ndst, const float* gain, int mode, LAS float* scr, int item, int lane) {
    const int nblk = Ndst / 32, kb = item / nblk, nb = item % nblk, k0 = 64 * kb, n0 = 32 * nb;
    int s0 = n0;
    if (mode == 1) { const int t = n0 >> 8, c = n0 & 255; s0 = (c < 128) ? (128 * t + c) : (DFF + 128 * t + (c - 128)); }
#pragma unroll 8
    for (int i = 0; i < 32; ++i) { const int kk = 2 * i + (lane >> 5); float w = W[(size_t)(k0 + kk) * ldw + s0 + (lane & 31)]; if (gain) w *= gain[k0 + kk]; scr[kk * 33 + (lane & 31)] = w; }
    LDS_WAIT(); asm volatile("" ::: "memory");
    const int c = lane & 7;
#pragma unroll
    for (int j = 0; j < 4; ++j) { const int n = (lane >> 3) + 8 * j; const LAS float* s = scr + (8 * c) * 33 + n;
        v4u o; o.x = pk2(s[0 * 33], s[1 * 33]); o.y = pk2(s[2 * 33], s[3 * 33]); o.z = pk2(s[4 * 33], s[5 * 33]); o.w = pk2(s[6 * 33], s[7 * 33]);
        *(GAS v4u*)(WT + (size_t)(n0 + n) * K + k0 + 8 * c) = o; }
    LDS_WAIT(); asm volatile("" ::: "memory");
}

__device__ __forceinline__ void prologue(const Args& a, LAS unsigned char* lds, int tid, int lane, int wave) {
    unsigned char* ws = a.ws;
    LAS float* scr = (LAS float*)(lds + wave * 16384);
    const int gw = blockIdx.x * NWAVES + wave, NGW = gridDim.x * NWAVES;
    constexpr int I_IN0 = (D / 64) * (4096 / 32), I_O = (D / 64) * (D / 32), I_13 = (D / 64) * (2 * DFF / 32), I_2 = (DFF / 64) * (D / 32), I_QKV = (D / 64) * (3072 / 32);
    constexpr int NITEMS = I_IN0 + I_O + I_13 + I_2 + I_QKV + I_O + I_13 + I_2;
    for (int it = gw; it < NITEMS; it += NGW) {
        int r = it;
        if (r < I_IN0) { tr_item(a.hgrn_w_in, 4096, D, (bf16*)(ws + WS_WIN0), 4096, nullptr, 0, scr, r, lane); continue; } r -= I_IN0;
        if (r < I_O) { tr_item(a.hgrn_w_out, D, D, (bf16*)(ws + WS_WOUT0), D, a.hgrn_out_norm, 0, scr, r, lane); continue; } r -= I_O;
        if (r < I_13) { tr_item(a.ffn_w13, 2 * DFF, D, (bf16*)(ws + WS_W13_0), 2 * DFF, a.norm_ffn, 1, scr, r, lane); continue; } r -= I_13;
        if (r < I_2) { tr_item(a.ffn_w2, D, DFF, (bf16*)(ws + WS_W2_0), D, nullptr, 0, scr, r, lane); continue; } r -= I_2;
        if (r < I_QKV) { tr_item(a.moba_w_in, 3072, D, (bf16*)(ws + WS_WQKV), 3072, a.norm_mix + D, 0, scr, r, lane); continue; } r -= I_QKV;
        if (r < I_O) { tr_item(a.moba_w_out, D, D, (bf16*)(ws + WS_WOUT1), D, nullptr, 0, scr, r, lane); continue; } r -= I_O;
        if (r < I_13) { tr_item(a.ffn_w13 + (size_t)D * 2 * DFF, 2 * DFF, D, (bf16*)(ws + WS_W13_1), 2 * DFF, a.norm_ffn + D, 1, scr, r, lane); continue; } r -= I_13;
        tr_item(a.ffn_w2 + (size_t)DFF * D, D, DFF, (bf16*)(ws + WS_W2_1), D, nullptr, 0, scr, r, lane);
    }
    bf16* XN0 = (bf16*)(ws + WS_A0);
    for (int m = gw; m < M; m += NGW) {
        const GAS f32x4* xr = (const GAS f32x4*)(a.x + (size_t)m * D) + lane;
        f32x4 v[4]; float s = 0.f;
#pragma unroll
        for (int j = 0; j < 4; ++j) { v[j] = xr[64 * j]; s += (v[j].x * v[j].x + v[j].y * v[j].y) + (v[j].z * v[j].z + v[j].w * v[j].w); }
        const float rstd = rsqrtf(wave_sum(s) * (1.f / D) + EPS);
        GAS unsigned long long* o8 = (GAS unsigned long long*)(XN0 + (size_t)m * D) + lane;
#pragma unroll
        for (int j = 0; j < 4; ++j) { const f32x4 g = *((const GAS f32x4*)a.norm_mix + lane + 64 * j);
            o8[64 * j] = (unsigned long long)pk2(v[j].x * rstd * g.x, v[j].y * rstd * g.y) | ((unsigned long long)pk2(v[j].z * rstd * g.z, v[j].w * rstd * g.w) << 32); }
    }
    if (blockIdx.x == 0) {
        float* lb = (float*)(ws + WS_LB); int* bkt = (int*)(ws + WS_BKT);
        for (int i = tid; i < 1024; i += NWAVES * 64) { const float l0 = a.lb_logits[i], l1 = a.lb_logits[1024 + i]; const float mx = fmaxf(l0, l1); const float e0 = expf(l0 - mx), e1 = expf(l1 - mx); lb[i] = e0 / (e0 + e1); }
        for (int i = tid; i < T; i += NWAVES * 64) {
            int bk;
            if (i < 16) bk = i;
            else { const float nf = (float)i; const float v = logf(nf / 16.f) / 4.1588830833596715f * 16.f; bk = 16 + (int)v; if (bk > 31) bk = 31; }
            bkt[i] = bk;
        }
    }
}

__device__ __forceinline__ void final_norm_phase(const Args& a, int lane, int wave) {
    const int gw = blockIdx.x * NWAVES + wave, NGW = gridDim.x * NWAVES;
    const float* SSQ = (const float*)(a.ws + WS_SSQ);
    for (int m = gw; m < M; m += NGW) {
        const float rstd = pg8::rstd_from16(SSQ + (size_t)m * 16);
        GAS f32x4* xr = (GAS f32x4*)(a.out + (size_t)m * D) + lane;
#pragma unroll
        for (int j = 0; j < 4; ++j) { const f32x4 g = *((const GAS f32x4*)a.final_norm + lane + 64 * j); f32x4 v = xr[64 * j]; v = v * rstd * g; xr[64 * j] = v; }
    }
}

__device__ __forceinline__ float sigmoidf_(float x) { return 1.f / (1.f + __expf(-x)); }

__device__ __forceinline__ void hgrn_semi_phase(const Args& a, LAS unsigned char* lds, int tid) {
    if (blockIdx.x >= 16) return;
    unsigned char* ws = a.ws;
    const bf16* QS = (const bf16*)(ws + WS_A1); const float* LF = (const float*)(ws + WS_A2); const bf16* INP = (const bf16*)(ws + WS_A3); const bf16* OG = (const bf16*)(ws + WS_A4);
    bf16* OGATED = (bf16*)(ws + WS_A0); float* SSQH = (float*)(ws + WS_SSQH);
    constexpr int TT = 8;
    LAS float* sq = (LAS float*)lds; LAS float* sf = sq + TT * 128; LAS float* sk = sf + TT * 128; LAS float* si = sk + TT * 128;
    LAS float* part = si + TT * 128;
    LAS float* osq = part + TT * 4 * 128;
    const int b = blockIdx.x >> 3, h = blockIdx.x & 7, d = tid & 127, ng = tid >> 7;
    float St[32];
#pragma unroll
    for (int n = 0; n < 32; ++n) St[n] = 0.f;
    for (int t0 = 0; t0 < T; t0 += TT) {
        __syncthreads();
        for (int e = tid; e < TT * 128; e += 512) {
            const int tt = e >> 7, n = e & 127; const size_t off = (size_t)(b * T + t0 + tt) * D + h * 128 + n;
            const float f = __expf(LF[off]);
            sq[e] = bf2f(QS[off]); sf[e] = f; sk[e] = 1.f - f; si[e] = bf2f(INP[off]);
        }
        __syncthreads();
#pragma unroll
        for (int tt = 0; tt < TT; ++tt) {
            const float iv = si[tt * 128 + d]; float o = 0.f;
#pragma unroll
            for (int n = 0; n < 32; ++n) {
                const int nn = tt * 128 + ng * 32 + n;
                St[n] = fmaf(sf[nn], St[n], sk[nn] * iv);
                o = fmaf(sq[nn], St[n], o);
            }
            part[(tt * 4 + ng) * 128 + d] = o;
        }
        __syncthreads();
        for (int e = tid; e < TT * 128; e += 512) {
            const int tt = e >> 7, dd = e & 127; const size_t off = (size_t)(b * T + t0 + tt) * D + h * 128 + dd;
            const float o = (part[(tt * 4 + 0) * 128 + dd] + part[(tt * 4 + 1) * 128 + dd]) + (part[(tt * 4 + 2) * 128 + dd] + part[(tt * 4 + 3) * 128 + dd]);
            osq[e] = o * o;
            OGATED[off] = (bf16)f2bf(o * bf2f(OG[off]));
        }
        __syncthreads();
        if (tid < TT) { float s = 0.f; for (int dd = 0; dd < 128; ++dd) s += osq[tid * 128 + dd]; SSQH[(size_t)(b * T + t0 + tid) * 8 + h] = s; }
    }
}

__device__ __forceinline__ void kmean_phase(const Args& a, int tid) {
    const bf16* K = (const bf16*)(a.ws + WS_A2) + (size_t)M * D; float* kmean = (float*)(a.ws + WS_KMEAN);
    for (int it = blockIdx.x; it < 128; it += gridDim.x) {
        const int bn = it >> 1, col = (it & 1) * 512 + tid;
        float s = 0.f;
        for (int r = 0; r < 256; ++r) s += bf2f(K[(size_t)(bn * 256 + r) * D + col]);
        kmean[bn * D + col] = s * (1.f / 256.f);
    }
}

__device__ __forceinline__ void topk_phase(const Args& a, LAS unsigned char* lds, int tid) {
    const bf16* Q = (const bf16*)(a.ws + WS_A2); const float* kmean = (const float*)(a.ws + WS_KMEAN); unsigned char* sel = a.ws + WS_SEL;
    LAS float* km = (LAS float*)lds;
    for (int it = blockIdx.x; it < 256; it += gridDim.x) {
        const int b = it >> 7, h = (it >> 4) & 7, qc = it & 15;
        __syncthreads();
        for (int e = tid; e < 32 * 128; e += 512) km[e] = kmean[(size_t)(b * 32 + (e >> 7)) * D + h * 128 + (e & 127)];
        __syncthreads();
        const int qpos = qc * 512 + tid, m = b * T + qpos, j = qpos >> 8;
        float g[32];
#pragma unroll
        for (int n = 0; n < 32; ++n) g[n] = 0.f;
        const uint4* qr = (const uint4*)(Q + (size_t)m * D + h * 128);
        for (int c = 0; c < 16; ++c) {
            const uint4 qq = qr[c]; const unsigned w[4] = {qq.x, qq.y, qq.z, qq.w};
            float qv[8];
#pragma unroll
            for (int e = 0; e < 4; ++e) { qv[2 * e] = __uint_as_float(w[e] << 16); qv[2 * e + 1] = __uint_as_float(w[e] & 0xffff0000u); }
#pragma unroll
            for (int n = 0; n < 32; ++n) {
#pragma unroll
                for (int e = 0; e < 8; ++e) g[n] = fmaf(qv[e], km[n * 128 + c * 8 + e], g[n]);
            }
        }
        unsigned used = 0u; unsigned packed = 0u;
#pragma unroll
        for (int s = 0; s < 3; ++s) { int best = 0; float bv = -INFINITY; bool have = false;
#pragma unroll
            for (int n = 0; n < 32; ++n) { const float gv = (n < j) ? g[n] : -INFINITY; const bool free_ = !((used >> n) & 1u); if (free_ && (!have || gv > bv)) { best = n; bv = gv; have = true; } }
            used |= 1u << best; packed |= (unsigned)best << (8 * s); }
        packed |= (unsigned)j << 24;
        *(unsigned*)(sel + ((size_t)m * 8 + h) * 4) = packed;
    }
}

__device__ __forceinline__ void moba_semi_phase(const Args& a, LAS unsigned char* lds, int tid) {
    const bf16* Q = (const bf16*)(a.ws + WS_A2); const bf16* K = Q + (size_t)M * D; const bf16* V = K + (size_t)M * D;
    const unsigned char* sel = a.ws + WS_SEL; const float* table = a.rel_table; const int* bucket = (const int*)(a.ws + WS_BKT);
    bf16* O = (bf16*)(a.ws + WS_A0);
    const int half = tid >> 8, t = tid & 255;
    LAS float* base = (LAS float*)(lds + half * 8192);
    LAS float* q = base; LAS float* p = base + 128; LAS float* red = base + 128 + 1024; LAS float* oacc = base + 128 + 1024 + 8;
    const float scale = 0.08838834764831845f;
    for (int it = blockIdx.x; it < M * H / 2; it += gridDim.x) {
        const int item = it * 2 + half; const int m = item >> 3, h = item & 7;
        const int b = m >> 13, qpos = m & (T - 1), j = qpos >> 8;
        __syncthreads();
        if (t < 128) q[t] = bf2f(Q[(size_t)m * D + h * 128 + t]);
        __syncthreads();
        const unsigned spk = *(const unsigned*)(sel + ((size_t)m * 8 + h) * 4);
        float lmax = -INFINITY; float lg[4];
#pragma unroll
        for (int pp = 0; pp < 4; ++pp) {
            const int bsel = (spk >> (8 * pp)) & 255; const bool valid = (pp < 3) ? (pp < j) : true;
            const int kpos = bsel * BLK + t;
            float v = -INFINITY;
            if (valid && kpos <= qpos) {
                const uint4* kr = (const uint4*)(K + (size_t)(b * T + kpos) * D + h * 128); float dot = 0.f;
                for (int c = 0; c < 16; ++c) { const uint4 kk = kr[c]; const unsigned w[4] = {kk.x, kk.y, kk.z, kk.w};
#pragma unroll
                    for (int e = 0; e < 4; ++e) { dot = fmaf(q[c * 8 + 2 * e], __uint_as_float(w[e] << 16), dot); dot = fmaf(q[c * 8 + 2 * e + 1], __uint_as_float(w[e] & 0xffff0000u), dot); } }
                v = dot * scale + table[bucket[qpos - kpos] * H + h];
            }
            lg[pp] = v; lmax = fmaxf(lmax, v);
        }
        for (int o = 32; o > 0; o >>= 1) lmax = fmaxf(lmax, __shfl_xor(lmax, o));
        __syncthreads();
        if ((t & 63) == 0) red[t >> 6] = lmax;
        __syncthreads();
        lmax = fmaxf(fmaxf(red[0], red[1]), fmaxf(red[2], red[3]));
        float ls = 0.f;
#pragma unroll
        for (int pp = 0; pp < 4; ++pp) { const float e = (lg[pp] == -INFINITY) ? 0.f : __expf(lg[pp] - lmax); lg[pp] = e; ls += e; }
        for (int o = 32; o > 0; o >>= 1) ls += __shfl_xor(ls, o);
        __syncthreads();
        if ((t & 63) == 0) red[4 + (t >> 6)] = ls;
        __syncthreads();
        ls = (red[4] + red[5]) + (red[6] + red[7]);
        const float inv = 1.f / ls;
#pragma unroll
        for (int pp = 0; pp < 4; ++pp) p[pp * 256 + t] = lg[pp] * inv;
        __syncthreads();
        {
            const int d = t & 127, hh = t >> 7; float o = 0.f;
            for (int pp = 0; pp < 4; ++pp) {
                const int bsel = (spk >> (8 * pp)) & 255;
                for (int r = hh * 128; r < hh * 128 + 128; ++r) { const float pv = p[pp * 256 + r]; if (pv != 0.f) o = fmaf(pv, bf2f(V[(size_t)(b * T + bsel * BLK + r) * D + h * 128 + d]), o); }
            }
            oacc[hh * 128 + d] = o;
        }
        __syncthreads();
        if (t < 128) O[(size_t)m * D + h * 128 + t] = (bf16)f2bf(oacc[t] + oacc[128 + t]);
    }
}

__global__ void __launch_bounds__(NWAVES * 64, 2) mk(Args a) {
    extern __shared__ __attribute__((aligned(16))) unsigned char lds_raw[];
    LAS unsigned char* lds = (LAS unsigned char*)lds_raw;
    const int tid = threadIdx.x, lane = tid & 63, wave = __builtin_amdgcn_readfirstlane(tid >> 6);
    unsigned char* ws = a.ws;
    const int lo = a.ph_lo, hi = a.ph_hi;
    const int G = gridDim.x;
    cg::grid_group grid = cg::this_grid();
#define IN(k) (lo <= (k) && (k) < hi)
#define SEAM(k) do { if (IN(k) && IN((k) + 1)) grid.sync(); } while (0)
    float* SSQ = (float*)(ws + WS_SSQ);
    if (IN(0)) { prologue(a, lds, tid, lane, wave); }
    SEAM(0);
    if (IN(1)) {
        pg8::Gemm g{(const bf16*)(ws + WS_A0), (const bf16*)(ws + WS_WIN0), M, 4096, D}; pg8::StaticOrder S; S.init(M, 4096, G, (int)blockIdx.x);
        pg8::EpiHgrnIn E{(bf16*)(ws + WS_A1), (float*)(ws + WS_A2), (bf16*)(ws + WS_A3), (bf16*)(ws + WS_A4), (const float*)(ws + WS_LB)};
        pg8::gemm_phase<pg8::EpiHgrnIn, pg8::StaticOrder, true, true>(lds, g, S, E);
    }
    SEAM(1);
    if (IN(2)) hgrn_semi_phase(a, lds, tid);
    SEAM(2);
    if (IN(3)) {
        pg8::Gemm g{(const bf16*)(ws + WS_A0), (const bf16*)(ws + WS_WOUT0), M, D, D}; pg8::StaticOrder S; S.init(M, D, G, (int)blockIdx.x);
        pg8::EpiResid<1, false> E{a.x, a.out, (bf16*)(ws + WS_A1), nullptr, SSQ, (const float*)(ws + WS_SSQH)};
        pg8::gemm_phase<pg8::EpiResid<1, false>, pg8::StaticOrder, true, true>(lds, g, S, E);
    }
    SEAM(3);
    if (IN(4)) {
        pg8::Gemm g{(const bf16*)(ws + WS_A1), (const bf16*)(ws + WS_W13_0), M, 2 * DFF, D}; pg8::StaticOrder S; S.init(M, 2 * DFF, G, (int)blockIdx.x);
        pg8::EpiSwiglu E{(bf16*)(ws + WS_A2), DFF, SSQ};
        pg8::gemm_phase<pg8::EpiSwiglu, pg8::StaticOrder, true, true>(lds, g, S, E);
    }
    SEAM(4);
    if (IN(5)) {
        pg8::Gemm g{(const bf16*)(ws + WS_A2), (const bf16*)(ws + WS_W2_0), M, D, DFF}; pg8::StaticOrder S; S.init(M, D, G, (int)blockIdx.x);
        pg8::EpiResid<0, false> E{a.out, a.out, (bf16*)(ws + WS_A1), nullptr, SSQ, nullptr};
        pg8::gemm_phase<pg8::EpiResid<0, false>, pg8::StaticOrder, true, true>(lds, g, S, E);
    }
    SEAM(5);
    if (IN(6)) {
        pg8::Gemm g{(const bf16*)(ws + WS_A1), (const bf16*)(ws + WS_WQKV), M, 3072, D}; pg8::StaticOrder S; S.init(M, 3072, G, (int)blockIdx.x);
        pg8::EpiQKV E{(bf16*)(ws + WS_A2), (size_t)M * D, SSQ};
        pg8::gemm_phase<pg8::EpiQKV, pg8::StaticOrder, true, true>(lds, g, S, E);
    }
    SEAM(6);
    if (IN(7)) kmean_phase(a, tid);
    SEAM(7);
    if (IN(8)) topk_phase(a, lds, tid);
    SEAM(8);
    if (IN(9)) moba_semi_phase(a, lds, tid);
    SEAM(9);
    if (IN(10)) {
        pg8::Gemm g{(const bf16*)(ws + WS_A0), (const bf16*)(ws + WS_WOUT1), M, D, D}; pg8::StaticOrder S; S.init(M, D, G, (int)blockIdx.x);
        pg8::EpiResid<0, false> E{a.out, a.out, (bf16*)(ws + WS_A1), nullptr, SSQ, nullptr};
        pg8::gemm_phase<pg8::EpiResid<0, false>, pg8::StaticOrder, true, true>(lds, g, S, E);
    }
    SEAM(10);
    if (IN(11)) {
        pg8::Gemm g{(const bf16*)(ws + WS_A1), (const bf16*)(ws + WS_W13_1), M, 2 * DFF, D}; pg8::StaticOrder S; S.init(M, 2 * DFF, G, (int)blockIdx.x);
        pg8::EpiSwiglu E{(bf16*)(ws + WS_A2), DFF, SSQ};
        pg8::gemm_phase<pg8::EpiSwiglu, pg8::StaticOrder, true, true>(lds, g, S, E);
    }
    SEAM(11);
    if (IN(12)) {
        pg8::Gemm g{(const bf16*)(ws + WS_A2), (const bf16*)(ws + WS_W2_1), M, D, DFF}; pg8::StaticOrder S; S.init(M, D, G, (int)blockIdx.x);
        pg8::EpiResid<0, false> E{a.out, a.out, (bf16*)(ws + WS_A1), nullptr, SSQ, nullptr};
        pg8::gemm_phase<pg8::EpiResid<0, false>, pg8::StaticOrder, true, true>(lds, g, S, E);
    }
    SEAM(12);
    if (IN(13)) final_norm_phase(a, lane, wave);
#undef IN
#undef SEAM
}

extern "C" void kernel_launch(void* const* d_in, const int* in_sizes, int n_in, void* d_out, int out_size, void* d_ws, size_t ws_size, hipStream_t stream) {
    static int grid = 0;
    if (grid == 0) {
        if (n_in != 13 || out_size != M * D || ws_size < WS_END) { fprintf(stderr, "kernel_launch: unexpected problem (n_in %d out %d ws %zu)\n", n_in, out_size, ws_size); grid = -1; return; }
        int dev = 0, cus = 0, per_cu = 0;
        (void)hipGetDevice(&dev); (void)hipDeviceGetAttribute(&cus, hipDeviceAttributeMultiprocessorCount, dev);
        if (hipFuncSetAttribute((const void*)mk, hipFuncAttributeMaxDynamicSharedMemorySize, LDS_BYTES) != hipSuccess) { fprintf(stderr, "kernel_launch: hipFuncSetAttribute failed\n"); grid = -1; return; }
        if (hipOccupancyMaxActiveBlocksPerMultiprocessor(&per_cu, (const void*)mk, NWAVES * 64, LDS_BYTES) != hipSuccess || per_cu < 1) { fprintf(stderr, "kernel_launch: occupancy query says %d\n", per_cu); (void)hipGetLastError(); grid = -1; return; }
        grid = cus;
        if (grid != 256) fprintf(stderr, "kernel_launch: note: %d CUs\n", grid);
    }
    if (grid < 0) return;
    Args a{};
    a.x = (const float*)d_in[0]; a.norm_mix = (const float*)d_in[1]; a.norm_ffn = (const float*)d_in[2]; a.hgrn_w_in = (const float*)d_in[3]; a.lb_logits = (const float*)d_in[4];
    a.hgrn_out_norm = (const float*)d_in[5]; a.hgrn_w_out = (const float*)d_in[6]; a.moba_w_in = (const float*)d_in[7]; a.moba_w_out = (const float*)d_in[8]; a.rel_table = (const float*)d_in[9];
    a.ffn_w13 = (const float*)d_in[10]; a.ffn_w2 = (const float*)d_in[11]; a.final_norm = (const float*)d_in[12];
    a.out = (float*)d_out; a.ws = (unsigned char*)d_ws;
    a.ph_lo = 0; a.ph_hi = 14;
    void* args[] = {&a};
    hipError_t e = hipLaunchCooperativeKernel((const void*)mk, dim3(grid), dim3(NWAVES * 64), args, LDS_BYTES, stream);
    if (e != hipSuccess) fprintf(stderr, "kernel_launch: cooperative launch failed: %s (grid %d)\n", hipGetErrorString(e), grid);
}
```

```cpp
#include <hip/hip_runtime.h>
#include <hip/hip_cooperative_groups.h>
#include <cstdio>
#include <cstdint>
#include <cmath>
namespace pg8 {
#define PG8_LAS __attribute__((address_space(3)))
typedef unsigned short bf16_t;
typedef short bf16x8 __attribute__((ext_vector_type(8)));
typedef float f32x4 __attribute__((ext_vector_type(4)));
typedef unsigned u32x4 __attribute__((ext_vector_type(4)));
constexpr int BM = 256, BK = 64, HALF = 128, HTB = HALF * BK * 2  , STAGE_BYTES = 8 * HTB, NXCD = 8, WGM = 8;

__host__ __device__ __forceinline__ int lds_byte(int r, int c) { const int st = (r >> 4) * 2 + (c >> 5), rr = r & 15, cc = c & 31, ob = rr * 64 + cc * 2; return st * 1024 + (ob ^ (((ob >> 9) & 1) << 5)); }
__host__ __device__ __forceinline__ void stage_rc(int b, int& R, int& C) { const int st = b / 1024, sb = b % 1024, swz = sb ^ (((sb >> 9) & 1) << 5); R = (st >> 1) * 16 + swz / 64; C = (st & 1) * 32 + (swz % 64) / 2; }
__host__ __device__ __forceinline__ int perm32(int rho) { const int n = rho >> 4, i = rho & 15; return 8 * (i >> 2) + 4 * n + (i & 3); }

struct Unit { int pm, pn; };
struct Gemm { const bf16_t* A; const bf16_t* Bt; int M, N, K; };

struct StaticOrder {
    int nM, nN, nwg, G, c;
    __host__ __device__ void init(int M, int N, int G_, int c_) { nM = M / BM; nN = N / BM; nwg = nM * nN; G = G_; c = c_; }
    __host__ __device__ bool next(int i, Unit& u) const {
        const long L = (long)i * G + c; if (L >= nwg) return false;
        int wgid = (int)L; { const int q = nwg / NXCD, r = nwg % NXCD, xcd = wgid % NXCD, off = wgid / NXCD; wgid = (xcd < r ? xcd * (q + 1) : r * (q + 1) + (xcd - r) * q) + off; }
        const int nig = WGM * nN, gid = wgid / nig, fm = gid * WGM, gsz = (nM - fm) < WGM ? (nM - fm) : WGM;
        u.pm = fm + ((wgid % nig) % gsz); u.pn = (wgid % nig) / gsz; return true;
    }
    __device__ __forceinline__ void a_ready(const Unit&) const {}
    __device__ __forceinline__ void done(const Unit&) const {}
};
__device__ __forceinline__ unsigned cvt_pk_bf16(float lo, float hi) { unsigned r; asm volatile("v_cvt_pk_bf16_f32 %0, %1, %2" : "=v"(r) : "v"(lo), "v"(hi)); return r; }
typedef float f32x2 __attribute__((ext_vector_type(2)));
typedef unsigned u32x2 __attribute__((ext_vector_type(2)));
__device__ __forceinline__ float sigm(float x) { return __builtin_amdgcn_rcpf(1.f + __expf(-x)); }
__device__ __forceinline__ float bf2f_lo(unsigned w) { return __uint_as_float(w << 16); }
__device__ __forceinline__ float bf2f_hi(unsigned w) { return __uint_as_float(w & 0xffff0000u); }
__device__ __forceinline__ float rstd_from16(const float* p) {
    const f32x4 a = *(const f32x4*)p, b = *(const f32x4*)(p + 4), c = *(const f32x4*)(p + 8), d = *(const f32x4*)(p + 12);
    const float s = ((a[0] + a[1]) + (a[2] + a[3])) + ((b[0] + b[1]) + (b[2] + b[3])) + ((c[0] + c[1]) + (c[2] + c[3])) + ((d[0] + d[1]) + (d[2] + d[3]));
    return rsqrtf(s * (1.f / 1024.f) + 1e-6f);
}
__device__ __forceinline__ float rstd_from8(const float* p) {
    const f32x4 a = *(const f32x4*)p, b = *(const f32x4*)(p + 4);
    const float s = ((a[0] + a[1]) + (a[2] + a[3])) + ((b[0] + b[1]) + (b[2] + b[3]));
    return rsqrtf(s * (1.f / 1024.f) + 1e-6f);
}

struct EpiHgrnIn {
    static constexpr bool PERM = true, AFTER_DRAIN = false;
    bf16_t* QS; float* LF; bf16_t* IN; bf16_t* OG; const float* lb;
    __device__ __forceinline__ void operator()(const f32x4 (&acc)[2][2][4][2], const Unit& u, int wr, int wc, int fr, int fq) const {
        const int type = u.pn >> 2;
        const int row0 = u.pm * BM + wr * 64 + fr;
        const int col0 = (u.pn & 3) * BM + wc * 32 + 8 * fq;
#pragma unroll
        for (int bj = 0; bj < 2; ++bj) {
            const int c = col0 + bj * HALF;
            f32x4 l0 = (f32x4){0.f, 0.f, 0.f, 0.f}, l1 = l0;
            if (type == 1) { l0 = *(const f32x4*)(lb + c); l1 = *(const f32x4*)(lb + c + 4); }
#pragma unroll
            for (int ai = 0; ai < 2; ++ai)
#pragma unroll
                for (int m = 0; m < 4; ++m) {
                    const size_t off = (size_t)(row0 + ai * HALF + m * 16) * 1024 + c;
                    f32x4 v0 = acc[ai][bj][m][0], v1 = acc[ai][bj][m][1];
                    if (type == 1) {
#pragma unroll
                        for (int i = 0; i < 4; ++i) { v0[i] = logf(l0[i] + (1.f - l0[i]) * sigm(v0[i])); v1[i] = logf(l1[i] + (1.f - l1[i]) * sigm(v1[i])); }
                        *(f32x4*)(LF + off) = v0; *(f32x4*)(LF + off + 4) = v1;
                    } else {
                        if (type == 0) {
#pragma unroll
                            for (int i = 0; i < 4; ++i) { v0[i] = v0[i] * sigm(v0[i]); v1[i] = v1[i] * sigm(v1[i]); }
                        } else if (type == 3) {
#pragma unroll
                            for (int i = 0; i < 4; ++i) { v0[i] = sigm(v0[i]); v1[i] = sigm(v1[i]); }
                        }
                        u32x4 w; w.x = cvt_pk_bf16(v0[0], v0[1]); w.y = cvt_pk_bf16(v0[2], v0[3]); w.z = cvt_pk_bf16(v1[0], v1[1]); w.w = cvt_pk_bf16(v1[2], v1[3]);
                        if (type == 0) *(u32x4*)(QS + off) = w;
                        else if (type == 2) *(u32x4*)(IN + off) = w;
                        else *(u32x4*)(OG + off) = w;
                    }
                }
        }
    }
};

template <int SCALE, bool WRITE_LO>
struct EpiResid {
    static constexpr bool PERM = false, AFTER_DRAIN = false;
    const float* R; float* Hout; bf16_t* HB; bf16_t* HBL; float* SSQ; const float* SSQIN;
    __device__ __forceinline__ void operator()(const f32x4 (&acc)[2][2][4][2], const Unit& u, int wr, int wc, int fr, int fq) const {
        const int col0 = u.pn * BM + wc * 32 + 4 * fq;
#pragma unroll
        for (int ai = 0; ai < 2; ++ai)
#pragma unroll
            for (int m = 0; m < 4; ++m) {
                const int row = u.pm * BM + ai * HALF + wr * 64 + m * 16 + fr;
                float sc = 1.f;
                if (SCALE == 1) sc = rstd_from8(SSQIN + (size_t)row * 8);
                const size_t off = (size_t)row * 1024 + col0;
                float ss = 0.f;
#pragma unroll
                for (int bj = 0; bj < 2; ++bj)
#pragma unroll
                    for (int n = 0; n < 2; ++n) {
                        const size_t o2 = off + bj * HALF + n * 16;
                        const f32x4 r = *(const f32x4*)(R + o2);
                        const f32x4 v = r + acc[ai][bj][m][n] * sc;
                        *(f32x4*)(Hout + o2) = v;
                        ss += (v[0] * v[0] + v[1] * v[1]) + (v[2] * v[2] + v[3] * v[3]);
                        u32x2 w; w.x = cvt_pk_bf16(v[0], v[1]); w.y = cvt_pk_bf16(v[2], v[3]);
                        *(u32x2*)(HB + o2) = w;
                        if (WRITE_LO) {
                            u32x2 l; l.x = cvt_pk_bf16(v[0] - bf2f_lo(w.x), v[1] - bf2f_hi(w.x)); l.y = cvt_pk_bf16(v[2] - bf2f_lo(w.y), v[3] - bf2f_hi(w.y));
                            *(u32x2*)(HBL + o2) = l;
                        }
                    }
                ss += __shfl_xor(ss, 16); ss += __shfl_xor(ss, 32);
                if (fq == 0) SSQ[(size_t)row * 16 + u.pn * 4 + wc] = ss;
                if (m & 1) asm volatile("" ::: "memory");
            }
    }
};

struct EpiSwiglu {
    static constexpr bool PERM = true, AFTER_DRAIN = false;
    bf16_t* HID; int ldh; const float* SSQIN;
    __device__ __forceinline__ void operator()(const f32x4 (&acc)[2][2][4][2], const Unit& u, int wr, int wc, int fr, int fq) const {
        const int col0 = u.pn * HALF + wc * 32 + 8 * fq;
#pragma unroll
        for (int ai = 0; ai < 2; ++ai)
#pragma unroll
            for (int m = 0; m < 4; ++m) {
                const int row = u.pm * BM + ai * HALF + wr * 64 + m * 16 + fr;
                const float sc = rstd_from16(SSQIN + (size_t)row * 16);
                f32x4 g0 = acc[ai][0][m][0] * sc, g1 = acc[ai][0][m][1] * sc, u0 = acc[ai][1][m][0] * sc, u1 = acc[ai][1][m][1] * sc;
#pragma unroll
                for (int i = 0; i < 4; ++i) { g0[i] = g0[i] * sigm(g0[i]) * u0[i]; g1[i] = g1[i] * sigm(g1[i]) * u1[i]; }
                u32x4 w; w.x = cvt_pk_bf16(g0[0], g0[1]); w.y = cvt_pk_bf16(g0[2], g0[3]); w.z = cvt_pk_bf16(g1[0], g1[1]); w.w = cvt_pk_bf16(g1[2], g1[3]);
                *(u32x4*)(HID + (size_t)row * ldh + col0) = w;
            }
    }
};

struct EpiQKV {
    static constexpr bool PERM = true, AFTER_DRAIN = false;
    bf16_t* O; size_t split_stride; const float* SSQIN;
    __device__ __forceinline__ void operator()(const f32x4 (&acc)[2][2][4][2], const Unit& u, int wr, int wc, int fr, int fq) const {
        const int t = u.pn >> 2;
        bf16_t* base = O + (size_t)t * split_stride;
        const int col0 = (u.pn & 3) * BM + wc * 32 + 8 * fq;
#pragma unroll
        for (int ai = 0; ai < 2; ++ai)
#pragma unroll
            for (int m = 0; m < 4; ++m) {
                const int row = u.pm * BM + ai * HALF + wr * 64 + m * 16 + fr;
                const float sc = rstd_from16(SSQIN + (size_t)row * 16);
#pragma unroll
                for (int bj = 0; bj < 2; ++bj) {
                    const f32x4 v0 = acc[ai][bj][m][0] * sc, v1 = acc[ai][bj][m][1] * sc;
                    u32x4 w; w.x = cvt_pk_bf16(v0[0], v0[1]); w.y = cvt_pk_bf16(v0[2], v0[3]); w.z = cvt_pk_bf16(v1[0], v1[1]); w.w = cvt_pk_bf16(v1[2], v1[3]);
                    *(u32x4*)(base + (size_t)row * 1024 + col0 + bj * HALF) = w;
                }
            }
    }
};

template <class Epi, class Sched, bool ALIGN_EPI = false, bool SP2 = false>
__device__ __forceinline__ void gemm_phase(PG8_LAS unsigned char* lds, const Gemm g, const Sched& S, const Epi& E) {
    const int tid = threadIdx.x, wid = __builtin_amdgcn_readfirstlane(tid >> 6), lane = tid & 63, wr = wid >> 2, wc = wid & 3, fr = lane & 15, fq = lane >> 4;
    const int K = g.K, nt = K / BK;
    unsigned voffA[2], voffB[2];
#pragma unroll
    for (int i = 0; i < 2; ++i) { int R, C; stage_rc(tid * 16 + i * 8192, R, C); const int Rb = Epi::PERM ? ((R & ~31) + perm32(R & 31)) : R;
        voffA[i] = (unsigned)(R * K + C) * 2u; voffB[i] = (unsigned)(Rb * K + C) * 2u; }
    const size_t kstep = (size_t)(BK * 2);
    const size_t hstep = (size_t)HALF * K * 2;
    const size_t tstep = 2 * hstep;
    const unsigned ldsw = (unsigned)wid * 1024u;
    const int aoff = lds_byte(wr * 64 + fr, fq * 8), boff = lds_byte(wc * 32 + fr, fq * 8);
#define PG8_SA(b, h) (((b) * 2 + (h)) * HTB)
#define PG8_SB(b, h) ((4 + (b) * 2 + (h)) * HTB)
#define PG8_STAGE(bufoff, gbase, voff) do { _Pragma("unroll") for (int _i = 0; _i < 2; ++_i) \
        __builtin_amdgcn_global_load_lds((const unsigned*)((const char*)(gbase) + (voff)[_i]), (PG8_LAS unsigned*)(lds + (bufoff) + ldsw + _i * 8192), 16, 0, 0); } while (0)
#define PG8_LDA(dst, b, h) do { _Pragma("unroll") for (int m = 0; m < 4; ++m) _Pragma("unroll") for (int k = 0; k < 2; ++k) dst[m][k] = *(const PG8_LAS bf16x8*)(lds + PG8_SA(b, h) + aoff + m * 2048 + k * 1024); } while (0)
#define PG8_LDB(dst, b, h) do { _Pragma("unroll") for (int n = 0; n < 2; ++n) _Pragma("unroll") for (int k = 0; k < 2; ++k) dst[n][k] = *(const PG8_LAS bf16x8*)(lds + PG8_SB(b, h) + boff + n * 2048 + k * 1024); } while (0)
#define PG8_MMA(ai, bj, At, Bt) do { __builtin_amdgcn_s_setprio(1); _Pragma("unroll") for (int m = 0; m < 4; ++m) _Pragma("unroll") for (int n = 0; n < 2; ++n) _Pragma("unroll") for (int k = 0; k < 2; ++k) \
        acc[ai][bj][m][n] = __builtin_amdgcn_mfma_f32_16x16x32_bf16(Bt[n][k], At[m][k], acc[ai][bj][m][n], 0, 0, 0); __builtin_amdgcn_s_setprio(0); } while (0)
#define PG8_WAIT_V(n) asm volatile("s_waitcnt vmcnt(" #n ")" ::: "memory")
#define PG8_WAIT_L(n) asm volatile("s_waitcnt lgkmcnt(" #n ")" ::: "memory")
#define PG8_BAR __builtin_amdgcn_s_barrier()
#define PG8_SCHED __builtin_amdgcn_sched_barrier(0)
    Unit cur, nxt; int ui = 0;
    if (!S.next(0, cur)) return;
    f32x4 acc[2][2][4][2];
#pragma unroll
    for (int a = 0; a < 2; ++a)
#pragma unroll
        for (int b = 0; b < 2; ++b)
#pragma unroll
            for (int m = 0; m < 4; ++m)
#pragma unroll
                for (int n = 0; n < 2; ++n) acc[a][b][m][n] = (f32x4){0.f, 0.f, 0.f, 0.f};
    bf16x8 At[4][2], B0[2][2], B1[2][2];
    const char* cA = (const char*)g.A + (size_t)cur.pm * tstep; const char* cB = (const char*)g.Bt + (size_t)cur.pn * tstep;
    S.a_ready(cur);
    if constexpr (SP2) {
        PG8_STAGE(PG8_SB(0, 0), cB, voffB); PG8_STAGE(PG8_SB(0, 1), cB + hstep, voffB); PG8_STAGE(PG8_SA(0, 0), cA, voffA); PG8_STAGE(PG8_SA(0, 1), cA + hstep, voffA);
        if (wr == 1) PG8_BAR;
        PG8_WAIT_V(2); PG8_BAR;
        PG8_STAGE(PG8_SB(1, 0), cB + kstep, voffB); PG8_STAGE(PG8_SA(1, 0), cA + kstep, voffA); PG8_STAGE(PG8_SB(1, 1), cB + hstep + kstep, voffB);
        PG8_WAIT_V(6); PG8_BAR;
    } else {
        PG8_STAGE(PG8_SB(0, 0), cB, voffB); PG8_STAGE(PG8_SA(0, 0), cA, voffA); PG8_STAGE(PG8_SB(0, 1), cB + hstep, voffB); PG8_STAGE(PG8_SA(0, 1), cA + hstep, voffA);
        if (wr == 1) PG8_BAR;
        PG8_WAIT_V(4); PG8_BAR;
        PG8_STAGE(PG8_SB(1, 0), cB + kstep, voffB); PG8_STAGE(PG8_SA(1, 0), cA + kstep, voffA); PG8_STAGE(PG8_SB(1, 1), cB + hstep + kstep, voffB);
        PG8_WAIT_V(6); PG8_BAR;
    }
    for (;;) {
        const bool has_next = S.next(ui + 1, nxt);
        const char* nA = has_next ? (const char*)g.A + (size_t)nxt.pm * tstep : cA; const char* nB = has_next ? (const char*)g.Bt + (size_t)nxt.pn * tstep : cB;
        for (int t = 0; t < nt; t += 2) {
            const bool last = (t == nt - 2);
            const char* a1 = cA + (size_t)(t + 1) * kstep;
            const char* a2 = last ? nA : cA + (size_t)(t + 2) * kstep; const char* b2 = last ? nB : cB + (size_t)(t + 2) * kstep;
            const char* a3 = a2 + kstep; const char* b3 = b2 + kstep;
            if (last && has_next) S.a_ready(nxt);
            if constexpr (SP2) {
            PG8_LDB(B0, 0, 0); PG8_LDB(B1, 0, 1); PG8_SCHED; PG8_LDA(At, 0, 0); PG8_STAGE(PG8_SA(1, 1), a1 + hstep, voffA);
            PG8_WAIT_V(8); PG8_WAIT_L(0); PG8_BAR; PG8_MMA(0, 0, At, B0); PG8_MMA(0, 1, At, B1); PG8_BAR; PG8_SCHED;
            PG8_LDA(At, 0, 1); PG8_STAGE(PG8_SB(0, 0), b2, voffB); PG8_STAGE(PG8_SB(0, 1), b2 + hstep, voffB); PG8_STAGE(PG8_SA(0, 0), a2, voffA);
            PG8_WAIT_V(8); PG8_WAIT_L(0); PG8_BAR; PG8_MMA(1, 0, At, B0); PG8_MMA(1, 1, At, B1); PG8_BAR; PG8_SCHED;
            PG8_LDB(B0, 1, 0); PG8_LDB(B1, 1, 1); PG8_SCHED; PG8_LDA(At, 1, 0); PG8_STAGE(PG8_SA(0, 1), a2 + hstep, voffA);
            PG8_WAIT_V(8); PG8_WAIT_L(0); PG8_BAR; PG8_MMA(0, 0, At, B0); PG8_MMA(0, 1, At, B1); PG8_BAR; PG8_SCHED;
            PG8_LDA(At, 1, 1); PG8_STAGE(PG8_SB(1, 0), b3, voffB); PG8_STAGE(PG8_SB(1, 1), b3 + hstep, voffB); PG8_STAGE(PG8_SA(1, 0), a3, voffA);
            PG8_WAIT_V(8); PG8_WAIT_L(0); PG8_BAR; PG8_MMA(1, 0, At, B0); PG8_MMA(1, 1, At, B1); PG8_BAR; PG8_SCHED;
            } else {
            PG8_LDB(B0, 0, 0); PG8_SCHED; PG8_LDA(At, 0, 0); PG8_STAGE(PG8_SA(1, 1), a1 + hstep, voffA);
            PG8_WAIT_L(8); PG8_BAR; PG8_WAIT_L(0); PG8_MMA(0, 0, At, B0); PG8_BAR; PG8_SCHED;
            PG8_LDB(B1, 0, 1); PG8_STAGE(PG8_SB(0, 0), b2, voffB);
            PG8_BAR; PG8_WAIT_L(0); PG8_MMA(0, 1, At, B1); PG8_BAR;
            PG8_LDA(At, 0, 1); PG8_STAGE(PG8_SA(0, 0), a2, voffA);
            PG8_BAR; PG8_WAIT_L(0); PG8_MMA(1, 0, At, B0); PG8_BAR; PG8_SCHED;
            PG8_STAGE(PG8_SB(0, 1), b2 + hstep, voffB);
            PG8_WAIT_V(6); PG8_BAR; PG8_MMA(1, 1, At, B1); PG8_BAR;
            PG8_LDB(B0, 1, 0); PG8_SCHED; PG8_LDA(At, 1, 0); PG8_STAGE(PG8_SA(0, 1), a2 + hstep, voffA);
            PG8_WAIT_L(8); PG8_BAR; PG8_WAIT_L(0); PG8_MMA(0, 0, At, B0); PG8_BAR; PG8_SCHED;
            PG8_LDB(B1, 1, 1); PG8_STAGE(PG8_SB(1, 0), b3, voffB);
            PG8_BAR; PG8_WAIT_L(0); PG8_MMA(0, 1, At, B1); PG8_BAR;
            PG8_LDA(At, 1, 1); PG8_STAGE(PG8_SA(1, 0), a3, voffA);
            PG8_BAR; PG8_WAIT_L(0); PG8_MMA(1, 0, At, B0); PG8_BAR; PG8_SCHED;
            PG8_STAGE(PG8_SB(1, 1), b3 + hstep, voffB);
            PG8_WAIT_V(6); PG8_BAR; PG8_MMA(1, 1, At, B1); PG8_BAR;
            }
        }
        if constexpr (ALIGN_EPI) { if (wr == 0) PG8_BAR; }
        if constexpr (!Epi::AFTER_DRAIN) { E(acc, cur, wr, wc, fr, fq); S.done(cur); }
        if (!has_next) break;
#pragma unroll
        for (int a = 0; a < 2; ++a)
#pragma unroll
            for (int b = 0; b < 2; ++b)
#pragma unroll
                for (int m = 0; m < 4; ++m)
#pragma unroll
                    for (int n = 0; n < 2; ++n) acc[a][b][m][n] = (f32x4){0.f, 0.f, 0.f, 0.f};
        cur = nxt; cA = nA; cB = nB; ++ui;
        if constexpr (ALIGN_EPI) { if (wr == 1) PG8_BAR; }
    }
    PG8_WAIT_V(0);
    if constexpr (!ALIGN_EPI) { if (wr == 0) PG8_BAR; }
    PG8_BAR;
    if constexpr (Epi::AFTER_DRAIN) { E.fused(acc, cur, wr, wc, fr, fq, lds, wid, lane); S.done(cur); }
#undef PG8_SA
#undef PG8_SB
#undef PG8_STAGE
#undef PG8_LDA
#undef PG8_LDB
#undef PG8_MMA
#undef PG8_WAIT_V
#undef PG8_WAIT_L
#undef PG8_BAR
#undef PG8_SCHED
}
}

namespace cg = cooperative_groups;
constexpr int NWAVES = 8;
constexpr int BATCH = 2, T = 8192, D = 1024, H = 8, DH = 128, DFF = 2816, NB = 32, BLK = 256;
constexpr int M = BATCH * T;
constexpr float EPS = 1e-6f;
constexpr size_t MiB = 1u << 20;
constexpr size_t WS_CTL = 0;
constexpr size_t WS_WQKV = 1 * MiB, WS_WOUT1 = 7 * MiB, WS_W13_1 = 9 * MiB, WS_W2_1 = 20 * MiB;
constexpr size_t WS_WIN0 = 26 * MiB, WS_WOUT0 = 34 * MiB, WS_W13_0 = 36 * MiB, WS_W2_0 = 47 * MiB;
constexpr size_t WS_SSQ = 53 * MiB;
constexpr size_t WS_SSQH = 54 * MiB;
constexpr size_t WS_LB = 54 * MiB + 512 * 1024;
constexpr size_t WS_BKT = WS_LB + 4096;
constexpr size_t WS_YMEAN = WS_BKT + 32768;
constexpr size_t WS_KMEAN = WS_YMEAN + 262144;
constexpr size_t WS_SEL = 55 * MiB + 512 * 1024;
constexpr size_t WS_G = 56 * MiB;
constexpr size_t WS_A0 = 60 * MiB;
constexpr size_t WS_A1 = 92 * MiB;
constexpr size_t WS_A2 = 124 * MiB;
constexpr size_t WS_A3 = 188 * MiB;
constexpr size_t WS_A4 = 220 * MiB;
constexpr size_t WS_END = 256 * MiB;
static_assert(WS_W2_0 + (size_t)D * DFF * 2 <= WS_SSQ && WS_G + 2 * MiB <= WS_A0 && WS_A4 + 32 * MiB <= WS_END, "ws map");

constexpr int LDS_BYTES = 147456;

#define GAS __attribute__((address_space(1)))
#define LAS __attribute__((address_space(3)))
typedef unsigned short bf16;
typedef unsigned v4u __attribute__((ext_vector_type(4)));
typedef float f32x4 __attribute__((ext_vector_type(4)));
#define LDS_WAIT() asm volatile("s_waitcnt lgkmcnt(0)" ::: "memory")
__device__ __forceinline__ unsigned f2bf(float f) { unsigned u = __builtin_bit_cast(unsigned, f); return (u + 0x7fffu + ((u >> 16) & 1u)) >> 16; }
__device__ __forceinline__ unsigned pk2(float lo, float hi) { return f2bf(lo) | (f2bf(hi) << 16); }
__device__ __forceinline__ float bf2f(unsigned short b) { return __uint_as_float((unsigned)b << 16); }
__device__ __forceinline__ float wave_sum(float v) {
#pragma unroll
    for (int o = 1; o < 64; o <<= 1) v += __shfl_xor(v, o);
    return v;
}

struct Args {
    const float* x; const float* norm_mix; const float* norm_ffn; const float* hgrn_w_in; const float* lb_logits; const float* hgrn_out_norm; const float* hgrn_w_out;
    const float* moba_w_in; const float* moba_w_out; const float* rel_table; const float* ffn_w13; const float* ffn_w2; const float* final_norm;
    float* out; unsigned char* ws; int ph_lo, ph_hi;
};

__device__ __forceinline__ void tr_item(const float* W, int ldw, int K, bf16* WT, int Ndst, const float* gain, int mode, LAS float* scr, int item, int lane) {
    const int nblk = Ndst / 32, kb = item / nblk, nb = item % nblk, k0 = 64 * kb, n0 = 32 * nb;
    int s0 = n0;
    if (mode == 1) { const int t = n0 >> 8, c = n0 & 255; s0 = (c < 128) ? (128 * t + c) : (DFF + 128 * t + (c - 128)); }
#pragma unroll 8
    for (int i = 0; i < 32; ++i) { const int kk = 2 * i + (lane >> 5); float w = W[(size_t)(k0 + kk) * ldw + s0 + (lane & 31)]; if (gain) w *= gain[k0 + kk]; scr[kk * 33 + (lane & 31)] = w; }
    LDS_WAIT(); asm volatile("" ::: "memory");
    const int c = lane & 7;
#pragma unroll
    for (int j = 0; j < 4; ++j) { const int n = (lane >> 3) + 8 * j; const LAS float* s = scr + (8 * c) * 33 + n;
        v4u o; o.x = pk2(s[0 * 33], s[1 * 33]); o.y = pk2(s[2 * 33], s[3 * 33]); o.z = pk2(s[4 * 33], s[5 * 33]); o.w = pk2(s[6 * 33], s[7 * 33]);
        *(GAS v4u*)(WT + (size_t)(n0 + n) * K + k0 + 8 * c) = o; }
    LDS_WAIT(); asm volatile("" ::: "memory");
}

__device__ __forceinline__ void prologue(const Args& a, LAS unsigned char* lds, int tid, int lane, int wave) {
    unsigned char* ws = a.ws;
    LAS float* scr = (LAS float*)(lds + wave * 16384);
    const int gw = blockIdx.x * NWAVES + wave, NGW = gridDim.x * NWAVES;
    constexpr int I_IN0 = (D / 64) * (4096 / 32), I_O = (D / 64) * (D / 32), I_13 = (D / 64) * (2 * DFF / 32), I_2 = (DFF / 64) * (D / 32), I_QKV = (D / 64) * (3072 / 32);
    constexpr int NITEMS = I_IN0 + I_O + I_13 + I_2 + I_QKV + I_O + I_13 + I_2;
    for (int it = gw; it < NITEMS; it += NGW) {
        int r = it;
        if (r < I_IN0) { tr_item(a.hgrn_w_in, 4096, D, (bf16*)(ws + WS_WIN0), 4096, nullptr, 0, scr, r, lane); continue; } r -= I_IN0;
        if (r < I_O) { tr_item(a.hgrn_w_out, D, D, (bf16*)(ws + WS_WOUT0), D, a.hgrn_out_norm, 0, scr, r, lane); continue; } r -= I_O;
        if (r < I_13) { tr_item(a.ffn_w13, 2 * DFF, D, (bf16*)(ws + WS_W13_0), 2 * DFF, a.norm_ffn, 1, scr, r, lane); continue; } r -= I_13;
        if (r < I_2) { tr_item(a.ffn_w2, D, DFF, (bf16*)(ws + WS_W2_0), D, nullptr, 0, scr, r, lane); continue; } r -= I_2;
        if (r < I_QKV) { tr_item(a.moba_w_in, 3072, D, (bf16*)(ws + WS_WQKV), 3072, a.norm_mix + D, 0, scr, r, lane); continue; } r -= I_QKV;
        if (r < I_O) { tr_item(a.moba_w_out, D, D, (bf16*)(ws + WS_WOUT1), D, nullptr, 0, scr, r, lane); continue; } r -= I_O;
        if (r < I_13) { tr_item(a.ffn_w13 + (size_t)D * 2 * DFF, 2 * DFF, D, (bf16*)(ws + WS_W13_1), 2 * DFF, a.norm_ffn + D, 1, scr, r, lane); continue; } r -= I_13;
        tr_item(a.ffn_w2 + (size_t)DFF * D, D, DFF, (bf16*)(ws + WS_W2_1), D, nullptr, 0, scr, r, lane);
    }
    bf16* XN0 = (bf16*)(ws + WS_A0);
    for (int m = gw; m < M; m += NGW) {
        const GAS f32x4* xr = (const GAS f32x4*)(a.x + (size_t)m * D) + lane;
        f32x4 v[4]; float s = 0.f;
#pragma unroll
        for (int j = 0; j < 4; ++j) { v[j] = xr[64 * j]; s += (v[j].x * v[j].x + v[j].y * v[j].y) + (v[j].z * v[j].z + v[j].w * v[j].w); }
        const float rstd = rsqrtf(wave_sum(s) * (1.f / D) + EPS);
        GAS unsigned long long* o8 = (GAS unsigned long long*)(XN0 + (size_t)m * D) + lane;
#pragma unroll
        for (int j = 0; j < 4; ++j) { const f32x4 g = *((const GAS f32x4*)a.norm_mix + lane + 64 * j);
            o8[64 * j] = (unsigned long long)pk2(v[j].x * rstd * g.x, v[j].y * rstd * g.y) | ((unsigned long long)pk2(v[j].z * rstd * g.z, v[j].w * rstd * g.w) << 32); }
    }
    if (blockIdx.x == 0) {
        float* lb = (float*)(ws + WS_LB); int* bkt = (int*)(ws + WS_BKT);
        for (int i = tid; i < 1024; i += NWAVES * 64) { const float l0 = a.lb_logits[i], l1 = a.lb_logits[1024 + i]; const float mx = fmaxf(l0, l1); const float e0 = expf(l0 - mx), e1 = expf(l1 - mx); lb[i] = e0 / (e0 + e1); }
        for (int i = tid; i < T; i += NWAVES * 64) {
            int bk;
            if (i < 16) bk = i;
            else { const float nf = (float)i; const float v = logf(nf / 16.f) / 4.1588830833596715f * 16.f; bk = 16 + (int)v; if (bk > 31) bk = 31; }
            bkt[i] = bk;
            if (i < 1024) { float* tab2 = (float*)(ws + WS_YMEAN);
#pragma unroll
                for (int hh = 0; hh < 8; ++hh) tab2[hh * 1024 + i] = a.rel_table[bk * 8 + hh] * 1.4426950408889634f; }
        }
        for (int i = tid; i < 512; i += NWAVES * 64) ((unsigned*)(ws + 4096))[i] = 0u;
    }
}

__device__ __forceinline__ void final_norm_phase(const Args& a, int lane, int wave) {
    const int gw = blockIdx.x * NWAVES + wave, NGW = gridDim.x * NWAVES;
    const float* SSQ = (const float*)(a.ws + WS_SSQ);
    for (int m = gw; m < M; m += NGW) {
        const float rstd = pg8::rstd_from16(SSQ + (size_t)m * 16);
        GAS f32x4* xr = (GAS f32x4*)(a.out + (size_t)m * D) + lane;
#pragma unroll
        for (int j = 0; j < 4; ++j) { const f32x4 g = *((const GAS f32x4*)a.final_norm + lane + 64 * j); f32x4 v = xr[64 * j]; v = v * rstd * g; xr[64 * j] = v; }
    }
}

__device__ __forceinline__ float sigmoidf_(float x) { return 1.f / (1.f + __expf(-x)); }

__device__ __forceinline__ void hgrn_semi_phase(const Args& a, LAS unsigned char* lds, int tid) {
    if (blockIdx.x >= 16) return;
    unsigned char* ws = a.ws;
    const bf16* QS = (const bf16*)(ws + WS_A1); const float* LF = (const float*)(ws + WS_A2); const bf16* INP = (const bf16*)(ws + WS_A3); const bf16* OG = (const bf16*)(ws + WS_A4);
    bf16* OGATED = (bf16*)(ws + WS_A0); float* SSQH = (float*)(ws + WS_SSQH);
    constexpr int TT = 8;
    LAS float* sq = (LAS float*)lds; LAS float* sf = sq + TT * 128; LAS float* sk = sf + TT * 128; LAS float* si = sk + TT * 128;
    LAS float* part = si + TT * 128;
    LAS float* osq = part + TT * 4 * 128;
    const int b = blockIdx.x >> 3, h = blockIdx.x & 7, d = tid & 127, ng = tid >> 7;
    float St[32];
#pragma unroll
    for (int n = 0; n < 32; ++n) St[n] = 0.f;
    for (int t0 = 0; t0 < T; t0 += TT) {
        __syncthreads();
        for (int e = tid; e < TT * 128; e += 512) {
            const int tt = e >> 7, n = e & 127; const size_t off = (size_t)(b * T + t0 + tt) * D + h * 128 + n;
            const float f = __expf(LF[off]);
            sq[e] = bf2f(QS[off]); sf[e] = f; sk[e] = 1.f - f; si[e] = bf2f(INP[off]);
        }
        __syncthreads();
#pragma unroll
        for (int tt = 0; tt < TT; ++tt) {
            const float iv = si[tt * 128 + d]; float o = 0.f;
#pragma unroll
            for (int n = 0; n < 32; ++n) {
                const int nn = tt * 128 + ng * 32 + n;
                St[n] = fmaf(sf[nn], St[n], sk[nn] * iv);
                o = fmaf(sq[nn], St[n], o);
            }
            part[(tt * 4 + ng) * 128 + d] = o;
        }
        __syncthreads();
        for (int e = tid; e < TT * 128; e += 512) {
            const int tt = e >> 7, dd = e & 127; const size_t off = (size_t)(b * T + t0 + tt) * D + h * 128 + dd;
            const float o = (part[(tt * 4 + 0) * 128 + dd] + part[(tt * 4 + 1) * 128 + dd]) + (part[(tt * 4 + 2) * 128 + dd] + part[(tt * 4 + 3) * 128 + dd]);
            osq[e] = o * o;
            OGATED[off] = (bf16)f2bf(o * bf2f(OG[off]));
        }
        __syncthreads();
        if (tid < TT) { float s = 0.f; for (int dd = 0; dd < 128; ++dd) s += osq[tid * 128 + dd]; SSQH[(size_t)(b * T + t0 + tid) * 8 + h] = s; }
    }
}

__device__ __forceinline__ void kmean_phase(const Args& a, int tid) {
    const bf16* K = (const bf16*)(a.ws + WS_A2) + (size_t)M * D; float* kmean = (float*)(a.ws + WS_KMEAN);
    for (int it = blockIdx.x; it < 128; it += gridDim.x) {
        const int bn = it >> 1, col = (it & 1) * 512 + tid;
        float s = 0.f;
        for (int r = 0; r < 256; ++r) s += bf2f(K[(size_t)(bn * 256 + r) * D + col]);
        kmean[bn * D + col] = s * (1.f / 256.f);
    }
}

namespace moba {
using bf16x8 = __attribute__((ext_vector_type(8))) short;
using s16x4 = __attribute__((ext_vector_type(4))) short;
using f32x16 = __attribute__((ext_vector_type(16))) float;
using u32x4 = __attribute__((ext_vector_type(4))) unsigned;
#define KSWZ(row, colB) ((row) * 256 + ((colB) ^ (((row) & 7) << 4)))
#define SBAR() __builtin_amdgcn_sched_barrier(0)
constexpr float C2 = 0.08838834764831845f * 1.4426950408889634f;
constexpr float LOG2E = 1.4426950408889634f;
__device__ __forceinline__ int crow(int r, int hi) { return (r & 3) + 8 * (r >> 2) + 4 * hi; }
__device__ __forceinline__ unsigned cvtpk(float lo, float hi) { unsigned r; asm volatile("v_cvt_pk_bf16_f32 %0, %1, %2" : "=v"(r) : "v"(lo), "v"(hi)); return r; }
__device__ __forceinline__ int v_st(int k, int c) { const int kk = (k & ~0xC) | ((k & 4) << 1) | ((k & 8) >> 1); return ((kk >> 3) * 4 + (c >> 5)) * 512 + ((kk & 7) * 32 + (c & 31)) * 2; }
__device__ __forceinline__ int v_rd_base(int lane) { return ((lane & 3) << 3) | (((lane >> 2) & 3) << 6) | (((lane >> 4) & 1) << 5) | (((lane >> 5) & 1) << 8); }
constexpr int v_rd_off(int d0, int ks, int half) { return d0 * 512 + ks * 4096 + half * 2048; }
template <int OFF> __device__ __forceinline__ s16x4 tr_read(int vb) {
    s16x4 r; asm volatile("ds_read_b64_tr_b16 %0, %1 offset:%2" : "=&v"(r) : "v"(vb), "i"(OFF) : "memory"); return r;
}
template <int D0> __device__ __forceinline__ void pv_one(f32x16& od, int vb, bf16x8 pa0, bf16x8 pa1, bf16x8 pa2, bf16x8 pa3) {
    const s16x4 l0 = tr_read<v_rd_off(D0, 0, 0)>(vb), h0 = tr_read<v_rd_off(D0, 0, 1)>(vb), l1 = tr_read<v_rd_off(D0, 1, 0)>(vb), h1 = tr_read<v_rd_off(D0, 1, 1)>(vb);
    const s16x4 l2 = tr_read<v_rd_off(D0, 2, 0)>(vb), h2 = tr_read<v_rd_off(D0, 2, 1)>(vb), l3 = tr_read<v_rd_off(D0, 3, 0)>(vb), h3 = tr_read<v_rd_off(D0, 3, 1)>(vb);
    asm volatile("s_waitcnt lgkmcnt(0)" ::: "memory"); SBAR();
#define PK(L, Hh) (bf16x8){L[0], L[1], L[2], L[3], Hh[0], Hh[1], Hh[2], Hh[3]}
    od = __builtin_amdgcn_mfma_f32_32x32x16_bf16(pa0, PK(l0, h0), od, 0, 0, 0);
    od = __builtin_amdgcn_mfma_f32_32x32x16_bf16(pa1, PK(l1, h1), od, 0, 0, 0);
    od = __builtin_amdgcn_mfma_f32_32x32x16_bf16(pa2, PK(l2, h2), od, 0, 0, 0);
    od = __builtin_amdgcn_mfma_f32_32x32x16_bf16(pa3, PK(l3, h3), od, 0, 0, 0);
#undef PK
}
__device__ __forceinline__ void qkt(f32x16& p0, f32x16& p1, const LAS unsigned char* Ks, const bf16x8 (&qr)[8], int r32, int hi) {
    p0 = f32x16{}; p1 = f32x16{};
#pragma unroll
    for (int d0 = 0; d0 < 8; ++d0) { const int cb = (d0 * 16 + hi * 8) * 2;
        const bf16x8 b0 = *(const LAS bf16x8*)(Ks + KSWZ(r32, cb));
        const bf16x8 b1 = *(const LAS bf16x8*)(Ks + KSWZ(32 + r32, cb));
        p0 = __builtin_amdgcn_mfma_f32_32x32x16_bf16(b0, qr[d0], p0, 0, 0, 0);
        p1 = __builtin_amdgcn_mfma_f32_32x32x16_bf16(b1, qr[d0], p1, 0, 0, 0); }
}
__device__ __forceinline__ void softmax_step(f32x16& p0, f32x16& p1, float& m_reg, float& l_reg, float& alpha, bf16x8& pa0, bf16x8& pa1, bf16x8& pa2, bf16x8& pa3) {
    float pmax = p0[0];
#pragma unroll
    for (int r = 1; r < 16; ++r) pmax = fmaxf(pmax, p0[r]);
#pragma unroll
    for (int r = 0; r < 16; ++r) pmax = fmaxf(pmax, p1[r]);
    { auto rr = __builtin_amdgcn_permlane32_swap(__float_as_uint(pmax), __float_as_uint(pmax), false, false);
      pmax = fmaxf(__uint_as_float(rr[0]), __uint_as_float(rr[1])); }
    const float mn = fmaxf(m_reg, pmax);
    alpha = __builtin_amdgcn_exp2f(m_reg - mn); m_reg = mn;
#pragma unroll
    for (int r = 0; r < 16; ++r) { p0[r] = __builtin_amdgcn_exp2f(p0[r] - mn); p1[r] = __builtin_amdgcn_exp2f(p1[r] - mn); }
    float ps = 0.f;
#pragma unroll
    for (int r = 0; r < 16; ++r) ps += p0[r];
#pragma unroll
    for (int r = 0; r < 16; ++r) ps += p1[r];
    { auto rr = __builtin_amdgcn_permlane32_swap(__float_as_uint(ps), __float_as_uint(ps), false, false);
      ps = __uint_as_float(rr[0]) + __uint_as_float(rr[1]); }
    l_reg = l_reg * alpha + ps;
#define PK4(P, BASE, OUT) do { unsigned a0 = cvtpk(P[BASE + 0], P[BASE + 1]), a1 = cvtpk(P[BASE + 2], P[BASE + 3]);   \
    unsigned b0 = cvtpk(P[BASE + 4], P[BASE + 5]), b1 = cvtpk(P[BASE + 6], P[BASE + 7]);                              \
    auto r0 = __builtin_amdgcn_permlane32_swap(a0, b0, false, false); auto r1 = __builtin_amdgcn_permlane32_swap(a1, b1, false, false); \
    u32x4 w = {r0[0], r1[0], r0[1], r1[1]}; OUT = *reinterpret_cast<bf16x8*>(&w); } while (0)
    PK4(p0, 0, pa0); PK4(p0, 8, pa1); PK4(p1, 0, pa2); PK4(p1, 8, pa3);
#undef PK4
}

constexpr int L_V = 0, L_K = 65536, L_TAB = 131072, L_WSCR = 135168, L_SCHED = 143360;

__device__ __forceinline__ void load_kv_block(LAS unsigned char* lds, const bf16* Kh, const bf16* Vh, int tid) {
    const int sr = tid >> 4, sc = (tid & 15) * 8;
#pragma unroll
    for (int kt = 0; kt < 4; ++kt) {
        const bf16x8 k0 = *(const bf16x8*)(Kh + (size_t)(kt * 64 + sr) * D + sc), k1 = *(const bf16x8*)(Kh + (size_t)(kt * 64 + 32 + sr) * D + sc);
        const bf16x8 v0 = *(const bf16x8*)(Vh + (size_t)(kt * 64 + sr) * D + sc), v1 = *(const bf16x8*)(Vh + (size_t)(kt * 64 + 32 + sr) * D + sc);
        *(LAS bf16x8*)(lds + L_K + kt * 16384 + KSWZ(sr, sc * 2)) = k0;
        *(LAS bf16x8*)(lds + L_K + kt * 16384 + KSWZ(32 + sr, sc * 2)) = k1;
        *(LAS bf16x8*)(lds + L_V + kt * 16384 + v_st(sr, sc)) = v0;
        *(LAS bf16x8*)(lds + L_V + kt * 16384 + v_st(32 + sr, sc)) = v1;
    }
}

template <bool CAUSAL>
__device__ __forceinline__ void wave_flash(LAS unsigned char* lds, const bf16x8 (&qr)[8], int qpos_rel, int ntile, int lane, int wid, f32x16 (&o)[4], float& m_reg, float& l_reg) {
    const int r32 = lane & 31, hi = lane >> 5;
    const LAS float* tab2 = (const LAS float*)(lds + L_TAB);
    LAS float* al_l = (LAS float*)(lds + L_WSCR + wid * 1024);
    const int vb0 = (int)(unsigned long)(lds + L_V) + v_rd_base(lane);
    const bool far = !CAUSAL && __all(qpos_rel - 255 >= 1023);
    const float cfar = tab2[1023];
    for (int kt = 0; kt < ntile; ++kt) {
        f32x16 p0, p1;
        qkt(p0, p1, lds + L_K + kt * 16384, qr, r32, hi);
        if (far) {
#pragma unroll
            for (int r = 0; r < 16; ++r) { p0[r] = fmaf(p0[r], C2, cfar); p1[r] = fmaf(p1[r], C2, cfar); }
        } else {
#pragma unroll
            for (int r = 0; r < 16; ++r) {
                const int d0_ = qpos_rel - (kt * 64 + crow(r, hi)), d1_ = d0_ - 32;
                const float b0 = tab2[min(max(d0_, 0), 1023)], b1 = tab2[min(max(d1_, 0), 1023)];
                float t0 = fmaf(p0[r], C2, b0), t1 = fmaf(p1[r], C2, b1);
                if (CAUSAL) { if (d0_ < 0) t0 = -1e30f; if (d1_ < 0) t1 = -1e30f; }
                p0[r] = t0; p1[r] = t1;
            }
        }
        float alpha; bf16x8 pa0, pa1, pa2, pa3;
        softmax_step(p0, p1, m_reg, l_reg, alpha, pa0, pa1, pa2, pa3);
        if (__any(alpha < 1.f)) {
            if (hi == 0) al_l[r32] = alpha;
            asm volatile("s_waitcnt lgkmcnt(0)" ::: "memory");
#pragma unroll
            for (int r = 0; r < 16; ++r) { const float av = al_l[crow(r, hi)];
#pragma unroll
                for (int d = 0; d < 4; ++d) o[d][r] *= av; }
        }
        const int vb = vb0 + kt * 16384;
        pv_one<0>(o[0], vb, pa0, pa1, pa2, pa3); pv_one<1>(o[1], vb, pa0, pa1, pa2, pa3); pv_one<2>(o[2], vb, pa0, pa1, pa2, pa3); pv_one<3>(o[3], vb, pa0, pa1, pa2, pa3);
    }
}
}

constexpr size_t WS_CNT = 4096;
constexpr size_t WS_TAB2 = WS_YMEAN;
constexpr size_t WS_LIST = WS_WIN0;
constexpr size_t WS_LSE = WS_G;
constexpr size_t WS_PO0 = WS_A0, WS_PO1 = WS_A1, WS_PO2 = WS_A4;

__device__ __forceinline__ void topk_phase(const Args& a, LAS unsigned char* lds, int tid) {
    const bf16* Q = (const bf16*)(a.ws + WS_A2); const float* kmean = (const float*)(a.ws + WS_KMEAN);
    unsigned* cnt = (unsigned*)(a.ws + WS_CNT); unsigned short* lists = (unsigned short*)(a.ws + WS_LIST);
    LAS float* km = (LAS float*)lds;
    LAS unsigned* lcnt = (LAS unsigned*)(lds + 16384);
    for (int it = blockIdx.x; it < 256; it += gridDim.x) {
        const int b = it >> 7, h = (it >> 4) & 7, qc = it & 15;
        __syncthreads();
        for (int e = tid; e < 32 * 128; e += 512) km[e] = kmean[(size_t)(b * 32 + (e >> 7)) * D + h * 128 + (e & 127)];
        if (tid < 64) lcnt[tid] = 0u;
        __syncthreads();
        const int qpos = qc * 512 + tid, m = b * T + qpos, j = qpos >> 8;
        float g[32];
#pragma unroll
        for (int n = 0; n < 32; ++n) g[n] = 0.f;
        const uint4* qr = (const uint4*)(Q + (size_t)m * D + h * 128);
        for (int c = 0; c < 16; ++c) {
            const uint4 qq = qr[c]; const unsigned w[4] = {qq.x, qq.y, qq.z, qq.w};
            float qv[8];
#pragma unroll
            for (int e = 0; e < 4; ++e) { qv[2 * e] = __uint_as_float(w[e] << 16); qv[2 * e + 1] = __uint_as_float(w[e] & 0xffff0000u); }
#pragma unroll
            for (int n = 0; n < 32; ++n) {
#pragma unroll
                for (int e = 0; e < 8; ++e) g[n] = fmaf(qv[e], km[n * 128 + c * 8 + e], g[n]);
            }
        }
        unsigned used = 0u; int selv[3]; unsigned lpos[3];
#pragma unroll
        for (int s = 0; s < 3; ++s) { int best = 0; float bv = -INFINITY; bool have = false;
#pragma unroll
            for (int n = 0; n < 32; ++n) { const float gv = (n < j) ? g[n] : -INFINITY; const bool free_ = !((used >> n) & 1u); if (free_ && (!have || gv > bv)) { best = n; bv = gv; have = true; } }
            used |= 1u << best; selv[s] = best;
            lpos[s] = 0u;
            if (s < j) lpos[s] = atomicAdd((unsigned*)&lcnt[best], 1u); }
        __syncthreads();
        if (tid < 32) { const unsigned c = lcnt[tid]; unsigned base = 0u; if (c) base = atomicAdd(&cnt[(b * 8 + h) * 32 + tid], c); lcnt[32 + tid] = base; }
        __syncthreads();
#pragma unroll
        for (int s = 0; s < 3; ++s)
            if (s < j) lists[(size_t)((b * 8 + h) * 32 + selv[s]) * 8192 + lcnt[32 + selv[s]] + lpos[s]] = (unsigned short)(qpos | (s << 13));
    }
}

__device__ __forceinline__ void attn_sel_phase(const Args& a, LAS unsigned char* lds, int tid, int lane, int wid) {
    using namespace moba;
    const bf16* Q = (const bf16*)(a.ws + WS_A2); const bf16* K = Q + (size_t)M * D; const bf16* V = K + (size_t)M * D;
    const unsigned* cnt = (const unsigned*)(a.ws + WS_CNT); const unsigned short* lists = (const unsigned short*)(a.ws + WS_LIST);
    const float* tab2g = (const float*)(a.ws + WS_TAB2); float* LSE = (float*)(a.ws + WS_LSE);
    LAS int* P = (LAS int*)(lds + L_SCHED);
    {
        const int ns = ((int)cnt[tid] + 31) >> 5;
        int v = ns;
#pragma unroll
        for (int o = 1; o < 64; o <<= 1) { const int t = __shfl_up(v, o); if (lane >= o) v += t; }
        LAS int* wt = (LAS int*)(lds + L_WSCR);
        if (lane == 63) wt[wid] = v;
        __syncthreads();
        int off = 0;
        for (int w = 0; w < wid; ++w) off += wt[w];
        P[tid + 1] = off + v;
        if (tid == 0) P[0] = 0;
        __syncthreads();
    }
    const int total = P[512];
    const int lo = (int)(((long)blockIdx.x * total) / gridDim.x), hiE = (int)(((long)(blockIdx.x + 1) * total) / gridDim.x);
    int li = 0;
    { int a_ = 0, b_ = 512; while (b_ - a_ > 1) { const int mid = (a_ + b_) >> 1; if (P[mid] <= lo) a_ = mid; else b_ = mid; } li = a_; }
    const int r32 = lane & 31, hi = lane >> 5;
    for (; li < 512 && P[li] < hiE; ++li) {
        const int p0_ = P[li], p1_ = P[li + 1];
        if (p1_ <= lo || p1_ == p0_) continue;
        const int seg_lo = max(lo, p0_) - p0_, seg_hi = min(hiE, p1_) - p0_;
        const int b = li >> 8, h = (li >> 5) & 7, n = li & 31;
        const int L = (int)cnt[li];
        __syncthreads();
        load_kv_block(lds, K + (size_t)(b * T + n * 256) * D + h * 128, V + (size_t)(b * T + n * 256) * D + h * 128, tid);
        for (int e = tid; e < 1024; e += 512) ((LAS float*)(lds + L_TAB))[e] = tab2g[h * 1024 + e];
        __syncthreads();
        const unsigned short* lp = lists + (size_t)li * 8192;
        for (int st = seg_lo + wid; st < seg_hi; st += 8) {
            const int e = st * 32 + r32; const bool valid = e < L;
            const unsigned ent = lp[valid ? e : (L - 1)];
            const int qpos = ent & 8191, slot = ent >> 13, m = b * T + qpos;
            bf16x8 qr[8];
            const bf16* Qw = Q + (size_t)m * D + h * 128 + hi * 8;
#pragma unroll
            for (int d0 = 0; d0 < 8; ++d0) qr[d0] = *(const bf16x8*)(Qw + d0 * 16);
            f32x16 o[4] = {}; float m_reg = -1e30f, l_reg = 0.f;
            wave_flash<false>(lds, qr, qpos - n * 256, 4, lane, wid, o, m_reg, l_reg);
            LAS float* li_l = (LAS float*)(lds + L_WSCR + wid * 1024 + 128);
            LAS int* row_l = (LAS int*)(lds + L_WSCR + wid * 1024 + 256);
            if (hi == 0) { li_l[r32] = __builtin_amdgcn_rcpf(l_reg); row_l[r32] = valid ? ((slot << 20) | m) : -1;
                if (valid) LSE[((size_t)slot * M + m) * 8 + h] = m_reg + __builtin_amdgcn_logf(l_reg); }
            asm volatile("s_waitcnt lgkmcnt(0)" ::: "memory");
#pragma unroll
            for (int r = 0; r < 16; ++r) {
                const int rw = crow(r, hi); const float rl = li_l[rw]; const int rm = row_l[rw];
                if (rm >= 0) {
                    const int sl = rm >> 20, mm = rm & 0xfffff;
                    bf16* po = (bf16*)(a.ws + (sl == 0 ? WS_PO0 : (sl == 1 ? WS_PO1 : WS_PO2))) + (size_t)mm * D + h * 128 + r32;
#pragma unroll
                    for (int d0 = 0; d0 < 4; ++d0) po[d0 * 32] = (bf16)f2bf(o[d0][r] * rl);
                }
            }
        }
    }
}

__device__ __forceinline__ void attn_own_phase(const Args& a, LAS unsigned char* lds, int tid, int lane, int wid) {
    using namespace moba;
    bf16* Q = (bf16*)(a.ws + WS_A2); const bf16* K = Q + (size_t)M * D; const bf16* V = K + (size_t)M * D;
    const float* tab2g = (const float*)(a.ws + WS_TAB2); const float* LSE = (const float*)(a.ws + WS_LSE);
    const int r32 = lane & 31, hi = lane >> 5;
    for (int u = blockIdx.x; u < 512; u += gridDim.x) {
        const int b = u >> 8, h = (u >> 5) & 7, n = u & 31;
        __syncthreads();
        load_kv_block(lds, K + (size_t)(b * T + n * 256) * D + h * 128, V + (size_t)(b * T + n * 256) * D + h * 128, tid);
        for (int e = tid; e < 1024; e += 512) ((LAS float*)(lds + L_TAB))[e] = tab2g[h * 1024 + e];
        __syncthreads();
        const int qrel = wid * 32 + r32, m = b * T + n * 256 + qrel;
        bf16x8 qr[8];
        const bf16* Qw = Q + (size_t)m * D + h * 128 + hi * 8;
#pragma unroll
        for (int d0 = 0; d0 < 8; ++d0) qr[d0] = *(const bf16x8*)(Qw + d0 * 16);
        f32x16 o[4] = {}; float m_reg = -1e30f, l_reg = 0.f;
        wave_flash<true>(lds, qr, qrel, (wid >> 1) + 1, lane, wid, o, m_reg, l_reg);
        const int nsel = n < 3 ? n : 3;
        float ls0 = -1e30f, ls1 = -1e30f, ls2 = -1e30f;
        if (nsel > 0) ls0 = LSE[((size_t)0 * M + m) * 8 + h];
        if (nsel > 1) ls1 = LSE[((size_t)1 * M + m) * 8 + h];
        if (nsel > 2) ls2 = LSE[((size_t)2 * M + m) * 8 + h];
        const float lown = m_reg + __builtin_amdgcn_logf(l_reg);
        const float Mx = fmaxf(fmaxf(lown, ls0), fmaxf(ls1, ls2));
        const float e0 = __builtin_amdgcn_exp2f(ls0 - Mx), e1 = __builtin_amdgcn_exp2f(ls1 - Mx), e2 = __builtin_amdgcn_exp2f(ls2 - Mx), eo = __builtin_amdgcn_exp2f(lown - Mx);
        const float iz = __builtin_amdgcn_rcpf((eo + e0) + (e1 + e2));
        LAS float* cf = (LAS float*)(lds + L_WSCR + wid * 1024 + 128);
        if (hi == 0) { cf[r32] = eo * iz * __builtin_amdgcn_rcpf(l_reg); cf[32 + r32] = e0 * iz; cf[64 + r32] = e1 * iz; cf[96 + r32] = e2 * iz; }
        asm volatile("s_waitcnt lgkmcnt(0)" ::: "memory");
        const bf16* P0 = (const bf16*)(a.ws + WS_PO0); const bf16* P1 = (const bf16*)(a.ws + WS_PO1); const bf16* P2 = (const bf16*)(a.ws + WS_PO2);
#pragma unroll
        for (int r = 0; r < 16; ++r) {
            const int rw = crow(r, hi);
            const float c_o = cf[rw], c0 = cf[32 + rw], c1 = cf[64 + rw], c2 = cf[96 + rw];
            const size_t off = (size_t)(b * T + n * 256 + wid * 32 + rw) * D + h * 128 + r32;
#pragma unroll
            for (int d0 = 0; d0 < 4; ++d0) {
                float v = o[d0][r] * c_o;
                if (nsel > 0) v = fmaf(c0, bf2f(P0[off + d0 * 32]), v);
                if (nsel > 1) v = fmaf(c1, bf2f(P1[off + d0 * 32]), v);
                if (nsel > 2) v = fmaf(c2, bf2f(P2[off + d0 * 32]), v);
                Q[off + d0 * 32] = (bf16)f2bf(v);
            }
        }
    }
}
__global__ void __launch_bounds__(NWAVES * 64, 2) mk(Args a) {
    extern __shared__ __attribute__((aligned(16))) unsigned char lds_raw[];
    LAS unsigned char* lds = (LAS unsigned char*)lds_raw;
    const int tid = threadIdx.x, lane = tid & 63, wave = __builtin_amdgcn_readfirstlane(tid >> 6);
    unsigned char* ws = a.ws;
    const int lo = a.ph_lo, hi = a.ph_hi;
    const int G = gridDim.x;
    cg::grid_group grid = cg::this_grid();
#define IN(k) (lo <= (k) && (k) < hi)
#define SEAM(k) do { if (IN(k) && IN((k) + 1)) grid.sync(); } while (0)
    float* SSQ = (float*)(ws + WS_SSQ);
    if (IN(0)) { prologue(a, lds, tid, lane, wave); }
    SEAM(0);
    if (IN(1)) {
        pg8::Gemm g{(const bf16*)(ws + WS_A0), (const bf16*)(ws + WS_WIN0), M, 4096, D}; pg8::StaticOrder S; S.init(M, 4096, G, (int)blockIdx.x);
        pg8::EpiHgrnIn E{(bf16*)(ws + WS_A1), (float*)(ws + WS_A2), (bf16*)(ws + WS_A3), (bf16*)(ws + WS_A4), (const float*)(ws + WS_LB)};
        pg8::gemm_phase<pg8::EpiHgrnIn, pg8::StaticOrder, true, true>(lds, g, S, E);
    }
    SEAM(1);
    if (IN(2)) hgrn_semi_phase(a, lds, tid);
    SEAM(2);
    if (IN(3)) {
        pg8::Gemm g{(const bf16*)(ws + WS_A0), (const bf16*)(ws + WS_WOUT0), M, D, D}; pg8::StaticOrder S; S.init(M, D, G, (int)blockIdx.x);
        pg8::EpiResid<1, false> E{a.x, a.out, (bf16*)(ws + WS_A1), nullptr, SSQ, (const float*)(ws + WS_SSQH)};
        pg8::gemm_phase<pg8::EpiResid<1, false>, pg8::StaticOrder, true, true>(lds, g, S, E);
    }
    SEAM(3);
    if (IN(4)) {
        pg8::Gemm g{(const bf16*)(ws + WS_A1), (const bf16*)(ws + WS_W13_0), M, 2 * DFF, D}; pg8::StaticOrder S; S.init(M, 2 * DFF, G, (int)blockIdx.x);
        pg8::EpiSwiglu E{(bf16*)(ws + WS_A2), DFF, SSQ};
        pg8::gemm_phase<pg8::EpiSwiglu, pg8::StaticOrder, true, true>(lds, g, S, E);
    }
    SEAM(4);
    if (IN(5)) {
        pg8::Gemm g{(const bf16*)(ws + WS_A2), (const bf16*)(ws + WS_W2_0), M, D, DFF}; pg8::StaticOrder S; S.init(M, D, G, (int)blockIdx.x);
        pg8::EpiResid<0, false> E{a.out, a.out, (bf16*)(ws + WS_A1), nullptr, SSQ, nullptr};
        pg8::gemm_phase<pg8::EpiResid<0, false>, pg8::StaticOrder, true, true>(lds, g, S, E);
    }
    SEAM(5);
    if (IN(6)) {
        pg8::Gemm g{(const bf16*)(ws + WS_A1), (const bf16*)(ws + WS_WQKV), M, 3072, D}; pg8::StaticOrder S; S.init(M, 3072, G, (int)blockIdx.x);
        pg8::EpiQKV E{(bf16*)(ws + WS_A2), (size_t)M * D, SSQ};
        pg8::gemm_phase<pg8::EpiQKV, pg8::StaticOrder, true, true>(lds, g, S, E);
    }
    SEAM(6);
    if (IN(7)) kmean_phase(a, tid);
    SEAM(7);
    if (IN(8)) topk_phase(a, lds, tid);
    SEAM(8);
    if (IN(9)) attn_sel_phase(a, lds, tid, lane, wave);
    SEAM(9);
    if (IN(10)) attn_own_phase(a, lds, tid, lane, wave);
    SEAM(10);
    if (IN(11)) {
        pg8::Gemm g{(const bf16*)(ws + WS_A2), (const bf16*)(ws + WS_WOUT1), M, D, D}; pg8::StaticOrder S; S.init(M, D, G, (int)blockIdx.x);
        pg8::EpiResid<0, false> E{a.out, a.out, (bf16*)(ws + WS_A1), nullptr, SSQ, nullptr};
        pg8::gemm_phase<pg8::EpiResid<0, false>, pg8::StaticOrder, true, true>(lds, g, S, E);
    }
    SEAM(11);
    if (IN(12)) {
        pg8::Gemm g{(const bf16*)(ws + WS_A1), (const bf16*)(ws + WS_W13_1), M, 2 * DFF, D}; pg8::StaticOrder S; S.init(M, 2 * DFF, G, (int)blockIdx.x);
        pg8::EpiSwiglu E{(bf16*)(ws + WS_A2), DFF, SSQ};
        pg8::gemm_phase<pg8::EpiSwiglu, pg8::StaticOrder, true, true>(lds, g, S, E);
    }
    SEAM(12);
    if (IN(13)) {
        pg8::Gemm g{(const bf16*)(ws + WS_A2), (const bf16*)(ws + WS_W2_1), M, D, DFF}; pg8::StaticOrder S; S.init(M, D, G, (int)blockIdx.x);
        pg8::EpiResid<0, false> E{a.out, a.out, (bf16*)(ws + WS_A1), nullptr, SSQ, nullptr};
        pg8::gemm_phase<pg8::EpiResid<0, false>, pg8::StaticOrder, true, true>(lds, g, S, E);
    }
    SEAM(13);
    if (IN(14)) final_norm_phase(a, lane, wave);
#undef IN
#undef SEAM
}

extern "C" void kernel_launch(void* const* d_in, const int* in_sizes, int n_in, void* d_out, int out_size, void* d_ws, size_t ws_size, hipStream_t stream) {
    static int grid = 0;
    if (grid == 0) {
        if (n_in != 13 || out_size != M * D || ws_size < WS_END) { fprintf(stderr, "kernel_launch: unexpected problem (n_in %d out %d ws %zu)\n", n_in, out_size, ws_size); grid = -1; return; }
        int dev = 0, cus = 0, per_cu = 0;
        (void)hipGetDevice(&dev); (void)hipDeviceGetAttribute(&cus, hipDeviceAttributeMultiprocessorCount, dev);
        if (hipFuncSetAttribute((const void*)mk, hipFuncAttributeMaxDynamicSharedMemorySize, LDS_BYTES) != hipSuccess) { fprintf(stderr, "kernel_launch: hipFuncSetAttribute failed\n"); grid = -1; return; }
        if (hipOccupancyMaxActiveBlocksPerMultiprocessor(&per_cu, (const void*)mk, NWAVES * 64, LDS_BYTES) != hipSuccess || per_cu < 1) { fprintf(stderr, "kernel_launch: occupancy query says %d\n", per_cu); (void)hipGetLastError(); grid = -1; return; }
        grid = cus;
        if (grid != 256) fprintf(stderr, "kernel_launch: note: %d CUs\n", grid);
    }
    if (grid < 0) return;
    Args a{};
    a.x = (const float*)d_in[0]; a.norm_mix = (const float*)d_in[1]; a.norm_ffn = (const float*)d_in[2]; a.hgrn_w_in = (const float*)d_in[3]; a.lb_logits = (const float*)d_in[4];
    a.hgrn_out_norm = (const float*)d_in[5]; a.hgrn_w_out = (const float*)d_in[6]; a.moba_w_in = (const float*)d_in[7]; a.moba_w_out = (const float*)d_in[8]; a.rel_table = (const float*)d_in[9];
    a.ffn_w13 = (const float*)d_in[10]; a.ffn_w2 = (const float*)d_in[11]; a.final_norm = (const float*)d_in[12];
    a.out = (float*)d_out; a.ws = (unsigned char*)d_ws;
    a.ph_lo = 0; a.ph_hi = 15;
    void* args[] = {&a};
    hipError_t e = hipLaunchCooperativeKernel((const void*)mk, dim3(grid), dim3(NWAVES * 64), args, LDS_BYTES, stream);
    if (e != hipSuccess) fprintf(stderr, "kernel_launch: cooperative launch failed: %s (grid %d)\n", hipGetErrorString(e), grid);
}
```

```cpp
#include <hip/hip_runtime.h>
#include <hip/hip_cooperative_groups.h>
#include <cstdio>
#include <cstdint>
#include <cmath>
namespace pg8 {
#define PG8_LAS __attribute__((address_space(3)))
typedef unsigned short bf16_t;
typedef short bf16x8 __attribute__((ext_vector_type(8)));
typedef float f32x4 __attribute__((ext_vector_type(4)));
typedef unsigned u32x4 __attribute__((ext_vector_type(4)));
constexpr int BM = 256, BK = 64, HALF = 128, HTB = HALF * BK * 2  , STAGE_BYTES = 8 * HTB, NXCD = 8, WGM = 8;

__host__ __device__ __forceinline__ int lds_byte(int r, int c) { const int st = (r >> 4) * 2 + (c >> 5), rr = r & 15, cc = c & 31, ob = rr * 64 + cc * 2; return st * 1024 + (ob ^ (((ob >> 9) & 1) << 5)); }
__host__ __device__ __forceinline__ void stage_rc(int b, int& R, int& C) { const int st = b / 1024, sb = b % 1024, swz = sb ^ (((sb >> 9) & 1) << 5); R = (st >> 1) * 16 + swz / 64; C = (st & 1) * 32 + (swz % 64) / 2; }
__host__ __device__ __forceinline__ int perm32(int rho) { const int n = rho >> 4, i = rho & 15; return 8 * (i >> 2) + 4 * n + (i & 3); }

struct Unit { int pm, pn; };
struct Gemm { const bf16_t* A; const bf16_t* Bt; int M, N, K; };

struct StaticOrder {
    int nM, nN, nwg, G, c;
    __host__ __device__ void init(int M, int N, int G_, int c_) { nM = M / BM; nN = N / BM; nwg = nM * nN; G = G_; c = c_; }
    __host__ __device__ bool next(int i, Unit& u) const {
        const long L = (long)i * G + c; if (L >= nwg) return false;
        int wgid = (int)L; { const int q = nwg / NXCD, r = nwg % NXCD, xcd = wgid % NXCD, off = wgid / NXCD; wgid = (xcd < r ? xcd * (q + 1) : r * (q + 1) + (xcd - r) * q) + off; }
        const int nig = WGM * nN, gid = wgid / nig, fm = gid * WGM, gsz = (nM - fm) < WGM ? (nM - fm) : WGM;
        u.pm = fm + ((wgid % nig) % gsz); u.pn = (wgid % nig) / gsz; return true;
    }
    __device__ __forceinline__ void a_ready(const Unit&) const {}
    __device__ __forceinline__ void done(const Unit&) const {}
};
__device__ __forceinline__ unsigned cvt_pk_bf16(float lo, float hi) { unsigned r; asm volatile("v_cvt_pk_bf16_f32 %0, %1, %2" : "=v"(r) : "v"(lo), "v"(hi)); return r; }
typedef float f32x2 __attribute__((ext_vector_type(2)));
typedef unsigned u32x2 __attribute__((ext_vector_type(2)));
__device__ __forceinline__ float sigm(float x) { return __builtin_amdgcn_rcpf(1.f + __expf(-x)); }
__device__ __forceinline__ float bf2f_lo(unsigned w) { return __uint_as_float(w << 16); }
__device__ __forceinline__ float bf2f_hi(unsigned w) { return __uint_as_float(w & 0xffff0000u); }
__device__ __forceinline__ float rstd_from16(const float* p) {
    const f32x4 a = *(const f32x4*)p, b = *(const f32x4*)(p + 4), c = *(const f32x4*)(p + 8), d = *(const f32x4*)(p + 12);
    const float s = ((a[0] + a[1]) + (a[2] + a[3])) + ((b[0] + b[1]) + (b[2] + b[3])) + ((c[0] + c[1]) + (c[2] + c[3])) + ((d[0] + d[1]) + (d[2] + d[3]));
    return rsqrtf(s * (1.f / 1024.f) + 1e-6f);
}
__device__ __forceinline__ float rstd_from8(const float* p) {
    const f32x4 a = *(const f32x4*)p, b = *(const f32x4*)(p + 4);
    const float s = ((a[0] + a[1]) + (a[2] + a[3])) + ((b[0] + b[1]) + (b[2] + b[3]));
    return rsqrtf(s * (1.f / 1024.f) + 1e-6f);
}

struct EpiHgrnIn {
    static constexpr bool PERM = true, AFTER_DRAIN = false;
    bf16_t* QS; float* LF; bf16_t* IN; bf16_t* OG; const float* lb;
    __device__ __forceinline__ void operator()(const f32x4 (&acc)[2][2][4][2], const Unit& u, int wr, int wc, int fr, int fq) const {
        const int type = u.pn >> 2;
        const int row0 = u.pm * BM + wr * 64 + fr;
        const int col0 = (u.pn & 3) * BM + wc * 32 + 8 * fq;
#pragma unroll
        for (int bj = 0; bj < 2; ++bj) {
            const int c = col0 + bj * HALF;
            f32x4 l0 = (f32x4){0.f, 0.f, 0.f, 0.f}, l1 = l0;
            if (type == 1) { l0 = *(const f32x4*)(lb + c); l1 = *(const f32x4*)(lb + c + 4); }
#pragma unroll
            for (int ai = 0; ai < 2; ++ai)
#pragma unroll
                for (int m = 0; m < 4; ++m) {
                    const size_t off = (size_t)(row0 + ai * HALF + m * 16) * 1024 + c;
                    f32x4 v0 = acc[ai][bj][m][0], v1 = acc[ai][bj][m][1];
                    if (type == 1) {
#pragma unroll
                        for (int i = 0; i < 4; ++i) { v0[i] = logf(l0[i] + (1.f - l0[i]) * sigm(v0[i])); v1[i] = logf(l1[i] + (1.f - l1[i]) * sigm(v1[i])); }
                        *(f32x4*)(LF + off) = v0; *(f32x4*)(LF + off + 4) = v1;
                    } else {
                        if (type == 0) {
#pragma unroll
                            for (int i = 0; i < 4; ++i) { v0[i] = v0[i] * sigm(v0[i]); v1[i] = v1[i] * sigm(v1[i]); }
                        } else if (type == 3) {
#pragma unroll
                            for (int i = 0; i < 4; ++i) { v0[i] = sigm(v0[i]); v1[i] = sigm(v1[i]); }
                        }
                        u32x4 w; w.x = cvt_pk_bf16(v0[0], v0[1]); w.y = cvt_pk_bf16(v0[2], v0[3]); w.z = cvt_pk_bf16(v1[0], v1[1]); w.w = cvt_pk_bf16(v1[2], v1[3]);
                        if (type == 0) *(u32x4*)(QS + off) = w;
                        else if (type == 2) *(u32x4*)(IN + off) = w;
                        else *(u32x4*)(OG + off) = w;
                    }
                }
        }
    }
};

template <int SCALE, bool WRITE_LO>
struct EpiResid {
    static constexpr bool PERM = false, AFTER_DRAIN = false;
    const float* R; float* Hout; bf16_t* HB; bf16_t* HBL; float* SSQ; const float* SSQIN;
    __device__ __forceinline__ void operator()(const f32x4 (&acc)[2][2][4][2], const Unit& u, int wr, int wc, int fr, int fq) const {
        const int col0 = u.pn * BM + wc * 32 + 4 * fq;
#pragma unroll
        for (int ai = 0; ai < 2; ++ai)
#pragma unroll
            for (int m = 0; m < 4; ++m) {
                const int row = u.pm * BM + ai * HALF + wr * 64 + m * 16 + fr;
                float sc = 1.f;
                if (SCALE == 1) sc = rstd_from8(SSQIN + (size_t)row * 8);
                const size_t off = (size_t)row * 1024 + col0;
                float ss = 0.f;
#pragma unroll
                for (int bj = 0; bj < 2; ++bj)
#pragma unroll
                    for (int n = 0; n < 2; ++n) {
                        const size_t o2 = off + bj * HALF + n * 16;
                        const f32x4 r = *(const f32x4*)(R + o2);
                        const f32x4 v = r + acc[ai][bj][m][n] * sc;
                        *(f32x4*)(Hout + o2) = v;
                        ss += (v[0] * v[0] + v[1] * v[1]) + (v[2] * v[2] + v[3] * v[3]);
                        u32x2 w; w.x = cvt_pk_bf16(v[0], v[1]); w.y = cvt_pk_bf16(v[2], v[3]);
                        *(u32x2*)(HB + o2) = w;
                        if (WRITE_LO) {
                            u32x2 l; l.x = cvt_pk_bf16(v[0] - bf2f_lo(w.x), v[1] - bf2f_hi(w.x)); l.y = cvt_pk_bf16(v[2] - bf2f_lo(w.y), v[3] - bf2f_hi(w.y));
                            *(u32x2*)(HBL + o2) = l;
                        }
                    }
                ss += __shfl_xor(ss, 16); ss += __shfl_xor(ss, 32);
                if (fq == 0) SSQ[(size_t)row * 16 + u.pn * 4 + wc] = ss;
                if (m & 1) asm volatile("" ::: "memory");
            }
    }
};

struct EpiSwiglu {
    static constexpr bool PERM = true, AFTER_DRAIN = false;
    bf16_t* HID; int ldh; const float* SSQIN;
    __device__ __forceinline__ void operator()(const f32x4 (&acc)[2][2][4][2], const Unit& u, int wr, int wc, int fr, int fq) const {
        const int col0 = u.pn * HALF + wc * 32 + 8 * fq;
#pragma unroll
        for (int ai = 0; ai < 2; ++ai)
#pragma unroll
            for (int m = 0; m < 4; ++m) {
                const int row = u.pm * BM + ai * HALF + wr * 64 + m * 16 + fr;
                const float sc = rstd_from16(SSQIN + (size_t)row * 16);
                f32x4 g0 = acc[ai][0][m][0] * sc, g1 = acc[ai][0][m][1] * sc, u0 = acc[ai][1][m][0] * sc, u1 = acc[ai][1][m][1] * sc;
#pragma unroll
                for (int i = 0; i < 4; ++i) { g0[i] = g0[i] * sigm(g0[i]) * u0[i]; g1[i] = g1[i] * sigm(g1[i]) * u1[i]; }
                u32x4 w; w.x = cvt_pk_bf16(g0[0], g0[1]); w.y = cvt_pk_bf16(g0[2], g0[3]); w.z = cvt_pk_bf16(g1[0], g1[1]); w.w = cvt_pk_bf16(g1[2], g1[3]);
                *(u32x4*)(HID + (size_t)row * ldh + col0) = w;
            }
    }
};

struct EpiQKV {
    static constexpr bool PERM = true, AFTER_DRAIN = false;
    bf16_t* O; size_t split_stride; const float* SSQIN;
    __device__ __forceinline__ void operator()(const f32x4 (&acc)[2][2][4][2], const Unit& u, int wr, int wc, int fr, int fq) const {
        const int t = u.pn >> 2;
        bf16_t* base = O + (size_t)t * split_stride;
        const int col0 = (u.pn & 3) * BM + wc * 32 + 8 * fq;
#pragma unroll
        for (int ai = 0; ai < 2; ++ai)
#pragma unroll
            for (int m = 0; m < 4; ++m) {
                const int row = u.pm * BM + ai * HALF + wr * 64 + m * 16 + fr;
                const float sc = rstd_from16(SSQIN + (size_t)row * 16);
#pragma unroll
                for (int bj = 0; bj < 2; ++bj) {
                    const f32x4 v0 = acc[ai][bj][m][0] * sc, v1 = acc[ai][bj][m][1] * sc;
                    u32x4 w; w.x = cvt_pk_bf16(v0[0], v0[1]); w.y = cvt_pk_bf16(v0[2], v0[3]); w.z = cvt_pk_bf16(v1[0], v1[1]); w.w = cvt_pk_bf16(v1[2], v1[3]);
                    *(u32x4*)(base + (size_t)row * 1024 + col0 + bj * HALF) = w;
                }
            }
    }
};

template <class Epi, class Sched, bool ALIGN_EPI = false, bool SP2 = false>
__device__ __forceinline__ void gemm_phase(PG8_LAS unsigned char* lds, const Gemm g, const Sched& S, const Epi& E) {
    const int tid = threadIdx.x, wid = __builtin_amdgcn_readfirstlane(tid >> 6), lane = tid & 63, wr = wid >> 2, wc = wid & 3, fr = lane & 15, fq = lane >> 4;
    const int K = g.K, nt = K / BK;
    unsigned voffA[2], voffB[2];
#pragma unroll
    for (int i = 0; i < 2; ++i) { int R, C; stage_rc(tid * 16 + i * 8192, R, C); const int Rb = Epi::PERM ? ((R & ~31) + perm32(R & 31)) : R;
        voffA[i] = (unsigned)(R * K + C) * 2u; voffB[i] = (unsigned)(Rb * K + C) * 2u; }
    const size_t kstep = (size_t)(BK * 2);
    const size_t hstep = (size_t)HALF * K * 2;
    const size_t tstep = 2 * hstep;
    const unsigned ldsw = (unsigned)wid * 1024u;
    const int aoff = lds_byte(wr * 64 + fr, fq * 8), boff = lds_byte(wc * 32 + fr, fq * 8);
#define PG8_SA(b, h) (((b) * 2 + (h)) * HTB)
#define PG8_SB(b, h) ((4 + (b) * 2 + (h)) * HTB)
#define PG8_STAGE(bufoff, gbase, voff) do { _Pragma("unroll") for (int _i = 0; _i < 2; ++_i) \
        __builtin_amdgcn_global_load_lds((const unsigned*)((const char*)(gbase) + (voff)[_i]), (PG8_LAS unsigned*)(lds + (bufoff) + ldsw + _i * 8192), 16, 0, 0); } while (0)
#define PG8_LDA(dst, b, h) do { _Pragma("unroll") for (int m = 0; m < 4; ++m) _Pragma("unroll") for (int k = 0; k < 2; ++k) dst[m][k] = *(const PG8_LAS bf16x8*)(lds + PG8_SA(b, h) + aoff + m * 2048 + k * 1024); } while (0)
#define PG8_LDB(dst, b, h) do { _Pragma("unroll") for (int n = 0; n < 2; ++n) _Pragma("unroll") for (int k = 0; k < 2; ++k) dst[n][k] = *(const PG8_LAS bf16x8*)(lds + PG8_SB(b, h) + boff + n * 2048 + k * 1024); } while (0)
#define PG8_MMA(ai, bj, At, Bt) do { __builtin_amdgcn_s_setprio(1); _Pragma("unroll") for (int m = 0; m < 4; ++m) _Pragma("unroll") for (int n = 0; n < 2; ++n) _Pragma("unroll") for (int k = 0; k < 2; ++k) \
        acc[ai][bj][m][n] = __builtin_amdgcn_mfma_f32_16x16x32_bf16(Bt[n][k], At[m][k], acc[ai][bj][m][n], 0, 0, 0); __builtin_amdgcn_s_setprio(0); } while (0)
#define PG8_WAIT_V(n) asm volatile("s_waitcnt vmcnt(" #n ")" ::: "memory")
#define PG8_WAIT_L(n) asm volatile("s_waitcnt lgkmcnt(" #n ")" ::: "memory")
#define PG8_BAR __builtin_amdgcn_s_barrier()
#define PG8_SCHED __builtin_amdgcn_sched_barrier(0)
    Unit cur, nxt; int ui = 0;
    if (!S.next(0, cur)) return;
    f32x4 acc[2][2][4][2];
#pragma unroll
    for (int a = 0; a < 2; ++a)
#pragma unroll
        for (int b = 0; b < 2; ++b)
#pragma unroll
            for (int m = 0; m < 4; ++m)
#pragma unroll
                for (int n = 0; n < 2; ++n) acc[a][b][m][n] = (f32x4){0.f, 0.f, 0.f, 0.f};
    bf16x8 At[4][2], B0[2][2], B1[2][2];
    const char* cA = (const char*)g.A + (size_t)cur.pm * tstep; const char* cB = (const char*)g.Bt + (size_t)cur.pn * tstep;
    S.a_ready(cur);
    if constexpr (SP2) {
        PG8_STAGE(PG8_SB(0, 0), cB, voffB); PG8_STAGE(PG8_SB(0, 1), cB + hstep, voffB); PG8_STAGE(PG8_SA(0, 0), cA, voffA); PG8_STAGE(PG8_SA(0, 1), cA + hstep, voffA);
        if (wr == 1) PG8_BAR;
        PG8_WAIT_V(2); PG8_BAR;
        PG8_STAGE(PG8_SB(1, 0), cB + kstep, voffB); PG8_STAGE(PG8_SA(1, 0), cA + kstep, voffA); PG8_STAGE(PG8_SB(1, 1), cB + hstep + kstep, voffB);
        PG8_WAIT_V(6); PG8_BAR;
    } else {
        PG8_STAGE(PG8_SB(0, 0), cB, voffB); PG8_STAGE(PG8_SA(0, 0), cA, voffA); PG8_STAGE(PG8_SB(0, 1), cB + hstep, voffB); PG8_STAGE(PG8_SA(0, 1), cA + hstep, voffA);
        if (wr == 1) PG8_BAR;
        PG8_WAIT_V(4); PG8_BAR;
        PG8_STAGE(PG8_SB(1, 0), cB + kstep, voffB); PG8_STAGE(PG8_SA(1, 0), cA + kstep, voffA); PG8_STAGE(PG8_SB(1, 1), cB + hstep + kstep, voffB);
        PG8_WAIT_V(6); PG8_BAR;
    }
    for (;;) {
        const bool has_next = S.next(ui + 1, nxt);
        const char* nA = has_next ? (const char*)g.A + (size_t)nxt.pm * tstep : cA; const char* nB = has_next ? (const char*)g.Bt + (size_t)nxt.pn * tstep : cB;
        for (int t = 0; t < nt; t += 2) {
            const bool last = (t == nt - 2);
            const char* a1 = cA + (size_t)(t + 1) * kstep;
            const char* a2 = last ? nA : cA + (size_t)(t + 2) * kstep; const char* b2 = last ? nB : cB + (size_t)(t + 2) * kstep;
            const char* a3 = a2 + kstep; const char* b3 = b2 + kstep;
            if (last && has_next) S.a_ready(nxt);
            if constexpr (SP2) {
            PG8_LDB(B0, 0, 0); PG8_LDB(B1, 0, 1); PG8_SCHED; PG8_LDA(At, 0, 0); PG8_STAGE(PG8_SA(1, 1), a1 + hstep, voffA);
            PG8_WAIT_V(8); PG8_WAIT_L(0); PG8_BAR; PG8_MMA(0, 0, At, B0); PG8_MMA(0, 1, At, B1); PG8_BAR; PG8_SCHED;
            PG8_LDA(At, 0, 1); PG8_STAGE(PG8_SB(0, 0), b2, voffB); PG8_STAGE(PG8_SB(0, 1), b2 + hstep, voffB); PG8_STAGE(PG8_SA(0, 0), a2, voffA);
            PG8_WAIT_V(8); PG8_WAIT_L(0); PG8_BAR; PG8_MMA(1, 0, At, B0); PG8_MMA(1, 1, At, B1); PG8_BAR; PG8_SCHED;
            PG8_LDB(B0, 1, 0); PG8_LDB(B1, 1, 1); PG8_SCHED; PG8_LDA(At, 1, 0); PG8_STAGE(PG8_SA(0, 1), a2 + hstep, voffA);
            PG8_WAIT_V(8); PG8_WAIT_L(0); PG8_BAR; PG8_MMA(0, 0, At, B0); PG8_MMA(0, 1, At, B1); PG8_BAR; PG8_SCHED;
            PG8_LDA(At, 1, 1); PG8_STAGE(PG8_SB(1, 0), b3, voffB); PG8_STAGE(PG8_SB(1, 1), b3 + hstep, voffB); PG8_STAGE(PG8_SA(1, 0), a3, voffA);
            PG8_WAIT_V(8); PG8_WAIT_L(0); PG8_BAR; PG8_MMA(1, 0, At, B0); PG8_MMA(1, 1, At, B1); PG8_BAR; PG8_SCHED;
            } else {
            PG8_LDB(B0, 0, 0); PG8_SCHED; PG8_LDA(At, 0, 0); PG8_STAGE(PG8_SA(1, 1), a1 + hstep, voffA);
            PG8_WAIT_L(8); PG8_BAR; PG8_WAIT_L(0); PG8_MMA(0, 0, At, B0); PG8_BAR; PG8_SCHED;
            PG8_LDB(B1, 0, 1); PG8_STAGE(PG8_SB(0, 0), b2, voffB);
            PG8_BAR; PG8_WAIT_L(0); PG8_MMA(0, 1, At, B1); PG8_BAR;
            PG8_LDA(At, 0, 1); PG8_STAGE(PG8_SA(0, 0), a2, voffA);
            PG8_BAR; PG8_WAIT_L(0); PG8_MMA(1, 0, At, B0); PG8_BAR; PG8_SCHED;
            PG8_STAGE(PG8_SB(0, 1), b2 + hstep, voffB);
            PG8_WAIT_V(6); PG8_BAR; PG8_MMA(1, 1, At, B1); PG8_BAR;
            PG8_LDB(B0, 1, 0); PG8_SCHED; PG8_LDA(At, 1, 0); PG8_STAGE(PG8_SA(0, 1), a2 + hstep, voffA);
            PG8_WAIT_L(8); PG8_BAR; PG8_WAIT_L(0); PG8_MMA(0, 0, At, B0); PG8_BAR; PG8_SCHED;
            PG8_LDB(B1, 1, 1); PG8_STAGE(PG8_SB(1, 0), b3, voffB);
            PG8_BAR; PG8_WAIT_L(0); PG8_MMA(0, 1, At, B1); PG8_BAR;
            PG8_LDA(At, 1, 1); PG8_STAGE(PG8_SA(1, 0), a3, voffA);
            PG8_BAR; PG8_WAIT_L(0); PG8_MMA(1, 0, At, B0); PG8_BAR; PG8_SCHED;
            PG8_STAGE(PG8_SB(1, 1), b3 + hstep, voffB);
            PG8_WAIT_V(6); PG8_BAR; PG8_MMA(1, 1, At, B1); PG8_BAR;
            }
        }
        if constexpr (ALIGN_EPI) { if (wr == 0) PG8_BAR; }
        if constexpr (!Epi::AFTER_DRAIN) { E(acc, cur, wr, wc, fr, fq); S.done(cur); }
        if (!has_next) break;
#pragma unroll
        for (int a = 0; a < 2; ++a)
#pragma unroll
            for (int b = 0; b < 2; ++b)
#pragma unroll
                for (int m = 0; m < 4; ++m)
#pragma unroll
                    for (int n = 0; n < 2; ++n) acc[a][b][m][n] = (f32x4){0.f, 0.f, 0.f, 0.f};
        cur = nxt; cA = nA; cB = nB; ++ui;
        if constexpr (ALIGN_EPI) { if (wr == 1) PG8_BAR; }
    }
    PG8_WAIT_V(0);
    if constexpr (!ALIGN_EPI) { if (wr == 0) PG8_BAR; }
    PG8_BAR;
    if constexpr (Epi::AFTER_DRAIN) { E.fused(acc, cur, wr, wc, fr, fq, lds, wid, lane); S.done(cur); }
#undef PG8_SA
#undef PG8_SB
#undef PG8_STAGE
#undef PG8_LDA
#undef PG8_LDB
#undef PG8_MMA
#undef PG8_WAIT_V
#undef PG8_WAIT_L
#undef PG8_BAR
#undef PG8_SCHED
}
}

namespace cg = cooperative_groups;
constexpr int NWAVES = 8;
constexpr int BATCH = 2, T = 8192, D = 1024, H = 8, DH = 128, DFF = 2816, NB = 32, BLK = 256;
constexpr int M = BATCH * T;
constexpr float EPS = 1e-6f;
constexpr size_t MiB = 1u << 20;
constexpr size_t WS_CTL = 0;
constexpr size_t WS_WQKV = 1 * MiB, WS_WOUT1 = 7 * MiB, WS_W13_1 = 9 * MiB, WS_W2_1 = 20 * MiB;
constexpr size_t WS_WIN0 = 26 * MiB, WS_WOUT0 = 34 * MiB, WS_W13_0 = 36 * MiB, WS_W2_0 = 47 * MiB;
constexpr size_t WS_SSQ = 53 * MiB;
constexpr size_t WS_SSQH = 54 * MiB;
constexpr size_t WS_LB = 54 * MiB + 512 * 1024;
constexpr size_t WS_BKT = WS_LB + 4096;
constexpr size_t WS_YMEAN = WS_BKT + 32768;
constexpr size_t WS_KMEAN = WS_YMEAN + 262144;
constexpr size_t WS_SEL = 55 * MiB + 512 * 1024;
constexpr size_t WS_G = 56 * MiB;
constexpr size_t WS_A0 = 60 * MiB;
constexpr size_t WS_A1 = 92 * MiB;
constexpr size_t WS_A2 = 124 * MiB;
constexpr size_t WS_A3 = 188 * MiB;
constexpr size_t WS_A4 = 220 * MiB;
constexpr size_t WS_END = 256 * MiB;
static_assert(WS_W2_0 + (size_t)D * DFF * 2 <= WS_SSQ && WS_G + 2 * MiB <= WS_A0 && WS_A4 + 32 * MiB <= WS_END, "ws map");

constexpr int LDS_BYTES = 147456;
constexpr int LDS_MISC = 147200;
constexpr size_t WS_BAR = 65536;

#define GAS __attribute__((address_space(1)))
#define LAS __attribute__((address_space(3)))
typedef unsigned short bf16;
typedef unsigned v4u __attribute__((ext_vector_type(4)));
typedef float f32x4 __attribute__((ext_vector_type(4)));
#define LDS_WAIT() asm volatile("s_waitcnt lgkmcnt(0)" ::: "memory")
__device__ __forceinline__ unsigned f2bf(float f) { unsigned u = __builtin_bit_cast(unsigned, f); return (u + 0x7fffu + ((u >> 16) & 1u)) >> 16; }
__device__ __forceinline__ unsigned pk2(float lo, float hi) { return f2bf(lo) | (f2bf(hi) << 16); }
__device__ __forceinline__ float bf2f(unsigned short b) { return __uint_as_float((unsigned)b << 16); }
__device__ __forceinline__ float wave_sum(float v) {
#pragma unroll
    for (int o = 1; o < 64; o <<= 1) v += __shfl_xor(v, o);
    return v;
}

struct Args {
    const float* x; const float* norm_mix; const float* norm_ffn; const float* hgrn_w_in; const float* lb_logits; const float* hgrn_out_norm; const float* hgrn_w_out;
    const float* moba_w_in; const float* moba_w_out; const float* rel_table; const float* ffn_w13; const float* ffn_w2; const float* final_norm;
    float* out; unsigned char* ws; int ph_lo, ph_hi;
};

__device__ __forceinline__ void tr_item(const float* W, int ldw, int K, bf16* WT, int Ndst, const float* gain, int mode, LAS float* scr, int item, int lane) {
    const int nblk = Ndst / 32, kb = item / nblk, nb = item % nblk, k0 = 64 * kb, n0 = 32 * nb;
    int s0 = n0;
    if (mode == 1) { const int t = n0 >> 8, c = n0 & 255; s0 = (c < 128) ? (128 * t + c) : (DFF + 128 * t + (c - 128)); }
#pragma unroll 8
    for (int i = 0; i < 32; ++i) { const int kk = 2 * i + (lane >> 5); float w = W[(size_t)(k0 + kk) * ldw + s0 + (lane & 31)]; if (gain) w *= gain[k0 + kk]; scr[kk * 33 + (lane & 31)] = w; }
    LDS_WAIT(); asm volatile("" ::: "memory");
    const int c = lane & 7;
#pragma unroll
    for (int j = 0; j < 4; ++j) { const int n = (lane >> 3) + 8 * j; const LAS float* s = scr + (8 * c) * 33 + n;
        v4u o; o.x = pk2(s[0 * 33], s[1 * 33]); o.y = pk2(s[2 * 33], s[3 * 33]); o.z = pk2(s[4 * 33], s[5 * 33]); o.w = pk2(s[6 * 33], s[7 * 33]);
        *(GAS v4u*)(WT + (size_t)(n0 + n) * K + k0 + 8 * c) = o; }
    LDS_WAIT(); asm volatile("" ::: "memory");
}

__device__ __forceinline__ void prologue(const Args& a, LAS unsigned char* lds, int tid, int lane, int wave) {
    unsigned char* ws = a.ws;
    LAS float* scr = (LAS float*)(lds + wave * 16384);
    const int gw = blockIdx.x * NWAVES + wave, NGW = gridDim.x * NWAVES;
    constexpr int I_IN0 = (D / 64) * (4096 / 32), I_O = (D / 64) * (D / 32), I_13 = (D / 64) * (2 * DFF / 32), I_2 = (DFF / 64) * (D / 32), I_QKV = (D / 64) * (3072 / 32);
    constexpr int NITEMS = I_IN0 + I_O + I_13 + I_2 + I_QKV + I_O + I_13 + I_2;
    for (int it = gw; it < NITEMS; it += NGW) {
        int r = it;
        if (r < I_IN0) { tr_item(a.hgrn_w_in, 4096, D, (bf16*)(ws + WS_WIN0), 4096, nullptr, 0, scr, r, lane); continue; } r -= I_IN0;
        if (r < I_O) { tr_item(a.hgrn_w_out, D, D, (bf16*)(ws + WS_WOUT0), D, a.hgrn_out_norm, 0, scr, r, lane); continue; } r -= I_O;
        if (r < I_13) { tr_item(a.ffn_w13, 2 * DFF, D, (bf16*)(ws + WS_W13_0), 2 * DFF, a.norm_ffn, 1, scr, r, lane); continue; } r -= I_13;
        if (r < I_2) { tr_item(a.ffn_w2, D, DFF, (bf16*)(ws + WS_W2_0), D, nullptr, 0, scr, r, lane); continue; } r -= I_2;
        if (r < I_QKV) { tr_item(a.moba_w_in, 3072, D, (bf16*)(ws + WS_WQKV), 3072, a.norm_mix + D, 0, scr, r, lane); continue; } r -= I_QKV;
        if (r < I_O) { tr_item(a.moba_w_out, D, D, (bf16*)(ws + WS_WOUT1), D, nullptr, 0, scr, r, lane); continue; } r -= I_O;
        if (r < I_13) { tr_item(a.ffn_w13 + (size_t)D * 2 * DFF, 2 * DFF, D, (bf16*)(ws + WS_W13_1), 2 * DFF, a.norm_ffn + D, 1, scr, r, lane); continue; } r -= I_13;
        tr_item(a.ffn_w2 + (size_t)DFF * D, D, DFF, (bf16*)(ws + WS_W2_1), D, nullptr, 0, scr, r, lane);
    }
    bf16* XN0 = (bf16*)(ws + WS_A0);
    for (int m = gw; m < M; m += NGW) {
        const GAS f32x4* xr = (const GAS f32x4*)(a.x + (size_t)m * D) + lane;
        f32x4 v[4]; float s = 0.f;
#pragma unroll
        for (int j = 0; j < 4; ++j) { v[j] = xr[64 * j]; s += (v[j].x * v[j].x + v[j].y * v[j].y) + (v[j].z * v[j].z + v[j].w * v[j].w); }
        const float rstd = rsqrtf(wave_sum(s) * (1.f / D) + EPS);
        GAS unsigned long long* o8 = (GAS unsigned long long*)(XN0 + (size_t)m * D) + lane;
#pragma unroll
        for (int j = 0; j < 4; ++j) { const f32x4 g = *((const GAS f32x4*)a.norm_mix + lane + 64 * j);
            o8[64 * j] = (unsigned long long)pk2(v[j].x * rstd * g.x, v[j].y * rstd * g.y) | ((unsigned long long)pk2(v[j].z * rstd * g.z, v[j].w * rstd * g.w) << 32); }
    }
    if (blockIdx.x == 0) {
        float* lb = (float*)(ws + WS_LB); int* bkt = (int*)(ws + WS_BKT);
        for (int i = tid; i < 1024; i += NWAVES * 64) { const float l0 = a.lb_logits[i], l1 = a.lb_logits[1024 + i]; const float mx = fmaxf(l0, l1); const float e0 = expf(l0 - mx), e1 = expf(l1 - mx); lb[i] = e0 / (e0 + e1); }
        for (int i = tid; i < T; i += NWAVES * 64) {
            int bk;
            if (i < 16) bk = i;
            else { const float nf = (float)i; const float v = logf(nf / 16.f) / 4.1588830833596715f * 16.f; bk = 16 + (int)v; if (bk > 31) bk = 31; }
            bkt[i] = bk;
            if (i < 1024) { float* tab2 = (float*)(ws + WS_YMEAN);
#pragma unroll
                for (int hh = 0; hh < 8; ++hh) tab2[hh * 1024 + i] = a.rel_table[bk * 8 + hh] * 1.4426950408889634f; }
        }
        for (int i = tid; i < 512; i += NWAVES * 64) ((unsigned*)(ws + 4096))[i] = 0u;
        for (int i = tid; i < 3456; i += NWAVES * 64) ((unsigned*)(ws + WS_BAR))[i] = 0u;
    }
}

__device__ __forceinline__ void final_norm_phase(const Args& a, int lane, int wave) {
    const int gw = blockIdx.x * NWAVES + wave, NGW = gridDim.x * NWAVES;
    const float* SSQ = (const float*)(a.ws + WS_SSQ);
    for (int m = gw; m < M; m += NGW) {
        const float rstd = pg8::rstd_from16(SSQ + (size_t)m * 16);
        GAS f32x4* xr = (GAS f32x4*)(a.out + (size_t)m * D) + lane;
#pragma unroll
        for (int j = 0; j < 4; ++j) { const f32x4 g = *((const GAS f32x4*)a.final_norm + lane + 64 * j); f32x4 v = xr[64 * j]; v = v * rstd * g; xr[64 * j] = v; }
    }
}

__device__ __forceinline__ float sigmoidf_(float x) { return 1.f / (1.f + __expf(-x)); }

__device__ __forceinline__ void kmean_phase(const Args& a, int tid) {
    const bf16* K = (const bf16*)(a.ws + WS_A2) + (size_t)M * D; float* kmean = (float*)(a.ws + WS_KMEAN);
    for (int it = blockIdx.x; it < 128; it += gridDim.x) {
        const int bn = it >> 1, col = (it & 1) * 512 + tid;
        float s = 0.f;
        for (int r = 0; r < 256; ++r) s += bf2f(K[(size_t)(bn * 256 + r) * D + col]);
        kmean[bn * D + col] = s * (1.f / 256.f);
    }
}

namespace moba {
using bf16x8 = __attribute__((ext_vector_type(8))) short;
using s16x4 = __attribute__((ext_vector_type(4))) short;
using f32x16 = __attribute__((ext_vector_type(16))) float;
using u32x4 = __attribute__((ext_vector_type(4))) unsigned;
#define KSWZ(row, colB) ((row) * 256 + ((colB) ^ (((row) & 7) << 4)))
#define SBAR() __builtin_amdgcn_sched_barrier(0)
constexpr float C2 = 0.08838834764831845f * 1.4426950408889634f;
constexpr float LOG2E = 1.4426950408889634f;
__device__ __forceinline__ int crow(int r, int hi) { return (r & 3) + 8 * (r >> 2) + 4 * hi; }
__device__ __forceinline__ unsigned cvtpk(float lo, float hi) { unsigned r; asm volatile("v_cvt_pk_bf16_f32 %0, %1, %2" : "=v"(r) : "v"(lo), "v"(hi)); return r; }
__device__ __forceinline__ int v_st(int k, int c) { const int kk = (k & ~0xC) | ((k & 4) << 1) | ((k & 8) >> 1); return ((kk >> 3) * 4 + (c >> 5)) * 512 + ((kk & 7) * 32 + (c & 31)) * 2; }
__device__ __forceinline__ int v_rd_base(int lane) { return ((lane & 3) << 3) | (((lane >> 2) & 3) << 6) | (((lane >> 4) & 1) << 5) | (((lane >> 5) & 1) << 8); }
constexpr int v_rd_off(int d0, int ks, int half) { return d0 * 512 + ks * 4096 + half * 2048; }
template <int OFF> __device__ __forceinline__ s16x4 tr_read(int vb) {
    s16x4 r; asm volatile("ds_read_b64_tr_b16 %0, %1 offset:%2" : "=&v"(r) : "v"(vb), "i"(OFF) : "memory"); return r;
}
template <int D0> __device__ __forceinline__ void pv_one(f32x16& od, int vb, bf16x8 pa0, bf16x8 pa1, bf16x8 pa2, bf16x8 pa3) {
    const s16x4 l0 = tr_read<v_rd_off(D0, 0, 0)>(vb), h0 = tr_read<v_rd_off(D0, 0, 1)>(vb), l1 = tr_read<v_rd_off(D0, 1, 0)>(vb), h1 = tr_read<v_rd_off(D0, 1, 1)>(vb);
    const s16x4 l2 = tr_read<v_rd_off(D0, 2, 0)>(vb), h2 = tr_read<v_rd_off(D0, 2, 1)>(vb), l3 = tr_read<v_rd_off(D0, 3, 0)>(vb), h3 = tr_read<v_rd_off(D0, 3, 1)>(vb);
    asm volatile("s_waitcnt lgkmcnt(0)" ::: "memory"); SBAR();
#define PK(L, Hh) (bf16x8){L[0], L[1], L[2], L[3], Hh[0], Hh[1], Hh[2], Hh[3]}
    od = __builtin_amdgcn_mfma_f32_32x32x16_bf16(pa0, PK(l0, h0), od, 0, 0, 0);
    od = __builtin_amdgcn_mfma_f32_32x32x16_bf16(pa1, PK(l1, h1), od, 0, 0, 0);
    od = __builtin_amdgcn_mfma_f32_32x32x16_bf16(pa2, PK(l2, h2), od, 0, 0, 0);
    od = __builtin_amdgcn_mfma_f32_32x32x16_bf16(pa3, PK(l3, h3), od, 0, 0, 0);
#undef PK
}
__device__ __forceinline__ void qkt(f32x16& p0, f32x16& p1, const LAS unsigned char* Ks, const bf16x8 (&qr)[8], int r32, int hi) {
    p0 = f32x16{}; p1 = f32x16{};
#pragma unroll
    for (int d0 = 0; d0 < 8; ++d0) { const int cb = (d0 * 16 + hi * 8) * 2;
        const bf16x8 b0 = *(const LAS bf16x8*)(Ks + KSWZ(r32, cb));
        const bf16x8 b1 = *(const LAS bf16x8*)(Ks + KSWZ(32 + r32, cb));
        p0 = __builtin_amdgcn_mfma_f32_32x32x16_bf16(b0, qr[d0], p0, 0, 0, 0);
        p1 = __builtin_amdgcn_mfma_f32_32x32x16_bf16(b1, qr[d0], p1, 0, 0, 0); }
}
__device__ __forceinline__ void softmax_step(f32x16& p0, f32x16& p1, float& m_reg, float& l_reg, float& alpha, bf16x8& pa0, bf16x8& pa1, bf16x8& pa2, bf16x8& pa3) {
    float pmax = p0[0];
#pragma unroll
    for (int r = 1; r < 16; ++r) pmax = fmaxf(pmax, p0[r]);
#pragma unroll
    for (int r = 0; r < 16; ++r) pmax = fmaxf(pmax, p1[r]);
    { auto rr = __builtin_amdgcn_permlane32_swap(__float_as_uint(pmax), __float_as_uint(pmax), false, false);
      pmax = fmaxf(__uint_as_float(rr[0]), __uint_as_float(rr[1])); }
    const float mn = fmaxf(m_reg, pmax);
    alpha = __builtin_amdgcn_exp2f(m_reg - mn); m_reg = mn;
#pragma unroll
    for (int r = 0; r < 16; ++r) { p0[r] = __builtin_amdgcn_exp2f(p0[r] - mn); p1[r] = __builtin_amdgcn_exp2f(p1[r] - mn); }
    float ps = 0.f;
#pragma unroll
    for (int r = 0; r < 16; ++r) ps += p0[r];
#pragma unroll
    for (int r = 0; r < 16; ++r) ps += p1[r];
    { auto rr = __builtin_amdgcn_permlane32_swap(__float_as_uint(ps), __float_as_uint(ps), false, false);
      ps = __uint_as_float(rr[0]) + __uint_as_float(rr[1]); }
    l_reg = l_reg * alpha + ps;
#define PK4(P, BASE, OUT) do { unsigned a0 = cvtpk(P[BASE + 0], P[BASE + 1]), a1 = cvtpk(P[BASE + 2], P[BASE + 3]);   \
    unsigned b0 = cvtpk(P[BASE + 4], P[BASE + 5]), b1 = cvtpk(P[BASE + 6], P[BASE + 7]);                              \
    auto r0 = __builtin_amdgcn_permlane32_swap(a0, b0, false, false); auto r1 = __builtin_amdgcn_permlane32_swap(a1, b1, false, false); \
    u32x4 w = {r0[0], r1[0], r0[1], r1[1]}; OUT = *reinterpret_cast<bf16x8*>(&w); } while (0)
    PK4(p0, 0, pa0); PK4(p0, 8, pa1); PK4(p1, 0, pa2); PK4(p1, 8, pa3);
#undef PK4
}

constexpr int L_V = 0, L_K = 65536, L_TAB = 131072, L_WSCR = 135168, L_SCHED = 143360;

__device__ __forceinline__ void load_kv_block(LAS unsigned char* lds, const bf16* Kh, const bf16* Vh, int tid) {
    const int sr = tid >> 4, sc = (tid & 15) * 8;
#pragma unroll
    for (int kt = 0; kt < 4; ++kt) {
        const bf16x8 k0 = *(const bf16x8*)(Kh + (size_t)(kt * 64 + sr) * D + sc), k1 = *(const bf16x8*)(Kh + (size_t)(kt * 64 + 32 + sr) * D + sc);
        const bf16x8 v0 = *(const bf16x8*)(Vh + (size_t)(kt * 64 + sr) * D + sc), v1 = *(const bf16x8*)(Vh + (size_t)(kt * 64 + 32 + sr) * D + sc);
        *(LAS bf16x8*)(lds + L_K + kt * 16384 + KSWZ(sr, sc * 2)) = k0;
        *(LAS bf16x8*)(lds + L_K + kt * 16384 + KSWZ(32 + sr, sc * 2)) = k1;
        *(LAS bf16x8*)(lds + L_V + kt * 16384 + v_st(sr, sc)) = v0;
        *(LAS bf16x8*)(lds + L_V + kt * 16384 + v_st(32 + sr, sc)) = v1;
    }
}

template <bool CAUSAL>
__device__ __forceinline__ void wave_flash(LAS unsigned char* lds, const bf16x8 (&qr)[8], int qpos_rel, int ntile, int lane, int wid, f32x16 (&o)[4], float& m_reg, float& l_reg) {
    const int r32 = lane & 31, hi = lane >> 5;
    const LAS float* tab2 = (const LAS float*)(lds + L_TAB);
    LAS float* al_l = (LAS float*)(lds + L_WSCR + wid * 1024);
    const int vb0 = (int)(unsigned long)(lds + L_V) + v_rd_base(lane);
    const bool far = !CAUSAL && __all(qpos_rel - 255 >= 1023);
    const float cfar = tab2[1023];
    for (int kt = 0; kt < ntile; ++kt) {
        f32x16 p0, p1;
        qkt(p0, p1, lds + L_K + kt * 16384, qr, r32, hi);
        if (far) {
#pragma unroll
            for (int r = 0; r < 16; ++r) { p0[r] = fmaf(p0[r], C2, cfar); p1[r] = fmaf(p1[r], C2, cfar); }
        } else {
#pragma unroll
            for (int r = 0; r < 16; ++r) {
                const int d0_ = qpos_rel - (kt * 64 + crow(r, hi)), d1_ = d0_ - 32;
                const float b0 = tab2[min(max(d0_, 0), 1023)], b1 = tab2[min(max(d1_, 0), 1023)];
                float t0 = fmaf(p0[r], C2, b0), t1 = fmaf(p1[r], C2, b1);
                if (CAUSAL) { if (d0_ < 0) t0 = -1e30f; if (d1_ < 0) t1 = -1e30f; }
                p0[r] = t0; p1[r] = t1;
            }
        }
        float alpha; bf16x8 pa0, pa1, pa2, pa3;
        softmax_step(p0, p1, m_reg, l_reg, alpha, pa0, pa1, pa2, pa3);
        if (__any(alpha < 1.f)) {
            if (hi == 0) al_l[r32] = alpha;
            asm volatile("s_waitcnt lgkmcnt(0)" ::: "memory");
#pragma unroll
            for (int r = 0; r < 16; ++r) { const float av = al_l[crow(r, hi)];
#pragma unroll
                for (int d = 0; d < 4; ++d) o[d][r] *= av; }
        }
        const int vb = vb0 + kt * 16384;
        pv_one<0>(o[0], vb, pa0, pa1, pa2, pa3); pv_one<1>(o[1], vb, pa0, pa1, pa2, pa3); pv_one<2>(o[2], vb, pa0, pa1, pa2, pa3); pv_one<3>(o[3], vb, pa0, pa1, pa2, pa3);
    }
}
}

constexpr size_t WS_CNT = 4096;
constexpr size_t WS_TAB2 = WS_YMEAN;
constexpr size_t WS_LIST = WS_WIN0;
constexpr size_t WS_LSE = WS_G;
constexpr size_t WS_PO0 = WS_A0, WS_PO1 = WS_A1, WS_PO2 = WS_A4;

__device__ __forceinline__ void topk_phase(const Args& a, LAS unsigned char* lds, int tid, int lane, int wid) {
    using namespace moba;
    const bf16* Q = (const bf16*)(a.ws + WS_A2); const float* kmean = (const float*)(a.ws + WS_KMEAN);
    unsigned* cnt = (unsigned*)(a.ws + WS_CNT); unsigned short* lists = (unsigned short*)(a.ws + WS_LIST);
    LAS unsigned* lcnt = (LAS unsigned*)lds;
    const int r32 = lane & 31, hi = lane >> 5;
    for (int it = blockIdx.x; it < 512; it += gridDim.x) {
        const int bh = it >> 5, j = it & 31, b = bh >> 3, h = bh & 7;
        if (j == 0) continue;
        __syncthreads();
        if (tid < 64) lcnt[tid] = 0u;
        __syncthreads();
        bf16x8 ahi[8], alo[8];
        const float* kp = kmean + (size_t)(b * 32 + r32) * D + h * 128 + hi * 8;
#pragma unroll
        for (int ks = 0; ks < 8; ++ks) {
            const f32x4 v0 = *(const f32x4*)(kp + 16 * ks), v1 = *(const f32x4*)(kp + 16 * ks + 4);
            const unsigned h0 = pk2(v0[0], v0[1]), h1 = pk2(v0[2], v0[3]), h2 = pk2(v1[0], v1[1]), h3 = pk2(v1[2], v1[3]);
            const unsigned l0 = pk2(v0[0] - __uint_as_float(h0 << 16), v0[1] - __uint_as_float(h0 & 0xffff0000u)), l1 = pk2(v0[2] - __uint_as_float(h1 << 16), v0[3] - __uint_as_float(h1 & 0xffff0000u));
            const unsigned l2 = pk2(v1[0] - __uint_as_float(h2 << 16), v1[1] - __uint_as_float(h2 & 0xffff0000u)), l3 = pk2(v1[2] - __uint_as_float(h3 << 16), v1[3] - __uint_as_float(h3 & 0xffff0000u));
            u32x4 wh = {h0, h1, h2, h3}, wl = {l0, l1, l2, l3};
            ahi[ks] = *reinterpret_cast<bf16x8*>(&wh); alo[ks] = *reinterpret_cast<bf16x8*>(&wl);
        }
        const int qpos = j * 256 + wid * 32 + r32, m = b * T + qpos;
        const bf16* Qw = Q + (size_t)m * D + h * 128 + hi * 8;
        f32x16 gacc = {};
#pragma unroll
        for (int ks = 0; ks < 8; ++ks) { const bf16x8 qv = *(const bf16x8*)(Qw + 16 * ks);
            gacc = __builtin_amdgcn_mfma_f32_32x32x16_bf16(ahi[ks], qv, gacc, 0, 0, 0);
            gacc = __builtin_amdgcn_mfma_f32_32x32x16_bf16(alo[ks], qv, gacc, 0, 0, 0); }
        float cv[6]; int ci[6];
        unsigned usedm = 0u;
#pragma unroll
        for (int s = 0; s < 3; ++s) { int best = 0; float val = -INFINITY; bool have = false;
#pragma unroll
            for (int r = 0; r < 16; ++r) { const float gv = (crow(r, hi) < j) ? gacc[r] : -INFINITY; const bool free_ = !((usedm >> r) & 1u); if (free_ && (!have || gv > val)) { best = r; val = gv; have = true; } }
            usedm |= 1u << best; cv[s] = val; ci[s] = crow(best, hi); }
#pragma unroll
        for (int s = 0; s < 3; ++s) { cv[3 + s] = __shfl_xor(cv[s], 32); ci[3 + s] = __shfl_xor(ci[s], 32); }
        int selv[3]; unsigned um = 0u;
#pragma unroll
        for (int s = 0; s < 3; ++s) { int best = 0; float val = 0.f; int bidx = 0; bool have = false;
#pragma unroll
            for (int c = 0; c < 6; ++c) { const bool free_ = !((um >> c) & 1u); if (free_ && (!have || cv[c] > val || (cv[c] == val && ci[c] < bidx))) { best = c; val = cv[c]; bidx = ci[c]; have = true; } }
            um |= 1u << best; selv[s] = bidx; }
        unsigned lpos[3] = {0u, 0u, 0u};
        if (hi == 0) {
#pragma unroll
            for (int s = 0; s < 3; ++s) if (s < j) lpos[s] = atomicAdd((unsigned*)&lcnt[selv[s]], 1u);
        }
        __syncthreads();
        if (tid < 32) { const unsigned c = lcnt[tid]; unsigned base = 0u; if (c) base = atomicAdd(&cnt[bh * 32 + tid], c); lcnt[32 + tid] = base; }
        __syncthreads();
        if (hi == 0) {
#pragma unroll
            for (int s = 0; s < 3; ++s)
                if (s < j) lists[(size_t)(bh * 32 + selv[s]) * 8192 + lcnt[32 + selv[s]] + lpos[s]] = (unsigned short)(qpos | (s << 13));
        }
    }
}

__device__ __forceinline__ void attn_sel_phase(const Args& a, LAS unsigned char* lds, int tid, int lane, int wid) {
    using namespace moba;
    const bf16* Q = (const bf16*)(a.ws + WS_A2); const bf16* K = Q + (size_t)M * D; const bf16* V = K + (size_t)M * D;
    const unsigned* cnt = (const unsigned*)(a.ws + WS_CNT); const unsigned short* lists = (const unsigned short*)(a.ws + WS_LIST);
    const float* tab2g = (const float*)(a.ws + WS_TAB2); float* LSE = (float*)(a.ws + WS_LSE);
    LAS int* P = (LAS int*)(lds + L_SCHED);
    {
        const int ns = ((int)cnt[tid] + 31) >> 5;
        int v = ns;
#pragma unroll
        for (int o = 1; o < 64; o <<= 1) { const int t = __shfl_up(v, o); if (lane >= o) v += t; }
        LAS int* wt = (LAS int*)(lds + L_WSCR);
        if (lane == 63) wt[wid] = v;
        __syncthreads();
        int off = 0;
        for (int w = 0; w < wid; ++w) off += wt[w];
        P[tid + 1] = off + v;
        if (tid == 0) P[0] = 0;
        __syncthreads();
    }
    const int total = P[512];
    const int lo = (int)(((long)blockIdx.x * total) / gridDim.x), hiE = (int)(((long)(blockIdx.x + 1) * total) / gridDim.x);
    int li = 0;
    { int a_ = 0, b_ = 512; while (b_ - a_ > 1) { const int mid = (a_ + b_) >> 1; if (P[mid] <= lo) a_ = mid; else b_ = mid; } li = a_; }
    const int r32 = lane & 31, hi = lane >> 5;
    for (; li < 512 && P[li] < hiE; ++li) {
        const int p0_ = P[li], p1_ = P[li + 1];
        if (p1_ <= lo || p1_ == p0_) continue;
        const int seg_lo = max(lo, p0_) - p0_, seg_hi = min(hiE, p1_) - p0_;
        const int b = li >> 8, h = (li >> 5) & 7, n = li & 31;
        const int L = (int)cnt[li];
        __syncthreads();
        load_kv_block(lds, K + (size_t)(b * T + n * 256) * D + h * 128, V + (size_t)(b * T + n * 256) * D + h * 128, tid);
        for (int e = tid; e < 1024; e += 512) ((LAS float*)(lds + L_TAB))[e] = tab2g[h * 1024 + e];
        __syncthreads();
        const unsigned short* lp = lists + (size_t)li * 8192;
        for (int st = seg_lo + wid; st < seg_hi; st += 8) {
            const int e = st * 32 + r32; const bool valid = e < L;
            const unsigned ent = lp[valid ? e : (L - 1)];
            const int qpos = ent & 8191, slot = ent >> 13, m = b * T + qpos;
            bf16x8 qr[8];
            const bf16* Qw = Q + (size_t)m * D + h * 128 + hi * 8;
#pragma unroll
            for (int d0 = 0; d0 < 8; ++d0) qr[d0] = *(const bf16x8*)(Qw + d0 * 16);
            f32x16 o[4] = {}; float m_reg = -1e30f, l_reg = 0.f;
            wave_flash<false>(lds, qr, qpos - n * 256, 4, lane, wid, o, m_reg, l_reg);
            LAS float* li_l = (LAS float*)(lds + L_WSCR + wid * 1024 + 128);
            LAS int* row_l = (LAS int*)(lds + L_WSCR + wid * 1024 + 256);
            if (hi == 0) { li_l[r32] = __builtin_amdgcn_rcpf(l_reg); row_l[r32] = valid ? ((slot << 20) | m) : -1;
                if (valid) LSE[((size_t)slot * M + m) * 8 + h] = m_reg + __builtin_amdgcn_logf(l_reg); }
            asm volatile("s_waitcnt lgkmcnt(0)" ::: "memory");
#pragma unroll
            for (int r = 0; r < 16; ++r) {
                const int rw = crow(r, hi); const float rl = li_l[rw]; const int rm = row_l[rw];
                if (rm >= 0) {
                    const int sl = rm >> 20, mm = rm & 0xfffff;
                    bf16* po = (bf16*)(a.ws + (sl == 0 ? WS_PO0 : (sl == 1 ? WS_PO1 : WS_PO2))) + (size_t)mm * D + h * 128 + r32;
#pragma unroll
                    for (int d0 = 0; d0 < 4; ++d0) po[d0 * 32] = (bf16)f2bf(o[d0][r] * rl);
                }
            }
        }
    }
}

__device__ __forceinline__ void attn_own_phase(const Args& a, LAS unsigned char* lds, int tid, int lane, int wid) {
    using namespace moba;
    bf16* Q = (bf16*)(a.ws + WS_A2); const bf16* K = Q + (size_t)M * D; const bf16* V = K + (size_t)M * D;
    const float* tab2g = (const float*)(a.ws + WS_TAB2); const float* LSE = (const float*)(a.ws + WS_LSE);
    const int r32 = lane & 31, hi = lane >> 5;
    for (int u = blockIdx.x; u < 512; u += gridDim.x) {
        const int b = u >> 8, h = (u >> 5) & 7, n = u & 31;
        __syncthreads();
        load_kv_block(lds, K + (size_t)(b * T + n * 256) * D + h * 128, V + (size_t)(b * T + n * 256) * D + h * 128, tid);
        for (int e = tid; e < 1024; e += 512) ((LAS float*)(lds + L_TAB))[e] = tab2g[h * 1024 + e];
        __syncthreads();
        const int qrel = wid * 32 + r32, m = b * T + n * 256 + qrel;
        bf16x8 qr[8];
        const bf16* Qw = Q + (size_t)m * D + h * 128 + hi * 8;
#pragma unroll
        for (int d0 = 0; d0 < 8; ++d0) qr[d0] = *(const bf16x8*)(Qw + d0 * 16);
        f32x16 o[4] = {}; float m_reg = -1e30f, l_reg = 0.f;
        wave_flash<true>(lds, qr, qrel, (wid >> 1) + 1, lane, wid, o, m_reg, l_reg);
        const int nsel = n < 3 ? n : 3;
        float ls0 = -1e30f, ls1 = -1e30f, ls2 = -1e30f;
        if (nsel > 0) ls0 = LSE[((size_t)0 * M + m) * 8 + h];
        if (nsel > 1) ls1 = LSE[((size_t)1 * M + m) * 8 + h];
        if (nsel > 2) ls2 = LSE[((size_t)2 * M + m) * 8 + h];
        const float lown = m_reg + __builtin_amdgcn_logf(l_reg);
        const float Mx = fmaxf(fmaxf(lown, ls0), fmaxf(ls1, ls2));
        const float e0 = __builtin_amdgcn_exp2f(ls0 - Mx), e1 = __builtin_amdgcn_exp2f(ls1 - Mx), e2 = __builtin_amdgcn_exp2f(ls2 - Mx), eo = __builtin_amdgcn_exp2f(lown - Mx);
        const float iz = __builtin_amdgcn_rcpf((eo + e0) + (e1 + e2));
        LAS float* cf = (LAS float*)(lds + L_WSCR + wid * 1024 + 128);
        if (hi == 0) { cf[r32] = eo * iz * __builtin_amdgcn_rcpf(l_reg); cf[32 + r32] = e0 * iz; cf[64 + r32] = e1 * iz; cf[96 + r32] = e2 * iz; }
        asm volatile("s_waitcnt lgkmcnt(0)" ::: "memory");
        const bf16* P0 = (const bf16*)(a.ws + WS_PO0); const bf16* P1 = (const bf16*)(a.ws + WS_PO1); const bf16* P2 = (const bf16*)(a.ws + WS_PO2);
#pragma unroll
        for (int r = 0; r < 16; ++r) {
            const int rw = crow(r, hi);
            const float c_o = cf[rw], c0 = cf[32 + rw], c1 = cf[64 + rw], c2 = cf[96 + rw];
            const size_t off = (size_t)(b * T + n * 256 + wid * 32 + rw) * D + h * 128 + r32;
#pragma unroll
            for (int d0 = 0; d0 < 4; ++d0) {
                float v = o[d0][r] * c_o;
                if (nsel > 0) v = fmaf(c0, bf2f(P0[off + d0 * 32]), v);
                if (nsel > 1) v = fmaf(c1, bf2f(P1[off + d0 * 32]), v);
                if (nsel > 2) v = fmaf(c2, bf2f(P2[off + d0 * 32]), v);
                Q[off + d0 * 32] = (bf16)f2bf(v);
            }
        }
    }
}
namespace hg {
using namespace moba;
constexpr int H_TQ = 0, H_TK = 16384, H_TKT = 32768, H_TI = 49152, H_SIMG = 65536, H_OST = 98304, H_EL = 132096;
constexpr int OST_LD = 132;
__device__ __forceinline__ int kt_off(int n, int s) { return n * 128 + ((((s >> 3) ^ ((n >> 1) & 7))) << 4) + (s & 7) * 2; }

template <bool PASS_B>
__device__ __forceinline__ void hgrn_unit(const Args& a, LAS unsigned char* lds, int u, int tid, int lane, int wid) {
    unsigned char* ws = a.ws;
    const bf16* QS = (const bf16*)(ws + WS_A1); const float* LF = (const float*)(ws + WS_A2); const bf16* INP = (const bf16*)(ws + WS_A3); const bf16* OG = (const bf16*)(ws + WS_A4);
    bf16* OGATED = (bf16*)(ws + WS_A0); float* SSQH = (float*)(ws + WS_SSQH);
    float* TG = a.out;
    float* DG = a.out + (size_t)256 * 128 * 128;
    const int bh = u >> 4, g = u & 15, b = bh >> 3, h = bh & 7;
    const int r32 = lane & 31, hi = lane >> 5, tb = wid >> 2, db = wid & 3;
    const int nl = lane & 15, tq = lane >> 4, npre = 16 * wid + nl;
    f32x16 Sacc[2] = {};
    float dg = 1.f;
    if (PASS_B) {
        for (int gp = 0; gp < g; ++gp) {
            const float* tg = TG + (size_t)(bh * 16 + gp) * 16384; const float* dgp = DG + (size_t)(bh * 16 + gp) * 128;
#pragma unroll
            for (int i = 0; i < 2; ++i) { const int nb = 2 * tb + i;
#pragma unroll
                for (int r = 0; r < 16; ++r) { const int n = 32 * nb + crow(r, hi); Sacc[i][r] = fmaf(Sacc[i][r], dgp[n], tg[(size_t)n * 128 + 32 * db + r32]); } }
        }
#pragma unroll
        for (int i = 0; i < 2; ++i) { const int nb = 2 * tb + i;
#pragma unroll
            for (int r = 0; r < 16; ++r) { const int n = 32 * nb + crow(r, hi);
                *(LAS unsigned short*)(lds + H_SIMG + (nb >> 1) * 16384 + v_st(n & 63, 32 * db + r32)) = (unsigned short)f2bf(Sacc[i][r]); } }
    }
    for (int c = 0; c < 8; ++c) {
        const size_t m0 = (size_t)b * T + g * 512 + c * 64;
        {
            float lf[16], qv[16];
            const size_t off0 = (m0 + 16 * tq) * D + h * 128 + npre;
#pragma unroll
            for (int i = 0; i < 16; ++i) { lf[i] = LF[off0 + (size_t)i * D]; if (PASS_B) qv[i] = bf2f(QS[off0 + (size_t)i * D]); }
            float cs[16]; float run = 0.f;
#pragma unroll
            for (int i = 0; i < 16; ++i) { run += lf[i]; cs[i] = run; }
            const float s0 = __shfl(run, nl), s1 = __shfl(run, nl + 16), s2 = __shfl(run, nl + 32), s3 = __shfl(run, nl + 48);
            const float pre = (tq > 0 ? s0 : 0.f) + (tq > 1 ? s1 : 0.f) + (tq > 2 ? s2 : 0.f);
            const float last = (s0 + s1) + (s2 + s3);
            unsigned kh[8];
#pragma unroll
            for (int i = 0; i < 16; i += 2) {
                float khv[2];
#pragma unroll
                for (int e = 0; e < 2; ++e) {
                    const int t = 16 * tq + i + e; const float cum = pre + cs[i + e];
                    const float kk = 1.f - __expf(lf[i + e]);
                    khv[e] = kk * __expf(last - cum);
                    if (PASS_B) {
                        *(LAS unsigned short*)(lds + H_TQ + KSWZ(t, npre * 2)) = (unsigned short)f2bf(qv[i + e] * __expf(cum));
                        *(LAS unsigned short*)(lds + H_TK + KSWZ(t, npre * 2)) = (unsigned short)f2bf(kk * __expf(-cum));
                    }
                }
                kh[i >> 1] = pk2(khv[0], khv[1]);
            }
            *(LAS u32x4*)(lds + H_TKT + kt_off(npre, 16 * tq)) = (u32x4){kh[0], kh[1], kh[2], kh[3]};
            *(LAS u32x4*)(lds + H_TKT + kt_off(npre, 16 * tq + 8)) = (u32x4){kh[4], kh[5], kh[6], kh[7]};
            const float el = __expf(last);
            if (tq == 0) *(LAS float*)(lds + H_EL + npre * 4) = el;
            dg *= el;
            const int sr = tid >> 4, sc = (tid & 15) * 8;
            const bf16x8 i0 = *(const bf16x8*)(INP + (m0 + sr) * D + h * 128 + sc), i1 = *(const bf16x8*)(INP + (m0 + 32 + sr) * D + h * 128 + sc);
            *(LAS bf16x8*)(lds + H_TI + v_st(sr, sc)) = i0;
            *(LAS bf16x8*)(lds + H_TI + v_st(32 + sr, sc)) = i1;
        }
        __syncthreads();
        {
            const int vbI = (int)(unsigned long)(lds + H_TI) + v_rd_base(lane) + db * 512;
            bf16x8 bI[4];
            {
                const s16x4 l0 = tr_read<v_rd_off(0, 0, 0)>(vbI), h0 = tr_read<v_rd_off(0, 0, 1)>(vbI), l1 = tr_read<v_rd_off(0, 1, 0)>(vbI), h1 = tr_read<v_rd_off(0, 1, 1)>(vbI);
                const s16x4 l2 = tr_read<v_rd_off(0, 2, 0)>(vbI), h2 = tr_read<v_rd_off(0, 2, 1)>(vbI), l3 = tr_read<v_rd_off(0, 3, 0)>(vbI), h3 = tr_read<v_rd_off(0, 3, 1)>(vbI);
                asm volatile("s_waitcnt lgkmcnt(0)" ::: "memory"); SBAR();
#define PK(L, Hh) (bf16x8){L[0], L[1], L[2], L[3], Hh[0], Hh[1], Hh[2], Hh[3]}
                bI[0] = PK(l0, h0); bI[1] = PK(l1, h1); bI[2] = PK(l2, h2); bI[3] = PK(l3, h3);
            }
            if (PASS_B) {
                const int t = 32 * tb + r32;
                bf16x8 qr[8];
#pragma unroll
                for (int d0 = 0; d0 < 8; ++d0) qr[d0] = *(const LAS bf16x8*)(lds + H_TQ + KSWZ(t, (d0 * 16 + hi * 8) * 2));
                f32x16 p0, p1;
                qkt(p0, p1, lds + H_TK, qr, r32, hi);
#pragma unroll
                for (int r = 0; r < 16; ++r) { const int s0_ = crow(r, hi); if (s0_ > t) p0[r] = 0.f; if (s0_ + 32 > t) p1[r] = 0.f; }
                bf16x8 pa0, pa1, pa2, pa3;
#define PK4(P, BASE, OUT) do { unsigned a0 = cvtpk(P[BASE + 0], P[BASE + 1]), a1 = cvtpk(P[BASE + 2], P[BASE + 3]);   \
    unsigned b0 = cvtpk(P[BASE + 4], P[BASE + 5]), b1 = cvtpk(P[BASE + 6], P[BASE + 7]);                              \
    auto r0 = __builtin_amdgcn_permlane32_swap(a0, b0, false, false); auto r1 = __builtin_amdgcn_permlane32_swap(a1, b1, false, false); \
    u32x4 w = {r0[0], r1[0], r0[1], r1[1]}; OUT = *reinterpret_cast<bf16x8*>(&w); } while (0)
                PK4(p0, 0, pa0); PK4(p0, 8, pa1); PK4(p1, 0, pa2); PK4(p1, 8, pa3);
#undef PK4
                f32x16 od = {};
                od = __builtin_amdgcn_mfma_f32_32x32x16_bf16(pa0, bI[0], od, 0, 0, 0);
                od = __builtin_amdgcn_mfma_f32_32x32x16_bf16(pa1, bI[1], od, 0, 0, 0);
                od = __builtin_amdgcn_mfma_f32_32x32x16_bf16(pa2, bI[2], od, 0, 0, 0);
                od = __builtin_amdgcn_mfma_f32_32x32x16_bf16(pa3, bI[3], od, 0, 0, 0);
#pragma unroll
                for (int hf = 0; hf < 2; ++hf) {
                    const int vbS = (int)(unsigned long)(lds + H_SIMG) + hf * 16384 + v_rd_base(lane) + db * 512;
                    const s16x4 l0 = tr_read<v_rd_off(0, 0, 0)>(vbS), h0 = tr_read<v_rd_off(0, 0, 1)>(vbS), l1 = tr_read<v_rd_off(0, 1, 0)>(vbS), h1 = tr_read<v_rd_off(0, 1, 1)>(vbS);
                    const s16x4 l2 = tr_read<v_rd_off(0, 2, 0)>(vbS), h2 = tr_read<v_rd_off(0, 2, 1)>(vbS), l3 = tr_read<v_rd_off(0, 3, 0)>(vbS), h3 = tr_read<v_rd_off(0, 3, 1)>(vbS);
                    asm volatile("s_waitcnt lgkmcnt(0)" ::: "memory"); SBAR();
                    od = __builtin_amdgcn_mfma_f32_32x32x16_bf16(qr[hf * 4 + 0], PK(l0, h0), od, 0, 0, 0);
                    od = __builtin_amdgcn_mfma_f32_32x32x16_bf16(qr[hf * 4 + 1], PK(l1, h1), od, 0, 0, 0);
                    od = __builtin_amdgcn_mfma_f32_32x32x16_bf16(qr[hf * 4 + 2], PK(l2, h2), od, 0, 0, 0);
                    od = __builtin_amdgcn_mfma_f32_32x32x16_bf16(qr[hf * 4 + 3], PK(l3, h3), od, 0, 0, 0);
                }
#undef PK
                LAS float* ost = (LAS float*)(lds + H_OST);
#pragma unroll
                for (int r = 0; r < 16; ++r) ost[(32 * tb + crow(r, hi)) * OST_LD + 32 * db + r32] = od[r];
            }
            const LAS float* el = (const LAS float*)(lds + H_EL);
#pragma unroll
            for (int i = 0; i < 2; ++i) { const int nb = 2 * tb + i;
#pragma unroll
                for (int r = 0; r < 16; ++r) Sacc[i][r] *= el[32 * nb + crow(r, hi)];
#pragma unroll
                for (int ks = 0; ks < 4; ++ks) {
                    const bf16x8 af = *(const LAS bf16x8*)(lds + H_TKT + kt_off(32 * nb + r32, 16 * ks + 8 * hi));
                    Sacc[i] = __builtin_amdgcn_mfma_f32_32x32x16_bf16(af, bI[ks], Sacc[i], 0, 0, 0);
                } }
        }
        __syncthreads();
        if (PASS_B) {
#pragma unroll
            for (int i = 0; i < 2; ++i) { const int nb = 2 * tb + i;
#pragma unroll
                for (int r = 0; r < 16; ++r) { const int n = 32 * nb + crow(r, hi);
                    *(LAS unsigned short*)(lds + H_SIMG + (nb >> 1) * 16384 + v_st(n & 63, 32 * db + r32)) = (unsigned short)f2bf(Sacc[i][r]); } }
            const int t = tid >> 3, seg = tid & 7; const size_t go = (m0 + t) * D + h * 128 + 16 * seg;
            const LAS float* orow = (const LAS float*)(lds + H_OST) + t * OST_LD + 16 * seg;
            const u32x4 g0 = *(const u32x4*)(OG + go), g1 = *(const u32x4*)(OG + go + 8);
            const unsigned gw[8] = {g0.x, g0.y, g0.z, g0.w, g1.x, g1.y, g1.z, g1.w};
            float ssq = 0.f; unsigned ow[8];
#pragma unroll
            for (int e = 0; e < 8; ++e) { const float o0 = orow[2 * e], o1 = orow[2 * e + 1]; ssq = fmaf(o0, o0, ssq); ssq = fmaf(o1, o1, ssq);
                ow[e] = pk2(o0 * __uint_as_float(gw[e] << 16), o1 * __uint_as_float(gw[e] & 0xffff0000u)); }
            *(u32x4*)(OGATED + go) = (u32x4){ow[0], ow[1], ow[2], ow[3]}; *(u32x4*)(OGATED + go + 8) = (u32x4){ow[4], ow[5], ow[6], ow[7]};
            ssq += __shfl_xor(ssq, 1); ssq += __shfl_xor(ssq, 2); ssq += __shfl_xor(ssq, 4);
            if (seg == 0) SSQH[(m0 + t) * 8 + h] = ssq;
        }
    }
    if (!PASS_B) {
        float* tg = TG + (size_t)u * 16384;
#pragma unroll
        for (int i = 0; i < 2; ++i) { const int nb = 2 * tb + i;
#pragma unroll
            for (int r = 0; r < 16; ++r) tg[(size_t)(32 * nb + crow(r, hi)) * 128 + 32 * db + r32] = Sacc[i][r]; }
        if (tq == 0) DG[(size_t)u * 128 + npre] = dg;
    }
    __syncthreads();
}
}

#define XB_TMO      128
#define XB_XCNT(j)  (256  + 64 * (j))
#define XB_XSUB(j)  (1280 + 64 * (j))
#define XB_XGEN(j)  (2304 + 64 * (j))
#define XB_TOP      3328
#define XB_TOPGEN   3392
#define XCD_BAR_WORDS 3456
#define XB_SPIN_CAP (1u << 18)

__device__ __forceinline__ unsigned xb_ld(unsigned* p)              { return __hip_atomic_load(p, __ATOMIC_RELAXED, __HIP_MEMORY_SCOPE_AGENT); }
__device__ __forceinline__ unsigned xb_add(unsigned* p, unsigned v) { return __hip_atomic_fetch_add(p, v, __ATOMIC_RELAXED, __HIP_MEMORY_SCOPE_AGENT); }
__device__ __forceinline__ unsigned xb_xcc_id() { return (unsigned)__builtin_amdgcn_s_getreg((3 << 11) | 20) & 0xFu; }
#define XB_SPIN(cond, bar) do { unsigned _sp = 0; while (cond) { __builtin_amdgcn_s_sleep(1); \
    if ((++_sp & 255u) == 0u) { if (xb_ld(&(bar)[XB_TMO])) break; if (_sp > XB_SPIN_CAP) { atomicAdd(&(bar)[XB_TMO], 1u); break; } } } } while (0)

struct XcdBarrier {
    unsigned* bar; unsigned x;
    volatile LAS unsigned* st;
};

__device__ __forceinline__ XcdBarrier xcd_barrier_post(unsigned* bar, volatile LAS unsigned* st) {
    XcdBarrier b; b.bar = bar; b.x = xb_xcc_id(); b.st = st;
    if (threadIdx.x == 0) (void)xb_add(&bar[XB_XCNT(b.x)], 1u);
    return b;
}
__device__ __forceinline__ void xcd_barrier_complete(unsigned* bar, unsigned x, unsigned& nloc, unsigned& nx) {
    const unsigned G = gridDim.x * gridDim.y * gridDim.z;
    unsigned sum, cnt, mine, sp = 0u;
    for (;;) {
        sum = 0u; cnt = 0u; mine = 0u;
#pragma unroll
        for (unsigned j = 0; j < 16; ++j) { const unsigned c = xb_ld(&bar[XB_XCNT(j)]); sum += c; cnt += (c > 0u) ? 1u : 0u; mine = (j == x) ? c : mine; }
        if (sum == G) break;
        __builtin_amdgcn_s_sleep(1);
        if ((++sp & 255u) == 0u) { if (xb_ld(&bar[XB_TMO])) break; if (sp > XB_SPIN_CAP) { atomicAdd(&bar[XB_TMO], 1u); break; } }
    }
    nloc = mine > 0u ? mine : 1u; nx = cnt > 0u ? cnt : 1u;
}

__device__ __forceinline__ void xcd_barrier(const XcdBarrier& b) {
    asm volatile("s_waitcnt vmcnt(0)" ::: "memory");
    __syncthreads();
    if (threadIdx.x == 0) {
        unsigned* bar = b.bar;
        __builtin_amdgcn_s_waitcnt(0);
        unsigned nloc = b.st[0], nx = b.st[1];
        if (nloc == 0u) { xcd_barrier_complete(bar, b.x, nloc, nx); b.st[0] = nloc; b.st[1] = nx; }
        const unsigned old = xb_add(&bar[XB_XSUB(b.x)], 1u);
        const unsigned gen = old / nloc;
        if (old + 1u == (gen + 1u) * nloc) {
            __builtin_amdgcn_fence(__ATOMIC_RELEASE, "agent");
            asm volatile("s_waitcnt vmcnt(0)" ::: "memory");
            const unsigned og = xb_add(&bar[XB_TOP], 1u);
            const unsigned tg = og / nx;
            if (og + 1u == (tg + 1u) * nx) xb_add(&bar[XB_TOPGEN], 1u);
            else XB_SPIN(xb_ld(&bar[XB_TOPGEN]) == tg, bar);
            __builtin_amdgcn_fence(__ATOMIC_ACQUIRE, "agent");
            xb_add(&bar[XB_XGEN(b.x)], 1u);
            asm volatile("s_waitcnt vmcnt(0)" ::: "memory");
        } else {
            XB_SPIN(xb_ld(&bar[XB_XGEN(b.x)]) == gen, bar);
            __builtin_amdgcn_fence(__ATOMIC_ACQUIRE, "agent");
            asm volatile("s_waitcnt vmcnt(0)" ::: "memory");
        }
    }
    __syncthreads();
}

__global__ void __launch_bounds__(NWAVES * 64, 2) mk(Args a) {
    extern __shared__ __attribute__((aligned(16))) unsigned char lds_raw[];
    LAS unsigned char* lds = (LAS unsigned char*)lds_raw;
    const int tid = threadIdx.x, lane = tid & 63, wave = __builtin_amdgcn_readfirstlane(tid >> 6);
    unsigned char* ws = a.ws;
    const int lo = a.ph_lo, hi = a.ph_hi;
    const int G = gridDim.x;
    cg::grid_group grid = cg::this_grid();
#define IN(k) (lo <= (k) && (k) < hi)
#define SEAM(k) do { if (IN(k) && IN((k) + 1)) { if ((k) == 0) { grid.sync(); bar = xcd_barrier_post((unsigned*)(ws + WS_BAR), MISC); } else xcd_barrier(bar); } } while (0)
#define GEMM_PHASE(EPI, ...) pg8::gemm_phase<EPI, pg8::StaticOrder, true, true>(lds, g, S, E)
    float* SSQ = (float*)(ws + WS_SSQ);
    volatile LAS unsigned* MISC = (volatile LAS unsigned*)(lds + LDS_MISC);
    if (tid < 2) MISC[tid] = 0u;
    __syncthreads();
    XcdBarrier bar; bar.bar = (unsigned*)(ws + WS_BAR); bar.x = 0; bar.st = MISC;
    int ph = 0;
    if (IN(ph)) { prologue(a, lds, tid, lane, wave); }
    SEAM(ph); ++ph;
    if (IN(ph)) {
        pg8::Gemm g{(const bf16*)(ws + WS_A0), (const bf16*)(ws + WS_WIN0), M, 4096, D}; pg8::StaticOrder S; S.init(M, 4096, G, (int)blockIdx.x);
        pg8::EpiHgrnIn E{(bf16*)(ws + WS_A1), (float*)(ws + WS_A2), (bf16*)(ws + WS_A3), (bf16*)(ws + WS_A4), (const float*)(ws + WS_LB)};
        pg8::gemm_phase<pg8::EpiHgrnIn, pg8::StaticOrder, true, true>(lds, g, S, E);
    }
    SEAM(ph); ++ph;
    if (IN(ph)) { for (int u = blockIdx.x; u < 256; u += G) hg::hgrn_unit<false>(a, lds, u, tid, lane, wave); }
    SEAM(ph); ++ph;
    if (IN(ph)) { for (int u = blockIdx.x; u < 256; u += G) hg::hgrn_unit<true>(a, lds, u, tid, lane, wave); }
    SEAM(ph); ++ph;
    if (IN(ph)) {
        pg8::Gemm g{(const bf16*)(ws + WS_A0), (const bf16*)(ws + WS_WOUT0), M, D, D}; pg8::StaticOrder S; S.init(M, D, G, (int)blockIdx.x);
        pg8::EpiResid<1, false> E{a.x, a.out, (bf16*)(ws + WS_A1), nullptr, SSQ, (const float*)(ws + WS_SSQH)};
        pg8::gemm_phase<pg8::EpiResid<1, false>, pg8::StaticOrder, true, true>(lds, g, S, E);
    }
    SEAM(ph); ++ph;
    if (IN(ph)) {
        pg8::Gemm g{(const bf16*)(ws + WS_A1), (const bf16*)(ws + WS_W13_0), M, 2 * DFF, D}; pg8::StaticOrder S; S.init(M, 2 * DFF, G, (int)blockIdx.x);
        pg8::EpiSwiglu E{(bf16*)(ws + WS_A2), DFF, SSQ};
        pg8::gemm_phase<pg8::EpiSwiglu, pg8::StaticOrder, true, true>(lds, g, S, E);
    }
    SEAM(ph); ++ph;
    if (IN(ph)) {
        pg8::Gemm g{(const bf16*)(ws + WS_A2), (const bf16*)(ws + WS_W2_0), M, D, DFF}; pg8::StaticOrder S; S.init(M, D, G, (int)blockIdx.x);
        pg8::EpiResid<0, false> E{a.out, a.out, (bf16*)(ws + WS_A1), nullptr, SSQ, nullptr};
        pg8::gemm_phase<pg8::EpiResid<0, false>, pg8::StaticOrder, true, true>(lds, g, S, E);
    }
    SEAM(ph); ++ph;
    if (IN(ph)) {
        pg8::Gemm g{(const bf16*)(ws + WS_A1), (const bf16*)(ws + WS_WQKV), M, 3072, D}; pg8::StaticOrder S; S.init(M, 3072, G, (int)blockIdx.x);
        pg8::EpiQKV E{(bf16*)(ws + WS_A2), (size_t)M * D, SSQ};
        pg8::gemm_phase<pg8::EpiQKV, pg8::StaticOrder, true, true>(lds, g, S, E);
    }
    SEAM(ph); ++ph;
    if (IN(ph)) kmean_phase(a, tid);
    SEAM(ph); ++ph;
    if (IN(ph)) topk_phase(a, lds, tid, lane, wave);
    SEAM(ph); ++ph;
    if (IN(ph)) attn_sel_phase(a, lds, tid, lane, wave);
    SEAM(ph); ++ph;
    if (IN(ph)) attn_own_phase(a, lds, tid, lane, wave);
    SEAM(ph); ++ph;
    if (IN(ph)) {
        pg8::Gemm g{(const bf16*)(ws + WS_A2), (const bf16*)(ws + WS_WOUT1), M, D, D}; pg8::StaticOrder S; S.init(M, D, G, (int)blockIdx.x);
        pg8::EpiResid<0, false> E{a.out, a.out, (bf16*)(ws + WS_A1), nullptr, SSQ, nullptr};
        pg8::gemm_phase<pg8::EpiResid<0, false>, pg8::StaticOrder, true, true>(lds, g, S, E);
    }
    SEAM(ph); ++ph;
    if (IN(ph)) {
        pg8::Gemm g{(const bf16*)(ws + WS_A1), (const bf16*)(ws + WS_W13_1), M, 2 * DFF, D}; pg8::StaticOrder S; S.init(M, 2 * DFF, G, (int)blockIdx.x);
        pg8::EpiSwiglu E{(bf16*)(ws + WS_A2), DFF, SSQ};
        pg8::gemm_phase<pg8::EpiSwiglu, pg8::StaticOrder, true, true>(lds, g, S, E);
    }
    SEAM(ph); ++ph;
    if (IN(ph)) {
        pg8::Gemm g{(const bf16*)(ws + WS_A2), (const bf16*)(ws + WS_W2_1), M, D, DFF}; pg8::StaticOrder S; S.init(M, D, G, (int)blockIdx.x);
        pg8::EpiResid<0, false> E{a.out, a.out, (bf16*)(ws + WS_A1), nullptr, SSQ, nullptr};
        pg8::gemm_phase<pg8::EpiResid<0, false>, pg8::StaticOrder, true, true>(lds, g, S, E);
    }
    SEAM(ph); ++ph;
    if (IN(ph)) final_norm_phase(a, lane, wave);
#undef IN
#undef SEAM
#undef GEMM_PHASE
}

extern "C" void kernel_launch(void* const* d_in, const int* in_sizes, int n_in, void* d_out, int out_size, void* d_ws, size_t ws_size, hipStream_t stream) {
    static int grid = 0;
    if (grid == 0) {
        if (n_in != 13 || out_size != M * D || ws_size < WS_END) { fprintf(stderr, "kernel_launch: unexpected problem (n_in %d out %d ws %zu)\n", n_in, out_size, ws_size); grid = -1; return; }
        int dev = 0, cus = 0, per_cu = 0;
        (void)hipGetDevice(&dev); (void)hipDeviceGetAttribute(&cus, hipDeviceAttributeMultiprocessorCount, dev);
        if (hipFuncSetAttribute((const void*)mk, hipFuncAttributeMaxDynamicSharedMemorySize, LDS_BYTES) != hipSuccess) { fprintf(stderr, "kernel_launch: hipFuncSetAttribute failed\n"); grid = -1; return; }
        if (hipOccupancyMaxActiveBlocksPerMultiprocessor(&per_cu, (const void*)mk, NWAVES * 64, LDS_BYTES) != hipSuccess || per_cu < 1) { fprintf(stderr, "kernel_launch: occupancy query says %d\n", per_cu); (void)hipGetLastError(); grid = -1; return; }
        grid = cus;
        if (grid != 256) fprintf(stderr, "kernel_launch: note: %d CUs\n", grid);
    }
    if (grid < 0) return;
    Args a{};
    a.x = (const float*)d_in[0]; a.norm_mix = (const float*)d_in[1]; a.norm_ffn = (const float*)d_in[2]; a.hgrn_w_in = (const float*)d_in[3]; a.lb_logits = (const float*)d_in[4];
    a.hgrn_out_norm = (const float*)d_in[5]; a.hgrn_w_out = (const float*)d_in[6]; a.moba_w_in = (const float*)d_in[7]; a.moba_w_out = (const float*)d_in[8]; a.rel_table = (const float*)d_in[9];
    a.ffn_w13 = (const float*)d_in[10]; a.ffn_w2 = (const float*)d_in[11]; a.final_norm = (const float*)d_in[12];
    a.out = (float*)d_out; a.ws = (unsigned char*)d_ws;
    a.ph_lo = 0; a.ph_hi = 16;
    void* args[] = {&a};
    hipError_t e = hipLaunchCooperativeKernel((const void*)mk, dim3(grid), dim3(NWAVES * 64), args, LDS_BYTES, stream);
    if (e != hipSuccess) fprintf(stderr, "kernel_launch: cooperative launch failed: %s (grid %d)\n", hipGetErrorString(e), grid);
}
```

```cpp
#include <hip/hip_runtime.h>
#include <hip/hip_cooperative_groups.h>
#include <cstdio>
#include <cstdint>
#include <cmath>
namespace pg8 {
#define PG8_LAS __attribute__((address_space(3)))
typedef unsigned short bf16_t;
typedef short bf16x8 __attribute__((ext_vector_type(8)));
typedef float f32x4 __attribute__((ext_vector_type(4)));
typedef unsigned u32x4 __attribute__((ext_vector_type(4)));
constexpr int BM = 256, BK = 64, HALF = 128, HTB = HALF * BK * 2  , STAGE_BYTES = 8 * HTB, NXCD = 8, WGM = 8;

__host__ __device__ __forceinline__ int lds_byte(int r, int c) { const int st = (r >> 4) * 2 + (c >> 5), rr = r & 15, cc = c & 31, ob = rr * 64 + cc * 2; return st * 1024 + (ob ^ (((ob >> 9) & 1) << 5)); }
__host__ __device__ __forceinline__ void stage_rc(int b, int& R, int& C) { const int st = b / 1024, sb = b % 1024, swz = sb ^ (((sb >> 9) & 1) << 5); R = (st >> 1) * 16 + swz / 64; C = (st & 1) * 32 + (swz % 64) / 2; }
__host__ __device__ __forceinline__ int perm32(int rho) { const int n = rho >> 4, i = rho & 15; return 8 * (i >> 2) + 4 * n + (i & 3); }

struct Unit { int pm, pn; };
struct Gemm { const bf16_t* A; const bf16_t* Bt; int M, N, K; };

struct StaticOrder {
    int nM, nN, nwg, G, c;
    __host__ __device__ void init(int M, int N, int G_, int c_) { nM = M / BM; nN = N / BM; nwg = nM * nN; G = G_; c = c_; }
    __host__ __device__ bool next(int i, Unit& u) const {
        const long L = (long)i * G + c; if (L >= nwg) return false;
        int wgid = (int)L; { const int q = nwg / NXCD, r = nwg % NXCD, xcd = wgid % NXCD, off = wgid / NXCD; wgid = (xcd < r ? xcd * (q + 1) : r * (q + 1) + (xcd - r) * q) + off; }
        const int nig = WGM * nN, gid = wgid / nig, fm = gid * WGM, gsz = (nM - fm) < WGM ? (nM - fm) : WGM;
        u.pm = fm + ((wgid % nig) % gsz); u.pn = (wgid % nig) / gsz; return true;
    }
    __device__ __forceinline__ void a_ready(const Unit&) const {}
    __device__ __forceinline__ void done(const Unit&) const {}
};
__device__ __forceinline__ unsigned cvt_pk_bf16(float lo, float hi) { unsigned r; asm volatile("v_cvt_pk_bf16_f32 %0, %1, %2" : "=v"(r) : "v"(lo), "v"(hi)); return r; }
typedef float f32x2 __attribute__((ext_vector_type(2)));
typedef unsigned u32x2 __attribute__((ext_vector_type(2)));
__device__ __forceinline__ float sigm(float x) { return __builtin_amdgcn_rcpf(1.f + __expf(-x)); }
__device__ __forceinline__ float bf2f_lo(unsigned w) { return __uint_as_float(w << 16); }
__device__ __forceinline__ float bf2f_hi(unsigned w) { return __uint_as_float(w & 0xffff0000u); }
__device__ __forceinline__ float rstd_from16(const float* p) {
    const f32x4 a = *(const f32x4*)p, b = *(const f32x4*)(p + 4), c = *(const f32x4*)(p + 8), d = *(const f32x4*)(p + 12);
    const float s = ((a[0] + a[1]) + (a[2] + a[3])) + ((b[0] + b[1]) + (b[2] + b[3])) + ((c[0] + c[1]) + (c[2] + c[3])) + ((d[0] + d[1]) + (d[2] + d[3]));
    return rsqrtf(s * (1.f / 1024.f) + 1e-6f);
}
__device__ __forceinline__ float rstd_from8(const float* p) {
    const f32x4 a = *(const f32x4*)p, b = *(const f32x4*)(p + 4);
    const float s = ((a[0] + a[1]) + (a[2] + a[3])) + ((b[0] + b[1]) + (b[2] + b[3]));
    return rsqrtf(s * (1.f / 1024.f) + 1e-6f);
}

struct EpiHgrnIn {
    static constexpr bool PERM = true, AFTER_DRAIN = false;
    bf16_t* QS; float* LF; bf16_t* IN; bf16_t* OG; const float* lb;
    __device__ __forceinline__ void operator()(const f32x4 (&acc)[2][2][4][2], const Unit& u, int wr, int wc, int fr, int fq) const {
        const int type = u.pn >> 2;
        const int row0 = u.pm * BM + wr * 64 + fr;
        const int col0 = (u.pn & 3) * BM + wc * 32 + 8 * fq;
#pragma unroll
        for (int bj = 0; bj < 2; ++bj) {
            const int c = col0 + bj * HALF;
            f32x4 l0 = (f32x4){0.f, 0.f, 0.f, 0.f}, l1 = l0;
            if (type == 1) { l0 = *(const f32x4*)(lb + c); l1 = *(const f32x4*)(lb + c + 4); }
#pragma unroll
            for (int ai = 0; ai < 2; ++ai)
#pragma unroll
                for (int m = 0; m < 4; ++m) {
                    const size_t off = (size_t)(row0 + ai * HALF + m * 16) * 1024 + c;
                    f32x4 v0 = acc[ai][bj][m][0], v1 = acc[ai][bj][m][1];
                    if (type == 1) {
#pragma unroll
                        for (int i = 0; i < 4; ++i) { v0[i] = logf(l0[i] + (1.f - l0[i]) * sigm(v0[i])); v1[i] = logf(l1[i] + (1.f - l1[i]) * sigm(v1[i])); }
                        *(f32x4*)(LF + off) = v0; *(f32x4*)(LF + off + 4) = v1;
                    } else {
                        if (type == 0) {
#pragma unroll
                            for (int i = 0; i < 4; ++i) { v0[i] = v0[i] * sigm(v0[i]); v1[i] = v1[i] * sigm(v1[i]); }
                        } else if (type == 3) {
#pragma unroll
                            for (int i = 0; i < 4; ++i) { v0[i] = sigm(v0[i]); v1[i] = sigm(v1[i]); }
                        }
                        u32x4 w; w.x = cvt_pk_bf16(v0[0], v0[1]); w.y = cvt_pk_bf16(v0[2], v0[3]); w.z = cvt_pk_bf16(v1[0], v1[1]); w.w = cvt_pk_bf16(v1[2], v1[3]);
                        if (type == 0) *(u32x4*)(QS + off) = w;
                        else if (type == 2) *(u32x4*)(IN + off) = w;
                        else *(u32x4*)(OG + off) = w;
                    }
                }
        }
    }
};

template <int SCALE, bool WRITE_LO>
struct EpiResid {
    static constexpr bool PERM = false, AFTER_DRAIN = false;
    const float* R; float* Hout; bf16_t* HB; bf16_t* HBL; float* SSQ; const float* SSQIN;
    __device__ __forceinline__ void operator()(const f32x4 (&acc)[2][2][4][2], const Unit& u, int wr, int wc, int fr, int fq) const {
        const int col0 = u.pn * BM + wc * 32 + 4 * fq;
#pragma unroll
        for (int ai = 0; ai < 2; ++ai)
#pragma unroll
            for (int m = 0; m < 4; ++m) {
                const int row = u.pm * BM + ai * HALF + wr * 64 + m * 16 + fr;
                float sc = 1.f;
                if (SCALE == 1) sc = rstd_from8(SSQIN + (size_t)row * 8);
                const size_t off = (size_t)row * 1024 + col0;
                float ss = 0.f;
#pragma unroll
                for (int bj = 0; bj < 2; ++bj)
#pragma unroll
                    for (int n = 0; n < 2; ++n) {
                        const size_t o2 = off + bj * HALF + n * 16;
                        const f32x4 r = *(const f32x4*)(R + o2);
                        const f32x4 v = r + acc[ai][bj][m][n] * sc;
                        *(f32x4*)(Hout + o2) = v;
                        ss += (v[0] * v[0] + v[1] * v[1]) + (v[2] * v[2] + v[3] * v[3]);
                        u32x2 w; w.x = cvt_pk_bf16(v[0], v[1]); w.y = cvt_pk_bf16(v[2], v[3]);
                        *(u32x2*)(HB + o2) = w;
                        if (WRITE_LO) {
                            u32x2 l; l.x = cvt_pk_bf16(v[0] - bf2f_lo(w.x), v[1] - bf2f_hi(w.x)); l.y = cvt_pk_bf16(v[2] - bf2f_lo(w.y), v[3] - bf2f_hi(w.y));
                            *(u32x2*)(HBL + o2) = l;
                        }
                    }
                ss += __shfl_xor(ss, 16); ss += __shfl_xor(ss, 32);
                if (fq == 0) SSQ[(size_t)row * 16 + u.pn * 4 + wc] = ss;
                if (m & 1) asm volatile("" ::: "memory");
            }
    }
};

struct EpiSwiglu {
    static constexpr bool PERM = true, AFTER_DRAIN = false;
    bf16_t* HID; int ldh; const float* SSQIN;
    __device__ __forceinline__ void operator()(const f32x4 (&acc)[2][2][4][2], const Unit& u, int wr, int wc, int fr, int fq) const {
        const int col0 = u.pn * HALF + wc * 32 + 8 * fq;
#pragma unroll
        for (int ai = 0; ai < 2; ++ai)
#pragma unroll
            for (int m = 0; m < 4; ++m) {
                const int row = u.pm * BM + ai * HALF + wr * 64 + m * 16 + fr;
                const float sc = rstd_from16(SSQIN + (size_t)row * 16);
                f32x4 g0 = acc[ai][0][m][0] * sc, g1 = acc[ai][0][m][1] * sc, u0 = acc[ai][1][m][0] * sc, u1 = acc[ai][1][m][1] * sc;
#pragma unroll
                for (int i = 0; i < 4; ++i) { g0[i] = g0[i] * sigm(g0[i]) * u0[i]; g1[i] = g1[i] * sigm(g1[i]) * u1[i]; }
                u32x4 w; w.x = cvt_pk_bf16(g0[0], g0[1]); w.y = cvt_pk_bf16(g0[2], g0[3]); w.z = cvt_pk_bf16(g1[0], g1[1]); w.w = cvt_pk_bf16(g1[2], g1[3]);
                *(u32x4*)(HID + (size_t)row * ldh + col0) = w;
            }
    }
};

struct EpiQKV {
    static constexpr bool PERM = true, AFTER_DRAIN = false;
    bf16_t* O; size_t split_stride; const float* SSQIN; float* KMEAN;
    __device__ __forceinline__ void operator()(const f32x4 (&acc)[2][2][4][2], const Unit& u, int wr, int wc, int fr, int fq) const {
        const int t = u.pn >> 2;
        bf16_t* base = O + (size_t)t * split_stride;
        const int col0 = (u.pn & 3) * BM + wc * 32 + 8 * fq;
        f32x4 cs[2][2];
#pragma unroll
        for (int bj = 0; bj < 2; ++bj) { cs[bj][0] = (f32x4){0.f, 0.f, 0.f, 0.f}; cs[bj][1] = cs[bj][0]; }
#pragma unroll
        for (int ai = 0; ai < 2; ++ai)
#pragma unroll
            for (int m = 0; m < 4; ++m) {
                const int row = u.pm * BM + ai * HALF + wr * 64 + m * 16 + fr;
                const float sc = rstd_from16(SSQIN + (size_t)row * 16);
#pragma unroll
                for (int bj = 0; bj < 2; ++bj) {
                    const f32x4 v0 = acc[ai][bj][m][0] * sc, v1 = acc[ai][bj][m][1] * sc;
                    cs[bj][0] += v0; cs[bj][1] += v1;
                    u32x4 w; w.x = cvt_pk_bf16(v0[0], v0[1]); w.y = cvt_pk_bf16(v0[2], v0[3]); w.z = cvt_pk_bf16(v1[0], v1[1]); w.w = cvt_pk_bf16(v1[2], v1[3]);
                    *(u32x4*)(base + (size_t)row * 1024 + col0 + bj * HALF) = w;
                }
            }
        if (t == 1) {
#pragma unroll
            for (int bj = 0; bj < 2; ++bj)
#pragma unroll
                for (int n = 0; n < 2; ++n)
#pragma unroll
                    for (int i = 0; i < 4; ++i) {
                        float s = cs[bj][n][i];
                        s += __shfl_xor(s, 1); s += __shfl_xor(s, 2); s += __shfl_xor(s, 4); s += __shfl_xor(s, 8);
                        if (fr == 0) atomicAdd(KMEAN + (size_t)u.pm * 1024 + col0 + bj * HALF + 4 * n + i, s * (1.f / 256.f));
                    }
        }
    }
};

template <class Epi, class Sched, bool ALIGN_EPI = false, bool SP2 = false>
__device__ __forceinline__ void gemm_phase(PG8_LAS unsigned char* lds, const Gemm g, const Sched& S, const Epi& E) {
    const int tid = threadIdx.x, wid = __builtin_amdgcn_readfirstlane(tid >> 6), lane = tid & 63, wr = wid >> 2, wc = wid & 3, fr = lane & 15, fq = lane >> 4;
    const int K = g.K, nt = K / BK;
    unsigned voffA[2], voffB[2];
#pragma unroll
    for (int i = 0; i < 2; ++i) { int R, C; stage_rc(tid * 16 + i * 8192, R, C); const int Rb = Epi::PERM ? ((R & ~31) + perm32(R & 31)) : R;
        voffA[i] = (unsigned)(R * K + C) * 2u; voffB[i] = (unsigned)(Rb * K + C) * 2u; }
    const size_t kstep = (size_t)(BK * 2);
    const size_t hstep = (size_t)HALF * K * 2;
    const size_t tstep = 2 * hstep;
    const unsigned ldsw = (unsigned)wid * 1024u;
    const int aoff = lds_byte(wr * 64 + fr, fq * 8), boff = lds_byte(wc * 32 + fr, fq * 8);
#define PG8_SA(b, h) (((b) * 2 + (h)) * HTB)
#define PG8_SB(b, h) ((4 + (b) * 2 + (h)) * HTB)
#define PG8_STAGE(bufoff, gbase, voff) do { _Pragma("unroll") for (int _i = 0; _i < 2; ++_i) \
        __builtin_amdgcn_global_load_lds((const unsigned*)((const char*)(gbase) + (voff)[_i]), (PG8_LAS unsigned*)(lds + (bufoff) + ldsw + _i * 8192), 16, 0, 0); } while (0)
#define PG8_LDA(dst, b, h) do { _Pragma("unroll") for (int m = 0; m < 4; ++m) _Pragma("unroll") for (int k = 0; k < 2; ++k) dst[m][k] = *(const PG8_LAS bf16x8*)(lds + PG8_SA(b, h) + aoff + m * 2048 + k * 1024); } while (0)
#define PG8_LDB(dst, b, h) do { _Pragma("unroll") for (int n = 0; n < 2; ++n) _Pragma("unroll") for (int k = 0; k < 2; ++k) dst[n][k] = *(const PG8_LAS bf16x8*)(lds + PG8_SB(b, h) + boff + n * 2048 + k * 1024); } while (0)
#define PG8_MMA(ai, bj, At, Bt) do { __builtin_amdgcn_s_setprio(1); _Pragma("unroll") for (int m = 0; m < 4; ++m) _Pragma("unroll") for (int n = 0; n < 2; ++n) _Pragma("unroll") for (int k = 0; k < 2; ++k) \
        acc[ai][bj][m][n] = __builtin_amdgcn_mfma_f32_16x16x32_bf16(Bt[n][k], At[m][k], acc[ai][bj][m][n], 0, 0, 0); __builtin_amdgcn_s_setprio(0); } while (0)
#define PG8_WAIT_V(n) asm volatile("s_waitcnt vmcnt(" #n ")" ::: "memory")
#define PG8_WAIT_L(n) asm volatile("s_waitcnt lgkmcnt(" #n ")" ::: "memory")
#define PG8_BAR __builtin_amdgcn_s_barrier()
#define PG8_SCHED __builtin_amdgcn_sched_barrier(0)
    Unit cur, nxt; int ui = 0;
    if (!S.next(0, cur)) return;
    f32x4 acc[2][2][4][2];
#pragma unroll
    for (int a = 0; a < 2; ++a)
#pragma unroll
        for (int b = 0; b < 2; ++b)
#pragma unroll
            for (int m = 0; m < 4; ++m)
#pragma unroll
                for (int n = 0; n < 2; ++n) acc[a][b][m][n] = (f32x4){0.f, 0.f, 0.f, 0.f};
    bf16x8 At[4][2], B0[2][2], B1[2][2];
    const char* cA = (const char*)g.A + (size_t)cur.pm * tstep; const char* cB = (const char*)g.Bt + (size_t)cur.pn * tstep;
    S.a_ready(cur);
    if constexpr (SP2) {
        PG8_STAGE(PG8_SB(0, 0), cB, voffB); PG8_STAGE(PG8_SB(0, 1), cB + hstep, voffB); PG8_STAGE(PG8_SA(0, 0), cA, voffA); PG8_STAGE(PG8_SA(0, 1), cA + hstep, voffA);
        if (wr == 1) PG8_BAR;
        PG8_WAIT_V(2); PG8_BAR;
        PG8_STAGE(PG8_SB(1, 0), cB + kstep, voffB); PG8_STAGE(PG8_SA(1, 0), cA + kstep, voffA); PG8_STAGE(PG8_SB(1, 1), cB + hstep + kstep, voffB);
        PG8_WAIT_V(6); PG8_BAR;
    } else {
        PG8_STAGE(PG8_SB(0, 0), cB, voffB); PG8_STAGE(PG8_SA(0, 0), cA, voffA); PG8_STAGE(PG8_SB(0, 1), cB + hstep, voffB); PG8_STAGE(PG8_SA(0, 1), cA + hstep, voffA);
        if (wr == 1) PG8_BAR;
        PG8_WAIT_V(4); PG8_BAR;
        PG8_STAGE(PG8_SB(1, 0), cB + kstep, voffB); PG8_STAGE(PG8_SA(1, 0), cA + kstep, voffA); PG8_STAGE(PG8_SB(1, 1), cB + hstep + kstep, voffB);
        PG8_WAIT_V(6); PG8_BAR;
    }
    for (;;) {
        const bool has_next = S.next(ui + 1, nxt);
        const char* nA = has_next ? (const char*)g.A + (size_t)nxt.pm * tstep : cA; const char* nB = has_next ? (const char*)g.Bt + (size_t)nxt.pn * tstep : cB;
        for (int t = 0; t < nt; t += 2) {
            const bool last = (t == nt - 2);
            const char* a1 = cA + (size_t)(t + 1) * kstep;
            const char* a2 = last ? nA : cA + (size_t)(t + 2) * kstep; const char* b2 = last ? nB : cB + (size_t)(t + 2) * kstep;
            const char* a3 = a2 + kstep; const char* b3 = b2 + kstep;
            if (last && has_next) S.a_ready(nxt);
            if constexpr (SP2) {
            PG8_LDB(B0, 0, 0); PG8_LDB(B1, 0, 1); PG8_SCHED; PG8_LDA(At, 0, 0); PG8_STAGE(PG8_SA(1, 1), a1 + hstep, voffA);
            PG8_WAIT_V(8); PG8_WAIT_L(0); PG8_BAR; PG8_MMA(0, 0, At, B0); PG8_MMA(0, 1, At, B1); PG8_BAR; PG8_SCHED;
            PG8_LDA(At, 0, 1); PG8_STAGE(PG8_SB(0, 0), b2, voffB); PG8_STAGE(PG8_SB(0, 1), b2 + hstep, voffB); PG8_STAGE(PG8_SA(0, 0), a2, voffA);
            PG8_WAIT_V(8); PG8_WAIT_L(0); PG8_BAR; PG8_MMA(1, 0, At, B0); PG8_MMA(1, 1, At, B1); PG8_BAR; PG8_SCHED;
            PG8_LDB(B0, 1, 0); PG8_LDB(B1, 1, 1); PG8_SCHED; PG8_LDA(At, 1, 0); PG8_STAGE(PG8_SA(0, 1), a2 + hstep, voffA);
            PG8_WAIT_V(8); PG8_WAIT_L(0); PG8_BAR; PG8_MMA(0, 0, At, B0); PG8_MMA(0, 1, At, B1); PG8_BAR; PG8_SCHED;
            PG8_LDA(At, 1, 1); PG8_STAGE(PG8_SB(1, 0), b3, voffB); PG8_STAGE(PG8_SB(1, 1), b3 + hstep, voffB); PG8_STAGE(PG8_SA(1, 0), a3, voffA);
            PG8_WAIT_V(8); PG8_WAIT_L(0); PG8_BAR; PG8_MMA(1, 0, At, B0); PG8_MMA(1, 1, At, B1); PG8_BAR; PG8_SCHED;
            } else {
            PG8_LDB(B0, 0, 0); PG8_SCHED; PG8_LDA(At, 0, 0); PG8_STAGE(PG8_SA(1, 1), a1 + hstep, voffA);
            PG8_WAIT_L(8); PG8_BAR; PG8_WAIT_L(0); PG8_MMA(0, 0, At, B0); PG8_BAR; PG8_SCHED;
            PG8_LDB(B1, 0, 1); PG8_STAGE(PG8_SB(0, 0), b2, voffB);
            PG8_BAR; PG8_WAIT_L(0); PG8_MMA(0, 1, At, B1); PG8_BAR;
            PG8_LDA(At, 0, 1); PG8_STAGE(PG8_SA(0, 0), a2, voffA);
            PG8_BAR; PG8_WAIT_L(0); PG8_MMA(1, 0, At, B0); PG8_BAR; PG8_SCHED;
            PG8_STAGE(PG8_SB(0, 1), b2 + hstep, voffB);
            PG8_WAIT_V(6); PG8_BAR; PG8_MMA(1, 1, At, B1); PG8_BAR;
            PG8_LDB(B0, 1, 0); PG8_SCHED; PG8_LDA(At, 1, 0); PG8_STAGE(PG8_SA(0, 1), a2 + hstep, voffA);
            PG8_WAIT_L(8); PG8_BAR; PG8_WAIT_L(0); PG8_MMA(0, 0, At, B0); PG8_BAR; PG8_SCHED;
            PG8_LDB(B1, 1, 1); PG8_STAGE(PG8_SB(1, 0), b3, voffB);
            PG8_BAR; PG8_WAIT_L(0); PG8_MMA(0, 1, At, B1); PG8_BAR;
            PG8_LDA(At, 1, 1); PG8_STAGE(PG8_SA(1, 0), a3, voffA);
            PG8_BAR; PG8_WAIT_L(0); PG8_MMA(1, 0, At, B0); PG8_BAR; PG8_SCHED;
            PG8_STAGE(PG8_SB(1, 1), b3 + hstep, voffB);
            PG8_WAIT_V(6); PG8_BAR; PG8_MMA(1, 1, At, B1); PG8_BAR;
            }
        }
        if constexpr (ALIGN_EPI) { if (wr == 0) PG8_BAR; }
        if constexpr (!Epi::AFTER_DRAIN) { E(acc, cur, wr, wc, fr, fq); S.done(cur); }
        if (!has_next) break;
#pragma unroll
        for (int a = 0; a < 2; ++a)
#pragma unroll
            for (int b = 0; b < 2; ++b)
#pragma unroll
                for (int m = 0; m < 4; ++m)
#pragma unroll
                    for (int n = 0; n < 2; ++n) acc[a][b][m][n] = (f32x4){0.f, 0.f, 0.f, 0.f};
        cur = nxt; cA = nA; cB = nB; ++ui;
        if constexpr (ALIGN_EPI) { if (wr == 1) PG8_BAR; }
    }
    PG8_WAIT_V(0);
    if constexpr (!ALIGN_EPI) { if (wr == 0) PG8_BAR; }
    PG8_BAR;
    if constexpr (Epi::AFTER_DRAIN) { E.fused(acc, cur, wr, wc, fr, fq, lds, wid, lane); S.done(cur); }
#undef PG8_SA
#undef PG8_SB
#undef PG8_STAGE
#undef PG8_LDA
#undef PG8_LDB
#undef PG8_MMA
#undef PG8_WAIT_V
#undef PG8_WAIT_L
#undef PG8_BAR
#undef PG8_SCHED
}
}

namespace cg = cooperative_groups;
constexpr int NWAVES = 8;
constexpr int BATCH = 2, T = 8192, D = 1024, H = 8, DH = 128, DFF = 2816, NB = 32, BLK = 256;
constexpr int M = BATCH * T;
constexpr float EPS = 1e-6f;
constexpr size_t MiB = 1u << 20;
constexpr size_t WS_CTL = 0;
constexpr size_t WS_WQKV = 1 * MiB, WS_WOUT1 = 7 * MiB, WS_W13_1 = 9 * MiB, WS_W2_1 = 20 * MiB;
constexpr size_t WS_WIN0 = 26 * MiB, WS_WOUT0 = 34 * MiB, WS_W13_0 = 36 * MiB, WS_W2_0 = 47 * MiB;
constexpr size_t WS_SSQ = 53 * MiB;
constexpr size_t WS_SSQH = 54 * MiB;
constexpr size_t WS_LB = 54 * MiB + 512 * 1024;
constexpr size_t WS_BKT = WS_LB + 4096;
constexpr size_t WS_YMEAN = WS_BKT + 32768;
constexpr size_t WS_KMEAN = WS_YMEAN + 262144;
constexpr size_t WS_SEL = 55 * MiB + 512 * 1024;
constexpr size_t WS_G = 56 * MiB;
constexpr size_t WS_A0 = 60 * MiB;
constexpr size_t WS_A1 = 92 * MiB;
constexpr size_t WS_A2 = 124 * MiB;
constexpr size_t WS_A3 = 188 * MiB;
constexpr size_t WS_A4 = 220 * MiB;
constexpr size_t WS_END = 256 * MiB;
static_assert(WS_W2_0 + (size_t)D * DFF * 2 <= WS_SSQ && WS_G + 2 * MiB <= WS_A0 && WS_A4 + 32 * MiB <= WS_END, "ws map");

constexpr int LDS_BYTES = 163840;
constexpr int LDS_MISC = 163584;
constexpr size_t WS_BAR = 65536;

#define GAS __attribute__((address_space(1)))
#define LAS __attribute__((address_space(3)))
typedef unsigned short bf16;
typedef unsigned v4u __attribute__((ext_vector_type(4)));
typedef float f32x4 __attribute__((ext_vector_type(4)));
#define LDS_WAIT() asm volatile("s_waitcnt lgkmcnt(0)" ::: "memory")
__device__ __forceinline__ unsigned f2bf(float f) { unsigned u = __builtin_bit_cast(unsigned, f); return (u + 0x7fffu + ((u >> 16) & 1u)) >> 16; }
__device__ __forceinline__ unsigned pk2(float lo, float hi) { return f2bf(lo) | (f2bf(hi) << 16); }
__device__ __forceinline__ float bf2f(unsigned short b) { return __uint_as_float((unsigned)b << 16); }
__device__ __forceinline__ float wave_sum(float v) {
#pragma unroll
    for (int o = 1; o < 64; o <<= 1) v += __shfl_xor(v, o);
    return v;
}

struct Args {
    const float* x; const float* norm_mix; const float* norm_ffn; const float* hgrn_w_in; const float* lb_logits; const float* hgrn_out_norm; const float* hgrn_w_out;
    const float* moba_w_in; const float* moba_w_out; const float* rel_table; const float* ffn_w13; const float* ffn_w2; const float* final_norm;
    float* out; unsigned char* ws; int ph_lo, ph_hi;
};

__device__ __forceinline__ void tr_item(const float* W, int ldw, int K, bf16* WT, int Ndst, const float* gain, int mode, LAS float* scr, int item, int lane) {
    const int nblk = Ndst / 64, kb = item / nblk, nb = item % nblk, k0 = 64 * kb, n0 = 64 * nb;
    int s0 = n0;
    if (mode == 1) { const int t = n0 >> 8, c = n0 & 255; s0 = (c < 128) ? (128 * t + c) : (DFF + 128 * t + (c - 128)); }
#pragma unroll 4
    for (int i = 0; i < 16; ++i) { const int kk = 4 * i + (lane >> 4);
        f32x4 w = *(const GAS f32x4*)(W + (size_t)(k0 + kk) * ldw + s0 + (lane & 15) * 4);
        if (gain) w = w * gain[k0 + kk];
        LAS float* d = scr + kk * 65 + (lane & 15) * 4; d[0] = w.x; d[1] = w.y; d[2] = w.z; d[3] = w.w; }
    LDS_WAIT(); asm volatile("" ::: "memory");
    const int c = lane & 7;
#pragma unroll
    for (int j = 0; j < 8; ++j) { const int n = (lane >> 3) + 8 * j; const LAS float* s = scr + (8 * c) * 65 + n;
        v4u o; o.x = pk2(s[0 * 65], s[1 * 65]); o.y = pk2(s[2 * 65], s[3 * 65]); o.z = pk2(s[4 * 65], s[5 * 65]); o.w = pk2(s[6 * 65], s[7 * 65]);
        *(GAS v4u*)(WT + (size_t)(n0 + n) * K + k0 + 8 * c) = o; }
    LDS_WAIT(); asm volatile("" ::: "memory");
}

__device__ __forceinline__ void prologue(const Args& a, LAS unsigned char* lds, int tid, int lane, int wave) {
    unsigned char* ws = a.ws;
    LAS float* scr = (LAS float*)(lds + wave * 16640);
    const int gw = blockIdx.x * NWAVES + wave, NGW = gridDim.x * NWAVES;
    constexpr int I_IN0 = (D / 64) * (4096 / 64), I_O = (D / 64) * (D / 64), I_13 = (D / 64) * (2 * DFF / 64), I_2 = (DFF / 64) * (D / 64), I_QKV = (D / 64) * (3072 / 64);
    constexpr int NITEMS = I_IN0 + I_O + I_13 + I_2 + I_QKV + I_O + I_13 + I_2;
    for (int it = gw; it < NITEMS; it += NGW) {
        int r = it;
        if (r < I_IN0) { tr_item(a.hgrn_w_in, 4096, D, (bf16*)(ws + WS_WIN0), 4096, nullptr, 0, scr, r, lane); continue; } r -= I_IN0;
        if (r < I_O) { tr_item(a.hgrn_w_out, D, D, (bf16*)(ws + WS_WOUT0), D, a.hgrn_out_norm, 0, scr, r, lane); continue; } r -= I_O;
        if (r < I_13) { tr_item(a.ffn_w13, 2 * DFF, D, (bf16*)(ws + WS_W13_0), 2 * DFF, a.norm_ffn, 1, scr, r, lane); continue; } r -= I_13;
        if (r < I_2) { tr_item(a.ffn_w2, D, DFF, (bf16*)(ws + WS_W2_0), D, nullptr, 0, scr, r, lane); continue; } r -= I_2;
        if (r < I_QKV) { tr_item(a.moba_w_in, 3072, D, (bf16*)(ws + WS_WQKV), 3072, a.norm_mix + D, 0, scr, r, lane); continue; } r -= I_QKV;
        if (r < I_O) { tr_item(a.moba_w_out, D, D, (bf16*)(ws + WS_WOUT1), D, nullptr, 0, scr, r, lane); continue; } r -= I_O;
        if (r < I_13) { tr_item(a.ffn_w13 + (size_t)D * 2 * DFF, 2 * DFF, D, (bf16*)(ws + WS_W13_1), 2 * DFF, a.norm_ffn + D, 1, scr, r, lane); continue; } r -= I_13;
        tr_item(a.ffn_w2 + (size_t)DFF * D, D, DFF, (bf16*)(ws + WS_W2_1), D, nullptr, 0, scr, r, lane);
    }
    bf16* XN0 = (bf16*)(ws + WS_A0);
    for (int m = gw; m < M; m += NGW) {
        const GAS f32x4* xr = (const GAS f32x4*)(a.x + (size_t)m * D) + lane;
        f32x4 v[4]; float s = 0.f;
#pragma unroll
        for (int j = 0; j < 4; ++j) { v[j] = xr[64 * j]; s += (v[j].x * v[j].x + v[j].y * v[j].y) + (v[j].z * v[j].z + v[j].w * v[j].w); }
        const float rstd = rsqrtf(wave_sum(s) * (1.f / D) + EPS);
        GAS unsigned long long* o8 = (GAS unsigned long long*)(XN0 + (size_t)m * D) + lane;
#pragma unroll
        for (int j = 0; j < 4; ++j) { const f32x4 g = *((const GAS f32x4*)a.norm_mix + lane + 64 * j);
            o8[64 * j] = (unsigned long long)pk2(v[j].x * rstd * g.x, v[j].y * rstd * g.y) | ((unsigned long long)pk2(v[j].z * rstd * g.z, v[j].w * rstd * g.w) << 32); }
    }
    for (int i = blockIdx.x * (NWAVES * 64) + tid; i < 64 * D; i += gridDim.x * NWAVES * 64) ((float*)(ws + WS_KMEAN))[i] = 0.f;
    if (blockIdx.x == 0) {
        float* lb = (float*)(ws + WS_LB); int* bkt = (int*)(ws + WS_BKT);
        for (int i = tid; i < 1024; i += NWAVES * 64) { const float l0 = a.lb_logits[i], l1 = a.lb_logits[1024 + i]; const float mx = fmaxf(l0, l1); const float e0 = expf(l0 - mx), e1 = expf(l1 - mx); lb[i] = e0 / (e0 + e1); }
        for (int i = tid; i < T; i += NWAVES * 64) {
            int bk;
            if (i < 16) bk = i;
            else { const float nf = (float)i; const float v = logf(nf / 16.f) / 4.1588830833596715f * 16.f; bk = 16 + (int)v; if (bk > 31) bk = 31; }
            bkt[i] = bk;
            if (i < 1024) { float* tab2 = (float*)(ws + WS_YMEAN);
#pragma unroll
                for (int hh = 0; hh < 8; ++hh) tab2[hh * 1024 + i] = a.rel_table[bk * 8 + hh] * 1.4426950408889634f; }
        }
        for (int i = tid; i < 512; i += NWAVES * 64) ((unsigned*)(ws + 4096))[i] = 0u;
        for (int i = tid; i < 3456; i += NWAVES * 64) ((unsigned*)(ws + WS_BAR))[i] = 0u;
    }
}

__device__ __forceinline__ void final_norm_phase(const Args& a, int lane, int wave) {
    const int gw = blockIdx.x * NWAVES + wave, NGW = gridDim.x * NWAVES;
    const float* SSQ = (const float*)(a.ws + WS_SSQ);
    for (int m = gw; m < M; m += NGW) {
        const float rstd = pg8::rstd_from16(SSQ + (size_t)m * 16);
        GAS f32x4* xr = (GAS f32x4*)(a.out + (size_t)m * D) + lane;
#pragma unroll
        for (int j = 0; j < 4; ++j) { const f32x4 g = *((const GAS f32x4*)a.final_norm + lane + 64 * j); f32x4 v = xr[64 * j]; v = v * rstd * g; xr[64 * j] = v; }
    }
}

__device__ __forceinline__ float sigmoidf_(float x) { return 1.f / (1.f + __expf(-x)); }

namespace moba {
using bf16x8 = __attribute__((ext_vector_type(8))) short;
using s16x4 = __attribute__((ext_vector_type(4))) short;
using f32x16 = __attribute__((ext_vector_type(16))) float;
using u32x4 = __attribute__((ext_vector_type(4))) unsigned;
#define KSWZ(row, colB) ((row) * 256 + ((colB) ^ (((row) & 7) << 4)))
#define SBAR() __builtin_amdgcn_sched_barrier(0)
constexpr float C2 = 0.08838834764831845f * 1.4426950408889634f;
constexpr float LOG2E = 1.4426950408889634f;
__device__ __forceinline__ int crow(int r, int hi) { return (r & 3) + 8 * (r >> 2) + 4 * hi; }
__device__ __forceinline__ unsigned cvtpk(float lo, float hi) { unsigned r; asm volatile("v_cvt_pk_bf16_f32 %0, %1, %2" : "=v"(r) : "v"(lo), "v"(hi)); return r; }
__device__ __forceinline__ int v_st(int k, int c) { const int kk = (k & ~0xC) | ((k & 4) << 1) | ((k & 8) >> 1); return ((kk >> 3) * 4 + (c >> 5)) * 512 + ((kk & 7) * 32 + (c & 31)) * 2; }
__device__ __forceinline__ int v_rd_base(int lane) { return ((lane & 3) << 3) | (((lane >> 2) & 3) << 6) | (((lane >> 4) & 1) << 5) | (((lane >> 5) & 1) << 8); }
constexpr int v_rd_off(int d0, int ks, int half) { return d0 * 512 + ks * 4096 + half * 2048; }
template <int OFF> __device__ __forceinline__ s16x4 tr_read(int vb) {
    s16x4 r; asm volatile("ds_read_b64_tr_b16 %0, %1 offset:%2" : "=&v"(r) : "v"(vb), "i"(OFF) : "memory"); return r;
}
template <int D0> __device__ __forceinline__ void pv_one(f32x16& od, int vb, bf16x8 pa0, bf16x8 pa1, bf16x8 pa2, bf16x8 pa3) {
    const s16x4 l0 = tr_read<v_rd_off(D0, 0, 0)>(vb), h0 = tr_read<v_rd_off(D0, 0, 1)>(vb), l1 = tr_read<v_rd_off(D0, 1, 0)>(vb), h1 = tr_read<v_rd_off(D0, 1, 1)>(vb);
    const s16x4 l2 = tr_read<v_rd_off(D0, 2, 0)>(vb), h2 = tr_read<v_rd_off(D0, 2, 1)>(vb), l3 = tr_read<v_rd_off(D0, 3, 0)>(vb), h3 = tr_read<v_rd_off(D0, 3, 1)>(vb);
    asm volatile("s_waitcnt lgkmcnt(0)" ::: "memory"); SBAR();
#define PK(L, Hh) (bf16x8){L[0], L[1], L[2], L[3], Hh[0], Hh[1], Hh[2], Hh[3]}
    od = __builtin_amdgcn_mfma_f32_32x32x16_bf16(pa0, PK(l0, h0), od, 0, 0, 0);
    od = __builtin_amdgcn_mfma_f32_32x32x16_bf16(pa1, PK(l1, h1), od, 0, 0, 0);
    od = __builtin_amdgcn_mfma_f32_32x32x16_bf16(pa2, PK(l2, h2), od, 0, 0, 0);
    od = __builtin_amdgcn_mfma_f32_32x32x16_bf16(pa3, PK(l3, h3), od, 0, 0, 0);
#undef PK
}
__device__ __forceinline__ void qkt(f32x16& p0, f32x16& p1, const LAS unsigned char* Ks, const bf16x8 (&qr)[8], int r32, int hi) {
    p0 = f32x16{}; p1 = f32x16{};
#pragma unroll
    for (int d0 = 0; d0 < 8; ++d0) { const int cb = (d0 * 16 + hi * 8) * 2;
        const bf16x8 b0 = *(const LAS bf16x8*)(Ks + KSWZ(r32, cb));
        const bf16x8 b1 = *(const LAS bf16x8*)(Ks + KSWZ(32 + r32, cb));
        p0 = __builtin_amdgcn_mfma_f32_32x32x16_bf16(b0, qr[d0], p0, 0, 0, 0);
        p1 = __builtin_amdgcn_mfma_f32_32x32x16_bf16(b1, qr[d0], p1, 0, 0, 0); }
}
__device__ __forceinline__ void softmax_step(f32x16& p0, f32x16& p1, float& m_reg, float& l_reg, float& alpha, bf16x8& pa0, bf16x8& pa1, bf16x8& pa2, bf16x8& pa3) {
    float pmax = p0[0];
#pragma unroll
    for (int r = 1; r < 16; ++r) pmax = fmaxf(pmax, p0[r]);
#pragma unroll
    for (int r = 0; r < 16; ++r) pmax = fmaxf(pmax, p1[r]);
    { auto rr = __builtin_amdgcn_permlane32_swap(__float_as_uint(pmax), __float_as_uint(pmax), false, false);
      pmax = fmaxf(__uint_as_float(rr[0]), __uint_as_float(rr[1])); }
    const float mn = fmaxf(m_reg, pmax);
    alpha = __builtin_amdgcn_exp2f(m_reg - mn); m_reg = mn;
#pragma unroll
    for (int r = 0; r < 16; ++r) { p0[r] = __builtin_amdgcn_exp2f(p0[r] - mn); p1[r] = __builtin_amdgcn_exp2f(p1[r] - mn); }
    float ps = 0.f;
#pragma unroll
    for (int r = 0; r < 16; ++r) ps += p0[r];
#pragma unroll
    for (int r = 0; r < 16; ++r) ps += p1[r];
    { auto rr = __builtin_amdgcn_permlane32_swap(__float_as_uint(ps), __float_as_uint(ps), false, false);
      ps = __uint_as_float(rr[0]) + __uint_as_float(rr[1]); }
    l_reg = l_reg * alpha + ps;
#define PK4(P, BASE, OUT) do { unsigned a0 = cvtpk(P[BASE + 0], P[BASE + 1]), a1 = cvtpk(P[BASE + 2], P[BASE + 3]);   \
    unsigned b0 = cvtpk(P[BASE + 4], P[BASE + 5]), b1 = cvtpk(P[BASE + 6], P[BASE + 7]);                              \
    auto r0 = __builtin_amdgcn_permlane32_swap(a0, b0, false, false); auto r1 = __builtin_amdgcn_permlane32_swap(a1, b1, false, false); \
    u32x4 w = {r0[0], r1[0], r0[1], r1[1]}; OUT = *reinterpret_cast<bf16x8*>(&w); } while (0)
    PK4(p0, 0, pa0); PK4(p0, 8, pa1); PK4(p1, 0, pa2); PK4(p1, 8, pa3);
#undef PK4
}

constexpr int L_V = 0, L_K = 65536, L_TAB = 131072, L_WSCR = 135168, L_SCHED = 143360, L_STG = 145920;

__device__ __forceinline__ void load_kv_block(LAS unsigned char* lds, const bf16* Kh, const bf16* Vh, int tid) {
    const int sr = tid >> 4, sc = (tid & 15) * 8;
#pragma unroll
    for (int kt = 0; kt < 4; ++kt) {
        const bf16x8 k0 = *(const bf16x8*)(Kh + (size_t)(kt * 64 + sr) * D + sc), k1 = *(const bf16x8*)(Kh + (size_t)(kt * 64 + 32 + sr) * D + sc);
        const bf16x8 v0 = *(const bf16x8*)(Vh + (size_t)(kt * 64 + sr) * D + sc), v1 = *(const bf16x8*)(Vh + (size_t)(kt * 64 + 32 + sr) * D + sc);
        *(LAS bf16x8*)(lds + L_K + kt * 16384 + KSWZ(sr, sc * 2)) = k0;
        *(LAS bf16x8*)(lds + L_K + kt * 16384 + KSWZ(32 + sr, sc * 2)) = k1;
        *(LAS bf16x8*)(lds + L_V + kt * 16384 + v_st(sr, sc)) = v0;
        *(LAS bf16x8*)(lds + L_V + kt * 16384 + v_st(32 + sr, sc)) = v1;
    }
}

template <bool CAUSAL>
__device__ __forceinline__ void wave_flash(LAS unsigned char* lds, const bf16x8 (&qr)[8], int qpos_rel, int ntile, int lane, int wid, f32x16 (&o)[4], float& m_reg, float& l_reg) {
    const int r32 = lane & 31, hi = lane >> 5;
    const LAS float* tab2 = (const LAS float*)(lds + L_TAB);
    LAS float* al_l = (LAS float*)(lds + L_WSCR + wid * 1024);
    const int vb0 = (int)(unsigned long)(lds + L_V) + v_rd_base(lane);
    const bool far = !CAUSAL && __all(qpos_rel - 255 >= 1023);
    const float cfar = tab2[1023];
    for (int kt = 0; kt < ntile; ++kt) {
        f32x16 p0, p1;
        qkt(p0, p1, lds + L_K + kt * 16384, qr, r32, hi);
        if (far) {
#pragma unroll
            for (int r = 0; r < 16; ++r) { p0[r] = fmaf(p0[r], C2, cfar); p1[r] = fmaf(p1[r], C2, cfar); }
        } else {
#pragma unroll
            for (int r = 0; r < 16; ++r) {
                const int d0_ = qpos_rel - (kt * 64 + crow(r, hi)), d1_ = d0_ - 32;
                const float b0 = tab2[min(max(d0_, 0), 1023)], b1 = tab2[min(max(d1_, 0), 1023)];
                float t0 = fmaf(p0[r], C2, b0), t1 = fmaf(p1[r], C2, b1);
                if (CAUSAL) { if (d0_ < 0) t0 = -1e30f; if (d1_ < 0) t1 = -1e30f; }
                p0[r] = t0; p1[r] = t1;
            }
        }
        float alpha; bf16x8 pa0, pa1, pa2, pa3;
        softmax_step(p0, p1, m_reg, l_reg, alpha, pa0, pa1, pa2, pa3);
        if (__any(alpha < 1.f)) {
            if (hi == 0) al_l[r32] = alpha;
            asm volatile("s_waitcnt lgkmcnt(0)" ::: "memory");
#pragma unroll
            for (int r = 0; r < 16; ++r) { const float av = al_l[crow(r, hi)];
#pragma unroll
                for (int d = 0; d < 4; ++d) o[d][r] *= av; }
        }
        const int vb = vb0 + kt * 16384;
        pv_one<0>(o[0], vb, pa0, pa1, pa2, pa3); pv_one<1>(o[1], vb, pa0, pa1, pa2, pa3); pv_one<2>(o[2], vb, pa0, pa1, pa2, pa3); pv_one<3>(o[3], vb, pa0, pa1, pa2, pa3);
    }
}
}

constexpr size_t WS_CNT = 4096;
constexpr size_t WS_TAB2 = WS_YMEAN;
constexpr size_t WS_LIST = WS_WIN0;
constexpr size_t WS_LSE = WS_G;
constexpr size_t WS_PO0 = WS_A0, WS_PO1 = WS_A1, WS_PO2 = WS_A4;

__device__ __forceinline__ void topk_phase(const Args& a, LAS unsigned char* lds, int tid, int lane, int wid) {
    using namespace moba;
    const bf16* Q = (const bf16*)(a.ws + WS_A2); const float* kmean = (const float*)(a.ws + WS_KMEAN);
    unsigned* cnt = (unsigned*)(a.ws + WS_CNT); unsigned short* lists = (unsigned short*)(a.ws + WS_LIST);
    LAS unsigned* lcnt = (LAS unsigned*)lds;
    const int r32 = lane & 31, hi = lane >> 5;
    for (int it = blockIdx.x; it < 512; it += gridDim.x) {
        const int bh = it >> 5, j = it & 31, b = bh >> 3, h = bh & 7;
        if (j == 0) continue;
        __syncthreads();
        if (tid < 64) lcnt[tid] = 0u;
        __syncthreads();
        bf16x8 ahi[8], alo[8];
        const float* kp = kmean + (size_t)(b * 32 + r32) * D + h * 128 + hi * 8;
#pragma unroll
        for (int ks = 0; ks < 8; ++ks) {
            const f32x4 v0 = *(const f32x4*)(kp + 16 * ks), v1 = *(const f32x4*)(kp + 16 * ks + 4);
            const unsigned h0 = pk2(v0[0], v0[1]), h1 = pk2(v0[2], v0[3]), h2 = pk2(v1[0], v1[1]), h3 = pk2(v1[2], v1[3]);
            const unsigned l0 = pk2(v0[0] - __uint_as_float(h0 << 16), v0[1] - __uint_as_float(h0 & 0xffff0000u)), l1 = pk2(v0[2] - __uint_as_float(h1 << 16), v0[3] - __uint_as_float(h1 & 0xffff0000u));
            const unsigned l2 = pk2(v1[0] - __uint_as_float(h2 << 16), v1[1] - __uint_as_float(h2 & 0xffff0000u)), l3 = pk2(v1[2] - __uint_as_float(h3 << 16), v1[3] - __uint_as_float(h3 & 0xffff0000u));
            u32x4 wh = {h0, h1, h2, h3}, wl = {l0, l1, l2, l3};
            ahi[ks] = *reinterpret_cast<bf16x8*>(&wh); alo[ks] = *reinterpret_cast<bf16x8*>(&wl);
        }
        const int qpos = j * 256 + wid * 32 + r32, m = b * T + qpos;
        const bf16* Qw = Q + (size_t)m * D + h * 128 + hi * 8;
        f32x16 gacc = {};
#pragma unroll
        for (int ks = 0; ks < 8; ++ks) { const bf16x8 qv = *(const bf16x8*)(Qw + 16 * ks);
            gacc = __builtin_amdgcn_mfma_f32_32x32x16_bf16(ahi[ks], qv, gacc, 0, 0, 0);
            gacc = __builtin_amdgcn_mfma_f32_32x32x16_bf16(alo[ks], qv, gacc, 0, 0, 0); }
        float cv[6]; int ci[6];
        unsigned usedm = 0u;
#pragma unroll
        for (int s = 0; s < 3; ++s) { int best = 0; float val = -INFINITY; bool have = false;
#pragma unroll
            for (int r = 0; r < 16; ++r) { const float gv = (crow(r, hi) < j) ? gacc[r] : -INFINITY; const bool free_ = !((usedm >> r) & 1u); if (free_ && (!have || gv > val)) { best = r; val = gv; have = true; } }
            usedm |= 1u << best; cv[s] = val; ci[s] = crow(best, hi); }
#pragma unroll
        for (int s = 0; s < 3; ++s) { cv[3 + s] = __shfl_xor(cv[s], 32); ci[3 + s] = __shfl_xor(ci[s], 32); }
        int selv[3]; unsigned um = 0u;
#pragma unroll
        for (int s = 0; s < 3; ++s) { int best = 0; float val = 0.f; int bidx = 0; bool have = false;
#pragma unroll
            for (int c = 0; c < 6; ++c) { const bool free_ = !((um >> c) & 1u); if (free_ && (!have || cv[c] > val || (cv[c] == val && ci[c] < bidx))) { best = c; val = cv[c]; bidx = ci[c]; have = true; } }
            um |= 1u << best; selv[s] = bidx; }
        unsigned lpos[3] = {0u, 0u, 0u};
        if (hi == 0) {
#pragma unroll
            for (int s = 0; s < 3; ++s) if (s < j) lpos[s] = atomicAdd((unsigned*)&lcnt[selv[s]], 1u);
        }
        __syncthreads();
        if (tid < 32) { const unsigned c = lcnt[tid]; unsigned base = 0u; if (c) base = atomicAdd(&cnt[bh * 32 + tid], c); lcnt[32 + tid] = base; }
        __syncthreads();
        if (hi == 0) {
#pragma unroll
            for (int s = 0; s < 3; ++s)
                if (s < j) lists[(size_t)(bh * 32 + selv[s]) * 8192 + lcnt[32 + selv[s]] + lpos[s]] = (unsigned short)(qpos | (s << 13));
        }
    }
}

__device__ __forceinline__ void attn_sel_phase(const Args& a, LAS unsigned char* lds, int tid, int lane, int wid) {
    using namespace moba;
    const bf16* Q = (const bf16*)(a.ws + WS_A2); const bf16* K = Q + (size_t)M * D; const bf16* V = K + (size_t)M * D;
    const unsigned* cnt = (const unsigned*)(a.ws + WS_CNT); const unsigned short* lists = (const unsigned short*)(a.ws + WS_LIST);
    const float* tab2g = (const float*)(a.ws + WS_TAB2); float* LSE = (float*)(a.ws + WS_LSE);
    LAS int* P = (LAS int*)(lds + L_SCHED);
    {
        const int ns = ((int)cnt[tid] + 31) >> 5;
        int v = ns ? 8 * ((ns + 7) >> 3) + 4 : 0;
#pragma unroll
        for (int o = 1; o < 64; o <<= 1) { const int t = __shfl_up(v, o); if (lane >= o) v += t; }
        LAS int* wt = (LAS int*)(lds + L_WSCR);
        if (lane == 63) wt[wid] = v;
        __syncthreads();
        int off = 0;
        for (int w = 0; w < wid; ++w) off += wt[w];
        P[tid + 1] = off + v;
        if (tid == 0) P[0] = 0;
        __syncthreads();
    }
    const int total = P[512];
    const int lo = (int)(((long)blockIdx.x * total) / gridDim.x), hiE = (int)(((long)(blockIdx.x + 1) * total) / gridDim.x);
    int li = 0;
    { int a_ = 0, b_ = 512; while (b_ - a_ > 1) { const int mid = (a_ + b_) >> 1; if (P[mid] <= lo) a_ = mid; else b_ = mid; } li = a_; }
    const int r32 = lane & 31, hi = lane >> 5;
    for (; li < 512 && P[li] < hiE; ++li) {
        const int p0_ = P[li], p1_ = P[li + 1];
        if (p1_ <= lo || p1_ == p0_) continue;
        const int L = (int)cnt[li], nsub = (L + 31) >> 5, cst = p1_ - p0_;
        const int x0 = max(lo, p0_) - p0_, x1 = min(hiE, p1_) - p0_;
        const int seg_lo = x0 <= 0 ? 0 : (x0 >= cst ? nsub : min(nsub, 8 * (max(x0 - 4, 0) >> 3)));
        const int seg_hi = x1 <= 0 ? 0 : (x1 >= cst ? nsub : min(nsub, 8 * (max(x1 - 4, 0) >> 3)));
        if (seg_lo >= seg_hi) continue;
        const int b = li >> 8, h = (li >> 5) & 7, n = li & 31;
        __syncthreads();
        load_kv_block(lds, K + (size_t)(b * T + n * 256) * D + h * 128, V + (size_t)(b * T + n * 256) * D + h * 128, tid);
        for (int e = tid; e < 1024; e += 512) ((LAS float*)(lds + L_TAB))[e] = tab2g[h * 1024 + e];
        __syncthreads();
        const unsigned short* lp = lists + (size_t)li * 8192;
        for (int st = seg_lo + wid; st < seg_hi; st += 8) {
            const int e = st * 32 + r32; const bool valid = e < L;
            const unsigned ent = lp[valid ? e : (L - 1)];
            const int qpos = ent & 8191, slot = ent >> 13, m = b * T + qpos;
            bf16x8 qr[8];
            const bf16* Qw = Q + (size_t)m * D + h * 128 + hi * 8;
#pragma unroll
            for (int d0 = 0; d0 < 8; ++d0) qr[d0] = *(const bf16x8*)(Qw + d0 * 16);
            f32x16 o[4] = {}; float m_reg = -1e30f, l_reg = 0.f;
            wave_flash<false>(lds, qr, qpos - n * 256, 4, lane, wid, o, m_reg, l_reg);
            LAS float* li_l = (LAS float*)(lds + L_WSCR + wid * 1024 + 128);
            LAS int* row_l = (LAS int*)(lds + L_WSCR + wid * 1024 + 256);
            if (hi == 0) { li_l[r32] = __builtin_amdgcn_rcpf(l_reg); row_l[r32] = valid ? ((slot << 20) | m) : -1;
                if (valid) LSE[((size_t)slot * M + m) * 8 + h] = m_reg + __builtin_amdgcn_logf(l_reg); }
            asm volatile("s_waitcnt lgkmcnt(0)" ::: "memory");
            LAS unsigned char* stg = lds + L_STG + wid * 2048;
            float rl[16];
#pragma unroll
            for (int r = 0; r < 16; ++r) rl[r] = li_l[crow(r, hi)];
#pragma unroll
            for (int d0 = 0; d0 < 4; ++d0) {
#pragma unroll
                for (int r = 0; r < 16; ++r) *(LAS unsigned short*)(stg + crow(r, hi) * 64 + r32 * 2) = (unsigned short)f2bf(o[d0][r] * rl[r]);
#pragma unroll
                for (int t2 = 0; t2 < 2; ++t2) {
                    const int id = t2 * 64 + lane, row = id >> 2, ch = id & 3;
                    const u32x4 v = *(const LAS u32x4*)(stg + row * 64 + ch * 16);
                    const int rm = row_l[row];
                    if (rm >= 0) {
                        const int sl = rm >> 20, mm = rm & 0xfffff;
                        *(u32x4*)((bf16*)(a.ws + (sl == 0 ? WS_PO0 : (sl == 1 ? WS_PO1 : WS_PO2))) + (size_t)mm * D + h * 128 + d0 * 32 + ch * 8) = v;
                    }
                }
            }
        }
    }
}

__device__ __forceinline__ void attn_own_phase(const Args& a, LAS unsigned char* lds, int tid, int lane, int wid) {
    using namespace moba;
    bf16* Q = (bf16*)(a.ws + WS_A2); const bf16* K = Q + (size_t)M * D; const bf16* V = K + (size_t)M * D;
    const float* tab2g = (const float*)(a.ws + WS_TAB2); const float* LSE = (const float*)(a.ws + WS_LSE);
    const int r32 = lane & 31, hi = lane >> 5;
    for (int u = blockIdx.x; u < 512; u += gridDim.x) {
        const int b = u >> 8, h = (u >> 5) & 7, n = u & 31;
        __syncthreads();
        load_kv_block(lds, K + (size_t)(b * T + n * 256) * D + h * 128, V + (size_t)(b * T + n * 256) * D + h * 128, tid);
        for (int e = tid; e < 1024; e += 512) ((LAS float*)(lds + L_TAB))[e] = tab2g[h * 1024 + e];
        __syncthreads();
        const int qrel = wid * 32 + r32, m = b * T + n * 256 + qrel;
        bf16x8 qr[8];
        const bf16* Qw = Q + (size_t)m * D + h * 128 + hi * 8;
#pragma unroll
        for (int d0 = 0; d0 < 8; ++d0) qr[d0] = *(const bf16x8*)(Qw + d0 * 16);
        f32x16 o[4] = {}; float m_reg = -1e30f, l_reg = 0.f;
        wave_flash<true>(lds, qr, qrel, (wid >> 1) + 1, lane, wid, o, m_reg, l_reg);
        const int nsel = n < 3 ? n : 3;
        float ls0 = -1e30f, ls1 = -1e30f, ls2 = -1e30f;
        if (nsel > 0) ls0 = LSE[((size_t)0 * M + m) * 8 + h];
        if (nsel > 1) ls1 = LSE[((size_t)1 * M + m) * 8 + h];
        if (nsel > 2) ls2 = LSE[((size_t)2 * M + m) * 8 + h];
        const float lown = m_reg + __builtin_amdgcn_logf(l_reg);
        const float Mx = fmaxf(fmaxf(lown, ls0), fmaxf(ls1, ls2));
        const float e0 = __builtin_amdgcn_exp2f(ls0 - Mx), e1 = __builtin_amdgcn_exp2f(ls1 - Mx), e2 = __builtin_amdgcn_exp2f(ls2 - Mx), eo = __builtin_amdgcn_exp2f(lown - Mx);
        const float iz = __builtin_amdgcn_rcpf((eo + e0) + (e1 + e2));
        LAS float* cf = (LAS float*)(lds + L_WSCR + wid * 1024 + 128);
        if (hi == 0) { cf[r32] = eo * iz * __builtin_amdgcn_rcpf(l_reg); cf[32 + r32] = e0 * iz; cf[64 + r32] = e1 * iz; cf[96 + r32] = e2 * iz; }
        asm volatile("s_waitcnt lgkmcnt(0)" ::: "memory");
        const bf16* P0 = (const bf16*)(a.ws + WS_PO0); const bf16* P1 = (const bf16*)(a.ws + WS_PO1); const bf16* P2 = (const bf16*)(a.ws + WS_PO2);
        LAS unsigned char* stg = lds + L_STG + wid * 2048;
        float co[16];
#pragma unroll
        for (int r = 0; r < 16; ++r) co[r] = cf[crow(r, hi)];
#pragma unroll
        for (int d0 = 0; d0 < 4; ++d0) {
#pragma unroll
            for (int r = 0; r < 16; ++r) *(LAS unsigned short*)(stg + crow(r, hi) * 64 + r32 * 2) = (unsigned short)f2bf(o[d0][r] * co[r]);
#pragma unroll
            for (int t2 = 0; t2 < 2; ++t2) {
                const int id = t2 * 64 + lane, row = id >> 2, ch = id & 3;
                const u32x4 ov = *(const LAS u32x4*)(stg + row * 64 + ch * 16);
                const size_t off = (size_t)(b * T + n * 256 + wid * 32 + row) * D + h * 128 + d0 * 32 + ch * 8;
                float acc[8];
                acc[0] = __uint_as_float(ov.x << 16); acc[1] = __uint_as_float(ov.x & 0xffff0000u); acc[2] = __uint_as_float(ov.y << 16); acc[3] = __uint_as_float(ov.y & 0xffff0000u);
                acc[4] = __uint_as_float(ov.z << 16); acc[5] = __uint_as_float(ov.z & 0xffff0000u); acc[6] = __uint_as_float(ov.w << 16); acc[7] = __uint_as_float(ov.w & 0xffff0000u);
#define ADDP(PP, CI) do { const u32x4 pv = *(const u32x4*)((PP) + off); const float cc = cf[(CI) * 32 + row];                                   \
    acc[0] = fmaf(cc, __uint_as_float(pv.x << 16), acc[0]); acc[1] = fmaf(cc, __uint_as_float(pv.x & 0xffff0000u), acc[1]);                     \
    acc[2] = fmaf(cc, __uint_as_float(pv.y << 16), acc[2]); acc[3] = fmaf(cc, __uint_as_float(pv.y & 0xffff0000u), acc[3]);                     \
    acc[4] = fmaf(cc, __uint_as_float(pv.z << 16), acc[4]); acc[5] = fmaf(cc, __uint_as_float(pv.z & 0xffff0000u), acc[5]);                     \
    acc[6] = fmaf(cc, __uint_as_float(pv.w << 16), acc[6]); acc[7] = fmaf(cc, __uint_as_float(pv.w & 0xffff0000u), acc[7]); } while (0)
                if (nsel > 0) ADDP(P0, 1);
                if (nsel > 1) ADDP(P1, 2);
                if (nsel > 2) ADDP(P2, 3);
#undef ADDP
                *(u32x4*)(Q + off) = (u32x4){pk2(acc[0], acc[1]), pk2(acc[2], acc[3]), pk2(acc[4], acc[5]), pk2(acc[6], acc[7])};
            }
        }
    }
}

namespace hg {
using namespace moba;
constexpr int H_TQ = 0, H_TK = 16384, H_TKT = 32768, H_TI = 49152, H_SIMG = 65536, H_OST = 98304, H_EL = 132096;
constexpr int OST_LD = 132;
__device__ __forceinline__ int kt_off(int n, int s) { return n * 128 + ((((s >> 3) ^ ((n >> 1) & 7))) << 4) + (s & 7) * 2; }

template <bool PASS_B>
__device__ __forceinline__ void hgrn_unit(const Args& a, LAS unsigned char* lds, int u, int tid, int lane, int wid) {
    unsigned char* ws = a.ws;
    const bf16* QS = (const bf16*)(ws + WS_A1); const float* LF = (const float*)(ws + WS_A2); const bf16* INP = (const bf16*)(ws + WS_A3); const bf16* OG = (const bf16*)(ws + WS_A4);
    bf16* OGATED = (bf16*)(ws + WS_A0); float* SSQH = (float*)(ws + WS_SSQH);
    float* TG = a.out;
    float* DG = a.out + (size_t)256 * 128 * 128;
    const int bh = u >> 4, g = u & 15, b = bh >> 3, h = bh & 7;
    const int r32 = lane & 31, hi = lane >> 5, tb = wid >> 2, db = wid & 3;
    const int nl = lane & 15, tq = lane >> 4, npre = 16 * wid + nl;
    f32x16 Sacc[2] = {};
    float dg = 1.f;
    if (PASS_B) {
        for (int gp = 0; gp < g; ++gp) {
            int lp_ = (4 * hi) * 128 + 32 * db + r32, lh_ = 4 * hi; asm volatile("" : "+v"(lp_), "+v"(lh_));
            const float* tg = TG + (size_t)(bh * 16 + gp) * 16384 + lp_; const float* dgp = DG + (size_t)(bh * 16 + gp) * 128 + lh_;
#pragma unroll
            for (int i = 0; i < 2; ++i) { const int nb = 2 * tb + i;
#pragma unroll
                for (int r = 0; r < 16; ++r) { const int n0_ = 32 * nb + (r & 3) + 8 * (r >> 2); Sacc[i][r] = fmaf(Sacc[i][r], dgp[n0_], tg[n0_ * 128]); } }
        }
#pragma unroll
        for (int i = 0; i < 2; ++i) { const int nb = 2 * tb + i;
#pragma unroll
            for (int r = 0; r < 16; ++r) { const int n = 32 * nb + crow(r, hi);
                *(LAS unsigned short*)(lds + H_SIMG + (nb >> 1) * 16384 + v_st(n & 63, 32 * db + r32)) = (unsigned short)f2bf(Sacc[i][r]); } }
    }
    float lfn[16]; unsigned short qn[16]; bf16x8 in0, in1; u32x4 gn0, gn1;
    const int sr = tid >> 4, sc = (tid & 15) * 8;
    const int pt = tid >> 3, pseg = tid & 7;
#define HG_LOAD(cc) do { const size_t m0_ = (size_t)b * T + g * 512 + (cc) * 64; const size_t off0_ = (m0_ + 16 * tq) * D + h * 128 + npre;                       \
        _Pragma("unroll") for (int i = 0; i < 16; ++i) { lfn[i] = LF[off0_ + (size_t)i * D]; if (PASS_B) qn[i] = QS[off0_ + (size_t)i * D]; }                      \
        in0 = *(const bf16x8*)(INP + (m0_ + sr) * D + h * 128 + sc); in1 = *(const bf16x8*)(INP + (m0_ + 32 + sr) * D + h * 128 + sc);                          \
        if (PASS_B) { const size_t go_ = (m0_ + pt) * D + h * 128 + 16 * pseg; gn0 = *(const u32x4*)(OG + go_); gn1 = *(const u32x4*)(OG + go_ + 8); } } while (0)
    HG_LOAD(0);
    for (int c = 0; c < 8; ++c) {
        const size_t m0 = (size_t)b * T + g * 512 + c * 64;
        u32x4 g0 = {}, g1 = {};
        {
            float lf[16], qv[16];
#pragma unroll
            for (int i = 0; i < 16; ++i) { lf[i] = lfn[i]; if (PASS_B) qv[i] = bf2f(qn[i]); }
            if (PASS_B) { g0 = gn0; g1 = gn1; }
            float cs[16]; float run = 0.f;
#pragma unroll
            for (int i = 0; i < 16; ++i) { run += lf[i]; cs[i] = run; }
            const float s0 = __shfl(run, nl), s1 = __shfl(run, nl + 16), s2 = __shfl(run, nl + 32), s3 = __shfl(run, nl + 48);
            const float pre = (tq > 0 ? s0 : 0.f) + (tq > 1 ? s1 : 0.f) + (tq > 2 ? s2 : 0.f);
            const float last = (s0 + s1) + (s2 + s3);
            unsigned kh[8];
#pragma unroll
            for (int i = 0; i < 16; i += 2) {
                float khv[2];
#pragma unroll
                for (int e = 0; e < 2; ++e) {
                    const int t = 16 * tq + i + e; const float cum = pre + cs[i + e];
                    const float kk = 1.f - __expf(lf[i + e]);
                    khv[e] = kk * __expf(last - cum);
                    if (PASS_B) {
                        *(LAS unsigned short*)(lds + H_TQ + KSWZ(t, npre * 2)) = (unsigned short)f2bf(qv[i + e] * __expf(cum));
                        *(LAS unsigned short*)(lds + H_TK + KSWZ(t, npre * 2)) = (unsigned short)f2bf(kk * __expf(-cum));
                    }
                }
                kh[i >> 1] = pk2(khv[0], khv[1]);
            }
            *(LAS u32x4*)(lds + H_TKT + kt_off(npre, 16 * tq)) = (u32x4){kh[0], kh[1], kh[2], kh[3]};
            *(LAS u32x4*)(lds + H_TKT + kt_off(npre, 16 * tq + 8)) = (u32x4){kh[4], kh[5], kh[6], kh[7]};
            const float el = __expf(last);
            if (tq == 0) *(LAS float*)(lds + H_EL + npre * 4) = el;
            dg *= el;
            *(LAS bf16x8*)(lds + H_TI + v_st(sr, sc)) = in0;
            *(LAS bf16x8*)(lds + H_TI + v_st(32 + sr, sc)) = in1;
        }
        __syncthreads();
        {
#define PK(L, Hh) (bf16x8){L[0], L[1], L[2], L[3], Hh[0], Hh[1], Hh[2], Hh[3]}
            bf16x8 pa0, pa1, pa2, pa3; bf16x8 qr[8];
            if (PASS_B) {
                const int t = 32 * tb + r32;
#pragma unroll
                for (int d0 = 0; d0 < 8; ++d0) qr[d0] = *(const LAS bf16x8*)(lds + H_TQ + KSWZ(t, (d0 * 16 + hi * 8) * 2));
                f32x16 p0, p1;
                qkt(p0, p1, lds + H_TK, qr, r32, hi);
#pragma unroll
                for (int r = 0; r < 16; ++r) { const int s0_ = crow(r, hi); if (s0_ > t) p0[r] = 0.f; if (s0_ + 32 > t) p1[r] = 0.f; }
#define PK4(P, BASE, OUT) do { unsigned a0 = cvtpk(P[BASE + 0], P[BASE + 1]), a1 = cvtpk(P[BASE + 2], P[BASE + 3]);   \
    unsigned b0 = cvtpk(P[BASE + 4], P[BASE + 5]), b1 = cvtpk(P[BASE + 6], P[BASE + 7]);                              \
    auto r0 = __builtin_amdgcn_permlane32_swap(a0, b0, false, false); auto r1 = __builtin_amdgcn_permlane32_swap(a1, b1, false, false); \
    u32x4 w = {r0[0], r1[0], r0[1], r1[1]}; OUT = *reinterpret_cast<bf16x8*>(&w); } while (0)
                PK4(p0, 0, pa0); PK4(p0, 8, pa1); PK4(p1, 0, pa2); PK4(p1, 8, pa3);
#undef PK4
            }
            if (c < 7) HG_LOAD(c + 1);
            const int vbI = (int)(unsigned long)(lds + H_TI) + v_rd_base(lane) + db * 512;
            bf16x8 bI[4];
            {
                const s16x4 l0 = tr_read<v_rd_off(0, 0, 0)>(vbI), h0 = tr_read<v_rd_off(0, 0, 1)>(vbI), l1 = tr_read<v_rd_off(0, 1, 0)>(vbI), h1 = tr_read<v_rd_off(0, 1, 1)>(vbI);
                const s16x4 l2 = tr_read<v_rd_off(0, 2, 0)>(vbI), h2 = tr_read<v_rd_off(0, 2, 1)>(vbI), l3 = tr_read<v_rd_off(0, 3, 0)>(vbI), h3 = tr_read<v_rd_off(0, 3, 1)>(vbI);
                asm volatile("s_waitcnt lgkmcnt(0)" ::: "memory"); SBAR();
                bI[0] = PK(l0, h0); bI[1] = PK(l1, h1); bI[2] = PK(l2, h2); bI[3] = PK(l3, h3);
            }
            if (PASS_B) {
                f32x16 od = {};
                od = __builtin_amdgcn_mfma_f32_32x32x16_bf16(pa0, bI[0], od, 0, 0, 0);
                od = __builtin_amdgcn_mfma_f32_32x32x16_bf16(pa1, bI[1], od, 0, 0, 0);
                od = __builtin_amdgcn_mfma_f32_32x32x16_bf16(pa2, bI[2], od, 0, 0, 0);
                od = __builtin_amdgcn_mfma_f32_32x32x16_bf16(pa3, bI[3], od, 0, 0, 0);
#pragma unroll
                for (int hf = 0; hf < 2; ++hf) {
                    const int vbS = (int)(unsigned long)(lds + H_SIMG) + hf * 16384 + v_rd_base(lane) + db * 512;
                    const s16x4 l0 = tr_read<v_rd_off(0, 0, 0)>(vbS), h0 = tr_read<v_rd_off(0, 0, 1)>(vbS), l1 = tr_read<v_rd_off(0, 1, 0)>(vbS), h1 = tr_read<v_rd_off(0, 1, 1)>(vbS);
                    const s16x4 l2 = tr_read<v_rd_off(0, 2, 0)>(vbS), h2 = tr_read<v_rd_off(0, 2, 1)>(vbS), l3 = tr_read<v_rd_off(0, 3, 0)>(vbS), h3 = tr_read<v_rd_off(0, 3, 1)>(vbS);
                    asm volatile("s_waitcnt lgkmcnt(0)" ::: "memory"); SBAR();
                    od = __builtin_amdgcn_mfma_f32_32x32x16_bf16(qr[hf * 4 + 0], PK(l0, h0), od, 0, 0, 0);
                    od = __builtin_amdgcn_mfma_f32_32x32x16_bf16(qr[hf * 4 + 1], PK(l1, h1), od, 0, 0, 0);
                    od = __builtin_amdgcn_mfma_f32_32x32x16_bf16(qr[hf * 4 + 2], PK(l2, h2), od, 0, 0, 0);
                    od = __builtin_amdgcn_mfma_f32_32x32x16_bf16(qr[hf * 4 + 3], PK(l3, h3), od, 0, 0, 0);
                }
#undef PK
                LAS float* ost = (LAS float*)(lds + H_OST);
#pragma unroll
                for (int r = 0; r < 16; ++r) ost[(32 * tb + crow(r, hi)) * OST_LD + 32 * db + r32] = od[r];
            }
            const LAS float* el = (const LAS float*)(lds + H_EL);
#pragma unroll
            for (int i = 0; i < 2; ++i) { const int nb = 2 * tb + i;
#pragma unroll
                for (int r = 0; r < 16; ++r) Sacc[i][r] *= el[32 * nb + crow(r, hi)];
#pragma unroll
                for (int ks = 0; ks < 4; ++ks) {
                    const bf16x8 af = *(const LAS bf16x8*)(lds + H_TKT + kt_off(32 * nb + r32, 16 * ks + 8 * hi));
                    Sacc[i] = __builtin_amdgcn_mfma_f32_32x32x16_bf16(af, bI[ks], Sacc[i], 0, 0, 0);
                } }
        }
        __syncthreads();
        if (PASS_B) {
#pragma unroll
            for (int i = 0; i < 2; ++i) { const int nb = 2 * tb + i;
#pragma unroll
                for (int r = 0; r < 16; ++r) { const int n = 32 * nb + crow(r, hi);
                    *(LAS unsigned short*)(lds + H_SIMG + (nb >> 1) * 16384 + v_st(n & 63, 32 * db + r32)) = (unsigned short)f2bf(Sacc[i][r]); } }
            const int t = pt, seg = pseg; const size_t go = (m0 + t) * D + h * 128 + 16 * seg;
            const LAS float* orow = (const LAS float*)(lds + H_OST) + t * OST_LD + 16 * seg;
            const unsigned gw[8] = {g0.x, g0.y, g0.z, g0.w, g1.x, g1.y, g1.z, g1.w};
            float ssq = 0.f; unsigned ow[8];
#pragma unroll
            for (int e = 0; e < 8; ++e) { const float o0 = orow[2 * e], o1 = orow[2 * e + 1]; ssq = fmaf(o0, o0, ssq); ssq = fmaf(o1, o1, ssq);
                ow[e] = pk2(o0 * __uint_as_float(gw[e] << 16), o1 * __uint_as_float(gw[e] & 0xffff0000u)); }
            *(u32x4*)(OGATED + go) = (u32x4){ow[0], ow[1], ow[2], ow[3]}; *(u32x4*)(OGATED + go + 8) = (u32x4){ow[4], ow[5], ow[6], ow[7]};
            ssq += __shfl_xor(ssq, 1); ssq += __shfl_xor(ssq, 2); ssq += __shfl_xor(ssq, 4);
            if (seg == 0) SSQH[(m0 + t) * 8 + h] = ssq;
        }
    }
    if (!PASS_B) {
        int col_ = 32 * db + r32; asm volatile("" : "+v"(col_));
        float* tg = TG + (size_t)u * 16384 + col_;
#pragma unroll
        for (int i = 0; i < 2; ++i) { const int nb = 2 * tb + i;
#pragma unroll
            for (int r = 0; r < 16; ++r) tg[(32 * nb + crow(r, hi)) * 128] = Sacc[i][r]; }
        if (tq == 0) DG[(size_t)u * 128 + npre] = dg;
    }
    __syncthreads();
#undef HG_LOAD
}
}

#define XB_TMO      128
#define XB_XCNT(j)  (256  + 64 * (j))
#define XB_XSUB(j)  (1280 + 64 * (j))
#define XB_XGEN(j)  (2304 + 64 * (j))
#define XB_TOP      3328
#define XB_TOPGEN   3392
#define XCD_BAR_WORDS 3456
#define XB_SPIN_CAP (1u << 18)

__device__ __forceinline__ unsigned xb_ld(unsigned* p)              { return __hip_atomic_load(p, __ATOMIC_RELAXED, __HIP_MEMORY_SCOPE_AGENT); }
__device__ __forceinline__ unsigned xb_add(unsigned* p, unsigned v) { return __hip_atomic_fetch_add(p, v, __ATOMIC_RELAXED, __HIP_MEMORY_SCOPE_AGENT); }
__device__ __forceinline__ unsigned xb_xcc_id() { return (unsigned)__builtin_amdgcn_s_getreg((3 << 11) | 20) & 0xFu; }
#define XB_SPIN(cond, bar) do { unsigned _sp = 0; while (cond) { __builtin_amdgcn_s_sleep(1); \
    if ((++_sp & 255u) == 0u) { if (xb_ld(&(bar)[XB_TMO])) break; if (_sp > XB_SPIN_CAP) { atomicAdd(&(bar)[XB_TMO], 1u); break; } } } } while (0)

struct XcdBarrier {
    unsigned* bar; unsigned x;
    volatile LAS unsigned* st;
};

__device__ __forceinline__ XcdBarrier xcd_barrier_post(unsigned* bar, volatile LAS unsigned* st) {
    XcdBarrier b; b.bar = bar; b.x = xb_xcc_id(); b.st = st;
    if (threadIdx.x == 0) (void)xb_add(&bar[XB_XCNT(b.x)], 1u);
    return b;
}
__device__ __forceinline__ void xcd_barrier_complete(unsigned* bar, unsigned x, unsigned& nloc, unsigned& nx) {
    const unsigned G = gridDim.x * gridDim.y * gridDim.z;
    unsigned sum, cnt, mine, sp = 0u;
    for (;;) {
        sum = 0u; cnt = 0u; mine = 0u;
#pragma unroll
        for (unsigned j = 0; j < 16; ++j) { const unsigned c = xb_ld(&bar[XB_XCNT(j)]); sum += c; cnt += (c > 0u) ? 1u : 0u; mine = (j == x) ? c : mine; }
        if (sum == G) break;
        __builtin_amdgcn_s_sleep(1);
        if ((++sp & 255u) == 0u) { if (xb_ld(&bar[XB_TMO])) break; if (sp > XB_SPIN_CAP) { atomicAdd(&bar[XB_TMO], 1u); break; } }
    }
    nloc = mine > 0u ? mine : 1u; nx = cnt > 0u ? cnt : 1u;
}

__device__ __forceinline__ void xcd_barrier(const XcdBarrier& b) {
    asm volatile("s_waitcnt vmcnt(0)" ::: "memory");
    __syncthreads();
    if (threadIdx.x == 0) {
        unsigned* bar = b.bar;
        __builtin_amdgcn_s_waitcnt(0);
        unsigned nloc = b.st[0], nx = b.st[1];
        if (nloc == 0u) { xcd_barrier_complete(bar, b.x, nloc, nx); b.st[0] = nloc; b.st[1] = nx; }
        const unsigned old = xb_add(&bar[XB_XSUB(b.x)], 1u);
        const unsigned gen = old / nloc;
        if (old + 1u == (gen + 1u) * nloc) {
            __builtin_amdgcn_fence(__ATOMIC_RELEASE, "agent");
            asm volatile("s_waitcnt vmcnt(0)" ::: "memory");
            const unsigned og = xb_add(&bar[XB_TOP], 1u);
            const unsigned tg = og / nx;
            if (og + 1u == (tg + 1u) * nx) xb_add(&bar[XB_TOPGEN], 1u);
            else XB_SPIN(xb_ld(&bar[XB_TOPGEN]) == tg, bar);
            __builtin_amdgcn_fence(__ATOMIC_ACQUIRE, "agent");
            xb_add(&bar[XB_XGEN(b.x)], 1u);
            asm volatile("s_waitcnt vmcnt(0)" ::: "memory");
        } else {
            XB_SPIN(xb_ld(&bar[XB_XGEN(b.x)]) == gen, bar);
            __builtin_amdgcn_fence(__ATOMIC_ACQUIRE, "agent");
            asm volatile("s_waitcnt vmcnt(0)" ::: "memory");
        }
    }
    __syncthreads();
}

__global__ void __launch_bounds__(NWAVES * 64, 2) mk(Args a) {
    extern __shared__ __attribute__((aligned(16))) unsigned char lds_raw[];
    LAS unsigned char* lds = (LAS unsigned char*)lds_raw;
    const int tid = threadIdx.x, lane = tid & 63, wave = __builtin_amdgcn_readfirstlane(tid >> 6);
    unsigned char* ws = a.ws;
    const int lo = a.ph_lo, hi = a.ph_hi;
    const int G = gridDim.x;
    cg::grid_group grid = cg::this_grid();
#define IN(k) (lo <= (k) && (k) < hi)
#define SEAM(k) do { if (IN(k) && IN((k) + 1)) { if ((k) == 0) { grid.sync(); bar = xcd_barrier_post((unsigned*)(ws + WS_BAR), MISC); } else xcd_barrier(bar); } } while (0)
#define GEMM_PHASE(EPI, ...) pg8::gemm_phase<EPI, pg8::StaticOrder, true, true>(lds, g, S, E)
    float* SSQ = (float*)(ws + WS_SSQ);
    volatile LAS unsigned* MISC = (volatile LAS unsigned*)(lds + LDS_MISC);
    if (tid < 2) MISC[tid] = 0u;
    __syncthreads();
    XcdBarrier bar; bar.bar = (unsigned*)(ws + WS_BAR); bar.x = 0; bar.st = MISC;
    int ph = 0;
#ifdef PROBE_LO
    unsigned long long pt0 = 0, pt1 = 0;
#define PMARK(k) do { if (blockIdx.x == 0) { if ((k) == PROBE_LO) pt0 = __builtin_amdgcn_s_memrealtime(); if ((k) == PROBE_HI + 1) pt1 = __builtin_amdgcn_s_memrealtime(); } } while (0)
#else
#define PMARK(k) do { } while (0)
#endif
    PMARK(ph);
    if (IN(ph)) { prologue(a, lds, tid, lane, wave); }
    SEAM(ph); ++ph; PMARK(ph);
    if (IN(ph)) {
        pg8::Gemm g{(const bf16*)(ws + WS_A0), (const bf16*)(ws + WS_WIN0), M, 4096, D}; pg8::StaticOrder S; S.init(M, 4096, G, (int)blockIdx.x);
        pg8::EpiHgrnIn E{(bf16*)(ws + WS_A1), (float*)(ws + WS_A2), (bf16*)(ws + WS_A3), (bf16*)(ws + WS_A4), (const float*)(ws + WS_LB)};
        pg8::gemm_phase<pg8::EpiHgrnIn, pg8::StaticOrder, true, true>(lds, g, S, E);
    }
    SEAM(ph); ++ph; PMARK(ph);
    if (IN(ph)) { for (int u = blockIdx.x; u < 256; u += G) hg::hgrn_unit<false>(a, lds, u, tid, lane, wave); }
    SEAM(ph); ++ph; PMARK(ph);
    if (IN(ph)) { for (int u = blockIdx.x; u < 256; u += G) hg::hgrn_unit<true>(a, lds, u, tid, lane, wave); }
    SEAM(ph); ++ph; PMARK(ph);
    if (IN(ph)) {
        pg8::Gemm g{(const bf16*)(ws + WS_A0), (const bf16*)(ws + WS_WOUT0), M, D, D}; pg8::StaticOrder S; S.init(M, D, G, (int)blockIdx.x);
        pg8::EpiResid<1, false> E{a.x, a.out, (bf16*)(ws + WS_A1), nullptr, SSQ, (const float*)(ws + WS_SSQH)};
        pg8::gemm_phase<pg8::EpiResid<1, false>, pg8::StaticOrder, true, true>(lds, g, S, E);
    }
    SEAM(ph); ++ph; PMARK(ph);
    if (IN(ph)) {
        pg8::Gemm g{(const bf16*)(ws + WS_A1), (const bf16*)(ws + WS_W13_0), M, 2 * DFF, D}; pg8::StaticOrder S; S.init(M, 2 * DFF, G, (int)blockIdx.x);
        pg8::EpiSwiglu E{(bf16*)(ws + WS_A2), DFF, SSQ};
        pg8::gemm_phase<pg8::EpiSwiglu, pg8::StaticOrder, true, true>(lds, g, S, E);
    }
    SEAM(ph); ++ph; PMARK(ph);
    if (IN(ph)) {
        pg8::Gemm g{(const bf16*)(ws + WS_A2), (const bf16*)(ws + WS_W2_0), M, D, DFF}; pg8::StaticOrder S; S.init(M, D, G, (int)blockIdx.x);
        pg8::EpiResid<0, false> E{a.out, a.out, (bf16*)(ws + WS_A1), nullptr, SSQ, nullptr};
        pg8::gemm_phase<pg8::EpiResid<0, false>, pg8::StaticOrder, true, true>(lds, g, S, E);
    }
    SEAM(ph); ++ph; PMARK(ph);
    if (IN(ph)) {
        pg8::Gemm g{(const bf16*)(ws + WS_A1), (const bf16*)(ws + WS_WQKV), M, 3072, D}; pg8::StaticOrder S; S.init(M, 3072, G, (int)blockIdx.x);
        pg8::EpiQKV E{(bf16*)(ws + WS_A2), (size_t)M * D, SSQ, (float*)(ws + WS_KMEAN)};
        pg8::gemm_phase<pg8::EpiQKV, pg8::StaticOrder, true, true>(lds, g, S, E);
    }
    SEAM(ph); ++ph; PMARK(ph);
    if (IN(ph)) topk_phase(a, lds, tid, lane, wave);
    SEAM(ph); ++ph; PMARK(ph);
    if (IN(ph)) attn_sel_phase(a, lds, tid, lane, wave);
    SEAM(ph); ++ph; PMARK(ph);
    if (IN(ph)) attn_own_phase(a, lds, tid, lane, wave);
    SEAM(ph); ++ph; PMARK(ph);
    if (IN(ph)) {
        pg8::Gemm g{(const bf16*)(ws + WS_A2), (const bf16*)(ws + WS_WOUT1), M, D, D}; pg8::StaticOrder S; S.init(M, D, G, (int)blockIdx.x);
        pg8::EpiResid<0, false> E{a.out, a.out, (bf16*)(ws + WS_A1), nullptr, SSQ, nullptr};
        pg8::gemm_phase<pg8::EpiResid<0, false>, pg8::StaticOrder, true, true>(lds, g, S, E);
    }
    SEAM(ph); ++ph; PMARK(ph);
    if (IN(ph)) {
        pg8::Gemm g{(const bf16*)(ws + WS_A1), (const bf16*)(ws + WS_W13_1), M, 2 * DFF, D}; pg8::StaticOrder S; S.init(M, 2 * DFF, G, (int)blockIdx.x);
        pg8::EpiSwiglu E{(bf16*)(ws + WS_A2), DFF, SSQ};
        pg8::gemm_phase<pg8::EpiSwiglu, pg8::StaticOrder, true, true>(lds, g, S, E);
    }
    SEAM(ph); ++ph; PMARK(ph);
    if (IN(ph)) {
        pg8::Gemm g{(const bf16*)(ws + WS_A2), (const bf16*)(ws + WS_W2_1), M, D, DFF}; pg8::StaticOrder S; S.init(M, D, G, (int)blockIdx.x);
        pg8::EpiResid<0, false> E{a.out, a.out, (bf16*)(ws + WS_A1), nullptr, SSQ, nullptr};
        pg8::gemm_phase<pg8::EpiResid<0, false>, pg8::StaticOrder, true, true>(lds, g, S, E);
    }
    SEAM(ph); ++ph; PMARK(ph);
    if (IN(ph)) final_norm_phase(a, lane, wave);
    ++ph; PMARK(ph);
#ifdef PROBE_LO
    if (blockIdx.x == 0) { const unsigned long long te = __builtin_amdgcn_s_memrealtime(); const unsigned long long w = 4ull * (pt1 - pt0); while (__builtin_amdgcn_s_memrealtime() - te < w) __builtin_amdgcn_s_sleep(8); }
#endif
#undef IN
#undef SEAM
#undef GEMM_PHASE
}

extern "C" void kernel_launch(void* const* d_in, const int* in_sizes, int n_in, void* d_out, int out_size, void* d_ws, size_t ws_size, hipStream_t stream) {
    static int grid = 0;
    if (grid == 0) {
        if (n_in != 13 || out_size != M * D || ws_size < WS_END) { fprintf(stderr, "kernel_launch: unexpected problem (n_in %d out %d ws %zu)\n", n_in, out_size, ws_size); grid = -1; return; }
        int dev = 0, cus = 0, per_cu = 0;
        (void)hipGetDevice(&dev); (void)hipDeviceGetAttribute(&cus, hipDeviceAttributeMultiprocessorCount, dev);
        if (hipFuncSetAttribute((const void*)mk, hipFuncAttributeMaxDynamicSharedMemorySize, LDS_BYTES) != hipSuccess) { fprintf(stderr, "kernel_launch: hipFuncSetAttribute failed\n"); grid = -1; return; }
        if (hipOccupancyMaxActiveBlocksPerMultiprocessor(&per_cu, (const void*)mk, NWAVES * 64, LDS_BYTES) != hipSuccess || per_cu < 1) { fprintf(stderr, "kernel_launch: occupancy query says %d\n", per_cu); (void)hipGetLastError(); grid = -1; return; }
        grid = cus;
        if (grid != 256) fprintf(stderr, "kernel_launch: note: %d CUs\n", grid);
    }
    if (grid < 0) return;
    Args a{};
    a.x = (const float*)d_in[0]; a.norm_mix = (const float*)d_in[1]; a.norm_ffn = (const float*)d_in[2]; a.hgrn_w_in = (const float*)d_in[3]; a.lb_logits = (const float*)d_in[4];
    a.hgrn_out_norm = (const float*)d_in[5]; a.hgrn_w_out = (const float*)d_in[6]; a.moba_w_in = (const float*)d_in[7]; a.moba_w_out = (const float*)d_in[8]; a.rel_table = (const float*)d_in[9];
    a.ffn_w13 = (const float*)d_in[10]; a.ffn_w2 = (const float*)d_in[11]; a.final_norm = (const float*)d_in[12];
    a.out = (float*)d_out; a.ws = (unsigned char*)d_ws;
    a.ph_lo = 0; a.ph_hi = 15;
    void* args[] = {&a};
    hipError_t e = hipLaunchCooperativeKernel((const void*)mk, dim3(grid), dim3(NWAVES * 64), args, LDS_BYTES, stream);
    if (e != hipSuccess) fprintf(stderr, "kernel_launch: cooperative launch failed: %s (grid %d)\n", hipGetErrorString(e), grid);
}
```

```cpp
#include <hip/hip_runtime.h>
#include <hip/hip_cooperative_groups.h>
#include <cstdio>
#include <cstdint>
#include <cmath>
namespace pg8 {
#define PG8_LAS __attribute__((address_space(3)))
typedef unsigned short bf16_t;
typedef short bf16x8 __attribute__((ext_vector_type(8)));
typedef float f32x4 __attribute__((ext_vector_type(4)));
typedef unsigned u32x4 __attribute__((ext_vector_type(4)));
constexpr int BM = 256, BK = 64, HALF = 128, HTB = HALF * BK * 2  , STAGE_BYTES = 8 * HTB, NXCD = 8, WGM = 8;

__host__ __device__ __forceinline__ int lds_byte(int r, int c) { const int st = (r >> 4) * 2 + (c >> 5), rr = r & 15, cc = c & 31, ob = rr * 64 + cc * 2; return st * 1024 + (ob ^ (((ob >> 9) & 1) << 5)); }
__host__ __device__ __forceinline__ void stage_rc(int b, int& R, int& C) { const int st = b / 1024, sb = b % 1024, swz = sb ^ (((sb >> 9) & 1) << 5); R = (st >> 1) * 16 + swz / 64; C = (st & 1) * 32 + (swz % 64) / 2; }
__host__ __device__ __forceinline__ int perm32(int rho) { const int n = rho >> 4, i = rho & 15; return 8 * (i >> 2) + 4 * n + (i & 3); }

struct Unit { int pm, pn; };
struct Gemm { const bf16_t* A; const bf16_t* Bt; int M, N, K; };

struct StaticOrder {
    int nM, nN, nwg, G, c;
    __host__ __device__ void init(int M, int N, int G_, int c_) { nM = M / BM; nN = N / BM; nwg = nM * nN; G = G_; c = c_; }
    __host__ __device__ bool next(int i, Unit& u) const {
        const long L = (long)i * G + c; if (L >= nwg) return false;
        int wgid = (int)L; { const int q = nwg / NXCD, r = nwg % NXCD, xcd = wgid % NXCD, off = wgid / NXCD; wgid = (xcd < r ? xcd * (q + 1) : r * (q + 1) + (xcd - r) * q) + off; }
        const int nig = WGM * nN, gid = wgid / nig, fm = gid * WGM, gsz = (nM - fm) < WGM ? (nM - fm) : WGM;
        u.pm = fm + ((wgid % nig) % gsz); u.pn = (wgid % nig) / gsz; return true;
    }
    __device__ __forceinline__ void a_ready(const Unit&) const {}
    __device__ __forceinline__ void done(const Unit&) const {}
};
__device__ __forceinline__ unsigned cvt_pk_bf16(float lo, float hi) { unsigned r; asm volatile("v_cvt_pk_bf16_f32 %0, %1, %2" : "=v"(r) : "v"(lo), "v"(hi)); return r; }
typedef float f32x2 __attribute__((ext_vector_type(2)));
typedef unsigned u32x2 __attribute__((ext_vector_type(2)));
__device__ __forceinline__ float sigm(float x) { return __builtin_amdgcn_rcpf(1.f + __expf(-x)); }
__device__ __forceinline__ float bf2f_lo(unsigned w) { return __uint_as_float(w << 16); }
__device__ __forceinline__ float bf2f_hi(unsigned w) { return __uint_as_float(w & 0xffff0000u); }
__device__ __forceinline__ float rstd_from16(const float* p) {
    const f32x4 a = *(const f32x4*)p, b = *(const f32x4*)(p + 4), c = *(const f32x4*)(p + 8), d = *(const f32x4*)(p + 12);
    const float s = ((a[0] + a[1]) + (a[2] + a[3])) + ((b[0] + b[1]) + (b[2] + b[3])) + ((c[0] + c[1]) + (c[2] + c[3])) + ((d[0] + d[1]) + (d[2] + d[3]));
    return rsqrtf(s * (1.f / 1024.f) + 1e-6f);
}
__device__ __forceinline__ float rstd_from8(const float* p) {
    const f32x4 a = *(const f32x4*)p, b = *(const f32x4*)(p + 4);
    const float s = ((a[0] + a[1]) + (a[2] + a[3])) + ((b[0] + b[1]) + (b[2] + b[3]));
    return rsqrtf(s * (1.f / 1024.f) + 1e-6f);
}

struct EpiHgrnIn {
    static constexpr bool PERM = true, AFTER_DRAIN = false;
    bf16_t* QS; float* LF; bf16_t* IN; bf16_t* OG; const float* lb;
    __device__ __forceinline__ void operator()(const f32x4 (&acc)[2][2][4][2], const Unit& u, int wr, int wc, int fr, int fq) const {
        const int type = u.pn >> 2;
        const int row0 = u.pm * BM + wr * 64 + fr;
        const int col0 = (u.pn & 3) * BM + wc * 32 + 8 * fq;
#pragma unroll
        for (int bj = 0; bj < 2; ++bj) {
            const int c = col0 + bj * HALF;
            f32x4 l0 = (f32x4){0.f, 0.f, 0.f, 0.f}, l1 = l0;
            if (type == 1) { l0 = *(const f32x4*)(lb + c); l1 = *(const f32x4*)(lb + c + 4); }
#pragma unroll
            for (int ai = 0; ai < 2; ++ai)
#pragma unroll
                for (int m = 0; m < 4; ++m) {
                    const size_t off = (size_t)(row0 + ai * HALF + m * 16) * 1024 + c;
                    f32x4 v0 = acc[ai][bj][m][0], v1 = acc[ai][bj][m][1];
                    if (type == 1) {
#pragma unroll
                        for (int i = 0; i < 4; ++i) { v0[i] = logf(l0[i] + (1.f - l0[i]) * sigm(v0[i])); v1[i] = logf(l1[i] + (1.f - l1[i]) * sigm(v1[i])); }
                        *(f32x4*)(LF + off) = v0; *(f32x4*)(LF + off + 4) = v1;
                    } else {
                        if (type == 0) {
#pragma unroll
                            for (int i = 0; i < 4; ++i) { v0[i] = v0[i] * sigm(v0[i]); v1[i] = v1[i] * sigm(v1[i]); }
                        } else if (type == 3) {
#pragma unroll
                            for (int i = 0; i < 4; ++i) { v0[i] = sigm(v0[i]); v1[i] = sigm(v1[i]); }
                        }
                        u32x4 w; w.x = cvt_pk_bf16(v0[0], v0[1]); w.y = cvt_pk_bf16(v0[2], v0[3]); w.z = cvt_pk_bf16(v1[0], v1[1]); w.w = cvt_pk_bf16(v1[2], v1[3]);
                        if (type == 0) *(u32x4*)(QS + off) = w;
                        else if (type == 2) *(u32x4*)(IN + off) = w;
                        else *(u32x4*)(OG + off) = w;
                    }
                }
        }
    }
};

template <int SCALE, bool RF32>
struct EpiResid {
    static constexpr bool PERM = true, AFTER_DRAIN = false;
    const void* R; bf16_t* HB; float* SSQ; const float* SSQIN;
    __device__ __forceinline__ void operator()(const f32x4 (&acc)[2][2][4][2], const Unit& u, int wr, int wc, int fr, int fq) const {
        const int col0 = u.pn * BM + wc * 32 + 8 * fq;
#pragma unroll
        for (int ai = 0; ai < 2; ++ai)
#pragma unroll
            for (int m = 0; m < 4; ++m) {
                const int row = u.pm * BM + ai * HALF + wr * 64 + m * 16 + fr;
                float sc = 1.f;
                if (SCALE == 1) sc = rstd_from8(SSQIN + (size_t)row * 8);
                const size_t off = (size_t)row * 1024 + col0;
                float ss = 0.f;
#pragma unroll
                for (int bj = 0; bj < 2; ++bj) {
                    const size_t o2 = off + bj * HALF;
                    f32x4 r0, r1;
                    if (RF32) { r0 = *(const f32x4*)((const float*)R + o2); r1 = *(const f32x4*)((const float*)R + o2 + 4); }
                    else { const u32x4 rw = *(const u32x4*)((const bf16_t*)R + o2);
                        r0 = (f32x4){bf2f_lo(rw.x), bf2f_hi(rw.x), bf2f_lo(rw.y), bf2f_hi(rw.y)}; r1 = (f32x4){bf2f_lo(rw.z), bf2f_hi(rw.z), bf2f_lo(rw.w), bf2f_hi(rw.w)}; }
                    const f32x4 v0 = r0 + acc[ai][bj][m][0] * sc, v1 = r1 + acc[ai][bj][m][1] * sc;
                    ss += ((v0[0] * v0[0] + v0[1] * v0[1]) + (v0[2] * v0[2] + v0[3] * v0[3])) + ((v1[0] * v1[0] + v1[1] * v1[1]) + (v1[2] * v1[2] + v1[3] * v1[3]));
                    u32x4 w; w.x = cvt_pk_bf16(v0[0], v0[1]); w.y = cvt_pk_bf16(v0[2], v0[3]); w.z = cvt_pk_bf16(v1[0], v1[1]); w.w = cvt_pk_bf16(v1[2], v1[3]);
                    *(u32x4*)(HB + o2) = w;
                }
                ss += __shfl_xor(ss, 16); ss += __shfl_xor(ss, 32);
                if (fq == 0) SSQ[(size_t)row * 16 + u.pn * 4 + wc] = ss;
                if (m & 1) asm volatile("" ::: "memory");
            }
    }
};

struct EpiSwiglu {
    static constexpr bool PERM = true, AFTER_DRAIN = false;
    bf16_t* HID; int ldh; const float* SSQIN;
    __device__ __forceinline__ void operator()(const f32x4 (&acc)[2][2][4][2], const Unit& u, int wr, int wc, int fr, int fq) const {
        const int col0 = u.pn * HALF + wc * 32 + 8 * fq;
#pragma unroll
        for (int ai = 0; ai < 2; ++ai)
#pragma unroll
            for (int m = 0; m < 4; ++m) {
                const int row = u.pm * BM + ai * HALF + wr * 64 + m * 16 + fr;
                const float sc = rstd_from16(SSQIN + (size_t)row * 16);
                f32x4 g0 = acc[ai][0][m][0] * sc, g1 = acc[ai][0][m][1] * sc, u0 = acc[ai][1][m][0] * sc, u1 = acc[ai][1][m][1] * sc;
#pragma unroll
                for (int i = 0; i < 4; ++i) { g0[i] = g0[i] * sigm(g0[i]) * u0[i]; g1[i] = g1[i] * sigm(g1[i]) * u1[i]; }
                u32x4 w; w.x = cvt_pk_bf16(g0[0], g0[1]); w.y = cvt_pk_bf16(g0[2], g0[3]); w.z = cvt_pk_bf16(g1[0], g1[1]); w.w = cvt_pk_bf16(g1[2], g1[3]);
                *(u32x4*)(HID + (size_t)row * ldh + col0) = w;
            }
    }
};

struct EpiQKV {
    static constexpr bool PERM = true, AFTER_DRAIN = false;
    bf16_t* O; size_t split_stride; const float* SSQIN; float* KMEAN;
    __device__ __forceinline__ void operator()(const f32x4 (&acc)[2][2][4][2], const Unit& u, int wr, int wc, int fr, int fq) const {
        const int t = u.pn >> 2;
        bf16_t* base = O + (size_t)t * split_stride;
        const int col0 = (u.pn & 3) * BM + wc * 32 + 8 * fq;
        f32x4 cs[2][2];
#pragma unroll
        for (int bj = 0; bj < 2; ++bj) { cs[bj][0] = (f32x4){0.f, 0.f, 0.f, 0.f}; cs[bj][1] = cs[bj][0]; }
#pragma unroll
        for (int ai = 0; ai < 2; ++ai)
#pragma unroll
            for (int m = 0; m < 4; ++m) {
                const int row = u.pm * BM + ai * HALF + wr * 64 + m * 16 + fr;
                const float sc = rstd_from16(SSQIN + (size_t)row * 16);
#pragma unroll
                for (int bj = 0; bj < 2; ++bj) {
                    const f32x4 v0 = acc[ai][bj][m][0] * sc, v1 = acc[ai][bj][m][1] * sc;
                    cs[bj][0] += v0; cs[bj][1] += v1;
                    u32x4 w; w.x = cvt_pk_bf16(v0[0], v0[1]); w.y = cvt_pk_bf16(v0[2], v0[3]); w.z = cvt_pk_bf16(v1[0], v1[1]); w.w = cvt_pk_bf16(v1[2], v1[3]);
                    *(u32x4*)(base + (size_t)row * 1024 + col0 + bj * HALF) = w;
                }
            }
        if (t == 1) {
#pragma unroll
            for (int bj = 0; bj < 2; ++bj)
#pragma unroll
                for (int n = 0; n < 2; ++n)
#pragma unroll
                    for (int i = 0; i < 4; ++i) {
                        float s = cs[bj][n][i];
                        s += __shfl_xor(s, 1); s += __shfl_xor(s, 2); s += __shfl_xor(s, 4); s += __shfl_xor(s, 8);
                        if (fr == 0) atomicAdd(KMEAN + (size_t)u.pm * 1024 + col0 + bj * HALF + 4 * n + i, s * (1.f / 256.f));
                    }
        }
    }
};

template <class Epi, class Sched, bool ALIGN_EPI = false, bool SP2 = false>
__device__ __forceinline__ void gemm_phase(PG8_LAS unsigned char* lds, const Gemm g, const Sched& S, const Epi& E) {
    const int tid = threadIdx.x, wid = __builtin_amdgcn_readfirstlane(tid >> 6), lane = tid & 63, wr = wid >> 2, wc = wid & 3, fr = lane & 15, fq = lane >> 4;
    const int K = g.K, nt = K / BK;
    unsigned voffA[2], voffB[2];
#pragma unroll
    for (int i = 0; i < 2; ++i) { int R, C; stage_rc(tid * 16 + i * 8192, R, C); const int Rb = Epi::PERM ? ((R & ~31) + perm32(R & 31)) : R;
        voffA[i] = (unsigned)(R * K + C) * 2u; voffB[i] = (unsigned)(Rb * K + C) * 2u; }
    const size_t kstep = (size_t)(BK * 2);
    const size_t hstep = (size_t)HALF * K * 2;
    const size_t tstep = 2 * hstep;
    const unsigned ldsw = (unsigned)wid * 1024u;
    const int aoff = lds_byte(wr * 64 + fr, fq * 8), boff = lds_byte(wc * 32 + fr, fq * 8);
#define PG8_SA(b, h) (((b) * 2 + (h)) * HTB)
#define PG8_SB(b, h) ((4 + (b) * 2 + (h)) * HTB)
#define PG8_STAGE(bufoff, gbase, voff) do { _Pragma("unroll") for (int _i = 0; _i < 2; ++_i) \
        __builtin_amdgcn_global_load_lds((const unsigned*)((const char*)(gbase) + (voff)[_i]), (PG8_LAS unsigned*)(lds + (bufoff) + ldsw + _i * 8192), 16, 0, 0); } while (0)
#define PG8_LDA(dst, b, h) do { _Pragma("unroll") for (int m = 0; m < 4; ++m) _Pragma("unroll") for (int k = 0; k < 2; ++k) dst[m][k] = *(const PG8_LAS bf16x8*)(lds + PG8_SA(b, h) + aoff + m * 2048 + k * 1024); } while (0)
#define PG8_LDB(dst, b, h) do { _Pragma("unroll") for (int n = 0; n < 2; ++n) _Pragma("unroll") for (int k = 0; k < 2; ++k) dst[n][k] = *(const PG8_LAS bf16x8*)(lds + PG8_SB(b, h) + boff + n * 2048 + k * 1024); } while (0)
#define PG8_MMA(ai, bj, At, Bt) do { __builtin_amdgcn_s_setprio(1); _Pragma("unroll") for (int m = 0; m < 4; ++m) _Pragma("unroll") for (int n = 0; n < 2; ++n) _Pragma("unroll") for (int k = 0; k < 2; ++k) \
        acc[ai][bj][m][n] = __builtin_amdgcn_mfma_f32_16x16x32_bf16(Bt[n][k], At[m][k], acc[ai][bj][m][n], 0, 0, 0); __builtin_amdgcn_s_setprio(0); } while (0)
#define PG8_WAIT_V(n) asm volatile("s_waitcnt vmcnt(" #n ")" ::: "memory")
#define PG8_WAIT_L(n) asm volatile("s_waitcnt lgkmcnt(" #n ")" ::: "memory")
#define PG8_BAR __builtin_amdgcn_s_barrier()
#define PG8_SCHED __builtin_amdgcn_sched_barrier(0)
    Unit cur, nxt; int ui = 0;
    if (!S.next(0, cur)) return;
    f32x4 acc[2][2][4][2];
#pragma unroll
    for (int a = 0; a < 2; ++a)
#pragma unroll
        for (int b = 0; b < 2; ++b)
#pragma unroll
            for (int m = 0; m < 4; ++m)
#pragma unroll
                for (int n = 0; n < 2; ++n) acc[a][b][m][n] = (f32x4){0.f, 0.f, 0.f, 0.f};
    bf16x8 At[4][2], B0[2][2], B1[2][2];
    const char* cA = (const char*)g.A + (size_t)cur.pm * tstep; const char* cB = (const char*)g.Bt + (size_t)cur.pn * tstep;
    S.a_ready(cur);
    if constexpr (SP2) {
        PG8_STAGE(PG8_SB(0, 0), cB, voffB); PG8_STAGE(PG8_SB(0, 1), cB + hstep, voffB); PG8_STAGE(PG8_SA(0, 0), cA, voffA); PG8_STAGE(PG8_SA(0, 1), cA + hstep, voffA);
        if (wr == 1) PG8_BAR;
        PG8_WAIT_V(2); PG8_BAR;
        PG8_STAGE(PG8_SB(1, 0), cB + kstep, voffB); PG8_STAGE(PG8_SA(1, 0), cA + kstep, voffA); PG8_STAGE(PG8_SB(1, 1), cB + hstep + kstep, voffB);
        PG8_WAIT_V(6); PG8_BAR;
    } else {
        PG8_STAGE(PG8_SB(0, 0), cB, voffB); PG8_STAGE(PG8_SA(0, 0), cA, voffA); PG8_STAGE(PG8_SB(0, 1), cB + hstep, voffB); PG8_STAGE(PG8_SA(0, 1), cA + hstep, voffA);
        if (wr == 1) PG8_BAR;
        PG8_WAIT_V(4); PG8_BAR;
        PG8_STAGE(PG8_SB(1, 0), cB + kstep, voffB); PG8_STAGE(PG8_SA(1, 0), cA + kstep, voffA); PG8_STAGE(PG8_SB(1, 1), cB + hstep + kstep, voffB);
        PG8_WAIT_V(6); PG8_BAR;
    }
    for (;;) {
        const bool has_next = S.next(ui + 1, nxt);
        const char* nA = has_next ? (const char*)g.A + (size_t)nxt.pm * tstep : cA; const char* nB = has_next ? (const char*)g.Bt + (size_t)nxt.pn * tstep : cB;
        for (int t = 0; t < nt; t += 2) {
            const bool last = (t == nt - 2);
            const char* a1 = cA + (size_t)(t + 1) * kstep;
            const char* a2 = last ? nA : cA + (size_t)(t + 2) * kstep; const char* b2 = last ? nB : cB + (size_t)(t + 2) * kstep;
            const char* a3 = a2 + kstep; const char* b3 = b2 + kstep;
            if (last && has_next) S.a_ready(nxt);
            if constexpr (SP2) {
            PG8_LDB(B0, 0, 0); PG8_LDB(B1, 0, 1); PG8_SCHED; PG8_LDA(At, 0, 0); PG8_STAGE(PG8_SA(1, 1), a1 + hstep, voffA);
            PG8_WAIT_V(8); PG8_WAIT_L(0); PG8_BAR; PG8_MMA(0, 0, At, B0); PG8_MMA(0, 1, At, B1); PG8_BAR; PG8_SCHED;
            PG8_LDA(At, 0, 1); PG8_STAGE(PG8_SB(0, 0), b2, voffB); PG8_STAGE(PG8_SB(0, 1), b2 + hstep, voffB); PG8_STAGE(PG8_SA(0, 0), a2, voffA);
            PG8_WAIT_V(8); PG8_WAIT_L(0); PG8_BAR; PG8_MMA(1, 0, At, B0); PG8_MMA(1, 1, At, B1); PG8_BAR; PG8_SCHED;
            PG8_LDB(B0, 1, 0); PG8_LDB(B1, 1, 1); PG8_SCHED; PG8_LDA(At, 1, 0); PG8_STAGE(PG8_SA(0, 1), a2 + hstep, voffA);
            PG8_WAIT_V(8); PG8_WAIT_L(0); PG8_BAR; PG8_MMA(0, 0, At, B0); PG8_MMA(0, 1, At, B1); PG8_BAR; PG8_SCHED;
            PG8_LDA(At, 1, 1); PG8_STAGE(PG8_SB(1, 0), b3, voffB); PG8_STAGE(PG8_SB(1, 1), b3 + hstep, voffB); PG8_STAGE(PG8_SA(1, 0), a3, voffA);
            PG8_WAIT_V(8); PG8_WAIT_L(0); PG8_BAR; PG8_MMA(1, 0, At, B0); PG8_MMA(1, 1, At, B1); PG8_BAR; PG8_SCHED;
            } else {
            PG8_LDB(B0, 0, 0); PG8_SCHED; PG8_LDA(At, 0, 0); PG8_STAGE(PG8_SA(1, 1), a1 + hstep, voffA);
            PG8_WAIT_L(8); PG8_BAR; PG8_WAIT_L(0); PG8_MMA(0, 0, At, B0); PG8_BAR; PG8_SCHED;
            PG8_LDB(B1, 0, 1); PG8_STAGE(PG8_SB(0, 0), b2, voffB);
            PG8_BAR; PG8_WAIT_L(0); PG8_MMA(0, 1, At, B1); PG8_BAR;
            PG8_LDA(At, 0, 1); PG8_STAGE(PG8_SA(0, 0), a2, voffA);
            PG8_BAR; PG8_WAIT_L(0); PG8_MMA(1, 0, At, B0); PG8_BAR; PG8_SCHED;
            PG8_STAGE(PG8_SB(0, 1), b2 + hstep, voffB);
            PG8_WAIT_V(6); PG8_BAR; PG8_MMA(1, 1, At, B1); PG8_BAR;
            PG8_LDB(B0, 1, 0); PG8_SCHED; PG8_LDA(At, 1, 0); PG8_STAGE(PG8_SA(0, 1), a2 + hstep, voffA);
            PG8_WAIT_L(8); PG8_BAR; PG8_WAIT_L(0); PG8_MMA(0, 0, At, B0); PG8_BAR; PG8_SCHED;
            PG8_LDB(B1, 1, 1); PG8_STAGE(PG8_SB(1, 0), b3, voffB);
            PG8_BAR; PG8_WAIT_L(0); PG8_MMA(0, 1, At, B1); PG8_BAR;
            PG8_LDA(At, 1, 1); PG8_STAGE(PG8_SA(1, 0), a3, voffA);
            PG8_BAR; PG8_WAIT_L(0); PG8_MMA(1, 0, At, B0); PG8_BAR; PG8_SCHED;
            PG8_STAGE(PG8_SB(1, 1), b3 + hstep, voffB);
            PG8_WAIT_V(6); PG8_BAR; PG8_MMA(1, 1, At, B1); PG8_BAR;
            }
        }
        if constexpr (ALIGN_EPI) { if (wr == 0) PG8_BAR; }
        if constexpr (!Epi::AFTER_DRAIN) { E(acc, cur, wr, wc, fr, fq); S.done(cur); }
        if (!has_next) break;
#pragma unroll
        for (int a = 0; a < 2; ++a)
#pragma unroll
            for (int b = 0; b < 2; ++b)
#pragma unroll
                for (int m = 0; m < 4; ++m)
#pragma unroll
                    for (int n = 0; n < 2; ++n) acc[a][b][m][n] = (f32x4){0.f, 0.f, 0.f, 0.f};
        cur = nxt; cA = nA; cB = nB; ++ui;
        if constexpr (ALIGN_EPI) { if (wr == 1) PG8_BAR; }
    }
    PG8_WAIT_V(0);
    if constexpr (!ALIGN_EPI) { if (wr == 0) PG8_BAR; }
    PG8_BAR;
    if constexpr (Epi::AFTER_DRAIN) { E.fused(acc, cur, wr, wc, fr, fq, lds, wid, lane); S.done(cur); }
#undef PG8_SA
#undef PG8_SB
#undef PG8_STAGE
#undef PG8_LDA
#undef PG8_LDB
#undef PG8_MMA
#undef PG8_WAIT_V
#undef PG8_WAIT_L
#undef PG8_BAR
#undef PG8_SCHED
}
}

namespace cg = cooperative_groups;
constexpr int NWAVES = 8;
constexpr int BATCH = 2, T = 8192, D = 1024, H = 8, DH = 128, DFF = 2816, NB = 32, BLK = 256;
constexpr int M = BATCH * T;
constexpr float EPS = 1e-6f;
constexpr size_t MiB = 1u << 20;
constexpr size_t WS_CTL = 0;
constexpr size_t WS_WQKV = 1 * MiB, WS_WOUT1 = 7 * MiB, WS_W13_1 = 9 * MiB, WS_W2_1 = 20 * MiB;
constexpr size_t WS_WIN0 = 26 * MiB, WS_WOUT0 = 34 * MiB, WS_W13_0 = 36 * MiB, WS_W2_0 = 47 * MiB;
constexpr size_t WS_SSQ = 53 * MiB;
constexpr size_t WS_SSQH = 54 * MiB;
constexpr size_t WS_LB = 54 * MiB + 512 * 1024;
constexpr size_t WS_BKT = WS_LB + 4096;
constexpr size_t WS_YMEAN = WS_BKT + 32768;
constexpr size_t WS_KMEAN = WS_YMEAN + 262144;
constexpr size_t WS_SEL = 55 * MiB + 512 * 1024;
constexpr size_t WS_G = 56 * MiB;
constexpr size_t WS_A0 = 60 * MiB;
constexpr size_t WS_A1 = 92 * MiB;
constexpr size_t WS_A2 = 124 * MiB;
constexpr size_t WS_A3 = 188 * MiB;
constexpr size_t WS_A4 = 220 * MiB;
constexpr size_t WS_END = 256 * MiB;
static_assert(WS_W2_0 + (size_t)D * DFF * 2 <= WS_SSQ && WS_G + 2 * MiB <= WS_A0 && WS_A4 + 32 * MiB <= WS_END, "ws map");

constexpr int LDS_BYTES = 163840;
constexpr int LDS_MISC = 163584;
constexpr size_t WS_BAR = 65536;

#define GAS __attribute__((address_space(1)))
#define LAS __attribute__((address_space(3)))
typedef unsigned short bf16;
typedef unsigned v4u __attribute__((ext_vector_type(4)));
typedef float f32x4 __attribute__((ext_vector_type(4)));
#define LDS_WAIT() asm volatile("s_waitcnt lgkmcnt(0)" ::: "memory")
__device__ __forceinline__ unsigned f2bf(float f) { unsigned u = __builtin_bit_cast(unsigned, f); return (u + 0x7fffu + ((u >> 16) & 1u)) >> 16; }
__device__ __forceinline__ unsigned pk2(float lo, float hi) { return f2bf(lo) | (f2bf(hi) << 16); }
__device__ __forceinline__ float bf2f(unsigned short b) { return __uint_as_float((unsigned)b << 16); }
__device__ __forceinline__ float wave_sum(float v) {
#pragma unroll
    for (int o = 1; o < 64; o <<= 1) v += __shfl_xor(v, o);
    return v;
}

struct Args {
    const float* x; const float* norm_mix; const float* norm_ffn; const float* hgrn_w_in; const float* lb_logits; const float* hgrn_out_norm; const float* hgrn_w_out;
    const float* moba_w_in; const float* moba_w_out; const float* rel_table; const float* ffn_w13; const float* ffn_w2; const float* final_norm;
    float* out; unsigned char* ws; int ph_lo, ph_hi;
};

__device__ __forceinline__ void tr_item(const float* W, int ldw, int K, bf16* WT, int Ndst, const float* gain, int mode, LAS float* scr, int item, int lane) {
    const int nblk = Ndst / 64, kb = item / nblk, nb = item % nblk, k0 = 64 * kb, n0 = 64 * nb;
    int s0 = n0;
    if (mode == 1) { const int t = n0 >> 8, c = n0 & 255; s0 = (c < 128) ? (128 * t + c) : (DFF + 128 * t + (c - 128)); }
#pragma unroll 4
    for (int i = 0; i < 16; ++i) { const int kk = 4 * i + (lane >> 4);
        f32x4 w = *(const GAS f32x4*)(W + (size_t)(k0 + kk) * ldw + s0 + (lane & 15) * 4);
        if (gain) w = w * gain[k0 + kk];
        LAS float* d = scr + kk * 65 + (lane & 15) * 4; d[0] = w.x; d[1] = w.y; d[2] = w.z; d[3] = w.w; }
    LDS_WAIT(); asm volatile("" ::: "memory");
    const int c = lane & 7;
#pragma unroll
    for (int j = 0; j < 8; ++j) { const int n = (lane >> 3) + 8 * j; const LAS float* s = scr + (8 * c) * 65 + n;
        v4u o; o.x = pk2(s[0 * 65], s[1 * 65]); o.y = pk2(s[2 * 65], s[3 * 65]); o.z = pk2(s[4 * 65], s[5 * 65]); o.w = pk2(s[6 * 65], s[7 * 65]);
        *(GAS v4u*)(WT + (size_t)(n0 + n) * K + k0 + 8 * c) = o; }
    LDS_WAIT(); asm volatile("" ::: "memory");
}

__device__ __forceinline__ void prologue(const Args& a, LAS unsigned char* lds, int tid, int lane, int wave) {
    unsigned char* ws = a.ws;
    LAS float* scr = (LAS float*)(lds + wave * 16640);
    const int gw = blockIdx.x * NWAVES + wave, NGW = gridDim.x * NWAVES;
    constexpr int I_IN0 = (D / 64) * (4096 / 64), I_O = (D / 64) * (D / 64), I_13 = (D / 64) * (2 * DFF / 64), I_2 = (DFF / 64) * (D / 64), I_QKV = (D / 64) * (3072 / 64);
    constexpr int NITEMS = I_IN0 + I_O + I_13 + I_2 + I_QKV + I_O + I_13 + I_2;
    for (int it = gw; it < NITEMS; it += NGW) {
        int r = it;
        if (r < I_IN0) { tr_item(a.hgrn_w_in, 4096, D, (bf16*)(ws + WS_WIN0), 4096, nullptr, 0, scr, r, lane); continue; } r -= I_IN0;
        if (r < I_O) { tr_item(a.hgrn_w_out, D, D, (bf16*)(ws + WS_WOUT0), D, a.hgrn_out_norm, 0, scr, r, lane); continue; } r -= I_O;
        if (r < I_13) { tr_item(a.ffn_w13, 2 * DFF, D, (bf16*)(ws + WS_W13_0), 2 * DFF, a.norm_ffn, 1, scr, r, lane); continue; } r -= I_13;
        if (r < I_2) { tr_item(a.ffn_w2, D, DFF, (bf16*)(ws + WS_W2_0), D, nullptr, 0, scr, r, lane); continue; } r -= I_2;
        if (r < I_QKV) { tr_item(a.moba_w_in, 3072, D, (bf16*)(ws + WS_WQKV), 3072, a.norm_mix + D, 0, scr, r, lane); continue; } r -= I_QKV;
        if (r < I_O) { tr_item(a.moba_w_out, D, D, (bf16*)(ws + WS_WOUT1), D, nullptr, 0, scr, r, lane); continue; } r -= I_O;
        if (r < I_13) { tr_item(a.ffn_w13 + (size_t)D * 2 * DFF, 2 * DFF, D, (bf16*)(ws + WS_W13_1), 2 * DFF, a.norm_ffn + D, 1, scr, r, lane); continue; } r -= I_13;
        tr_item(a.ffn_w2 + (size_t)DFF * D, D, DFF, (bf16*)(ws + WS_W2_1), D, nullptr, 0, scr, r, lane);
    }
    bf16* XN0 = (bf16*)(ws + WS_A0);
    for (int m = gw; m < M; m += NGW) {
        const GAS f32x4* xr = (const GAS f32x4*)(a.x + (size_t)m * D) + lane;
        f32x4 v[4]; float s = 0.f;
#pragma unroll
        for (int j = 0; j < 4; ++j) { v[j] = xr[64 * j]; s += (v[j].x * v[j].x + v[j].y * v[j].y) + (v[j].z * v[j].z + v[j].w * v[j].w); }
        const float rstd = rsqrtf(wave_sum(s) * (1.f / D) + EPS);
        GAS unsigned long long* o8 = (GAS unsigned long long*)(XN0 + (size_t)m * D) + lane;
#pragma unroll
        for (int j = 0; j < 4; ++j) { const f32x4 g = *((const GAS f32x4*)a.norm_mix + lane + 64 * j);
            o8[64 * j] = (unsigned long long)pk2(v[j].x * rstd * g.x, v[j].y * rstd * g.y) | ((unsigned long long)pk2(v[j].z * rstd * g.z, v[j].w * rstd * g.w) << 32); }
    }
    for (int i = blockIdx.x * (NWAVES * 64) + tid; i < 64 * D; i += gridDim.x * NWAVES * 64) ((float*)(ws + WS_KMEAN))[i] = 0.f;
    if (blockIdx.x == 0) {
        float* lb = (float*)(ws + WS_LB); int* bkt = (int*)(ws + WS_BKT);
        for (int i = tid; i < 1024; i += NWAVES * 64) { const float l0 = a.lb_logits[i], l1 = a.lb_logits[1024 + i]; const float mx = fmaxf(l0, l1); const float e0 = expf(l0 - mx), e1 = expf(l1 - mx); lb[i] = e0 / (e0 + e1); }
        for (int i = tid; i < T; i += NWAVES * 64) {
            int bk;
            if (i < 16) bk = i;
            else { const float nf = (float)i; const float v = logf(nf / 16.f) / 4.1588830833596715f * 16.f; bk = 16 + (int)v; if (bk > 31) bk = 31; }
            bkt[i] = bk;
            if (i < 1024) { float* tab2 = (float*)(ws + WS_YMEAN);
#pragma unroll
                for (int hh = 0; hh < 8; ++hh) tab2[hh * 1024 + i] = a.rel_table[bk * 8 + hh] * 1.4426950408889634f; }
        }
        for (int i = tid; i < 1024; i += NWAVES * 64) ((unsigned*)(ws + 4096))[i] = 0u;
        for (int i = tid; i < 3456; i += NWAVES * 64) ((unsigned*)(ws + WS_BAR))[i] = 0u;
    }
}

__device__ __forceinline__ void final_norm_phase(const Args& a, int lane, int wave) {
    const int gw = blockIdx.x * NWAVES + wave, NGW = gridDim.x * NWAVES;
    const float* SSQ = (const float*)(a.ws + WS_SSQ); const bf16* HB = (const bf16*)(a.ws + WS_A1);
    for (int m = gw; m < M; m += NGW) {
        const float rstd = pg8::rstd_from16(SSQ + (size_t)m * 16);
        const GAS v4u* hr = (const GAS v4u*)(HB + (size_t)m * D) + lane;
        GAS f32x4* orow = (GAS f32x4*)(a.out + (size_t)m * D);
#pragma unroll
        for (int j = 0; j < 2; ++j) {
            const v4u w = hr[64 * j]; const int c = (64 * j + lane) * 8;
            const f32x4 g0 = *(const GAS f32x4*)(a.final_norm + c), g1 = *(const GAS f32x4*)(a.final_norm + c + 4);
            f32x4 o0, o1;
            o0.x = __uint_as_float(w.x << 16) * rstd * g0.x; o0.y = __uint_as_float(w.x & 0xffff0000u) * rstd * g0.y; o0.z = __uint_as_float(w.y << 16) * rstd * g0.z; o0.w = __uint_as_float(w.y & 0xffff0000u) * rstd * g0.w;
            o1.x = __uint_as_float(w.z << 16) * rstd * g1.x; o1.y = __uint_as_float(w.z & 0xffff0000u) * rstd * g1.y; o1.z = __uint_as_float(w.w << 16) * rstd * g1.z; o1.w = __uint_as_float(w.w & 0xffff0000u) * rstd * g1.w;
            orow[c / 4] = o0; orow[c / 4 + 1] = o1;
        }
    }
}

__device__ __forceinline__ float sigmoidf_(float x) { return 1.f / (1.f + __expf(-x)); }

namespace moba {
using bf16x8 = __attribute__((ext_vector_type(8))) short;
using s16x4 = __attribute__((ext_vector_type(4))) short;
using f32x16 = __attribute__((ext_vector_type(16))) float;
using u32x4 = __attribute__((ext_vector_type(4))) unsigned;
#define KSWZ(row, colB) ((row) * 256 + ((colB) ^ (((row) & 7) << 4)))
#define SBAR() __builtin_amdgcn_sched_barrier(0)
constexpr float C2 = 0.08838834764831845f * 1.4426950408889634f;
constexpr float LOG2E = 1.4426950408889634f;
__device__ __forceinline__ int crow(int r, int hi) { return (r & 3) + 8 * (r >> 2) + 4 * hi; }
__device__ __forceinline__ unsigned cvtpk(float lo, float hi) { unsigned r; asm volatile("v_cvt_pk_bf16_f32 %0, %1, %2" : "=v"(r) : "v"(lo), "v"(hi)); return r; }
__device__ __forceinline__ int v_st(int k, int c) { const int kk = (k & ~0xC) | ((k & 4) << 1) | ((k & 8) >> 1); return ((kk >> 3) * 4 + (c >> 5)) * 512 + ((kk & 7) * 32 + (c & 31)) * 2; }
__device__ __forceinline__ int v_rd_base(int lane) { return ((lane & 3) << 3) | (((lane >> 2) & 3) << 6) | (((lane >> 4) & 1) << 5) | (((lane >> 5) & 1) << 8); }
constexpr int v_rd_off(int d0, int ks, int half) { return d0 * 512 + ks * 4096 + half * 2048; }
template <int OFF> __device__ __forceinline__ s16x4 tr_read(int vb) {
    s16x4 r; asm volatile("ds_read_b64_tr_b16 %0, %1 offset:%2" : "=&v"(r) : "v"(vb), "i"(OFF) : "memory"); return r;
}
template <int D0> __device__ __forceinline__ void pv_one(f32x16& od, int vb, bf16x8 pa0, bf16x8 pa1, bf16x8 pa2, bf16x8 pa3) {
    const s16x4 l0 = tr_read<v_rd_off(D0, 0, 0)>(vb), h0 = tr_read<v_rd_off(D0, 0, 1)>(vb), l1 = tr_read<v_rd_off(D0, 1, 0)>(vb), h1 = tr_read<v_rd_off(D0, 1, 1)>(vb);
    const s16x4 l2 = tr_read<v_rd_off(D0, 2, 0)>(vb), h2 = tr_read<v_rd_off(D0, 2, 1)>(vb), l3 = tr_read<v_rd_off(D0, 3, 0)>(vb), h3 = tr_read<v_rd_off(D0, 3, 1)>(vb);
    asm volatile("s_waitcnt lgkmcnt(0)" ::: "memory"); SBAR();
#define PK(L, Hh) (bf16x8){L[0], L[1], L[2], L[3], Hh[0], Hh[1], Hh[2], Hh[3]}
    od = __builtin_amdgcn_mfma_f32_32x32x16_bf16(pa0, PK(l0, h0), od, 0, 0, 0);
    od = __builtin_amdgcn_mfma_f32_32x32x16_bf16(pa1, PK(l1, h1), od, 0, 0, 0);
    od = __builtin_amdgcn_mfma_f32_32x32x16_bf16(pa2, PK(l2, h2), od, 0, 0, 0);
    od = __builtin_amdgcn_mfma_f32_32x32x16_bf16(pa3, PK(l3, h3), od, 0, 0, 0);
#undef PK
}
__device__ __forceinline__ void qkt(f32x16& p0, f32x16& p1, const LAS unsigned char* Ks, const bf16x8 (&qr)[8], int r32, int hi) {
    p0 = f32x16{}; p1 = f32x16{};
#pragma unroll
    for (int d0 = 0; d0 < 8; ++d0) { const int cb = (d0 * 16 + hi * 8) * 2;
        const bf16x8 b0 = *(const LAS bf16x8*)(Ks + KSWZ(r32, cb));
        const bf16x8 b1 = *(const LAS bf16x8*)(Ks + KSWZ(32 + r32, cb));
        p0 = __builtin_amdgcn_mfma_f32_32x32x16_bf16(b0, qr[d0], p0, 0, 0, 0);
        p1 = __builtin_amdgcn_mfma_f32_32x32x16_bf16(b1, qr[d0], p1, 0, 0, 0); }
}
}

constexpr size_t WS_CNT = 4096;
constexpr size_t WS_TAB2 = WS_YMEAN;
constexpr size_t WS_LIST = WS_WIN0;
constexpr size_t WS_LSE = WS_G;
constexpr size_t WS_PO0 = WS_A0, WS_PO2 = WS_A4;

__device__ __forceinline__ void topk_phase(const Args& a, LAS unsigned char* lds, int tid, int lane, int wid) {
    using namespace moba;
    const bf16* Q = (const bf16*)(a.ws + WS_A2); const float* kmean = (const float*)(a.ws + WS_KMEAN);
    unsigned* cnt = (unsigned*)(a.ws + WS_CNT); unsigned short* lists = (unsigned short*)(a.ws + WS_LIST);
    LAS unsigned* lcnt = (LAS unsigned*)lds;
    const int r32 = lane & 31, hi = lane >> 5;
    for (int it = blockIdx.x; it < 512; it += gridDim.x) {
        const int bh = it >> 5, j = it & 31, b = bh >> 3, h = bh & 7;
        if (j == 0) continue;
        __syncthreads();
        if (tid < 64) lcnt[tid] = 0u;
        __syncthreads();
        bf16x8 ahi[8], alo[8];
        const float* kp = kmean + (size_t)(b * 32 + r32) * D + h * 128 + hi * 8;
#pragma unroll
        for (int ks = 0; ks < 8; ++ks) {
            const f32x4 v0 = *(const f32x4*)(kp + 16 * ks), v1 = *(const f32x4*)(kp + 16 * ks + 4);
            const unsigned h0 = pk2(v0[0], v0[1]), h1 = pk2(v0[2], v0[3]), h2 = pk2(v1[0], v1[1]), h3 = pk2(v1[2], v1[3]);
            const unsigned l0 = pk2(v0[0] - __uint_as_float(h0 << 16), v0[1] - __uint_as_float(h0 & 0xffff0000u)), l1 = pk2(v0[2] - __uint_as_float(h1 << 16), v0[3] - __uint_as_float(h1 & 0xffff0000u));
            const unsigned l2 = pk2(v1[0] - __uint_as_float(h2 << 16), v1[1] - __uint_as_float(h2 & 0xffff0000u)), l3 = pk2(v1[2] - __uint_as_float(h3 << 16), v1[3] - __uint_as_float(h3 & 0xffff0000u));
            u32x4 wh = {h0, h1, h2, h3}, wl = {l0, l1, l2, l3};
            ahi[ks] = *reinterpret_cast<bf16x8*>(&wh); alo[ks] = *reinterpret_cast<bf16x8*>(&wl);
        }
        const int qpos = j * 256 + wid * 32 + r32, m = b * T + qpos;
        const bf16* Qw = Q + (size_t)m * D + h * 128 + hi * 8;
        f32x16 gacc = {};
#pragma unroll
        for (int ks = 0; ks < 8; ++ks) { const bf16x8 qv = *(const bf16x8*)(Qw + 16 * ks);
            gacc = __builtin_amdgcn_mfma_f32_32x32x16_bf16(ahi[ks], qv, gacc, 0, 0, 0);
            gacc = __builtin_amdgcn_mfma_f32_32x32x16_bf16(alo[ks], qv, gacc, 0, 0, 0); }
        float cv[6]; int ci[6];
        unsigned usedm = 0u;
#pragma unroll
        for (int s = 0; s < 3; ++s) { int best = 0; float val = -INFINITY; bool have = false;
#pragma unroll
            for (int r = 0; r < 16; ++r) { const float gv = (crow(r, hi) < j) ? gacc[r] : -INFINITY; const bool free_ = !((usedm >> r) & 1u); if (free_ && (!have || gv > val)) { best = r; val = gv; have = true; } }
            usedm |= 1u << best; cv[s] = val; ci[s] = crow(best, hi); }
#pragma unroll
        for (int s = 0; s < 3; ++s) { cv[3 + s] = __shfl_xor(cv[s], 32); ci[3 + s] = __shfl_xor(ci[s], 32); }
        int selv[3]; unsigned um = 0u;
#pragma unroll
        for (int s = 0; s < 3; ++s) { int best = 0; float val = 0.f; int bidx = 0; bool have = false;
#pragma unroll
            for (int c = 0; c < 6; ++c) { const bool free_ = !((um >> c) & 1u); if (free_ && (!have || cv[c] > val || (cv[c] == val && ci[c] < bidx))) { best = c; val = cv[c]; bidx = ci[c]; have = true; } }
            um |= 1u << best; selv[s] = bidx; }
        unsigned lpos[3] = {0u, 0u, 0u};
        if (hi == 0) {
#pragma unroll
            for (int s = 0; s < 3; ++s) if (s < j) lpos[s] = atomicAdd((unsigned*)&lcnt[selv[s]], 1u);
        }
        __syncthreads();
        if (tid < 32) { const unsigned c = lcnt[tid]; const int near = (j - tid <= 4) ? 1 : 0; unsigned base = 0u; if (c) base = atomicAdd(&cnt[(bh * 32 + tid) * 2 + near], c); lcnt[32 + tid] = base + (near ? 7168u : 0u); }
        __syncthreads();
        if (hi == 0) {
#pragma unroll
            for (int s = 0; s < 3; ++s)
                if (s < j) lists[(size_t)(bh * 32 + selv[s]) * 8192 + lcnt[32 + selv[s]] + lpos[s]] = (unsigned short)(qpos | (s << 13));
        }
    }
}

namespace moba {
constexpr int E_K0 = 0, E_V0 = 16384, E_K1 = 32768, E_V1 = 49152, E_TAB = 65536, E_WSCR = 73728, E_STG = 81920, E_SCHED = 98304;

constexpr float THR2 = 11.5f;
template <bool CAUSAL>
__device__ __forceinline__ void tile_step(const LAS unsigned char* Kb, int vb, const LAS float* tab2, LAS float* al_l, const bf16x8 (&qr)[8], int qpos_rel, int kt, bool near, int r32, int hi,
                                          f32x16 (&o)[4], float& m_reg, float& l_reg) {
    f32x16 p0, p1;
    qkt(p0, p1, Kb, qr, r32, hi);
    float sc = C2, cadd = tab2[1023];
    if (CAUSAL || near) {
        int dbase = qpos_rel - kt * 64 - 4 * hi; asm volatile("" : "+v"(dbase));
#pragma unroll
        for (int r = 0; r < 16; ++r) {
            const int d0_ = dbase - ((r & 3) + 8 * (r >> 2)), d1_ = d0_ - 32;
            float t0, t1;
            if (!CAUSAL) { t0 = fmaf(p0[r], C2, tab2[min(d0_, 1023)]); t1 = fmaf(p1[r], C2, tab2[min(d1_, 1023)]); }
            else { t0 = fmaf(p0[r], C2, tab2[max(d0_, 0)]); t1 = fmaf(p1[r], C2, tab2[max(d1_, 0)]); if (d0_ < 0) t0 = -1e30f; if (d1_ < 0) t1 = -1e30f; }
            p0[r] = t0; p1[r] = t1;
        }
        sc = 1.f; cadd = 0.f;
    }
    float pmax = p0[0];
#pragma unroll
    for (int r = 1; r < 16; ++r) pmax = fmaxf(pmax, p0[r]);
#pragma unroll
    for (int r = 0; r < 16; ++r) pmax = fmaxf(pmax, p1[r]);
    { auto rr = __builtin_amdgcn_permlane32_swap(__float_as_uint(pmax), __float_as_uint(pmax), false, false);
      pmax = fmaxf(__uint_as_float(rr[0]), __uint_as_float(rr[1])); }
    pmax = fmaf(pmax, sc, cadd);
    float alpha = 1.f;
    if (!__all(pmax - m_reg <= THR2)) {
        const float mn = fmaxf(m_reg, pmax);
        alpha = __builtin_amdgcn_exp2f(m_reg - mn); m_reg = mn;
        if (hi == 0) al_l[r32] = alpha;
        asm volatile("s_waitcnt lgkmcnt(0)" ::: "memory");
#pragma unroll
        for (int r = 0; r < 16; ++r) { const float av = al_l[crow(r, hi)];
#pragma unroll
            for (int d = 0; d < 4; ++d) o[d][r] *= av; }
    }
    const float off = cadd - m_reg;
#pragma unroll
    for (int r = 0; r < 16; ++r) { p0[r] = __builtin_amdgcn_exp2f(fmaf(p0[r], sc, off)); p1[r] = __builtin_amdgcn_exp2f(fmaf(p1[r], sc, off)); }
    float ps = 0.f;
#pragma unroll
    for (int r = 0; r < 16; ++r) ps += p0[r];
#pragma unroll
    for (int r = 0; r < 16; ++r) ps += p1[r];
    { auto rr = __builtin_amdgcn_permlane32_swap(__float_as_uint(ps), __float_as_uint(ps), false, false);
      ps = __uint_as_float(rr[0]) + __uint_as_float(rr[1]); }
    l_reg = l_reg * alpha + ps;
    bf16x8 pa0, pa1, pa2, pa3;
#define PK4(P, BASE, OUT) do { unsigned a0 = cvtpk(P[BASE + 0], P[BASE + 1]), a1 = cvtpk(P[BASE + 2], P[BASE + 3]);   \
    unsigned b0 = cvtpk(P[BASE + 4], P[BASE + 5]), b1 = cvtpk(P[BASE + 6], P[BASE + 7]);                              \
    auto r0 = __builtin_amdgcn_permlane32_swap(a0, b0, false, false); auto r1 = __builtin_amdgcn_permlane32_swap(a1, b1, false, false); \
    u32x4 w = {r0[0], r1[0], r0[1], r1[1]}; OUT = *reinterpret_cast<bf16x8*>(&w); } while (0)
    PK4(p0, 0, pa0); PK4(p0, 8, pa1); PK4(p1, 0, pa2); PK4(p1, 8, pa3);
#undef PK4
    pv_one<0>(o[0], vb, pa0, pa1, pa2, pa3); pv_one<1>(o[1], vb, pa0, pa1, pa2, pa3); pv_one<2>(o[2], vb, pa0, pa1, pa2, pa3); pv_one<3>(o[3], vb, pa0, pa1, pa2, pa3);
}
}

template <bool OWN>
__device__ __forceinline__ void attn_engine(const Args& a, LAS unsigned char* lds, int tid, int lane, int wid) {
    using namespace moba;
    bf16* Q = (bf16*)(a.ws + WS_A2); const bf16* K = Q + (size_t)M * D; const bf16* V = K + (size_t)M * D;
    const unsigned* cnt = (const unsigned*)(a.ws + WS_CNT); const unsigned short* lists = (const unsigned short*)(a.ws + WS_LIST);
    const float* tab2g = (const float*)(a.ws + WS_TAB2); float* LSE = (float*)(a.ws + WS_LSE);
    const long po1off = (long)((const unsigned char*)a.out - a.ws);
    const int r32 = lane & 31, hi = lane >> 5, sr = tid >> 4, sc = (tid & 15) * 8;
    LAS int* P = (LAS int*)(lds + E_SCHED);
    int TR = 512;
    if (!OWN) {
        const int c0_ = ((int)cnt[2 * tid] + 255) >> 8, c1_ = ((int)cnt[2 * tid + 1] + 255) >> 8;
        int v = c0_ + c1_;
#pragma unroll
        for (int o_ = 1; o_ < 64; o_ <<= 1) { const int t_ = __shfl_up(v, o_); if (lane >= o_) v += t_; }
        LAS int* wt = (LAS int*)(lds + E_WSCR);
        if (lane == 63) wt[wid] = v;
        __syncthreads();
        int off = 0;
        for (int w = 0; w < wid; ++w) off += wt[w];
        P[2 * tid + 2] = off + v; P[2 * tid + 1] = off + v - c1_;
        if (tid == 0) P[0] = 0;
        __syncthreads();
        TR = P[1024];
    }
    const int R0 = (int)(((long)blockIdx.x * TR) / gridDim.x), R1 = (int)(((long)(blockIdx.x + 1) * TR) / gridDim.x);
    if (R0 >= R1) return;
#define AE_LOC(rd_, li_, r_) do { if (OWN) { li_ = (rd_); r_ = 0; } else { int a_ = 0, b_ = 1024; while (b_ - a_ > 1) { const int mid_ = (a_ + b_) >> 1; if (P[mid_] <= (rd_)) a_ = mid_; else b_ = mid_; } li_ = a_; r_ = (rd_) - P[a_]; } } while (0)
#define AE_TLOAD(Kt_, Vt_) do { ks0 = *(const bf16x8*)((Kt_) + (size_t)sr * D + sc); ks1 = *(const bf16x8*)((Kt_) + (size_t)(32 + sr) * D + sc);                 \
        vs0 = *(const bf16x8*)((Vt_) + (size_t)sr * D + sc); vs1 = *(const bf16x8*)((Vt_) + (size_t)(32 + sr) * D + sc); } while (0)
#define AE_TWRITE(bi_) do { *(LAS bf16x8*)(lds + ((bi_) ? E_K1 : E_K0) + KSWZ(sr, sc * 2)) = ks0; *(LAS bf16x8*)(lds + ((bi_) ? E_K1 : E_K0) + KSWZ(32 + sr, sc * 2)) = ks1;   \
        *(LAS bf16x8*)(lds + ((bi_) ? E_V1 : E_V0) + v_st(sr, sc)) = vs0; *(LAS bf16x8*)(lds + ((bi_) ? E_V1 : E_V0) + v_st(32 + sr, sc)) = vs1; } while (0)
    bf16x8 ks0, ks1, vs0, vs1;
    int li, rr; AE_LOC(R0, li, rr);
    int b = (OWN ? li : (li >> 1)) >> 8, h = ((OWN ? li : (li >> 1)) >> 5) & 7, n = (OWN ? li : (li >> 1)) & 31;
    int L = OWN ? 256 : (int)cnt[li];
    const bf16* Kt = K + (size_t)(b * T + n * 256) * D + h * 128; const bf16* Vt = V + (size_t)(b * T + n * 256) * D + h * 128;
    AE_TLOAD(Kt, Vt);
    int tabsel = 0;
    for (int e = tid; e < 1024; e += 512) ((LAS float*)(lds + E_TAB))[e] = tab2g[h * 1024 + e];
    int ent, qpos, slot; bool valid;
    {
        const int e = rr * 256 + wid * 32 + r32; valid = e < L;
        if (OWN) ent = n * 256 + wid * 32 + r32; else ent = lists[(size_t)(li >> 1) * 8192 + (li & 1) * 7168 + (valid ? e : (L - 1))];
    }
    bf16x8 qr[8];
    {
        const bf16* Qw = Q + (size_t)(b * T + (ent & 8191)) * D + h * 128 + hi * 8;
#pragma unroll
        for (int d0 = 0; d0 < 8; ++d0) qr[d0] = *(const bf16x8*)(Qw + d0 * 16);
    }
    AE_TWRITE(0);
    __syncthreads();
    int step = 0;
    LAS float* al_l = (LAS float*)(lds + E_WSCR + wid * 1024);
    for (int rd = R0; rd < R1; ++rd) {
        const bool has_next = rd + 1 < R1;
        int nli = li, nrr = rr; if (has_next) AE_LOC(rd + 1, nli, nrr);
        const int nl2_ = OWN ? nli : (nli >> 1); const int nb_ = nl2_ >> 8, nh = (nl2_ >> 5) & 7, nn = nl2_ & 31;
        const int nL = OWN ? 256 : (has_next ? (int)cnt[nli] : L);
        const bf16* Ktn = K + (size_t)(nb_ * T + nn * 256) * D + nh * 128; const bf16* Vtn = V + (size_t)(nb_ * T + nn * 256) * D + nh * 128;
        qpos = ent & 8191; slot = ent >> 13;
        const int m = b * T + qpos, qrel = qpos - n * 256;
        const bool wave_on = OWN ? true : ((rr * 256 + wid * 32) < L);
        const bool near_ = !OWN && (li & 1);
        const LAS float* tab2 = (const LAS float*)(lds + E_TAB + tabsel * 4096);
        f32x16 o[4] = {}; float m_reg = -1e30f, l_reg = 0.f;
        float ls0 = -1e30f, ls1 = -1e30f, ls2 = -1e30f;
        const int nsel = n < 3 ? n : 3;
        int nent = ent; bool nvalid = valid;
#pragma unroll 1
        for (int kt = 0; kt < 4; ++kt) {
            const bool more = (kt < 3) || has_next;
            if (more) { if (kt < 3) AE_TLOAD(Kt + (size_t)(kt + 1) * 64 * D, Vt + (size_t)(kt + 1) * 64 * D); else AE_TLOAD(Ktn, Vtn); }
            const int bi = step & 1;
            if (OWN && kt == 3) {
                if (nsel > 0) ls0 = LSE[((size_t)0 * M + m) * 8 + h];
                if (nsel > 1) ls1 = LSE[((size_t)1 * M + m) * 8 + h];
                if (nsel > 2) ls2 = LSE[((size_t)2 * M + m) * 8 + h];
            }
            if (wave_on && (!OWN || kt <= (wid >> 1))) {
                const LAS unsigned char* Kb_ = lds + (bi ? E_K1 : E_K0); const int vb_ = (int)(unsigned long)(lds + (bi ? E_V1 : E_V0)) + v_rd_base(lane);
                tile_step<OWN>(Kb_, vb_, tab2, al_l, qr, qrel, kt, near_, r32, hi, o, m_reg, l_reg);
            }
            if (has_next && kt == 1) {
                const int e = nrr * 256 + wid * 32 + r32; nvalid = e < nL;
                if (OWN) nent = nn * 256 + wid * 32 + r32; else nent = lists[(size_t)(nli >> 1) * 8192 + (nli & 1) * 7168 + (nvalid ? e : (nL - 1))];
            }
            if (has_next && kt == 3) {
                const bf16* Qw = Q + (size_t)(nb_ * T + (nent & 8191)) * D + nh * 128 + hi * 8;
#pragma unroll
                for (int d0 = 0; d0 < 8; ++d0) qr[d0] = *(const bf16x8*)(Qw + d0 * 16);
            }
            if (more) AE_TWRITE(bi ^ 1);
            if (kt == 3 && has_next && nh != h) { for (int e = tid; e < 1024; e += 512) ((LAS float*)(lds + E_TAB + (tabsel ^ 1) * 4096))[e] = tab2g[nh * 1024 + e]; }
            __syncthreads();
            ++step;
        }
        if (wave_on) {
            LAS unsigned char* stg = lds + E_STG + wid * 2048;
            if (!OWN) {
                LAS float* li_l = (LAS float*)(lds + E_WSCR + wid * 1024 + 128);
                LAS int* row_l = (LAS int*)(lds + E_WSCR + wid * 1024 + 256);
                if (hi == 0) { li_l[r32] = __builtin_amdgcn_rcpf(l_reg); row_l[r32] = valid ? ((slot << 20) | m) : -1;
                    if (valid) LSE[((size_t)slot * M + m) * 8 + h] = m_reg + __builtin_amdgcn_logf(l_reg); }
                asm volatile("s_waitcnt lgkmcnt(0)" ::: "memory");
                float rl[16];
#pragma unroll
                for (int r = 0; r < 16; ++r) rl[r] = li_l[crow(r, hi)];
#pragma unroll
                for (int d0 = 0; d0 < 4; ++d0) {
#pragma unroll
                    for (int r = 0; r < 16; ++r) *(LAS unsigned short*)(stg + crow(r, hi) * 64 + r32 * 2) = (unsigned short)f2bf(o[d0][r] * rl[r]);
#pragma unroll
                    for (int t2 = 0; t2 < 2; ++t2) {
                        const int id = t2 * 64 + lane, row = id >> 2, ch = id & 3;
                        const u32x4 v = *(const LAS u32x4*)(stg + row * 64 + ch * 16);
                        const int rm = row_l[row];
                        if (rm >= 0) {
                            const int sl = rm >> 20, mm = rm & 0xfffff;
                            *(u32x4*)((bf16*)(a.ws + (sl == 0 ? (long)WS_PO0 : (sl == 1 ? po1off : (long)WS_PO2))) + (size_t)mm * D + h * 128 + d0 * 32 + ch * 8) = v;
                        }
                    }
                }
            } else {
                const float lown = m_reg + __builtin_amdgcn_logf(l_reg);
                const float Mx = fmaxf(fmaxf(lown, ls0), fmaxf(ls1, ls2));
                const float e0 = __builtin_amdgcn_exp2f(ls0 - Mx), e1 = __builtin_amdgcn_exp2f(ls1 - Mx), e2 = __builtin_amdgcn_exp2f(ls2 - Mx), eo = __builtin_amdgcn_exp2f(lown - Mx);
                const float iz = __builtin_amdgcn_rcpf((eo + e0) + (e1 + e2));
                LAS float* cf = (LAS float*)(lds + E_WSCR + wid * 1024 + 128);
                if (hi == 0) { cf[r32] = eo * iz * __builtin_amdgcn_rcpf(l_reg); cf[32 + r32] = e0 * iz; cf[64 + r32] = e1 * iz; cf[96 + r32] = e2 * iz; }
                asm volatile("s_waitcnt lgkmcnt(0)" ::: "memory");
                const bf16* P0 = (const bf16*)(a.ws + WS_PO0); const bf16* P1 = (const bf16*)a.out; const bf16* P2 = (const bf16*)(a.ws + WS_PO2);
                float co[16];
#pragma unroll
                for (int r = 0; r < 16; ++r) co[r] = cf[crow(r, hi)];
#pragma unroll
                for (int d0 = 0; d0 < 4; ++d0) {
#pragma unroll
                    for (int r = 0; r < 16; ++r) *(LAS unsigned short*)(stg + crow(r, hi) * 64 + r32 * 2) = (unsigned short)f2bf(o[d0][r] * co[r]);
#pragma unroll
                    for (int t2 = 0; t2 < 2; ++t2) {
                        const int id = t2 * 64 + lane, row = id >> 2, ch = id & 3;
                        const u32x4 ov = *(const LAS u32x4*)(stg + row * 64 + ch * 16);
                        const size_t off = (size_t)(b * T + n * 256 + wid * 32 + row) * D + h * 128 + d0 * 32 + ch * 8;
                        float acc[8];
                        acc[0] = __uint_as_float(ov.x << 16); acc[1] = __uint_as_float(ov.x & 0xffff0000u); acc[2] = __uint_as_float(ov.y << 16); acc[3] = __uint_as_float(ov.y & 0xffff0000u);
                        acc[4] = __uint_as_float(ov.z << 16); acc[5] = __uint_as_float(ov.z & 0xffff0000u); acc[6] = __uint_as_float(ov.w << 16); acc[7] = __uint_as_float(ov.w & 0xffff0000u);
#define ADDP(PP, CI) do { const u32x4 pv = *(const u32x4*)((PP) + off); const float cc = cf[(CI) * 32 + row];                                   \
    acc[0] = fmaf(cc, __uint_as_float(pv.x << 16), acc[0]); acc[1] = fmaf(cc, __uint_as_float(pv.x & 0xffff0000u), acc[1]);                     \
    acc[2] = fmaf(cc, __uint_as_float(pv.y << 16), acc[2]); acc[3] = fmaf(cc, __uint_as_float(pv.y & 0xffff0000u), acc[3]);                     \
    acc[4] = fmaf(cc, __uint_as_float(pv.z << 16), acc[4]); acc[5] = fmaf(cc, __uint_as_float(pv.z & 0xffff0000u), acc[5]);                     \
    acc[6] = fmaf(cc, __uint_as_float(pv.w << 16), acc[6]); acc[7] = fmaf(cc, __uint_as_float(pv.w & 0xffff0000u), acc[7]); } while (0)
                        if (nsel > 0) ADDP(P0, 1);
                        if (nsel > 1) ADDP(P1, 2);
                        if (nsel > 2) ADDP(P2, 3);
#undef ADDP
                        *(u32x4*)(Q + off) = (u32x4){pk2(acc[0], acc[1]), pk2(acc[2], acc[3]), pk2(acc[4], acc[5]), pk2(acc[6], acc[7])};
                    }
                }
            }
        }
        if (nh != h) tabsel ^= 1;
        li = nli; rr = nrr; b = nb_; h = nh; n = nn; L = nL; Kt = Ktn; Vt = Vtn; ent = nent; valid = nvalid;
    }
    __syncthreads();
#undef AE_LOC
#undef AE_TLOAD
#undef AE_TWRITE
}

namespace hg {
using namespace moba;
constexpr int H_TQ = 0, H_TK = 16384, H_TKT = 32768, H_TI = 49152, H_SIMG = 65536, H_OST = 98304, H_EL = 132096;
constexpr int OST_LD = 132;
__device__ __forceinline__ int kt_off(int n, int s) { return n * 128 + ((((s >> 3) ^ ((n >> 1) & 7))) << 4) + (s & 7) * 2; }

template <bool PASS_B>
__device__ __forceinline__ void hgrn_unit(const Args& a, LAS unsigned char* lds, int u, int tid, int lane, int wid) {
    unsigned char* ws = a.ws;
    const bf16* QS = (const bf16*)(ws + WS_A1); const float* LF = (const float*)(ws + WS_A2); const bf16* INP = (const bf16*)(ws + WS_A3); const bf16* OG = (const bf16*)(ws + WS_A4);
    bf16* OGATED = (bf16*)(ws + WS_A0); float* SSQH = (float*)(ws + WS_SSQH);
    float* TG = a.out;
    float* DG = a.out + (size_t)256 * 128 * 128;
    const int bh = u >> 4, g = u & 15, b = bh >> 3, h = bh & 7;
    const int r32 = lane & 31, hi = lane >> 5, tb = wid >> 2, db = wid & 3;
    const int nl = lane & 15, tq = lane >> 4, npre = 16 * wid + nl;
    f32x16 Sacc[2] = {};
    float dg = 1.f;
    if (PASS_B) {
        for (int gp = 0; gp < g; ++gp) {
            int lp_ = (4 * hi) * 128 + 32 * db + r32, lh_ = 4 * hi; asm volatile("" : "+v"(lp_), "+v"(lh_));
            const float* tg = TG + (size_t)(bh * 16 + gp) * 16384 + lp_; const float* dgp = DG + (size_t)(bh * 16 + gp) * 128 + lh_;
#pragma unroll
            for (int i = 0; i < 2; ++i) { const int nb = 2 * tb + i;
#pragma unroll
                for (int r = 0; r < 16; ++r) { const int n0_ = 32 * nb + (r & 3) + 8 * (r >> 2); Sacc[i][r] = fmaf(Sacc[i][r], dgp[n0_], tg[n0_ * 128]); } }
        }
#pragma unroll
        for (int i = 0; i < 2; ++i) { const int nb = 2 * tb + i;
#pragma unroll
            for (int r = 0; r < 16; ++r) { const int n = 32 * nb + crow(r, hi);
                *(LAS unsigned short*)(lds + H_SIMG + (nb >> 1) * 16384 + v_st(n & 63, 32 * db + r32)) = (unsigned short)f2bf(Sacc[i][r]); } }
    }
    float lfn[16]; unsigned short qn[16]; bf16x8 in0, in1; u32x4 gn0, gn1;
    const int sr = tid >> 4, sc = (tid & 15) * 8;
    const int pt = tid >> 3, pseg = tid & 7;
#define HG_LOAD(cc) do { const size_t m0_ = (size_t)b * T + g * 512 + (cc) * 64; const size_t off0_ = (m0_ + 16 * tq) * D + h * 128 + npre;                       \
        _Pragma("unroll") for (int i = 0; i < 16; ++i) { lfn[i] = LF[off0_ + (size_t)i * D]; if (PASS_B) qn[i] = QS[off0_ + (size_t)i * D]; }                      \
        in0 = *(const bf16x8*)(INP + (m0_ + sr) * D + h * 128 + sc); in1 = *(const bf16x8*)(INP + (m0_ + 32 + sr) * D + h * 128 + sc);                          \
        if (PASS_B) { const size_t go_ = (m0_ + pt) * D + h * 128 + 16 * pseg; gn0 = *(const u32x4*)(OG + go_); gn1 = *(const u32x4*)(OG + go_ + 8); } } while (0)
    HG_LOAD(0);
    for (int c = 0; c < 8; ++c) {
        const size_t m0 = (size_t)b * T + g * 512 + c * 64;
        u32x4 g0 = {}, g1 = {};
        {
            float lf[16], qv[16];
#pragma unroll
            for (int i = 0; i < 16; ++i) { lf[i] = lfn[i]; if (PASS_B) qv[i] = bf2f(qn[i]); }
            if (PASS_B) { g0 = gn0; g1 = gn1; }
            float cs[16]; float run = 0.f;
#pragma unroll
            for (int i = 0; i < 16; ++i) { run += lf[i]; cs[i] = run; }
            const float s0 = __shfl(run, nl), s1 = __shfl(run, nl + 16), s2 = __shfl(run, nl + 32), s3 = __shfl(run, nl + 48);
            const float pre = (tq > 0 ? s0 : 0.f) + (tq > 1 ? s1 : 0.f) + (tq > 2 ? s2 : 0.f);
            const float last = (s0 + s1) + (s2 + s3);
            unsigned kh[8];
#pragma unroll
            for (int i = 0; i < 16; i += 2) {
                float khv[2];
#pragma unroll
                for (int e = 0; e < 2; ++e) {
                    const int t = 16 * tq + i + e; const float cum = pre + cs[i + e];
                    const float kk = 1.f - __expf(lf[i + e]);
                    khv[e] = kk * __expf(last - cum);
                    if (PASS_B) {
                        *(LAS unsigned short*)(lds + H_TQ + KSWZ(t, npre * 2)) = (unsigned short)f2bf(qv[i + e] * __expf(cum));
                        *(LAS unsigned short*)(lds + H_TK + KSWZ(t, npre * 2)) = (unsigned short)f2bf(kk * __expf(-cum));
                    }
                }
                kh[i >> 1] = pk2(khv[0], khv[1]);
            }
            *(LAS u32x4*)(lds + H_TKT + kt_off(npre, 16 * tq)) = (u32x4){kh[0], kh[1], kh[2], kh[3]};
            *(LAS u32x4*)(lds + H_TKT + kt_off(npre, 16 * tq + 8)) = (u32x4){kh[4], kh[5], kh[6], kh[7]};
            const float el = __expf(last);
            if (tq == 0) *(LAS float*)(lds + H_EL + npre * 4) = el;
            dg *= el;
            *(LAS bf16x8*)(lds + H_TI + v_st(sr, sc)) = in0;
            *(LAS bf16x8*)(lds + H_TI + v_st(32 + sr, sc)) = in1;
        }
        __syncthreads();
        {
#define PK(L, Hh) (bf16x8){L[0], L[1], L[2], L[3], Hh[0], Hh[1], Hh[2], Hh[3]}
            bf16x8 pa0, pa1, pa2, pa3; bf16x8 qr[8];
            if (PASS_B) {
                const int t = 32 * tb + r32;
#pragma unroll
                for (int d0 = 0; d0 < 8; ++d0) qr[d0] = *(const LAS bf16x8*)(lds + H_TQ + KSWZ(t, (d0 * 16 + hi * 8) * 2));
                f32x16 p0, p1;
                qkt(p0, p1, lds + H_TK, qr, r32, hi);
#pragma unroll
                for (int r = 0; r < 16; ++r) { const int s0_ = crow(r, hi); if (s0_ > t) p0[r] = 0.f; if (s0_ + 32 > t) p1[r] = 0.f; }
#define PK4(P, BASE, OUT) do { unsigned a0 = cvtpk(P[BASE + 0], P[BASE + 1]), a1 = cvtpk(P[BASE + 2], P[BASE + 3]);   \
    unsigned b0 = cvtpk(P[BASE + 4], P[BASE + 5]), b1 = cvtpk(P[BASE + 6], P[BASE + 7]);                              \
    auto r0 = __builtin_amdgcn_permlane32_swap(a0, b0, false, false); auto r1 = __builtin_amdgcn_permlane32_swap(a1, b1, false, false); \
    u32x4 w = {r0[0], r1[0], r0[1], r1[1]}; OUT = *reinterpret_cast<bf16x8*>(&w); } while (0)
                PK4(p0, 0, pa0); PK4(p0, 8, pa1); PK4(p1, 0, pa2); PK4(p1, 8, pa3);
#undef PK4
            }
            if (c < 7) HG_LOAD(c + 1);
            const int vbI = (int)(unsigned long)(lds + H_TI) + v_rd_base(lane) + db * 512;
            bf16x8 bI[4];
            {
                const s16x4 l0 = tr_read<v_rd_off(0, 0, 0)>(vbI), h0 = tr_read<v_rd_off(0, 0, 1)>(vbI), l1 = tr_read<v_rd_off(0, 1, 0)>(vbI), h1 = tr_read<v_rd_off(0, 1, 1)>(vbI);
                const s16x4 l2 = tr_read<v_rd_off(0, 2, 0)>(vbI), h2 = tr_read<v_rd_off(0, 2, 1)>(vbI), l3 = tr_read<v_rd_off(0, 3, 0)>(vbI), h3 = tr_read<v_rd_off(0, 3, 1)>(vbI);
                asm volatile("s_waitcnt lgkmcnt(0)" ::: "memory"); SBAR();
                bI[0] = PK(l0, h0); bI[1] = PK(l1, h1); bI[2] = PK(l2, h2); bI[3] = PK(l3, h3);
            }
            if (PASS_B) {
                f32x16 od = {};
                od = __builtin_amdgcn_mfma_f32_32x32x16_bf16(pa0, bI[0], od, 0, 0, 0);
                od = __builtin_amdgcn_mfma_f32_32x32x16_bf16(pa1, bI[1], od, 0, 0, 0);
                od = __builtin_amdgcn_mfma_f32_32x32x16_bf16(pa2, bI[2], od, 0, 0, 0);
                od = __builtin_amdgcn_mfma_f32_32x32x16_bf16(pa3, bI[3], od, 0, 0, 0);
#pragma unroll
                for (int hf = 0; hf < 2; ++hf) {
                    const int vbS = (int)(unsigned long)(lds + H_SIMG) + hf * 16384 + v_rd_base(lane) + db * 512;
                    const s16x4 l0 = tr_read<v_rd_off(0, 0, 0)>(vbS), h0 = tr_read<v_rd_off(0, 0, 1)>(vbS), l1 = tr_read<v_rd_off(0, 1, 0)>(vbS), h1 = tr_read<v_rd_off(0, 1, 1)>(vbS);
                    const s16x4 l2 = tr_read<v_rd_off(0, 2, 0)>(vbS), h2 = tr_read<v_rd_off(0, 2, 1)>(vbS), l3 = tr_read<v_rd_off(0, 3, 0)>(vbS), h3 = tr_read<v_rd_off(0, 3, 1)>(vbS);
                    asm volatile("s_waitcnt lgkmcnt(0)" ::: "memory"); SBAR();
                    od = __builtin_amdgcn_mfma_f32_32x32x16_bf16(qr[hf * 4 + 0], PK(l0, h0), od, 0, 0, 0);
                    od = __builtin_amdgcn_mfma_f32_32x32x16_bf16(qr[hf * 4 + 1], PK(l1, h1), od, 0, 0, 0);
                    od = __builtin_amdgcn_mfma_f32_32x32x16_bf16(qr[hf * 4 + 2], PK(l2, h2), od, 0, 0, 0);
                    od = __builtin_amdgcn_mfma_f32_32x32x16_bf16(qr[hf * 4 + 3], PK(l3, h3), od, 0, 0, 0);
                }
#undef PK
                LAS float* ost = (LAS float*)(lds + H_OST);
#pragma unroll
                for (int r = 0; r < 16; ++r) ost[(32 * tb + crow(r, hi)) * OST_LD + 32 * db + r32] = od[r];
            }
            const LAS float* el = (const LAS float*)(lds + H_EL);
#pragma unroll
            for (int i = 0; i < 2; ++i) { const int nb = 2 * tb + i;
#pragma unroll
                for (int r = 0; r < 16; ++r) Sacc[i][r] *= el[32 * nb + crow(r, hi)];
#pragma unroll
                for (int ks = 0; ks < 4; ++ks) {
                    const bf16x8 af = *(const LAS bf16x8*)(lds + H_TKT + kt_off(32 * nb + r32, 16 * ks + 8 * hi));
                    Sacc[i] = __builtin_amdgcn_mfma_f32_32x32x16_bf16(af, bI[ks], Sacc[i], 0, 0, 0);
                } }
        }
        __syncthreads();
        if (PASS_B) {
#pragma unroll
            for (int i = 0; i < 2; ++i) { const int nb = 2 * tb + i;
#pragma unroll
                for (int r = 0; r < 16; ++r) { const int n = 32 * nb + crow(r, hi);
                    *(LAS unsigned short*)(lds + H_SIMG + (nb >> 1) * 16384 + v_st(n & 63, 32 * db + r32)) = (unsigned short)f2bf(Sacc[i][r]); } }
            const int t = pt, seg = pseg; const size_t go = (m0 + t) * D + h * 128 + 16 * seg;
            const LAS float* orow = (const LAS float*)(lds + H_OST) + t * OST_LD + 16 * seg;
            const unsigned gw[8] = {g0.x, g0.y, g0.z, g0.w, g1.x, g1.y, g1.z, g1.w};
            float ssq = 0.f; unsigned ow[8];
#pragma unroll
            for (int e = 0; e < 8; ++e) { const float o0 = orow[2 * e], o1 = orow[2 * e + 1]; ssq = fmaf(o0, o0, ssq); ssq = fmaf(o1, o1, ssq);
                ow[e] = pk2(o0 * __uint_as_float(gw[e] << 16), o1 * __uint_as_float(gw[e] & 0xffff0000u)); }
            *(u32x4*)(OGATED + go) = (u32x4){ow[0], ow[1], ow[2], ow[3]}; *(u32x4*)(OGATED + go + 8) = (u32x4){ow[4], ow[5], ow[6], ow[7]};
            ssq += __shfl_xor(ssq, 1); ssq += __shfl_xor(ssq, 2); ssq += __shfl_xor(ssq, 4);
            if (seg == 0) SSQH[(m0 + t) * 8 + h] = ssq;
        }
    }
    if (!PASS_B) {
        int col_ = 32 * db + r32; asm volatile("" : "+v"(col_));
        float* tg = TG + (size_t)u * 16384 + col_;
#pragma unroll
        for (int i = 0; i < 2; ++i) { const int nb = 2 * tb + i;
#pragma unroll
            for (int r = 0; r < 16; ++r) tg[(32 * nb + crow(r, hi)) * 128] = Sacc[i][r]; }
        if (tq == 0) DG[(size_t)u * 128 + npre] = dg;
    }
    __syncthreads();
#undef HG_LOAD
}
}

#define XB_TMO      128
#define XB_XCNT(j)  (256  + 64 * (j))
#define XB_XSUB(j)  (1280 + 64 * (j))
#define XB_XGEN(j)  (2304 + 64 * (j))
#define XB_TOP      3328
#define XB_TOPGEN   3392
#define XCD_BAR_WORDS 3456
#define XB_SPIN_CAP (1u << 18)

__device__ __forceinline__ unsigned xb_ld(unsigned* p)              { return __hip_atomic_load(p, __ATOMIC_RELAXED, __HIP_MEMORY_SCOPE_AGENT); }
__device__ __forceinline__ unsigned xb_add(unsigned* p, unsigned v) { return __hip_atomic_fetch_add(p, v, __ATOMIC_RELAXED, __HIP_MEMORY_SCOPE_AGENT); }
__device__ __forceinline__ unsigned xb_xcc_id() { return (unsigned)__builtin_amdgcn_s_getreg((3 << 11) | 20) & 0xFu; }
#define XB_SPIN(cond, bar) do { unsigned _sp = 0; while (cond) { __builtin_amdgcn_s_sleep(1); \
    if ((++_sp & 255u) == 0u) { if (xb_ld(&(bar)[XB_TMO])) break; if (_sp > XB_SPIN_CAP) { atomicAdd(&(bar)[XB_TMO], 1u); break; } } } } while (0)

struct XcdBarrier {
    unsigned* bar; unsigned x;
    volatile LAS unsigned* st;
};

__device__ __forceinline__ XcdBarrier xcd_barrier_post(unsigned* bar, volatile LAS unsigned* st) {
    XcdBarrier b; b.bar = bar; b.x = xb_xcc_id(); b.st = st;
    if (threadIdx.x == 0) (void)xb_add(&bar[XB_XCNT(b.x)], 1u);
    return b;
}
__device__ __forceinline__ void xcd_barrier_complete(unsigned* bar, unsigned x, unsigned& nloc, unsigned& nx) {
    const unsigned G = gridDim.x * gridDim.y * gridDim.z;
    unsigned sum, cnt, mine, sp = 0u;
    for (;;) {
        sum = 0u; cnt = 0u; mine = 0u;
#pragma unroll
        for (unsigned j = 0; j < 16; ++j) { const unsigned c = xb_ld(&bar[XB_XCNT(j)]); sum += c; cnt += (c > 0u) ? 1u : 0u; mine = (j == x) ? c : mine; }
        if (sum == G) break;
        __builtin_amdgcn_s_sleep(1);
        if ((++sp & 255u) == 0u) { if (xb_ld(&bar[XB_TMO])) break; if (sp > XB_SPIN_CAP) { atomicAdd(&bar[XB_TMO], 1u); break; } }
    }
    nloc = mine > 0u ? mine : 1u; nx = cnt > 0u ? cnt : 1u;
}

__device__ __forceinline__ void xcd_barrier(const XcdBarrier& b) {
    asm volatile("s_waitcnt vmcnt(0)" ::: "memory");
    __syncthreads();
    if (threadIdx.x == 0) {
        unsigned* bar = b.bar;
        __builtin_amdgcn_s_waitcnt(0);
        unsigned nloc = b.st[0], nx = b.st[1];
        if (nloc == 0u) { xcd_barrier_complete(bar, b.x, nloc, nx); b.st[0] = nloc; b.st[1] = nx; }
        const unsigned old = xb_add(&bar[XB_XSUB(b.x)], 1u);
        const unsigned gen = old / nloc;
        if (old + 1u == (gen + 1u) * nloc) {
            __builtin_amdgcn_fence(__ATOMIC_RELEASE, "agent");
            asm volatile("s_waitcnt vmcnt(0)" ::: "memory");
            const unsigned og = xb_add(&bar[XB_TOP], 1u);
            const unsigned tg = og / nx;
            if (og + 1u == (tg + 1u) * nx) xb_add(&bar[XB_TOPGEN], 1u);
            else XB_SPIN(xb_ld(&bar[XB_TOPGEN]) == tg, bar);
            __builtin_amdgcn_fence(__ATOMIC_ACQUIRE, "agent");
            xb_add(&bar[XB_XGEN(b.x)], 1u);
            asm volatile("s_waitcnt vmcnt(0)" ::: "memory");
        } else {
            XB_SPIN(xb_ld(&bar[XB_XGEN(b.x)]) == gen, bar);
            __builtin_amdgcn_fence(__ATOMIC_ACQUIRE, "agent");
            asm volatile("s_waitcnt vmcnt(0)" ::: "memory");
        }
    }
    __syncthreads();
}

__global__ void __launch_bounds__(NWAVES * 64, 2) mk(Args a) {
    extern __shared__ __attribute__((aligned(16))) unsigned char lds_raw[];
    LAS unsigned char* lds = (LAS unsigned char*)lds_raw;
    const int tid = threadIdx.x, lane = tid & 63, wave = __builtin_amdgcn_readfirstlane(tid >> 6);
    unsigned char* ws = a.ws;
    const int lo = a.ph_lo, hi = a.ph_hi;
    const int G = gridDim.x;
    cg::grid_group grid = cg::this_grid();
#define IN(k) (lo <= (k) && (k) < hi)
#define SEAM(k) do { if (IN(k) && IN((k) + 1)) { if ((k) == 0) { grid.sync(); bar = xcd_barrier_post((unsigned*)(ws + WS_BAR), MISC); } else xcd_barrier(bar); } } while (0)
#define GEMM_PHASE(EPI, ...) pg8::gemm_phase<EPI, pg8::StaticOrder, true, true>(lds, g, S, E)
    float* SSQ = (float*)(ws + WS_SSQ);
    volatile LAS unsigned* MISC = (volatile LAS unsigned*)(lds + LDS_MISC);
    if (tid < 2) MISC[tid] = 0u;
    __syncthreads();
    XcdBarrier bar; bar.bar = (unsigned*)(ws + WS_BAR); bar.x = 0; bar.st = MISC;
    int ph = 0;
#ifdef PROBE_LO
    unsigned long long pt0 = 0, pt1 = 0;
#define PMARK(k) do { if (blockIdx.x == 0) { if ((k) == PROBE_LO) pt0 = __builtin_amdgcn_s_memrealtime(); if ((k) == PROBE_HI + 1) pt1 = __builtin_amdgcn_s_memrealtime(); } } while (0)
#else
#define PMARK(k) do { } while (0)
#endif
    PMARK(ph);
    if (IN(ph)) { prologue(a, lds, tid, lane, wave); }
    SEAM(ph); ++ph; PMARK(ph);
    if (IN(ph)) {
        pg8::Gemm g{(const bf16*)(ws + WS_A0), (const bf16*)(ws + WS_WIN0), M, 4096, D}; pg8::StaticOrder S; S.init(M, 4096, G, (int)blockIdx.x);
        pg8::EpiHgrnIn E{(bf16*)(ws + WS_A1), (float*)(ws + WS_A2), (bf16*)(ws + WS_A3), (bf16*)(ws + WS_A4), (const float*)(ws + WS_LB)};
        pg8::gemm_phase<pg8::EpiHgrnIn, pg8::StaticOrder, true, true>(lds, g, S, E);
    }
    SEAM(ph); ++ph; PMARK(ph);
    if (IN(ph)) { for (int u = blockIdx.x; u < 256; u += G) hg::hgrn_unit<false>(a, lds, u, tid, lane, wave); }
    SEAM(ph); ++ph; PMARK(ph);
    if (IN(ph)) { for (int u = blockIdx.x; u < 256; u += G) hg::hgrn_unit<true>(a, lds, u, tid, lane, wave); }
    SEAM(ph); ++ph; PMARK(ph);
    if (IN(ph)) {
        pg8::Gemm g{(const bf16*)(ws + WS_A0), (const bf16*)(ws + WS_WOUT0), M, D, D}; pg8::StaticOrder S; S.init(M, D, G, (int)blockIdx.x);
        pg8::EpiResid<1, true> E{a.x, (bf16*)(ws + WS_A1), SSQ, (const float*)(ws + WS_SSQH)};
        pg8::gemm_phase<pg8::EpiResid<1, true>, pg8::StaticOrder, true, true>(lds, g, S, E);
    }
    SEAM(ph); ++ph; PMARK(ph);
    if (IN(ph)) {
        pg8::Gemm g{(const bf16*)(ws + WS_A1), (const bf16*)(ws + WS_W13_0), M, 2 * DFF, D}; pg8::StaticOrder S; S.init(M, 2 * DFF, G, (int)blockIdx.x);
        pg8::EpiSwiglu E{(bf16*)(ws + WS_A2), DFF, SSQ};
        pg8::gemm_phase<pg8::EpiSwiglu, pg8::StaticOrder, true, true>(lds, g, S, E);
    }
    SEAM(ph); ++ph; PMARK(ph);
    if (IN(ph)) {
        pg8::Gemm g{(const bf16*)(ws + WS_A2), (const bf16*)(ws + WS_W2_0), M, D, DFF}; pg8::StaticOrder S; S.init(M, D, G, (int)blockIdx.x);
        pg8::EpiResid<0, false> E{(const void*)(ws + WS_A1), (bf16*)(ws + WS_A1), SSQ, nullptr};
        pg8::gemm_phase<pg8::EpiResid<0, false>, pg8::StaticOrder, true, true>(lds, g, S, E);
    }
    SEAM(ph); ++ph; PMARK(ph);
    if (IN(ph)) {
        pg8::Gemm g{(const bf16*)(ws + WS_A1), (const bf16*)(ws + WS_WQKV), M, 3072, D}; pg8::StaticOrder S; S.init(M, 3072, G, (int)blockIdx.x);
        pg8::EpiQKV E{(bf16*)(ws + WS_A2), (size_t)M * D, SSQ, (float*)(ws + WS_KMEAN)};
        pg8::gemm_phase<pg8::EpiQKV, pg8::StaticOrder, true, true>(lds, g, S, E);
    }
    SEAM(ph); ++ph; PMARK(ph);
    if (IN(ph)) topk_phase(a, lds, tid, lane, wave);
    SEAM(ph); ++ph; PMARK(ph);
    if (IN(ph)) attn_engine<false>(a, lds, tid, lane, wave);
    SEAM(ph); ++ph; PMARK(ph);
    if (IN(ph)) attn_engine<true>(a, lds, tid, lane, wave);
    SEAM(ph); ++ph; PMARK(ph);
    if (IN(ph)) {
        pg8::Gemm g{(const bf16*)(ws + WS_A2), (const bf16*)(ws + WS_WOUT1), M, D, D}; pg8::StaticOrder S; S.init(M, D, G, (int)blockIdx.x);
        pg8::EpiResid<0, false> E{(const void*)(ws + WS_A1), (bf16*)(ws + WS_A1), SSQ, nullptr};
        pg8::gemm_phase<pg8::EpiResid<0, false>, pg8::StaticOrder, true, true>(lds, g, S, E);
    }
    SEAM(ph); ++ph; PMARK(ph);
    if (IN(ph)) {
        pg8::Gemm g{(const bf16*)(ws + WS_A1), (const bf16*)(ws + WS_W13_1), M, 2 * DFF, D}; pg8::StaticOrder S; S.init(M, 2 * DFF, G, (int)blockIdx.x);
        pg8::EpiSwiglu E{(bf16*)(ws + WS_A2), DFF, SSQ};
        pg8::gemm_phase<pg8::EpiSwiglu, pg8::StaticOrder, true, true>(lds, g, S, E);
    }
    SEAM(ph); ++ph; PMARK(ph);
    if (IN(ph)) {
        pg8::Gemm g{(const bf16*)(ws + WS_A2), (const bf16*)(ws + WS_W2_1), M, D, DFF}; pg8::StaticOrder S; S.init(M, D, G, (int)blockIdx.x);
        pg8::EpiResid<0, false> E{(const void*)(ws + WS_A1), (bf16*)(ws + WS_A1), SSQ, nullptr};
        pg8::gemm_phase<pg8::EpiResid<0, false>, pg8::StaticOrder, true, true>(lds, g, S, E);
    }
    SEAM(ph); ++ph; PMARK(ph);
    if (IN(ph)) final_norm_phase(a, lane, wave);
    ++ph; PMARK(ph);
#ifdef PROBE_LO
    if (blockIdx.x == 0) { const unsigned long long te = __builtin_amdgcn_s_memrealtime(); const unsigned long long w = 4ull * (pt1 - pt0); while (__builtin_amdgcn_s_memrealtime() - te < w) __builtin_amdgcn_s_sleep(8); }
#endif
#undef IN
#undef SEAM
#undef GEMM_PHASE
}

extern "C" void kernel_launch(void* const* d_in, const int* in_sizes, int n_in, void* d_out, int out_size, void* d_ws, size_t ws_size, hipStream_t stream) {
    static int grid = 0;
    if (grid == 0) {
        if (n_in != 13 || out_size != M * D || ws_size < WS_END) { fprintf(stderr, "kernel_launch: unexpected problem (n_in %d out %d ws %zu)\n", n_in, out_size, ws_size); grid = -1; return; }
        int dev = 0, cus = 0, per_cu = 0;
        (void)hipGetDevice(&dev); (void)hipDeviceGetAttribute(&cus, hipDeviceAttributeMultiprocessorCount, dev);
        if (hipFuncSetAttribute((const void*)mk, hipFuncAttributeMaxDynamicSharedMemorySize, LDS_BYTES) != hipSuccess) { fprintf(stderr, "kernel_launch: hipFuncSetAttribute failed\n"); grid = -1; return; }
        if (hipOccupancyMaxActiveBlocksPerMultiprocessor(&per_cu, (const void*)mk, NWAVES * 64, LDS_BYTES) != hipSuccess || per_cu < 1) { fprintf(stderr, "kernel_launch: occupancy query says %d\n", per_cu); (void)hipGetLastError(); grid = -1; return; }
        grid = cus;
        if (grid != 256) fprintf(stderr, "kernel_launch: note: %d CUs\n", grid);
    }
    if (grid < 0) return;
    Args a{};
    a.x = (const float*)d_in[0]; a.norm_mix = (const float*)d_in[1]; a.norm_ffn = (const float*)d_in[2]; a.hgrn_w_in = (const float*)d_in[3]; a.lb_logits = (const float*)d_in[4];
    a.hgrn_out_norm = (const float*)d_in[5]; a.hgrn_w_out = (const float*)d_in[6]; a.moba_w_in = (const float*)d_in[7]; a.moba_w_out = (const float*)d_in[8]; a.rel_table = (const float*)d_in[9];
    a.ffn_w13 = (const float*)d_in[10]; a.ffn_w2 = (const float*)d_in[11]; a.final_norm = (const float*)d_in[12];
    a.out = (float*)d_out; a.ws = (unsigned char*)d_ws;
    a.ph_lo = 0; a.ph_hi = 15;
    void* args[] = {&a};
    hipError_t e = hipLaunchCooperativeKernel((const void*)mk, dim3(grid), dim3(NWAVES * 64), args, LDS_BYTES, stream);
    if (e != hipSuccess) fprintf(stderr, "kernel_launch: cooperative launch failed: %s (grid %d)\n", hipGetErrorString(e), grid);
}
```

```cpp
#include <hip/hip_runtime.h>
#include <hip/hip_cooperative_groups.h>
#include <cstdio>
#include <cstdint>
#include <cmath>
namespace pg8 {
#define PG8_LAS __attribute__((address_space(3)))
typedef unsigned short bf16_t;
typedef short bf16x8 __attribute__((ext_vector_type(8)));
typedef float f32x4 __attribute__((ext_vector_type(4)));
typedef unsigned u32x4 __attribute__((ext_vector_type(4)));
constexpr int BM = 256, BK = 64, HALF = 128, HTB = HALF * BK * 2  , STAGE_BYTES = 8 * HTB, NXCD = 8, WGM = 8;

__host__ __device__ __forceinline__ int lds_byte(int r, int c) { const int st = (r >> 4) * 2 + (c >> 5), rr = r & 15, cc = c & 31, ob = rr * 64 + cc * 2; return st * 1024 + (ob ^ (((ob >> 9) & 1) << 5)); }
__host__ __device__ __forceinline__ void stage_rc(int b, int& R, int& C) { const int st = b / 1024, sb = b % 1024, swz = sb ^ (((sb >> 9) & 1) << 5); R = (st >> 1) * 16 + swz / 64; C = (st & 1) * 32 + (swz % 64) / 2; }
__host__ __device__ __forceinline__ int perm32(int rho) { const int n = rho >> 4, i = rho & 15; return 8 * (i >> 2) + 4 * n + (i & 3); }

struct Unit { int pm, pn; };
struct Gemm { const bf16_t* A; const bf16_t* Bt; int M, N, K; };

struct StaticOrder {
    int nM, nN, nwg, G, c;
    __host__ __device__ void init(int M, int N, int G_, int c_) { nM = M / BM; nN = N / BM; nwg = nM * nN; G = G_; c = c_; }
    __host__ __device__ bool next(int i, Unit& u) const {
        const long L = (long)i * G + c; if (L >= nwg) return false;
        int wgid = (int)L; { const int q = nwg / NXCD, r = nwg % NXCD, xcd = wgid % NXCD, off = wgid / NXCD; wgid = (xcd < r ? xcd * (q + 1) : r * (q + 1) + (xcd - r) * q) + off; }
        const int nig = WGM * nN, gid = wgid / nig, fm = gid * WGM, gsz = (nM - fm) < WGM ? (nM - fm) : WGM;
        u.pm = fm + ((wgid % nig) % gsz); u.pn = (wgid % nig) / gsz; return true;
    }
    __device__ __forceinline__ void a_ready(const Unit&) const {}
    __device__ __forceinline__ void done(const Unit&) const {}
};
typedef float f32x2 __attribute__((ext_vector_type(2)));
typedef __bf16 bf16x2_cv __attribute__((ext_vector_type(2)));
__device__ __forceinline__ unsigned cvt_pk_bf16(float lo, float hi) { f32x2 v = {lo, hi}; bf16x2_cv b = __builtin_convertvector(v, bf16x2_cv); return __builtin_bit_cast(unsigned, b); }

typedef unsigned u32x2 __attribute__((ext_vector_type(2)));
__device__ __forceinline__ float sigm(float x) { return __builtin_amdgcn_rcpf(1.f + __expf(-x)); }
__device__ __forceinline__ float bf2f_lo(unsigned w) { return __uint_as_float(w << 16); }
__device__ __forceinline__ float bf2f_hi(unsigned w) { return __uint_as_float(w & 0xffff0000u); }
__device__ __forceinline__ float rstd_from16(const float* p) {
    const f32x4 a = *(const f32x4*)p, b = *(const f32x4*)(p + 4), c = *(const f32x4*)(p + 8), d = *(const f32x4*)(p + 12);
    const float s = ((a[0] + a[1]) + (a[2] + a[3])) + ((b[0] + b[1]) + (b[2] + b[3])) + ((c[0] + c[1]) + (c[2] + c[3])) + ((d[0] + d[1]) + (d[2] + d[3]));
    return rsqrtf(s * (1.f / 1024.f) + 1e-6f);
}
__device__ __forceinline__ float rstd_from8(const float* p) {
    const f32x4 a = *(const f32x4*)p, b = *(const f32x4*)(p + 4);
    const float s = ((a[0] + a[1]) + (a[2] + a[3])) + ((b[0] + b[1]) + (b[2] + b[3]));
    return rsqrtf(s * (1.f / 1024.f) + 1e-6f);
}

struct EpiHgrnIn {
    static constexpr bool PERM = true, AFTER_DRAIN = false;
    bf16_t* QS; float* LF; bf16_t* IN; bf16_t* OG; const float* lb;
    __device__ __forceinline__ void operator()(const f32x4 (&acc)[2][2][4][2], const Unit& u, int wr, int wc, int fr, int fq) const {
        const int type = u.pn >> 2;
        const int row0 = u.pm * BM + wr * 64 + fr;
        const int col0 = (u.pn & 3) * BM + wc * 32 + 8 * fq;
#pragma unroll
        for (int bj = 0; bj < 2; ++bj) {
            const int c = col0 + bj * HALF;
            f32x4 l0 = (f32x4){0.f, 0.f, 0.f, 0.f}, l1 = l0;
            if (type == 1) { l0 = *(const f32x4*)(lb + c); l1 = *(const f32x4*)(lb + c + 4); }
#pragma unroll
            for (int ai = 0; ai < 2; ++ai)
#pragma unroll
                for (int m = 0; m < 4; ++m) {
                    const size_t off = (size_t)(row0 + ai * HALF + m * 16) * 1024 + c;
                    f32x4 v0 = acc[ai][bj][m][0], v1 = acc[ai][bj][m][1];
                    if (type == 1) {
#pragma unroll
                        for (int i = 0; i < 4; ++i) { v0[i] = logf(l0[i] + (1.f - l0[i]) * sigm(v0[i])); v1[i] = logf(l1[i] + (1.f - l1[i]) * sigm(v1[i])); }
                        *(f32x4*)(LF + off) = v0; *(f32x4*)(LF + off + 4) = v1;
                    } else {
                        if (type == 0) {
#pragma unroll
                            for (int i = 0; i < 4; ++i) { v0[i] = v0[i] * sigm(v0[i]); v1[i] = v1[i] * sigm(v1[i]); }
                        } else if (type == 3) {
#pragma unroll
                            for (int i = 0; i < 4; ++i) { v0[i] = sigm(v0[i]); v1[i] = sigm(v1[i]); }
                        }
                        u32x4 w; w.x = cvt_pk_bf16(v0[0], v0[1]); w.y = cvt_pk_bf16(v0[2], v0[3]); w.z = cvt_pk_bf16(v1[0], v1[1]); w.w = cvt_pk_bf16(v1[2], v1[3]);
                        if (type == 0) *(u32x4*)(QS + off) = w;
                        else if (type == 2) *(u32x4*)(IN + off) = w;
                        else *(u32x4*)(OG + off) = w;
                    }
                }
        }
    }
};

template <int SCALE, bool RF32>
struct EpiResid {
    static constexpr bool PERM = true, AFTER_DRAIN = false;
    const void* R; bf16_t* HB; float* SSQ; const float* SSQIN;
    __device__ __forceinline__ void operator()(const f32x4 (&acc)[2][2][4][2], const Unit& u, int wr, int wc, int fr, int fq) const {
        const int col0 = u.pn * BM + wc * 32 + 8 * fq;
#pragma unroll
        for (int ai = 0; ai < 2; ++ai)
#pragma unroll
            for (int m = 0; m < 4; ++m) {
                const int row = u.pm * BM + ai * HALF + wr * 64 + m * 16 + fr;
                float sc = 1.f;
                if (SCALE == 1) sc = rstd_from8(SSQIN + (size_t)row * 8);
                const size_t off = (size_t)row * 1024 + col0;
                float ss = 0.f;
#pragma unroll
                for (int bj = 0; bj < 2; ++bj) {
                    const size_t o2 = off + bj * HALF;
                    f32x4 r0, r1;
                    if (RF32) { r0 = *(const f32x4*)((const float*)R + o2); r1 = *(const f32x4*)((const float*)R + o2 + 4); }
                    else { const u32x4 rw = *(const u32x4*)((const bf16_t*)R + o2);
                        r0 = (f32x4){bf2f_lo(rw.x), bf2f_hi(rw.x), bf2f_lo(rw.y), bf2f_hi(rw.y)}; r1 = (f32x4){bf2f_lo(rw.z), bf2f_hi(rw.z), bf2f_lo(rw.w), bf2f_hi(rw.w)}; }
                    const f32x4 v0 = r0 + acc[ai][bj][m][0] * sc, v1 = r1 + acc[ai][bj][m][1] * sc;
                    ss += ((v0[0] * v0[0] + v0[1] * v0[1]) + (v0[2] * v0[2] + v0[3] * v0[3])) + ((v1[0] * v1[0] + v1[1] * v1[1]) + (v1[2] * v1[2] + v1[3] * v1[3]));
                    u32x4 w; w.x = cvt_pk_bf16(v0[0], v0[1]); w.y = cvt_pk_bf16(v0[2], v0[3]); w.z = cvt_pk_bf16(v1[0], v1[1]); w.w = cvt_pk_bf16(v1[2], v1[3]);
                    *(u32x4*)(HB + o2) = w;
                }
                ss += __shfl_xor(ss, 16); ss += __shfl_xor(ss, 32);
                if (fq == 0) SSQ[(size_t)row * 16 + u.pn * 4 + wc] = ss;
                if (m & 1) asm volatile("" ::: "memory");
            }
    }
};

struct EpiSwiglu {
    static constexpr bool PERM = true, AFTER_DRAIN = false;
    bf16_t* HID; int ldh; const float* SSQIN;
    __device__ __forceinline__ void operator()(const f32x4 (&acc)[2][2][4][2], const Unit& u, int wr, int wc, int fr, int fq) const {
        const int col0 = u.pn * HALF + wc * 32 + 8 * fq;
#pragma unroll
        for (int ai = 0; ai < 2; ++ai)
#pragma unroll
            for (int m = 0; m < 4; ++m) {
                const int row = u.pm * BM + ai * HALF + wr * 64 + m * 16 + fr;
                const float sc = rstd_from16(SSQIN + (size_t)row * 16);
                f32x4 g0 = acc[ai][0][m][0] * sc, g1 = acc[ai][0][m][1] * sc, u0 = acc[ai][1][m][0] * sc, u1 = acc[ai][1][m][1] * sc;
#pragma unroll
                for (int i = 0; i < 4; ++i) { g0[i] = g0[i] * sigm(g0[i]) * u0[i]; g1[i] = g1[i] * sigm(g1[i]) * u1[i]; }
                u32x4 w; w.x = cvt_pk_bf16(g0[0], g0[1]); w.y = cvt_pk_bf16(g0[2], g0[3]); w.z = cvt_pk_bf16(g1[0], g1[1]); w.w = cvt_pk_bf16(g1[2], g1[3]);
                *(u32x4*)(HID + (size_t)row * ldh + col0) = w;
            }
    }
};

struct EpiQKV {
    static constexpr bool PERM = true, AFTER_DRAIN = false;
    bf16_t* O; size_t split_stride; const float* SSQIN; float* KMEAN;
    __device__ __forceinline__ void operator()(const f32x4 (&acc)[2][2][4][2], const Unit& u, int wr, int wc, int fr, int fq) const {
        const int t = u.pn >> 2;
        bf16_t* base = O + (size_t)t * split_stride;
        const int col0 = (u.pn & 3) * BM + wc * 32 + 8 * fq;
        f32x4 cs[2][2];
#pragma unroll
        for (int bj = 0; bj < 2; ++bj) { cs[bj][0] = (f32x4){0.f, 0.f, 0.f, 0.f}; cs[bj][1] = cs[bj][0]; }
#pragma unroll
        for (int ai = 0; ai < 2; ++ai)
#pragma unroll
            for (int m = 0; m < 4; ++m) {
                const int row = u.pm * BM + ai * HALF + wr * 64 + m * 16 + fr;
                const float sc = rstd_from16(SSQIN + (size_t)row * 16);
#pragma unroll
                for (int bj = 0; bj < 2; ++bj) {
                    const f32x4 v0 = acc[ai][bj][m][0] * sc, v1 = acc[ai][bj][m][1] * sc;
                    cs[bj][0] += v0; cs[bj][1] += v1;
                    u32x4 w; w.x = cvt_pk_bf16(v0[0], v0[1]); w.y = cvt_pk_bf16(v0[2], v0[3]); w.z = cvt_pk_bf16(v1[0], v1[1]); w.w = cvt_pk_bf16(v1[2], v1[3]);
                    *(u32x4*)(base + (size_t)row * 1024 + col0 + bj * HALF) = w;
                }
            }
        if (t == 1) {
#pragma unroll
            for (int bj = 0; bj < 2; ++bj)
#pragma unroll
                for (int n = 0; n < 2; ++n)
#pragma unroll
                    for (int i = 0; i < 4; ++i) {
                        float s = cs[bj][n][i];
                        s += __shfl_xor(s, 1); s += __shfl_xor(s, 2); s += __shfl_xor(s, 4); s += __shfl_xor(s, 8);
                        if (fr == 0) atomicAdd(KMEAN + (size_t)u.pm * 1024 + col0 + bj * HALF + 4 * n + i, s * (1.f / 256.f));
                    }
        }
    }
};

#ifdef PROBE_GEMM_EPI
#define PG8_PS_B() do { __builtin_amdgcn_sched_barrier(0); psec -= __builtin_amdgcn_s_memrealtime(); __builtin_amdgcn_sched_barrier(0); } while (0)
#define PG8_PS_E() do { __builtin_amdgcn_sched_barrier(0); psec += __builtin_amdgcn_s_memrealtime(); __builtin_amdgcn_sched_barrier(0); } while (0)
#else
#define PG8_PS_B() do { } while (0)
#define PG8_PS_E() do { } while (0)
#endif
template <class Epi, class Sched, bool ALIGN_EPI = false, bool SP2 = false>
__device__ __forceinline__ void gemm_phase(PG8_LAS unsigned char* lds, const Gemm g, const Sched& S, const Epi& E, unsigned long long& psec) {
    const int tid = threadIdx.x, wid = __builtin_amdgcn_readfirstlane(tid >> 6), lane = tid & 63, wr = wid >> 2, wc = wid & 3, fr = lane & 15, fq = lane >> 4;
    const int K = g.K, nt = K / BK;
    unsigned voffA[2], voffB[2];
#pragma unroll
    for (int i = 0; i < 2; ++i) { int R, C; stage_rc(tid * 16 + i * 8192, R, C); const int Rb = Epi::PERM ? ((R & ~31) + perm32(R & 31)) : R;
        voffA[i] = (unsigned)(R * K + C) * 2u; voffB[i] = (unsigned)(Rb * K + C) * 2u; }
    const size_t kstep = (size_t)(BK * 2);
    const size_t hstep = (size_t)HALF * K * 2;
    const size_t tstep = 2 * hstep;
    const unsigned ldsw = (unsigned)wid * 1024u;
    const int aoff = lds_byte(wr * 64 + fr, fq * 8), boff = lds_byte(wc * 32 + fr, fq * 8);
#define PG8_SA(b, h) (((b) * 2 + (h)) * HTB)
#define PG8_SB(b, h) ((4 + (b) * 2 + (h)) * HTB)
#define PG8_STAGE(bufoff, gbase, voff) do { _Pragma("unroll") for (int _i = 0; _i < 2; ++_i) \
        __builtin_amdgcn_global_load_lds((const unsigned*)((const char*)(gbase) + (voff)[_i]), (PG8_LAS unsigned*)(lds + (bufoff) + ldsw + _i * 8192), 16, 0, 0); } while (0)
#define PG8_LDA(dst, b, h) do { _Pragma("unroll") for (int m = 0; m < 4; ++m) _Pragma("unroll") for (int k = 0; k < 2; ++k) dst[m][k] = *(const PG8_LAS bf16x8*)(lds + PG8_SA(b, h) + aoff + m * 2048 + k * 1024); } while (0)
#define PG8_LDB(dst, b, h) do { _Pragma("unroll") for (int n = 0; n < 2; ++n) _Pragma("unroll") for (int k = 0; k < 2; ++k) dst[n][k] = *(const PG8_LAS bf16x8*)(lds + PG8_SB(b, h) + boff + n * 2048 + k * 1024); } while (0)
#define PG8_MMA(ai, bj, At, Bt) do { __builtin_amdgcn_s_setprio(1); _Pragma("unroll") for (int m = 0; m < 4; ++m) _Pragma("unroll") for (int n = 0; n < 2; ++n) _Pragma("unroll") for (int k = 0; k < 2; ++k) \
        acc[ai][bj][m][n] = __builtin_amdgcn_mfma_f32_16x16x32_bf16(Bt[n][k], At[m][k], acc[ai][bj][m][n], 0, 0, 0); __builtin_amdgcn_s_setprio(0); } while (0)
#define PG8_WAIT_V(n) asm volatile("s_waitcnt vmcnt(" #n ")" ::: "memory")
#define PG8_WAIT_L(n) asm volatile("s_waitcnt lgkmcnt(" #n ")" ::: "memory")
#define PG8_BAR __builtin_amdgcn_s_barrier()
#define PG8_SCHED __builtin_amdgcn_sched_barrier(0)
    Unit cur, nxt; int ui = 0;
    if (!S.next(0, cur)) return;
    f32x4 acc[2][2][4][2];
#pragma unroll
    for (int a = 0; a < 2; ++a)
#pragma unroll
        for (int b = 0; b < 2; ++b)
#pragma unroll
            for (int m = 0; m < 4; ++m)
#pragma unroll
                for (int n = 0; n < 2; ++n) acc[a][b][m][n] = (f32x4){0.f, 0.f, 0.f, 0.f};
    bf16x8 At[4][2], B0[2][2], B1[2][2];
    const char* cA = (const char*)g.A + (size_t)cur.pm * tstep; const char* cB = (const char*)g.Bt + (size_t)cur.pn * tstep;
    S.a_ready(cur);
    if constexpr (SP2) {
        PG8_STAGE(PG8_SB(0, 0), cB, voffB); PG8_STAGE(PG8_SB(0, 1), cB + hstep, voffB); PG8_STAGE(PG8_SA(0, 0), cA, voffA); PG8_STAGE(PG8_SA(0, 1), cA + hstep, voffA);
        if (wr == 1) PG8_BAR;
        PG8_WAIT_V(2); PG8_BAR;
        PG8_STAGE(PG8_SB(1, 0), cB + kstep, voffB); PG8_STAGE(PG8_SA(1, 0), cA + kstep, voffA); PG8_STAGE(PG8_SB(1, 1), cB + hstep + kstep, voffB);
        PG8_WAIT_V(6); PG8_BAR;
    } else {
        PG8_STAGE(PG8_SB(0, 0), cB, voffB); PG8_STAGE(PG8_SA(0, 0), cA, voffA); PG8_STAGE(PG8_SB(0, 1), cB + hstep, voffB); PG8_STAGE(PG8_SA(0, 1), cA + hstep, voffA);
        if (wr == 1) PG8_BAR;
        PG8_WAIT_V(4); PG8_BAR;
        PG8_STAGE(PG8_SB(1, 0), cB + kstep, voffB); PG8_STAGE(PG8_SA(1, 0), cA + kstep, voffA); PG8_STAGE(PG8_SB(1, 1), cB + hstep + kstep, voffB);
        PG8_WAIT_V(6); PG8_BAR;
    }
    for (;;) {
        const bool has_next = S.next(ui + 1, nxt);
        const char* nA = has_next ? (const char*)g.A + (size_t)nxt.pm * tstep : cA; const char* nB = has_next ? (const char*)g.Bt + (size_t)nxt.pn * tstep : cB;
        for (int t = 0; t < nt; t += 2) {
            const bool last = (t == nt - 2);
            const char* a1 = cA + (size_t)(t + 1) * kstep;
            const char* a2 = last ? nA : cA + (size_t)(t + 2) * kstep; const char* b2 = last ? nB : cB + (size_t)(t + 2) * kstep;
            const char* a3 = a2 + kstep; const char* b3 = b2 + kstep;
            if (last && has_next) S.a_ready(nxt);
            if constexpr (SP2) {
            PG8_LDB(B0, 0, 0); PG8_LDB(B1, 0, 1); PG8_SCHED; PG8_LDA(At, 0, 0); PG8_STAGE(PG8_SA(1, 1), a1 + hstep, voffA);
            PG8_WAIT_V(8); PG8_WAIT_L(0); PG8_BAR; PG8_MMA(0, 0, At, B0); PG8_MMA(0, 1, At, B1); PG8_BAR; PG8_SCHED;
            PG8_LDA(At, 0, 1); PG8_STAGE(PG8_SB(0, 0), b2, voffB); PG8_STAGE(PG8_SB(0, 1), b2 + hstep, voffB); PG8_STAGE(PG8_SA(0, 0), a2, voffA);
            PG8_WAIT_V(8); PG8_WAIT_L(0); PG8_BAR; PG8_MMA(1, 0, At, B0); PG8_MMA(1, 1, At, B1); PG8_BAR; PG8_SCHED;
            PG8_LDB(B0, 1, 0); PG8_LDB(B1, 1, 1); PG8_SCHED; PG8_LDA(At, 1, 0); PG8_STAGE(PG8_SA(0, 1), a2 + hstep, voffA);
            PG8_WAIT_V(8); PG8_WAIT_L(0); PG8_BAR; PG8_MMA(0, 0, At, B0); PG8_MMA(0, 1, At, B1); PG8_BAR; PG8_SCHED;
            PG8_LDA(At, 1, 1); PG8_STAGE(PG8_SB(1, 0), b3, voffB); PG8_STAGE(PG8_SB(1, 1), b3 + hstep, voffB); PG8_STAGE(PG8_SA(1, 0), a3, voffA);
            PG8_WAIT_V(8); PG8_WAIT_L(0); PG8_BAR; PG8_MMA(1, 0, At, B0); PG8_MMA(1, 1, At, B1); PG8_BAR; PG8_SCHED;
            } else {
            PG8_LDB(B0, 0, 0); PG8_SCHED; PG8_LDA(At, 0, 0); PG8_STAGE(PG8_SA(1, 1), a1 + hstep, voffA);
            PG8_WAIT_L(8); PG8_BAR; PG8_WAIT_L(0); PG8_MMA(0, 0, At, B0); PG8_BAR; PG8_SCHED;
            PG8_LDB(B1, 0, 1); PG8_STAGE(PG8_SB(0, 0), b2, voffB);
            PG8_BAR; PG8_WAIT_L(0); PG8_MMA(0, 1, At, B1); PG8_BAR;
            PG8_LDA(At, 0, 1); PG8_STAGE(PG8_SA(0, 0), a2, voffA);
            PG8_BAR; PG8_WAIT_L(0); PG8_MMA(1, 0, At, B0); PG8_BAR; PG8_SCHED;
            PG8_STAGE(PG8_SB(0, 1), b2 + hstep, voffB);
            PG8_WAIT_V(6); PG8_BAR; PG8_MMA(1, 1, At, B1); PG8_BAR;
            PG8_LDB(B0, 1, 0); PG8_SCHED; PG8_LDA(At, 1, 0); PG8_STAGE(PG8_SA(0, 1), a2 + hstep, voffA);
            PG8_WAIT_L(8); PG8_BAR; PG8_WAIT_L(0); PG8_MMA(0, 0, At, B0); PG8_BAR; PG8_SCHED;
            PG8_LDB(B1, 1, 1); PG8_STAGE(PG8_SB(1, 0), b3, voffB);
            PG8_BAR; PG8_WAIT_L(0); PG8_MMA(0, 1, At, B1); PG8_BAR;
            PG8_LDA(At, 1, 1); PG8_STAGE(PG8_SA(1, 0), a3, voffA);
            PG8_BAR; PG8_WAIT_L(0); PG8_MMA(1, 0, At, B0); PG8_BAR; PG8_SCHED;
            PG8_STAGE(PG8_SB(1, 1), b3 + hstep, voffB);
            PG8_WAIT_V(6); PG8_BAR; PG8_MMA(1, 1, At, B1); PG8_BAR;
            }
        }
        if constexpr (ALIGN_EPI) { if (wr == 0) PG8_BAR; }
        if constexpr (!Epi::AFTER_DRAIN) { PG8_PS_B(); E(acc, cur, wr, wc, fr, fq); S.done(cur); PG8_PS_E(); }
        if (!has_next) break;
#pragma unroll
        for (int a = 0; a < 2; ++a)
#pragma unroll
            for (int b = 0; b < 2; ++b)
#pragma unroll
                for (int m = 0; m < 4; ++m)
#pragma unroll
                    for (int n = 0; n < 2; ++n) acc[a][b][m][n] = (f32x4){0.f, 0.f, 0.f, 0.f};
        cur = nxt; cA = nA; cB = nB; ++ui;
        if constexpr (ALIGN_EPI) { if (wr == 1) PG8_BAR; }
    }
    PG8_WAIT_V(0);
    if constexpr (!ALIGN_EPI) { if (wr == 0) PG8_BAR; }
    PG8_BAR;
    if constexpr (Epi::AFTER_DRAIN) { E.fused(acc, cur, wr, wc, fr, fq, lds, wid, lane); S.done(cur); }
#undef PG8_SA
#undef PG8_SB
#undef PG8_STAGE
#undef PG8_LDA
#undef PG8_LDB
#undef PG8_MMA
#undef PG8_WAIT_V
#undef PG8_WAIT_L
#undef PG8_BAR
#undef PG8_SCHED
}
}

namespace cg = cooperative_groups;
constexpr int NWAVES = 8;
constexpr int BATCH = 2, T = 8192, D = 1024, H = 8, DH = 128, DFF = 2816, NB = 32, BLK = 256;
constexpr int M = BATCH * T;
constexpr float EPS = 1e-6f;
constexpr size_t MiB = 1u << 20;
constexpr size_t WS_CTL = 0;
constexpr size_t WS_WQKV = 1 * MiB, WS_WOUT1 = 7 * MiB, WS_W13_1 = 9 * MiB, WS_W2_1 = 20 * MiB;
constexpr size_t WS_WIN0 = 26 * MiB, WS_WOUT0 = 34 * MiB, WS_W13_0 = 36 * MiB, WS_W2_0 = 47 * MiB;
constexpr size_t WS_SSQ = 53 * MiB;
constexpr size_t WS_SSQH = 54 * MiB;
constexpr size_t WS_LB = 54 * MiB + 512 * 1024;
constexpr size_t WS_BKT = WS_LB + 4096;
constexpr size_t WS_YMEAN = WS_BKT + 32768;
constexpr size_t WS_KMEAN = WS_YMEAN + 262144;
constexpr size_t WS_SEL = 55 * MiB + 512 * 1024;
constexpr size_t WS_G = 56 * MiB;
constexpr size_t WS_A0 = 60 * MiB;
constexpr size_t WS_A1 = 92 * MiB;
constexpr size_t WS_A2 = 124 * MiB;
constexpr size_t WS_A3 = 188 * MiB;
constexpr size_t WS_A4 = 220 * MiB;
constexpr size_t WS_END = 256 * MiB;
static_assert(WS_W2_0 + (size_t)D * DFF * 2 <= WS_SSQ && WS_G + 2 * MiB <= WS_A0 && WS_A4 + 32 * MiB <= WS_END, "ws map");

constexpr int LDS_BYTES = 163840;
constexpr int LDS_MISC = 163584;
constexpr size_t WS_BAR = 65536;

#define GAS __attribute__((address_space(1)))
#define LAS __attribute__((address_space(3)))
typedef unsigned short bf16;
typedef unsigned v4u __attribute__((ext_vector_type(4)));
typedef float f32x4 __attribute__((ext_vector_type(4)));
#define LDS_WAIT() asm volatile("s_waitcnt lgkmcnt(0)" ::: "memory")
__device__ __forceinline__ unsigned f2bf(float f) { unsigned u = __builtin_bit_cast(unsigned, f); return (u + 0x7fffu + ((u >> 16) & 1u)) >> 16; }
__device__ __forceinline__ unsigned pk2(float lo, float hi) { return f2bf(lo) | (f2bf(hi) << 16); }
__device__ __forceinline__ float bf2f(unsigned short b) { return __uint_as_float((unsigned)b << 16); }
__device__ __forceinline__ float wave_sum(float v) {
#pragma unroll
    for (int o = 1; o < 64; o <<= 1) v += __shfl_xor(v, o);
    return v;
}

struct Args {
    const float* x; const float* norm_mix; const float* norm_ffn; const float* hgrn_w_in; const float* lb_logits; const float* hgrn_out_norm; const float* hgrn_w_out;
    const float* moba_w_in; const float* moba_w_out; const float* rel_table; const float* ffn_w13; const float* ffn_w2; const float* final_norm;
    float* out; unsigned char* ws; int ph_lo, ph_hi;
};

__device__ __forceinline__ void tr_item(const float* W, int ldw, int K, bf16* WT, int Ndst, const float* gain, int mode, LAS float* scr, int item, int lane) {
    const int nblk = Ndst / 64, kb = item / nblk, nb = item % nblk, k0 = 64 * kb, n0 = 64 * nb;
    int s0 = n0;
    if (mode == 1) { const int t = n0 >> 8, c = n0 & 255; s0 = (c < 128) ? (128 * t + c) : (DFF + 128 * t + (c - 128)); }
    f32x4 wv[16];
#pragma unroll
    for (int i = 0; i < 16; ++i) wv[i] = *(const GAS f32x4*)(W + (size_t)(k0 + 4 * i + (lane >> 4)) * ldw + s0 + (lane & 15) * 4);
#pragma unroll
    for (int i = 0; i < 16; ++i) { const int kk = 4 * i + (lane >> 4);
        f32x4 w = wv[i];
        if (gain) w = w * gain[k0 + kk];
        LAS float* d = scr + kk * 65 + (lane & 15) * 4; d[0] = w.x; d[1] = w.y; d[2] = w.z; d[3] = w.w; }
    LDS_WAIT(); asm volatile("" ::: "memory");
    const int c = lane & 7;
#pragma unroll
    for (int j = 0; j < 8; ++j) { const int n = (lane >> 3) + 8 * j; const LAS float* s = scr + (8 * c) * 65 + n;
        v4u o; o.x = pk2(s[0 * 65], s[1 * 65]); o.y = pk2(s[2 * 65], s[3 * 65]); o.z = pk2(s[4 * 65], s[5 * 65]); o.w = pk2(s[6 * 65], s[7 * 65]);
        *(GAS v4u*)(WT + (size_t)(n0 + n) * K + k0 + 8 * c) = o; }
    LDS_WAIT(); asm volatile("" ::: "memory");
}

__device__ __forceinline__ void prologue(const Args& a, LAS unsigned char* lds, int tid, int lane, int wave) {
    unsigned char* ws = a.ws;
    LAS float* scr = (LAS float*)(lds + wave * 16640);
    const int gw = blockIdx.x * NWAVES + wave, NGW = gridDim.x * NWAVES;
    constexpr int I_IN0 = (D / 64) * (4096 / 64), I_O = (D / 64) * (D / 64), I_13 = (D / 64) * (2 * DFF / 64), I_2 = (DFF / 64) * (D / 64);
    constexpr int NITEMS = I_IN0 + I_O + I_13 + I_2;
    for (int it = gw; it < NITEMS; it += NGW) {
        int r = it;
        if (r < I_IN0) { tr_item(a.hgrn_w_in, 4096, D, (bf16*)(ws + WS_WIN0), 4096, nullptr, 0, scr, r, lane); continue; } r -= I_IN0;
        if (r < I_O) { tr_item(a.hgrn_w_out, D, D, (bf16*)(ws + WS_WOUT0), D, a.hgrn_out_norm, 0, scr, r, lane); continue; } r -= I_O;
        if (r < I_13) { tr_item(a.ffn_w13, 2 * DFF, D, (bf16*)(ws + WS_W13_0), 2 * DFF, a.norm_ffn, 1, scr, r, lane); continue; } r -= I_13;
        tr_item(a.ffn_w2, D, DFF, (bf16*)(ws + WS_W2_0), D, nullptr, 0, scr, r, lane);
    }
    bf16* XN0 = (bf16*)(ws + WS_A0);
    for (int m = 2 * gw; m < M; m += 2 * NGW) {
        const GAS f32x4* xr = (const GAS f32x4*)(a.x + (size_t)m * D) + lane;
        f32x4 v[8]; float s0 = 0.f, s1 = 0.f;
#pragma unroll
        for (int j = 0; j < 8; ++j) v[j] = xr[64 * j];
#pragma unroll
        for (int j = 0; j < 4; ++j) { s0 += (v[j].x * v[j].x + v[j].y * v[j].y) + (v[j].z * v[j].z + v[j].w * v[j].w); s1 += (v[4 + j].x * v[4 + j].x + v[4 + j].y * v[4 + j].y) + (v[4 + j].z * v[4 + j].z + v[4 + j].w * v[4 + j].w); }
        const float r0 = rsqrtf(wave_sum(s0) * (1.f / D) + EPS), r1 = rsqrtf(wave_sum(s1) * (1.f / D) + EPS);
        GAS unsigned long long* o8 = (GAS unsigned long long*)(XN0 + (size_t)m * D) + lane;
#pragma unroll
        for (int j = 0; j < 8; ++j) { const f32x4 g = *((const GAS f32x4*)a.norm_mix + lane + 64 * (j & 3)); const float rs = j < 4 ? r0 : r1;
            o8[64 * j] = (unsigned long long)pk2(v[j].x * rs * g.x, v[j].y * rs * g.y) | ((unsigned long long)pk2(v[j].z * rs * g.z, v[j].w * rs * g.w) << 32); }
    }
    for (int i = blockIdx.x * (NWAVES * 64) + tid; i < 64 * D; i += gridDim.x * NWAVES * 64) ((float*)(ws + WS_KMEAN))[i] = 0.f;
    if (blockIdx.x == 0) {
        float* lb = (float*)(ws + WS_LB); int* bkt = (int*)(ws + WS_BKT);
        for (int i = tid; i < 1024; i += NWAVES * 64) { const float l0 = a.lb_logits[i], l1 = a.lb_logits[1024 + i]; const float mx = fmaxf(l0, l1); const float e0 = expf(l0 - mx), e1 = expf(l1 - mx); lb[i] = e0 / (e0 + e1); }
        for (int i = tid; i < T; i += NWAVES * 64) {
            int bk;
            if (i < 16) bk = i;
            else { const float nf = (float)i; const float v = logf(nf / 16.f) / 4.1588830833596715f * 16.f; bk = 16 + (int)v; if (bk > 31) bk = 31; }
            bkt[i] = bk;
            if (i < 1024) { float* tab2 = (float*)(ws + WS_YMEAN);
#pragma unroll
                for (int hh = 0; hh < 8; ++hh) tab2[hh * 1024 + i] = a.rel_table[bk * 8 + hh] * 1.4426950408889634f; }
        }
        for (int i = tid; i < 1024; i += NWAVES * 64) ((unsigned*)(ws + 4096))[i] = 0u;
        for (int i = tid; i < 3456; i += NWAVES * 64) ((unsigned*)(ws + WS_BAR))[i] = 0u;
    }
}

__device__ __forceinline__ void convert_l1_weights(const Args& a, LAS unsigned char* lds, int lane, int wave, int rank, int nrank) {
    unsigned char* ws = a.ws;
    LAS float* scr = (LAS float*)(lds + wave * 16640);
    const int gw = rank * NWAVES + wave, NGW = nrank * NWAVES;
    constexpr int I_O = (D / 64) * (D / 64), I_13 = (D / 64) * (2 * DFF / 64), I_2 = (DFF / 64) * (D / 64), I_QKV = (D / 64) * (3072 / 64);
    constexpr int NITEMS = I_QKV + I_O + I_13 + I_2;
    for (int it = gw; it < NITEMS; it += NGW) {
        int r = it;
        if (r < I_QKV) { tr_item(a.moba_w_in, 3072, D, (bf16*)(ws + WS_WQKV), 3072, a.norm_mix + D, 0, scr, r, lane); continue; } r -= I_QKV;
        if (r < I_O) { tr_item(a.moba_w_out, D, D, (bf16*)(ws + WS_WOUT1), D, nullptr, 0, scr, r, lane); continue; } r -= I_O;
        if (r < I_13) { tr_item(a.ffn_w13 + (size_t)D * 2 * DFF, 2 * DFF, D, (bf16*)(ws + WS_W13_1), 2 * DFF, a.norm_ffn + D, 1, scr, r, lane); continue; } r -= I_13;
        tr_item(a.ffn_w2 + (size_t)DFF * D, D, DFF, (bf16*)(ws + WS_W2_1), D, nullptr, 0, scr, r, lane);
    }
}

__device__ __forceinline__ void final_norm_phase(const Args& a, int lane, int wave) {
    const int gw = blockIdx.x * NWAVES + wave, NGW = gridDim.x * NWAVES;
    const float* SSQ = (const float*)(a.ws + WS_SSQ); const bf16* HB = (const bf16*)(a.ws + WS_A1);
    for (int m = gw; m < M; m += NGW) {
        const float rstd = pg8::rstd_from16(SSQ + (size_t)m * 16);
        const GAS v4u* hr = (const GAS v4u*)(HB + (size_t)m * D) + lane;
        GAS f32x4* orow = (GAS f32x4*)(a.out + (size_t)m * D);
#pragma unroll
        for (int j = 0; j < 2; ++j) {
            const v4u w = hr[64 * j]; const int c = (64 * j + lane) * 8;
            const f32x4 g0 = *(const GAS f32x4*)(a.final_norm + c), g1 = *(const GAS f32x4*)(a.final_norm + c + 4);
            f32x4 o0, o1;
            o0.x = __uint_as_float(w.x << 16) * rstd * g0.x; o0.y = __uint_as_float(w.x & 0xffff0000u) * rstd * g0.y; o0.z = __uint_as_float(w.y << 16) * rstd * g0.z; o0.w = __uint_as_float(w.y & 0xffff0000u) * rstd * g0.w;
            o1.x = __uint_as_float(w.z << 16) * rstd * g1.x; o1.y = __uint_as_float(w.z & 0xffff0000u) * rstd * g1.y; o1.z = __uint_as_float(w.w << 16) * rstd * g1.z; o1.w = __uint_as_float(w.w & 0xffff0000u) * rstd * g1.w;
            orow[c / 4] = o0; orow[c / 4 + 1] = o1;
        }
    }
}

__device__ __forceinline__ float sigmoidf_(float x) { return 1.f / (1.f + __expf(-x)); }

namespace moba {
using bf16x8 = __attribute__((ext_vector_type(8))) short;
using s16x4 = __attribute__((ext_vector_type(4))) short;
using f32x16 = __attribute__((ext_vector_type(16))) float;
using u32x4 = __attribute__((ext_vector_type(4))) unsigned;
#define KSWZ(row, colB) ((row) * 256 + ((colB) ^ (((row) & 7) << 4)))
#define SBAR() __builtin_amdgcn_sched_barrier(0)
constexpr float C2 = 0.08838834764831845f * 1.4426950408889634f;
constexpr float LOG2E = 1.4426950408889634f;
__device__ __forceinline__ int crow(int r, int hi) { return (r & 3) + 8 * (r >> 2) + 4 * hi; }
__device__ __forceinline__ unsigned cvtpk(float lo, float hi) { return pg8::cvt_pk_bf16(lo, hi); }
__device__ __forceinline__ int v_st(int k, int c) { const int kk = (k & ~0xC) | ((k & 4) << 1) | ((k & 8) >> 1); return ((kk >> 3) * 4 + (c >> 5)) * 512 + ((kk & 7) * 32 + (c & 31)) * 2; }
__device__ __forceinline__ int v_rd_base(int lane) { return ((lane & 3) << 3) | (((lane >> 2) & 3) << 6) | (((lane >> 4) & 1) << 5) | (((lane >> 5) & 1) << 8); }
constexpr int v_rd_off(int d0, int ks, int half) { return d0 * 512 + ks * 4096 + half * 2048; }
template <int OFF> __device__ __forceinline__ s16x4 tr_read(int vb) {
    s16x4 r; asm volatile("ds_read_b64_tr_b16 %0, %1 offset:%2" : "=&v"(r) : "v"(vb), "i"(OFF) : "memory"); return r;
}
template <int D0> __device__ __forceinline__ void pv_one(f32x16& od, int vb, bf16x8 pa0, bf16x8 pa1, bf16x8 pa2, bf16x8 pa3) {
    const s16x4 l0 = tr_read<v_rd_off(D0, 0, 0)>(vb), h0 = tr_read<v_rd_off(D0, 0, 1)>(vb), l1 = tr_read<v_rd_off(D0, 1, 0)>(vb), h1 = tr_read<v_rd_off(D0, 1, 1)>(vb);
    const s16x4 l2 = tr_read<v_rd_off(D0, 2, 0)>(vb), h2 = tr_read<v_rd_off(D0, 2, 1)>(vb), l3 = tr_read<v_rd_off(D0, 3, 0)>(vb), h3 = tr_read<v_rd_off(D0, 3, 1)>(vb);
    asm volatile("s_waitcnt lgkmcnt(0)" ::: "memory"); SBAR();
#define PK(L, Hh) (bf16x8){L[0], L[1], L[2], L[3], Hh[0], Hh[1], Hh[2], Hh[3]}
    od = __builtin_amdgcn_mfma_f32_32x32x16_bf16(pa0, PK(l0, h0), od, 0, 0, 0);
    od = __builtin_amdgcn_mfma_f32_32x32x16_bf16(pa1, PK(l1, h1), od, 0, 0, 0);
    od = __builtin_amdgcn_mfma_f32_32x32x16_bf16(pa2, PK(l2, h2), od, 0, 0, 0);
    od = __builtin_amdgcn_mfma_f32_32x32x16_bf16(pa3, PK(l3, h3), od, 0, 0, 0);
#undef PK
}
__device__ __forceinline__ void qkt(f32x16& p0, f32x16& p1, const LAS unsigned char* Ks, const bf16x8 (&qr)[8], int r32, int hi) {
    p0 = f32x16{}; p1 = f32x16{};
#pragma unroll
    for (int d0 = 0; d0 < 8; ++d0) { const int cb = (d0 * 16 + hi * 8) * 2;
        const bf16x8 b0 = *(const LAS bf16x8*)(Ks + KSWZ(r32, cb));
        const bf16x8 b1 = *(const LAS bf16x8*)(Ks + KSWZ(32 + r32, cb));
        p0 = __builtin_amdgcn_mfma_f32_32x32x16_bf16(b0, qr[d0], p0, 0, 0, 0);
        p1 = __builtin_amdgcn_mfma_f32_32x32x16_bf16(b1, qr[d0], p1, 0, 0, 0); }
}
}

constexpr size_t WS_CNT = 4096;
constexpr size_t WS_TAB2 = WS_YMEAN;
constexpr size_t WS_LIST = WS_WIN0;
constexpr size_t WS_LSE = WS_G;
constexpr size_t WS_PO0 = WS_A0, WS_PO2 = WS_A4;

__device__ __forceinline__ void topk_phase(const Args& a, LAS unsigned char* lds, int tid, int lane, int wid) {
    using namespace moba;
    const bf16* Q = (const bf16*)(a.ws + WS_A2); const float* kmean = (const float*)(a.ws + WS_KMEAN);
    unsigned* cnt = (unsigned*)(a.ws + WS_CNT); unsigned short* lists = (unsigned short*)(a.ws + WS_LIST);
    LAS unsigned* lcnt = (LAS unsigned*)lds;
    const int r32 = lane & 31, hi = lane >> 5;
    for (int it = blockIdx.x; it < 512; it += gridDim.x) {
        const int bh = it >> 5, j = it & 31, b = bh >> 3, h = bh & 7;
        if (j == 0) continue;
        __syncthreads();
        if (tid < 64) lcnt[tid] = 0u;
        __syncthreads();
        bf16x8 ahi[8], alo[8];
        const float* kp = kmean + (size_t)(b * 32 + r32) * D + h * 128 + hi * 8;
#pragma unroll
        for (int ks = 0; ks < 8; ++ks) {
            const f32x4 v0 = *(const f32x4*)(kp + 16 * ks), v1 = *(const f32x4*)(kp + 16 * ks + 4);
            const unsigned h0 = pk2(v0[0], v0[1]), h1 = pk2(v0[2], v0[3]), h2 = pk2(v1[0], v1[1]), h3 = pk2(v1[2], v1[3]);
            const unsigned l0 = pk2(v0[0] - __uint_as_float(h0 << 16), v0[1] - __uint_as_float(h0 & 0xffff0000u)), l1 = pk2(v0[2] - __uint_as_float(h1 << 16), v0[3] - __uint_as_float(h1 & 0xffff0000u));
            const unsigned l2 = pk2(v1[0] - __uint_as_float(h2 << 16), v1[1] - __uint_as_float(h2 & 0xffff0000u)), l3 = pk2(v1[2] - __uint_as_float(h3 << 16), v1[3] - __uint_as_float(h3 & 0xffff0000u));
            u32x4 wh = {h0, h1, h2, h3}, wl = {l0, l1, l2, l3};
            ahi[ks] = *reinterpret_cast<bf16x8*>(&wh); alo[ks] = *reinterpret_cast<bf16x8*>(&wl);
        }
        const int qpos = j * 256 + wid * 32 + r32, m = b * T + qpos;
        const bf16* Qw = Q + (size_t)m * D + h * 128 + hi * 8;
        f32x16 gacc = {};
#pragma unroll
        for (int ks = 0; ks < 8; ++ks) { const bf16x8 qv = *(const bf16x8*)(Qw + 16 * ks);
            gacc = __builtin_amdgcn_mfma_f32_32x32x16_bf16(ahi[ks], qv, gacc, 0, 0, 0);
            gacc = __builtin_amdgcn_mfma_f32_32x32x16_bf16(alo[ks], qv, gacc, 0, 0, 0); }
        float cv[6]; int ci[6];
        unsigned usedm = 0u;
#pragma unroll
        for (int s = 0; s < 3; ++s) { int best = 0; float val = -INFINITY; bool have = false;
#pragma unroll
            for (int r = 0; r < 16; ++r) { const float gv = (crow(r, hi) < j) ? gacc[r] : -INFINITY; const bool free_ = !((usedm >> r) & 1u); if (free_ && (!have || gv > val)) { best = r; val = gv; have = true; } }
            usedm |= 1u << best; cv[s] = val; ci[s] = crow(best, hi); }
#pragma unroll
        for (int s = 0; s < 3; ++s) { cv[3 + s] = __shfl_xor(cv[s], 32); ci[3 + s] = __shfl_xor(ci[s], 32); }
        int selv[3]; unsigned um = 0u;
#pragma unroll
        for (int s = 0; s < 3; ++s) { int best = 0; float val = 0.f; int bidx = 0; bool have = false;
#pragma unroll
            for (int c = 0; c < 6; ++c) { const bool free_ = !((um >> c) & 1u); if (free_ && (!have || cv[c] > val || (cv[c] == val && ci[c] < bidx))) { best = c; val = cv[c]; bidx = ci[c]; have = true; } }
            um |= 1u << best; selv[s] = bidx; }
        unsigned lpos[3] = {0u, 0u, 0u};
        if (hi == 0) {
#pragma unroll
            for (int s = 0; s < 3; ++s) if (s < j) lpos[s] = atomicAdd((unsigned*)&lcnt[selv[s]], 1u);
        }
        __syncthreads();
        if (tid < 32) { const unsigned c = lcnt[tid]; const int near = (j - tid <= 4) ? 1 : 0; unsigned base = 0u; if (c) base = atomicAdd(&cnt[(bh * 32 + tid) * 2 + near], c); lcnt[32 + tid] = base + (near ? 7168u : 0u); }
        __syncthreads();
        if (hi == 0) {
#pragma unroll
            for (int s = 0; s < 3; ++s)
                if (s < j) lists[(size_t)(bh * 32 + selv[s]) * 8192 + lcnt[32 + selv[s]] + lpos[s]] = (unsigned short)(qpos | (s << 13));
        }
    }
}

#ifdef PROBE_SEC_ATT
#define PS_B(id) do { if ((id) == PROBE_SEC_ATT && (OWN ? 1 : 0) == PROBE_OWN) { __builtin_amdgcn_sched_barrier(0); psec -= __builtin_amdgcn_s_memrealtime(); __builtin_amdgcn_sched_barrier(0); } } while (0)
#define PS_E(id) do { if ((id) == PROBE_SEC_ATT && (OWN ? 1 : 0) == PROBE_OWN) { __builtin_amdgcn_sched_barrier(0); psec += __builtin_amdgcn_s_memrealtime(); __builtin_amdgcn_sched_barrier(0); } } while (0)
#else
#define PS_B(id) do { } while (0)
#define PS_E(id) do { } while (0)
#endif
namespace moba {
constexpr int E_K0 = 0, E_V0 = 16384, E_K1 = 32768, E_V1 = 49152, E_TAB = 65536, E_WSCR = 73728, E_STG = 81920, E_SCHED = 98304;

constexpr float THR2 = 11.5f;
template <bool CAUSAL>
__device__ __forceinline__ void tile_step(const LAS unsigned char* Kb, int vb, const LAS float* tab2, LAS float* al_l, const bf16x8 (&qr)[8], int qpos_rel, int kt, bool near, int r32, int hi,
                                          f32x16 (&o)[4], float& m_reg, float& l_reg) {
    f32x16 p0, p1;
    qkt(p0, p1, Kb, qr, r32, hi);
    float sc = C2, cadd = tab2[1023];
    if (CAUSAL || near) {
        int dbase = qpos_rel - kt * 64 - 4 * hi; asm volatile("" : "+v"(dbase));
#pragma unroll
        for (int r = 0; r < 16; ++r) {
            const int d0_ = dbase - ((r & 3) + 8 * (r >> 2)), d1_ = d0_ - 32;
            float t0, t1;
            if (!CAUSAL) { t0 = fmaf(p0[r], C2, tab2[min(d0_, 1023)]); t1 = fmaf(p1[r], C2, tab2[min(d1_, 1023)]); }
            else { t0 = fmaf(p0[r], C2, tab2[max(d0_, 0)]); t1 = fmaf(p1[r], C2, tab2[max(d1_, 0)]); if (d0_ < 0) t0 = -1e30f; if (d1_ < 0) t1 = -1e30f; }
            p0[r] = t0; p1[r] = t1;
        }
        sc = 1.f; cadd = 0.f;
    }
    float pmax = p0[0];
#pragma unroll
    for (int r = 1; r < 16; ++r) pmax = fmaxf(pmax, p0[r]);
#pragma unroll
    for (int r = 0; r < 16; ++r) pmax = fmaxf(pmax, p1[r]);
    { auto rr = __builtin_amdgcn_permlane32_swap(__float_as_uint(pmax), __float_as_uint(pmax), false, false);
      pmax = fmaxf(__uint_as_float(rr[0]), __uint_as_float(rr[1])); }
    pmax = fmaf(pmax, sc, cadd);
    const bool raise = (pmax - m_reg) > THR2;
    const float mn = raise ? pmax : m_reg;
    const float alpha = raise ? __builtin_amdgcn_exp2f(m_reg - mn) : 1.f;
    m_reg = mn;
    if (__any(raise)) {
        if (hi == 0) al_l[r32] = alpha;
        asm volatile("s_waitcnt lgkmcnt(0)" ::: "memory");
#pragma unroll
        for (int r = 0; r < 16; ++r) { const float av = al_l[crow(r, hi)];
#pragma unroll
            for (int d = 0; d < 4; ++d) o[d][r] *= av; }
    }
    const float off = cadd - m_reg;
#pragma unroll
    for (int r = 0; r < 16; ++r) { p0[r] = __builtin_amdgcn_exp2f(fmaf(p0[r], sc, off)); p1[r] = __builtin_amdgcn_exp2f(fmaf(p1[r], sc, off)); }
    float ps = 0.f;
#pragma unroll
    for (int r = 0; r < 16; ++r) ps += p0[r];
#pragma unroll
    for (int r = 0; r < 16; ++r) ps += p1[r];
    { auto rr = __builtin_amdgcn_permlane32_swap(__float_as_uint(ps), __float_as_uint(ps), false, false);
      ps = __uint_as_float(rr[0]) + __uint_as_float(rr[1]); }
    l_reg = l_reg * alpha + ps;
    bf16x8 pa0, pa1, pa2, pa3;
#define PK4(P, BASE, OUT) do { unsigned a0 = cvtpk(P[BASE + 0], P[BASE + 1]), a1 = cvtpk(P[BASE + 2], P[BASE + 3]);   \
    unsigned b0 = cvtpk(P[BASE + 4], P[BASE + 5]), b1 = cvtpk(P[BASE + 6], P[BASE + 7]);                              \
    auto r0 = __builtin_amdgcn_permlane32_swap(a0, b0, false, false); auto r1 = __builtin_amdgcn_permlane32_swap(a1, b1, false, false); \
    u32x4 w = {r0[0], r1[0], r0[1], r1[1]}; OUT = *reinterpret_cast<bf16x8*>(&w); } while (0)
    PK4(p0, 0, pa0); PK4(p0, 8, pa1); PK4(p1, 0, pa2); PK4(p1, 8, pa3);
#undef PK4
    pv_one<0>(o[0], vb, pa0, pa1, pa2, pa3); pv_one<1>(o[1], vb, pa0, pa1, pa2, pa3); pv_one<2>(o[2], vb, pa0, pa1, pa2, pa3); pv_one<3>(o[3], vb, pa0, pa1, pa2, pa3);
}
}

template <bool OWN>
__device__ __forceinline__ void attn_engine(const Args& a, LAS unsigned char* lds, int tid, int lane, int wid, unsigned long long& psec) {
    using namespace moba;
    bf16* Q = (bf16*)(a.ws + WS_A2); const bf16* K = Q + (size_t)M * D; const bf16* V = K + (size_t)M * D;
    const unsigned* cnt = (const unsigned*)(a.ws + WS_CNT); const unsigned short* lists = (const unsigned short*)(a.ws + WS_LIST);
    const float* tab2g = (const float*)(a.ws + WS_TAB2); float* LSE = (float*)(a.ws + WS_LSE);
    const long po1off = (long)((const unsigned char*)a.out - a.ws);
    const int r32 = lane & 31, hi = lane >> 5, sr = tid >> 4, sc = (tid & 15) * 8;
    LAS int* P = (LAS int*)(lds + E_SCHED);
    int TR = 512;
    if (!OWN) {
        const int c0_ = ((int)cnt[2 * tid] + 255) >> 8, c1_ = ((int)cnt[2 * tid + 1] + 255) >> 8;
        int v = c0_ + c1_;
#pragma unroll
        for (int o_ = 1; o_ < 64; o_ <<= 1) { const int t_ = __shfl_up(v, o_); if (lane >= o_) v += t_; }
        LAS int* wt = (LAS int*)(lds + E_WSCR);
        if (lane == 63) wt[wid] = v;
        __syncthreads();
        int off = 0;
        for (int w = 0; w < wid; ++w) off += wt[w];
        P[2 * tid + 2] = off + v; P[2 * tid + 1] = off + v - c1_;
        if (tid == 0) P[0] = 0;
        __syncthreads();
        TR = P[1024];
    }
    const int R0 = (int)(((long)blockIdx.x * TR) / gridDim.x), R1 = (int)(((long)(blockIdx.x + 1) * TR) / gridDim.x);
    if (R0 >= R1) return;
#define AE_LOC(rd_, li_, r_) do { if (OWN) { li_ = (rd_); r_ = 0; } else { int a_ = 0, b_ = 1024; while (b_ - a_ > 1) { const int mid_ = (a_ + b_) >> 1; if (P[mid_] <= (rd_)) a_ = mid_; else b_ = mid_; } li_ = a_; r_ = (rd_) - P[a_]; } } while (0)
#define AE_TLOAD(Kt_, Vt_) do { ks0 = *(const bf16x8*)((Kt_) + (size_t)sr * D + sc); ks1 = *(const bf16x8*)((Kt_) + (size_t)(32 + sr) * D + sc);                 \
        vs0 = *(const bf16x8*)((Vt_) + (size_t)sr * D + sc); vs1 = *(const bf16x8*)((Vt_) + (size_t)(32 + sr) * D + sc); } while (0)
#define AE_TWRITE(bi_) do { *(LAS bf16x8*)(lds + ((bi_) ? E_K1 : E_K0) + KSWZ(sr, sc * 2)) = ks0; *(LAS bf16x8*)(lds + ((bi_) ? E_K1 : E_K0) + KSWZ(32 + sr, sc * 2)) = ks1;   \
        *(LAS bf16x8*)(lds + ((bi_) ? E_V1 : E_V0) + v_st(sr, sc)) = vs0; *(LAS bf16x8*)(lds + ((bi_) ? E_V1 : E_V0) + v_st(32 + sr, sc)) = vs1; } while (0)
    bf16x8 ks0, ks1, vs0, vs1;
    int li, rr; AE_LOC(R0, li, rr);
    int b = (OWN ? li : (li >> 1)) >> 8, h = ((OWN ? li : (li >> 1)) >> 5) & 7, n = (OWN ? li : (li >> 1)) & 31;
    int L = OWN ? 256 : (int)cnt[li];
    const bf16* Kt = K + (size_t)(b * T + n * 256) * D + h * 128; const bf16* Vt = V + (size_t)(b * T + n * 256) * D + h * 128;
    AE_TLOAD(Kt, Vt);
    int tabsel = 0;
    for (int e = tid; e < 1024; e += 512) ((LAS float*)(lds + E_TAB))[e] = tab2g[h * 1024 + e];
    int ent, qpos, slot; bool valid;
    {
        const int e = rr * 256 + wid * 32 + r32; valid = e < L;
        if (OWN) ent = n * 256 + wid * 32 + r32; else ent = lists[(size_t)(li >> 1) * 8192 + (li & 1) * 7168 + (valid ? e : (L - 1))];
    }
    bf16x8 qr[8];
    {
        const bf16* Qw = Q + (size_t)(b * T + (ent & 8191)) * D + h * 128 + hi * 8;
#pragma unroll
        for (int d0 = 0; d0 < 8; ++d0) qr[d0] = *(const bf16x8*)(Qw + d0 * 16);
    }
    AE_TWRITE(0);
    __syncthreads();
    int step = 0;
    LAS float* al_l = (LAS float*)(lds + E_WSCR + wid * 1024);
    for (int rd = R0; rd < R1; ++rd) {
        const bool has_next = rd + 1 < R1;
        int nli = li, nrr = rr; if (has_next) AE_LOC(rd + 1, nli, nrr);
        const int nl2_ = OWN ? nli : (nli >> 1); const int nb_ = nl2_ >> 8, nh = (nl2_ >> 5) & 7, nn = nl2_ & 31;
        const int nL = OWN ? 256 : (has_next ? (int)cnt[nli] : L);
        const bf16* Ktn = K + (size_t)(nb_ * T + nn * 256) * D + nh * 128; const bf16* Vtn = V + (size_t)(nb_ * T + nn * 256) * D + nh * 128;
        qpos = ent & 8191; slot = ent >> 13;
        const int m = b * T + qpos, qrel = qpos - n * 256;
        const bool wave_on = OWN ? true : ((rr * 256 + wid * 32) < L);
        const bool near_ = !OWN && (li & 1);
        const LAS float* tab2 = (const LAS float*)(lds + E_TAB + tabsel * 4096);
        f32x16 o[4] = {}; float m_reg = -1e30f, l_reg = 0.f;
        float ls0 = -1e30f, ls1 = -1e30f, ls2 = -1e30f;
        const int nsel = n < 3 ? n : 3;
        int nent = ent; bool nvalid = valid;
#pragma unroll 1
        for (int kt = 0; kt < 4; ++kt) {
            const bool more = (kt < 3) || has_next;
            if (more) { if (kt < 3) AE_TLOAD(Kt + (size_t)(kt + 1) * 64 * D, Vt + (size_t)(kt + 1) * 64 * D); else AE_TLOAD(Ktn, Vtn); }
            const int bi = step & 1;
            PS_B(1);
            if (OWN && kt == 3) {
                if (nsel > 0) ls0 = LSE[((size_t)0 * M + m) * 8 + h];
                if (nsel > 1) ls1 = LSE[((size_t)1 * M + m) * 8 + h];
                if (nsel > 2) ls2 = LSE[((size_t)2 * M + m) * 8 + h];
            }
            if (wave_on && (!OWN || kt <= (wid >> 1))) {
                const LAS unsigned char* Kb_ = lds + (bi ? E_K1 : E_K0); const int vb_ = (int)(unsigned long)(lds + (bi ? E_V1 : E_V0)) + v_rd_base(lane);
                tile_step<OWN>(Kb_, vb_, tab2, al_l, qr, qrel, kt, near_, r32, hi, o, m_reg, l_reg);
            }
            PS_E(1); PS_B(2);
            if (has_next && kt == 1) {
                const int e = nrr * 256 + wid * 32 + r32; nvalid = e < nL;
                if (OWN) nent = nn * 256 + wid * 32 + r32; else nent = lists[(size_t)(nli >> 1) * 8192 + (nli & 1) * 7168 + (nvalid ? e : (nL - 1))];
            }
            if (has_next && kt == 3) {
                const bf16* Qw = Q + (size_t)(nb_ * T + (nent & 8191)) * D + nh * 128 + hi * 8;
#pragma unroll
                for (int d0 = 0; d0 < 8; ++d0) qr[d0] = *(const bf16x8*)(Qw + d0 * 16);
            }
            if (more) AE_TWRITE(bi ^ 1);
            if (kt == 3 && has_next && nh != h) { for (int e = tid; e < 1024; e += 512) ((LAS float*)(lds + E_TAB + (tabsel ^ 1) * 4096))[e] = tab2g[nh * 1024 + e]; }
            __syncthreads();
            PS_E(2);
            ++step;
        }
        PS_B(3);
        if (wave_on) {
            LAS unsigned char* stg = lds + E_STG + wid * 2048;
            if (!OWN) {
                LAS float* li_l = (LAS float*)(lds + E_WSCR + wid * 1024 + 128);
                LAS int* row_l = (LAS int*)(lds + E_WSCR + wid * 1024 + 256);
                if (hi == 0) { li_l[r32] = __builtin_amdgcn_rcpf(l_reg); row_l[r32] = valid ? ((slot << 20) | m) : -1;
                    if (valid) LSE[((size_t)slot * M + m) * 8 + h] = m_reg + __builtin_amdgcn_logf(l_reg); }
                asm volatile("s_waitcnt lgkmcnt(0)" ::: "memory");
                float rl[16];
#pragma unroll
                for (int r = 0; r < 16; ++r) rl[r] = li_l[crow(r, hi)];
#pragma unroll
                for (int d0 = 0; d0 < 4; ++d0) {
#pragma unroll
                    for (int r = 0; r < 16; ++r) *(LAS unsigned short*)(stg + crow(r, hi) * 64 + r32 * 2) = (unsigned short)f2bf(o[d0][r] * rl[r]);
#pragma unroll
                    for (int t2 = 0; t2 < 2; ++t2) {
                        const int id = t2 * 64 + lane, row = id >> 2, ch = id & 3;
                        const u32x4 v = *(const LAS u32x4*)(stg + row * 64 + ch * 16);
                        const int rm = row_l[row];
                        if (rm >= 0) {
                            const int sl = rm >> 20, mm = rm & 0xfffff;
                            *(u32x4*)((bf16*)(a.ws + (sl == 0 ? (long)WS_PO0 : (sl == 1 ? po1off : (long)WS_PO2))) + (size_t)mm * D + h * 128 + d0 * 32 + ch * 8) = v;
                        }
                    }
                }
            } else {
                const float lown = m_reg + __builtin_amdgcn_logf(l_reg);
                const float Mx = fmaxf(fmaxf(lown, ls0), fmaxf(ls1, ls2));
                const float e0 = __builtin_amdgcn_exp2f(ls0 - Mx), e1 = __builtin_amdgcn_exp2f(ls1 - Mx), e2 = __builtin_amdgcn_exp2f(ls2 - Mx), eo = __builtin_amdgcn_exp2f(lown - Mx);
                const float iz = __builtin_amdgcn_rcpf((eo + e0) + (e1 + e2));
                LAS float* cf = (LAS float*)(lds + E_WSCR + wid * 1024 + 128);
                if (hi == 0) { cf[r32] = eo * iz * __builtin_amdgcn_rcpf(l_reg); cf[32 + r32] = e0 * iz; cf[64 + r32] = e1 * iz; cf[96 + r32] = e2 * iz; }
                asm volatile("s_waitcnt lgkmcnt(0)" ::: "memory");
                const bf16* P0 = (const bf16*)(a.ws + WS_PO0); const bf16* P1 = (const bf16*)a.out; const bf16* P2 = (const bf16*)(a.ws + WS_PO2);
                float co[16];
#pragma unroll
                for (int r = 0; r < 16; ++r) co[r] = cf[crow(r, hi)];
#pragma unroll
                for (int d0 = 0; d0 < 4; ++d0) {
#pragma unroll
                    for (int r = 0; r < 16; ++r) *(LAS unsigned short*)(stg + crow(r, hi) * 64 + r32 * 2) = (unsigned short)f2bf(o[d0][r] * co[r]);
#pragma unroll
                    for (int t2 = 0; t2 < 2; ++t2) {
                        const int id = t2 * 64 + lane, row = id >> 2, ch = id & 3;
                        const u32x4 ov = *(const LAS u32x4*)(stg + row * 64 + ch * 16);
                        const size_t off = (size_t)(b * T + n * 256 + wid * 32 + row) * D + h * 128 + d0 * 32 + ch * 8;
                        float acc[8];
                        acc[0] = __uint_as_float(ov.x << 16); acc[1] = __uint_as_float(ov.x & 0xffff0000u); acc[2] = __uint_as_float(ov.y << 16); acc[3] = __uint_as_float(ov.y & 0xffff0000u);
                        acc[4] = __uint_as_float(ov.z << 16); acc[5] = __uint_as_float(ov.z & 0xffff0000u); acc[6] = __uint_as_float(ov.w << 16); acc[7] = __uint_as_float(ov.w & 0xffff0000u);
#define ADDP(PP, CI) do { const u32x4 pv = *(const u32x4*)((PP) + off); const float cc = cf[(CI) * 32 + row];                                   \
    acc[0] = fmaf(cc, __uint_as_float(pv.x << 16), acc[0]); acc[1] = fmaf(cc, __uint_as_float(pv.x & 0xffff0000u), acc[1]);                     \
    acc[2] = fmaf(cc, __uint_as_float(pv.y << 16), acc[2]); acc[3] = fmaf(cc, __uint_as_float(pv.y & 0xffff0000u), acc[3]);                     \
    acc[4] = fmaf(cc, __uint_as_float(pv.z << 16), acc[4]); acc[5] = fmaf(cc, __uint_as_float(pv.z & 0xffff0000u), acc[5]);                     \
    acc[6] = fmaf(cc, __uint_as_float(pv.w << 16), acc[6]); acc[7] = fmaf(cc, __uint_as_float(pv.w & 0xffff0000u), acc[7]); } while (0)
                        if (nsel > 0) ADDP(P0, 1);
                        if (nsel > 1) ADDP(P1, 2);
                        if (nsel > 2) ADDP(P2, 3);
#undef ADDP
                        *(u32x4*)(Q + off) = (u32x4){pk2(acc[0], acc[1]), pk2(acc[2], acc[3]), pk2(acc[4], acc[5]), pk2(acc[6], acc[7])};
                    }
                }
            }
        }
        PS_E(3);
        if (nh != h) tabsel ^= 1;
        li = nli; rr = nrr; b = nb_; h = nh; n = nn; L = nL; Kt = Ktn; Vt = Vtn; ent = nent; valid = nvalid;
    }
    __syncthreads();
#undef AE_LOC
#undef AE_TLOAD
#undef AE_TWRITE
}

#ifndef PROBE_BLK
#define PROBE_BLK 0
#endif
#ifdef PROBE_HG
#define HS_B(id) do { if ((id) == PROBE_HG && PASS_B == (PROBE_HG_B != 0)) { __builtin_amdgcn_sched_barrier(0); psec -= __builtin_amdgcn_s_memrealtime(); __builtin_amdgcn_sched_barrier(0); } } while (0)
#define HS_E(id) do { if ((id) == PROBE_HG && PASS_B == (PROBE_HG_B != 0)) { __builtin_amdgcn_sched_barrier(0); psec += __builtin_amdgcn_s_memrealtime(); __builtin_amdgcn_sched_barrier(0); } } while (0)
#else
#define HS_B(id) do { } while (0)
#define HS_E(id) do { } while (0)
#endif
namespace hg {
using namespace moba;
#ifndef HG_NEW_SIMG
#define HG_NEW_SIMG 1
#endif
constexpr int H_TQ = 0, H_TK = 16384, H_TKT = 32768, H_TI = 49152, H_SIMG = 65536, H_OST = 98304, H_EL = 132096;
constexpr int OST_LD = 132;
typedef float f32x2_t __attribute__((ext_vector_type(2))); typedef __bf16 bf16x2_t __attribute__((ext_vector_type(2)));
__device__ __forceinline__ unsigned cvtpk_s(float lo, float hi) { f32x2_t v = {lo, hi}; bf16x2_t b = __builtin_convertvector(v, bf16x2_t); return __builtin_bit_cast(unsigned, b); }
__device__ __forceinline__ int v_st64(int k, int c) { const int kk = (k & ~0xC) | ((k & 4) << 1) | ((k & 8) >> 1); return ((kk >> 3) * 2 + (c >> 5)) * 512 + ((kk & 7) * 32 + (c & 31)) * 2; }
constexpr int v_rd_off64(int tile, int cb, int ks, int half) { return tile * 8192 + cb * 512 + ks * 2048 + half * 1024; }
__device__ __forceinline__ void simg_store(LAS unsigned char* lds, int img_off, const f32x16& S, int nb, int d, int hi) {
#pragma unroll
    for (int q4 = 0; q4 < 4; ++q4) { const int n = 32 * nb + 8 * q4 + 4 * hi;
        typedef unsigned u32x2_ __attribute__((ext_vector_type(2)));
        *(LAS u32x2_*)(lds + img_off + KSWZ(d, 2 * n)) = (u32x2_){cvtpk_s(S[4 * q4 + 0], S[4 * q4 + 1]), cvtpk_s(S[4 * q4 + 2], S[4 * q4 + 3])}; }
}
__device__ __forceinline__ int kt_off(int n, int s) { return n * 128 + ((((s >> 3) ^ ((n >> 1) & 7))) << 4) + (s & 7) * 2; }

template <bool PASS_B>
__device__ __forceinline__ void hgrn_unit(const Args& a, LAS unsigned char* lds, int u, int tid, int lane, int wid, unsigned long long& psec) {
    unsigned char* ws = a.ws;
    const bf16* QS = (const bf16*)(ws + WS_A1); const float* LF = (const float*)(ws + WS_A2); const bf16* INP = (const bf16*)(ws + WS_A3); const bf16* OG = (const bf16*)(ws + WS_A4);
    bf16* OGATED = (bf16*)(ws + WS_A0); float* SSQH = (float*)(ws + WS_SSQH);
    float* TG = a.out;
    float* DG = a.out + (size_t)256 * 128 * 128;
    const int bh = u >> 4, g = u & 15, b = bh >> 3, h = bh & 7;
    const int r32 = lane & 31, hi = lane >> 5, tb = wid >> 2, db = wid & 3;
    const int nl = lane & 15, tq = lane >> 4, npre = 16 * wid + nl;
    f32x16 Sacc[2] = {};
    float dg = 1.f;
#if HG_NEW_SIMG
#define HG_SIMG_WRITE() do { simg_store(lds, H_SIMG, Sacc[0], 2 * tb, 32 * db + r32, hi); simg_store(lds, H_SIMG, Sacc[1], 2 * tb + 1, 32 * db + r32, hi); } while (0)
#else
#define HG_SIMG_WRITE() do { _Pragma("unroll") for (int i = 0; i < 2; ++i) { const int nb = 2 * tb + i; _Pragma("unroll") for (int r = 0; r < 16; ++r) { const int n = 32 * nb + crow(r, hi); \
        *(LAS unsigned short*)(lds + H_SIMG + (nb >> 1) * 16384 + v_st(n & 63, 32 * db + r32)) = (unsigned short)f2bf(Sacc[i][r]); } } } while (0)
#endif
    if (PASS_B) {
        HS_B(1);
        {
            LAS float* dl = (LAS float*)(lds + H_OST);
            for (int e = tid; e < g * 128; e += NWAVES * 64) dl[e] = DG[(size_t)(bh * 16) * 128 + e];
            __syncthreads();
            for (int gp0 = 0; gp0 < g; gp0 += 4) {
                int lo_ = (wid * 8 * 64 + lane) * 4; asm volatile("" : "+v"(lo_));
                const float* tg = TG + (size_t)(bh * 16 + gp0) * 16384 + lo_;
                f32x4 tv[4][8];
#pragma unroll
                for (int k = 0; k < 4; ++k) if (gp0 + k < g) {
#pragma unroll
                    for (int j = 0; j < 8; ++j) tv[k][j] = *(const f32x4*)(tg + (size_t)k * 16384 + j * 256);
                }
#pragma unroll
                for (int k = 0; k < 4; ++k) if (gp0 + k < g) {
#pragma unroll
                    for (int i = 0; i < 2; ++i)
#pragma unroll
                        for (int r = 0; r < 16; ++r) Sacc[i][r] = fmaf(Sacc[i][r], dl[(gp0 + k) * 128 + 32 * (2 * tb + i) + crow(r, hi)], tv[k][i * 4 + (r >> 2)][r & 3]);
                }
            }
            __syncthreads();
        }
        HG_SIMG_WRITE();
        HS_E(1);
    }
    float lfn[16]; unsigned short qn[16]; bf16x8 in0, in1; u32x4 gn0, gn1;
    const int sr = tid >> 4, sc = (tid & 15) * 8;
    const int pt = tid >> 3, pseg = tid & 7;
#define HG_LOAD(cc) do { const size_t m0_ = (size_t)b * T + g * 512 + (cc) * 64; const size_t off0_ = (m0_ + 16 * tq) * D + h * 128 + npre;                       \
        _Pragma("unroll") for (int i = 0; i < 16; ++i) { lfn[i] = LF[off0_ + (size_t)i * D]; if (PASS_B) qn[i] = QS[off0_ + (size_t)i * D]; }                      \
        in0 = *(const bf16x8*)(INP + (m0_ + sr) * D + h * 128 + sc); in1 = *(const bf16x8*)(INP + (m0_ + 32 + sr) * D + h * 128 + sc);                          \
        if (PASS_B) { const size_t go_ = (m0_ + pt) * D + h * 128 + 16 * pseg; gn0 = *(const u32x4*)(OG + go_); gn1 = *(const u32x4*)(OG + go_ + 8); } } while (0)
    HG_LOAD(0);
    for (int c = 0; c < 8; ++c) {
        const size_t m0 = (size_t)b * T + g * 512 + c * 64;
        u32x4 g0 = {}, g1 = {};
        HS_B(2);
        {
            float lf[16], qv[16];
#pragma unroll
            for (int i = 0; i < 16; ++i) { lf[i] = lfn[i]; if (PASS_B) qv[i] = bf2f(qn[i]); }
            if (PASS_B) { g0 = gn0; g1 = gn1; }
            float cs[16]; float run = 0.f;
#pragma unroll
            for (int i = 0; i < 16; ++i) { run += lf[i]; cs[i] = run; }
            const float s0 = __shfl(run, nl), s1 = __shfl(run, nl + 16), s2 = __shfl(run, nl + 32), s3 = __shfl(run, nl + 48);
            const float pre = (tq > 0 ? s0 : 0.f) + (tq > 1 ? s1 : 0.f) + (tq > 2 ? s2 : 0.f);
            const float last = (s0 + s1) + (s2 + s3);
            unsigned kh[8], qw[8], kw[8];
#pragma unroll
            for (int i = 0; i < 16; i += 2) {
                float khv[2], qtv[2], ktv[2];
#pragma unroll
                for (int e = 0; e < 2; ++e) {
                    const float cum = pre + cs[i + e];
                    const float kk = 1.f - __expf(lf[i + e]);
                    khv[e] = kk * __expf(last - cum);
                    if (PASS_B) { qtv[e] = qv[i + e] * __expf(cum); ktv[e] = kk * __expf(-cum); }
                }
                kh[i >> 1] = cvtpk(khv[0], khv[1]);
                if (PASS_B) { qw[i >> 1] = cvtpk(qtv[0], qtv[1]); kw[i >> 1] = cvtpk(ktv[0], ktv[1]); }
            }
            if (PASS_B) {
                const int io = (npre >> 6) * 8192 + v_st64(npre & 63, 16 * tq);
                *(LAS u32x4*)(lds + H_TQ + io) = (u32x4){qw[0], qw[1], qw[2], qw[3]}; *(LAS u32x4*)(lds + H_TQ + io + 16) = (u32x4){qw[4], qw[5], qw[6], qw[7]};
                *(LAS u32x4*)(lds + H_TK + io) = (u32x4){kw[0], kw[1], kw[2], kw[3]}; *(LAS u32x4*)(lds + H_TK + io + 16) = (u32x4){kw[4], kw[5], kw[6], kw[7]};
            }
            *(LAS u32x4*)(lds + H_TKT + kt_off(npre, 16 * tq)) = (u32x4){kh[0], kh[1], kh[2], kh[3]};
            *(LAS u32x4*)(lds + H_TKT + kt_off(npre, 16 * tq + 8)) = (u32x4){kh[4], kh[5], kh[6], kh[7]};
            const float el = __expf(last);
            if (tq == 0) *(LAS float*)(lds + H_EL + npre * 4) = el;
            dg *= el;
            *(LAS bf16x8*)(lds + H_TI + v_st(sr, sc)) = in0;
            *(LAS bf16x8*)(lds + H_TI + v_st(32 + sr, sc)) = in1;
        }
        __syncthreads();
        HS_E(2); HS_B(3);
        {
#define PK(L, Hh) (bf16x8){L[0], L[1], L[2], L[3], Hh[0], Hh[1], Hh[2], Hh[3]}
            bf16x8 pa0, pa1, pa2, pa3; bf16x8 qr[8];
            if (PASS_B) {
                const int t = 32 * tb + r32;
                const int vbQ = (int)(unsigned long)(lds + H_TQ) + v_rd_base(lane) + tb * 512, vbK = (int)(unsigned long)(lds + H_TK) + v_rd_base(lane);
                {
                    s16x4 ql[8], qh[8];
#define HG_QRD(d0_) ql[d0_] = tr_read<v_rd_off64((d0_) >> 2, 0, (d0_) & 3, 0)>(vbQ); qh[d0_] = tr_read<v_rd_off64((d0_) >> 2, 0, (d0_) & 3, 1)>(vbQ);
                    HG_QRD(0) HG_QRD(1) HG_QRD(2) HG_QRD(3) HG_QRD(4) HG_QRD(5) HG_QRD(6) HG_QRD(7)
#undef HG_QRD
                    asm volatile("s_waitcnt lgkmcnt(0)" ::: "memory"); SBAR();
#pragma unroll
                    for (int d0 = 0; d0 < 8; ++d0) qr[d0] = PK(ql[d0], qh[d0]);
                }
                f32x16 p0 = {}, p1 = {};
                s16x4 ka[8], kb[8];
#define HG_KRD(dst_, da_, db2_) do { \
                    dst_[0] = tr_read<v_rd_off64((da_) >> 2, 0, (da_) & 3, 0)>(vbK); dst_[1] = tr_read<v_rd_off64((da_) >> 2, 0, (da_) & 3, 1)>(vbK);     \
                    dst_[2] = tr_read<v_rd_off64((da_) >> 2, 1, (da_) & 3, 0)>(vbK); dst_[3] = tr_read<v_rd_off64((da_) >> 2, 1, (da_) & 3, 1)>(vbK);     \
                    dst_[4] = tr_read<v_rd_off64((db2_) >> 2, 0, (db2_) & 3, 0)>(vbK); dst_[5] = tr_read<v_rd_off64((db2_) >> 2, 0, (db2_) & 3, 1)>(vbK); \
                    dst_[6] = tr_read<v_rd_off64((db2_) >> 2, 1, (db2_) & 3, 0)>(vbK); dst_[7] = tr_read<v_rd_off64((db2_) >> 2, 1, (db2_) & 3, 1)>(vbK); } while (0)
#define HG_KMM(src_, da_, db2_) do { \
                    p0 = __builtin_amdgcn_mfma_f32_32x32x16_bf16(PK(src_[0], src_[1]), qr[da_], p0, 0, 0, 0); p1 = __builtin_amdgcn_mfma_f32_32x32x16_bf16(PK(src_[2], src_[3]), qr[da_], p1, 0, 0, 0);     \
                    p0 = __builtin_amdgcn_mfma_f32_32x32x16_bf16(PK(src_[4], src_[5]), qr[db2_], p0, 0, 0, 0); p1 = __builtin_amdgcn_mfma_f32_32x32x16_bf16(PK(src_[6], src_[7]), qr[db2_], p1, 0, 0, 0); } while (0)
                HG_KRD(ka, 0, 1); HG_KRD(kb, 2, 3);
                asm volatile("s_waitcnt lgkmcnt(8)" ::: "memory"); SBAR(); HG_KMM(ka, 0, 1); SBAR();
                HG_KRD(ka, 4, 5);
                asm volatile("s_waitcnt lgkmcnt(8)" ::: "memory"); SBAR(); HG_KMM(kb, 2, 3); SBAR();
                HG_KRD(kb, 6, 7);
                asm volatile("s_waitcnt lgkmcnt(8)" ::: "memory"); SBAR(); HG_KMM(ka, 4, 5); SBAR();
                asm volatile("s_waitcnt lgkmcnt(0)" ::: "memory"); SBAR(); HG_KMM(kb, 6, 7);
#undef HG_KRD
#undef HG_KMM
#pragma unroll
                for (int r = 0; r < 16; ++r) { const int s0_ = crow(r, hi); if (s0_ > t) p0[r] = 0.f; if (s0_ + 32 > t) p1[r] = 0.f; }
#define PK4(P, BASE, OUT) do { unsigned a0 = cvtpk(P[BASE + 0], P[BASE + 1]), a1 = cvtpk(P[BASE + 2], P[BASE + 3]);   \
    unsigned b0 = cvtpk(P[BASE + 4], P[BASE + 5]), b1 = cvtpk(P[BASE + 6], P[BASE + 7]);                              \
    auto r0 = __builtin_amdgcn_permlane32_swap(a0, b0, false, false); auto r1 = __builtin_amdgcn_permlane32_swap(a1, b1, false, false); \
    u32x4 w = {r0[0], r1[0], r0[1], r1[1]}; OUT = *reinterpret_cast<bf16x8*>(&w); } while (0)
                PK4(p0, 0, pa0); PK4(p0, 8, pa1); PK4(p1, 0, pa2); PK4(p1, 8, pa3);
#undef PK4
            }
            if (c < 7) HG_LOAD(c + 1);
            const int vbI = (int)(unsigned long)(lds + H_TI) + v_rd_base(lane) + db * 512;
            bf16x8 bI[4];
            {
                const s16x4 l0 = tr_read<v_rd_off(0, 0, 0)>(vbI), h0 = tr_read<v_rd_off(0, 0, 1)>(vbI), l1 = tr_read<v_rd_off(0, 1, 0)>(vbI), h1 = tr_read<v_rd_off(0, 1, 1)>(vbI);
                const s16x4 l2 = tr_read<v_rd_off(0, 2, 0)>(vbI), h2 = tr_read<v_rd_off(0, 2, 1)>(vbI), l3 = tr_read<v_rd_off(0, 3, 0)>(vbI), h3 = tr_read<v_rd_off(0, 3, 1)>(vbI);
                asm volatile("s_waitcnt lgkmcnt(0)" ::: "memory"); SBAR();
                bI[0] = PK(l0, h0); bI[1] = PK(l1, h1); bI[2] = PK(l2, h2); bI[3] = PK(l3, h3);
            }
            if (PASS_B) {
                f32x16 od = {};
                od = __builtin_amdgcn_mfma_f32_32x32x16_bf16(pa0, bI[0], od, 0, 0, 0);
                od = __builtin_amdgcn_mfma_f32_32x32x16_bf16(pa1, bI[1], od, 0, 0, 0);
                od = __builtin_amdgcn_mfma_f32_32x32x16_bf16(pa2, bI[2], od, 0, 0, 0);
                od = __builtin_amdgcn_mfma_f32_32x32x16_bf16(pa3, bI[3], od, 0, 0, 0);
#if HG_NEW_SIMG
#pragma unroll
                for (int ks = 0; ks < 8; ++ks) {
                    const bf16x8 bs = *(const LAS bf16x8*)(lds + H_SIMG + KSWZ(32 * db + r32, (16 * ks + 8 * hi) * 2));
                    od = __builtin_amdgcn_mfma_f32_32x32x16_bf16(qr[ks], bs, od, 0, 0, 0);
                }
#else
#pragma unroll
                for (int hf = 0; hf < 2; ++hf) {
                    const int vbS = (int)(unsigned long)(lds + H_SIMG) + hf * 16384 + v_rd_base(lane) + db * 512;
                    const s16x4 l0 = tr_read<v_rd_off(0, 0, 0)>(vbS), h0 = tr_read<v_rd_off(0, 0, 1)>(vbS), l1 = tr_read<v_rd_off(0, 1, 0)>(vbS), h1 = tr_read<v_rd_off(0, 1, 1)>(vbS);
                    const s16x4 l2 = tr_read<v_rd_off(0, 2, 0)>(vbS), h2 = tr_read<v_rd_off(0, 2, 1)>(vbS), l3 = tr_read<v_rd_off(0, 3, 0)>(vbS), h3 = tr_read<v_rd_off(0, 3, 1)>(vbS);
                    asm volatile("s_waitcnt lgkmcnt(0)" ::: "memory"); SBAR();
                    od = __builtin_amdgcn_mfma_f32_32x32x16_bf16(qr[hf * 4 + 0], PK(l0, h0), od, 0, 0, 0);
                    od = __builtin_amdgcn_mfma_f32_32x32x16_bf16(qr[hf * 4 + 1], PK(l1, h1), od, 0, 0, 0);
                    od = __builtin_amdgcn_mfma_f32_32x32x16_bf16(qr[hf * 4 + 2], PK(l2, h2), od, 0, 0, 0);
                    od = __builtin_amdgcn_mfma_f32_32x32x16_bf16(qr[hf * 4 + 3], PK(l3, h3), od, 0, 0, 0);
                }
#endif
#undef PK
                LAS float* ost = (LAS float*)(lds + H_OST);
#pragma unroll
                for (int r = 0; r < 16; ++r) ost[(32 * tb + crow(r, hi)) * OST_LD + 32 * db + r32] = od[r];
            }
            const LAS float* el = (const LAS float*)(lds + H_EL);
#pragma unroll
            for (int i = 0; i < 2; ++i) { const int nb = 2 * tb + i;
#pragma unroll
                for (int r = 0; r < 16; ++r) Sacc[i][r] *= el[32 * nb + crow(r, hi)];
#pragma unroll
                for (int ks = 0; ks < 4; ++ks) {
                    const bf16x8 af = *(const LAS bf16x8*)(lds + H_TKT + kt_off(32 * nb + r32, 16 * ks + 8 * hi));
                    Sacc[i] = __builtin_amdgcn_mfma_f32_32x32x16_bf16(af, bI[ks], Sacc[i], 0, 0, 0);
                } }
        }
        HS_E(3); HS_B(4);
        __syncthreads();
        if (PASS_B) {
            HG_SIMG_WRITE();
            const int t = pt, seg = pseg; const size_t go = (m0 + t) * D + h * 128 + 16 * seg;
            const LAS float* orow = (const LAS float*)(lds + H_OST) + t * OST_LD + 16 * seg;
            const unsigned gw[8] = {g0.x, g0.y, g0.z, g0.w, g1.x, g1.y, g1.z, g1.w};
            float ssq = 0.f; unsigned ow[8];
#pragma unroll
            for (int e = 0; e < 8; ++e) { const float o0 = orow[2 * e], o1 = orow[2 * e + 1]; ssq = fmaf(o0, o0, ssq); ssq = fmaf(o1, o1, ssq);
                ow[e] = pk2(o0 * __uint_as_float(gw[e] << 16), o1 * __uint_as_float(gw[e] & 0xffff0000u)); }
            *(u32x4*)(OGATED + go) = (u32x4){ow[0], ow[1], ow[2], ow[3]}; *(u32x4*)(OGATED + go + 8) = (u32x4){ow[4], ow[5], ow[6], ow[7]};
            ssq += __shfl_xor(ssq, 1); ssq += __shfl_xor(ssq, 2); ssq += __shfl_xor(ssq, 4);
            if (seg == 0) SSQH[(m0 + t) * 8 + h] = ssq;
        }
        HS_E(4);
    }
    if (!PASS_B) {
        int lo_ = (wid * 8 * 64 + lane) * 4; asm volatile("" : "+v"(lo_));
        float* tg = TG + (size_t)u * 16384 + lo_;
#pragma unroll
        for (int i = 0; i < 2; ++i)
#pragma unroll
            for (int q4 = 0; q4 < 4; ++q4) *(f32x4*)(tg + (i * 4 + q4) * 256) = (f32x4){Sacc[i][4 * q4], Sacc[i][4 * q4 + 1], Sacc[i][4 * q4 + 2], Sacc[i][4 * q4 + 3]};
        if (tq == 0) DG[(size_t)u * 128 + npre] = dg;
    }
    __syncthreads();
#undef HG_LOAD
#undef HG_SIMG_WRITE
}
}

#define XB_TMO      128
#define XB_XCNT(j)  (256  + 64 * (j))
#define XB_XSUB(j)  (1280 + 64 * (j))
#define XB_XGEN(j)  (2304 + 64 * (j))
#define XB_TOP      3328
#define XB_TOPGEN   3392
#define XCD_BAR_WORDS 3456
#define XB_SPIN_CAP (1u << 18)

__device__ __forceinline__ unsigned xb_ld(unsigned* p)              { return __hip_atomic_load(p, __ATOMIC_RELAXED, __HIP_MEMORY_SCOPE_AGENT); }
__device__ __forceinline__ unsigned xb_add(unsigned* p, unsigned v) { return __hip_atomic_fetch_add(p, v, __ATOMIC_RELAXED, __HIP_MEMORY_SCOPE_AGENT); }
__device__ __forceinline__ unsigned xb_xcc_id() { return (unsigned)__builtin_amdgcn_s_getreg((3 << 11) | 20) & 0xFu; }
#define XB_SPIN(cond, bar) do { unsigned _sp = 0; while (cond) { __builtin_amdgcn_s_sleep(1); \
    if ((++_sp & 255u) == 0u) { if (xb_ld(&(bar)[XB_TMO])) break; if (_sp > XB_SPIN_CAP) { atomicAdd(&(bar)[XB_TMO], 1u); break; } } } } while (0)

struct XcdBarrier {
    unsigned* bar; unsigned x;
    volatile LAS unsigned* st;
};

__device__ __forceinline__ XcdBarrier xcd_barrier_post(unsigned* bar, volatile LAS unsigned* st) {
    XcdBarrier b; b.bar = bar; b.x = xb_xcc_id(); b.st = st;
    if (threadIdx.x == 0) (void)xb_add(&bar[XB_XCNT(b.x)], 1u);
    return b;
}
__device__ __forceinline__ void xcd_barrier_complete(unsigned* bar, unsigned x, unsigned& nloc, unsigned& nx) {
    const unsigned G = gridDim.x * gridDim.y * gridDim.z;
    unsigned sum, cnt, mine, sp = 0u;
    for (;;) {
        sum = 0u; cnt = 0u; mine = 0u;
#pragma unroll
        for (unsigned j = 0; j < 16; ++j) { const unsigned c = xb_ld(&bar[XB_XCNT(j)]); sum += c; cnt += (c > 0u) ? 1u : 0u; mine = (j == x) ? c : mine; }
        if (sum == G) break;
        __builtin_amdgcn_s_sleep(1);
        if ((++sp & 255u) == 0u) { if (xb_ld(&bar[XB_TMO])) break; if (sp > XB_SPIN_CAP) { atomicAdd(&bar[XB_TMO], 1u); break; } }
    }
    nloc = mine > 0u ? mine : 1u; nx = cnt > 0u ? cnt : 1u;
}

__device__ __forceinline__ void xcd_barrier(const XcdBarrier& b) {
    asm volatile("s_waitcnt vmcnt(0)" ::: "memory");
    __syncthreads();
    if (threadIdx.x == 0) {
        unsigned* bar = b.bar;
        __builtin_amdgcn_s_waitcnt(0);
        unsigned nloc = b.st[0], nx = b.st[1];
        if (nloc == 0u) { xcd_barrier_complete(bar, b.x, nloc, nx); b.st[0] = nloc; b.st[1] = nx; }
        const unsigned old = xb_add(&bar[XB_XSUB(b.x)], 1u);
        const unsigned gen = old / nloc;
        if (old + 1u == (gen + 1u) * nloc) {
            __builtin_amdgcn_fence(__ATOMIC_RELEASE, "agent");
            asm volatile("s_waitcnt vmcnt(0)" ::: "memory");
            const unsigned og = xb_add(&bar[XB_TOP], 1u);
            const unsigned tg = og / nx;
            if (og + 1u == (tg + 1u) * nx) xb_add(&bar[XB_TOPGEN], 1u);
            else XB_SPIN(xb_ld(&bar[XB_TOPGEN]) == tg, bar);
            __builtin_amdgcn_fence(__ATOMIC_ACQUIRE, "agent");
            xb_add(&bar[XB_XGEN(b.x)], 1u);
            asm volatile("s_waitcnt vmcnt(0)" ::: "memory");
        } else {
            XB_SPIN(xb_ld(&bar[XB_XGEN(b.x)]) == gen, bar);
            __builtin_amdgcn_fence(__ATOMIC_ACQUIRE, "agent");
            asm volatile("s_waitcnt vmcnt(0)" ::: "memory");
        }
    }
    __syncthreads();
}

__global__ void __launch_bounds__(NWAVES * 64, 2) mk(Args a) {
    extern __shared__ __attribute__((aligned(16))) unsigned char lds_raw[];
    LAS unsigned char* lds = (LAS unsigned char*)lds_raw;
    const int tid = threadIdx.x, lane = tid & 63, wave = __builtin_amdgcn_readfirstlane(tid >> 6);
    unsigned char* ws = a.ws;
    const int lo = a.ph_lo, hi = a.ph_hi;
    const int G = gridDim.x;
    cg::grid_group grid = cg::this_grid();
#define IN(k) (lo <= (k) && (k) < hi)
#define SEAM(k) do { if (IN(k) && IN((k) + 1)) { if ((k) == 0) { grid.sync(); bar = xcd_barrier_post((unsigned*)(ws + WS_BAR), MISC); } else xcd_barrier(bar); } } while (0)
    float* SSQ = (float*)(ws + WS_SSQ);
    volatile LAS unsigned* MISC = (volatile LAS unsigned*)(lds + LDS_MISC);
    if (tid < 2) MISC[tid] = 0u;
    __syncthreads();
    XcdBarrier bar; bar.bar = (unsigned*)(ws + WS_BAR); bar.x = 0; bar.st = MISC;
    int ph = 0;
    unsigned long long psec = 0ull, pdummy = 0ull;
#ifdef PROBE_GEMM_EPI
#define PSE_SEL(k) (((k) == PROBE_GEMM_EPI) ? psec : pdummy)
#else
#define PSE_SEL(k) pdummy
#endif
#ifdef PROBE_LO
    unsigned long long pt0 = 0, pt1 = 0;
#define PMARK(k) do { if (blockIdx.x == PROBE_BLK) { if ((k) == PROBE_LO) pt0 = __builtin_amdgcn_s_memrealtime(); if ((k) == PROBE_HI + 1) pt1 = __builtin_amdgcn_s_memrealtime(); } } while (0)
#else
#define PMARK(k) do { } while (0)
#endif
    PMARK(ph);
    if (IN(ph)) { prologue(a, lds, tid, lane, wave); }
    SEAM(ph); ++ph; PMARK(ph);
    if (IN(ph)) {
        pg8::Gemm g{(const bf16*)(ws + WS_A0), (const bf16*)(ws + WS_WIN0), M, 4096, D}; pg8::StaticOrder S; S.init(M, 4096, G, (int)blockIdx.x);
        pg8::EpiHgrnIn E{(bf16*)(ws + WS_A1), (float*)(ws + WS_A2), (bf16*)(ws + WS_A3), (bf16*)(ws + WS_A4), (const float*)(ws + WS_LB)};
        pg8::gemm_phase<pg8::EpiHgrnIn, pg8::StaticOrder, true, true>(lds, g, S, E, PSE_SEL(ph));
    }
    SEAM(ph); ++ph; PMARK(ph);
    if (IN(ph)) { for (int v = blockIdx.x; v < 256; v += G) { const int u = (G == 256) ? (((v & 7) * 2 + (v >> 7)) * 16 + ((v >> 3) & 15)) : v; hg::hgrn_unit<false>(a, lds, u, tid, lane, wave, psec); } }
    SEAM(ph); ++ph; PMARK(ph);
    if (IN(ph)) { for (int v = blockIdx.x; v < 256; v += G) { const int u = (G == 256) ? (((v & 7) * 2 + (v >> 7)) * 16 + ((v >> 3) & 15)) : v; hg::hgrn_unit<true>(a, lds, u, tid, lane, wave, psec); } }
    SEAM(ph); ++ph; PMARK(ph);
    if (IN(ph)) {
        pg8::Gemm g{(const bf16*)(ws + WS_A0), (const bf16*)(ws + WS_WOUT0), M, D, D}; pg8::StaticOrder S; S.init(M, D, G, (int)blockIdx.x);
        pg8::EpiResid<1, true> E{a.x, (bf16*)(ws + WS_A1), SSQ, (const float*)(ws + WS_SSQH)};
        pg8::gemm_phase<pg8::EpiResid<1, true>, pg8::StaticOrder, true, true>(lds, g, S, E, PSE_SEL(ph));
    }
    SEAM(ph); ++ph; PMARK(ph);
    if (IN(ph)) {
        pg8::Gemm g{(const bf16*)(ws + WS_A1), (const bf16*)(ws + WS_W13_0), M, 2 * DFF, D}; pg8::StaticOrder S; S.init(M, 2 * DFF, G, (int)blockIdx.x);
        pg8::EpiSwiglu E{(bf16*)(ws + WS_A2), DFF, SSQ};
        pg8::gemm_phase<pg8::EpiSwiglu, pg8::StaticOrder, true, true>(lds, g, S, E, PSE_SEL(ph));
        { const int nun = (M / 256) * (2 * DFF / 256), rem = nun % G; const int idle0 = rem ? rem : 0, nidle = rem ? G - rem : G;
          if ((int)blockIdx.x >= idle0) { __syncthreads(); convert_l1_weights(a, lds, lane, wave, (int)blockIdx.x - idle0, nidle); } }
    }
    SEAM(ph); ++ph; PMARK(ph);
    if (IN(ph)) {
        pg8::Gemm g{(const bf16*)(ws + WS_A2), (const bf16*)(ws + WS_W2_0), M, D, DFF}; pg8::StaticOrder S; S.init(M, D, G, (int)blockIdx.x);
        pg8::EpiResid<0, false> E{(const void*)(ws + WS_A1), (bf16*)(ws + WS_A1), SSQ, nullptr};
        pg8::gemm_phase<pg8::EpiResid<0, false>, pg8::StaticOrder, true, true>(lds, g, S, E, PSE_SEL(ph));
    }
    SEAM(ph); ++ph; PMARK(ph);
    if (IN(ph)) {
        pg8::Gemm g{(const bf16*)(ws + WS_A1), (const bf16*)(ws + WS_WQKV), M, 3072, D}; pg8::StaticOrder S; S.init(M, 3072, G, (int)blockIdx.x);
        pg8::EpiQKV E{(bf16*)(ws + WS_A2), (size_t)M * D, SSQ, (float*)(ws + WS_KMEAN)};
        pg8::gemm_phase<pg8::EpiQKV, pg8::StaticOrder, true, true>(lds, g, S, E, PSE_SEL(ph));
    }
    SEAM(ph); ++ph; PMARK(ph);
    if (IN(ph)) topk_phase(a, lds, tid, lane, wave);
    SEAM(ph); ++ph; PMARK(ph);
    if (IN(ph)) attn_engine<false>(a, lds, tid, lane, wave, psec);
    SEAM(ph); ++ph; PMARK(ph);
    if (IN(ph)) attn_engine<true>(a, lds, tid, lane, wave, psec);
    SEAM(ph); ++ph; PMARK(ph);
    if (IN(ph)) {
        pg8::Gemm g{(const bf16*)(ws + WS_A2), (const bf16*)(ws + WS_WOUT1), M, D, D}; pg8::StaticOrder S; S.init(M, D, G, (int)blockIdx.x);
        pg8::EpiResid<0, false> E{(const void*)(ws + WS_A1), (bf16*)(ws + WS_A1), SSQ, nullptr};
        pg8::gemm_phase<pg8::EpiResid<0, false>, pg8::StaticOrder, true, true>(lds, g, S, E, PSE_SEL(ph));
    }
    SEAM(ph); ++ph; PMARK(ph);
    if (IN(ph)) {
        pg8::Gemm g{(const bf16*)(ws + WS_A1), (const bf16*)(ws + WS_W13_1), M, 2 * DFF, D}; pg8::StaticOrder S; S.init(M, 2 * DFF, G, (int)blockIdx.x);
        pg8::EpiSwiglu E{(bf16*)(ws + WS_A2), DFF, SSQ};
        pg8::gemm_phase<pg8::EpiSwiglu, pg8::StaticOrder, true, true>(lds, g, S, E, PSE_SEL(ph));
    }
    SEAM(ph); ++ph; PMARK(ph);
    if (IN(ph)) {
        pg8::Gemm g{(const bf16*)(ws + WS_A2), (const bf16*)(ws + WS_W2_1), M, D, DFF}; pg8::StaticOrder S; S.init(M, D, G, (int)blockIdx.x);
        pg8::EpiResid<0, false> E{(const void*)(ws + WS_A1), (bf16*)(ws + WS_A1), SSQ, nullptr};
        pg8::gemm_phase<pg8::EpiResid<0, false>, pg8::StaticOrder, true, true>(lds, g, S, E, PSE_SEL(ph));
    }
    SEAM(ph); ++ph; PMARK(ph);
    if (IN(ph)) final_norm_phase(a, lane, wave);
    ++ph; PMARK(ph);
#ifdef PROBE_LO
    if (blockIdx.x == PROBE_BLK) { const unsigned long long te = __builtin_amdgcn_s_memrealtime(); unsigned long long w = 4ull * (pt1 - pt0);
#if defined(PROBE_SEC_ATT) || defined(PROBE_HG) || defined(PROBE_GEMM_EPI)
        w = 4ull * psec;
#endif
        while (__builtin_amdgcn_s_memrealtime() - te < w) __builtin_amdgcn_s_sleep(8); }
#endif
#undef IN
#undef SEAM
#undef GEMM_PHASE
}

extern "C" void kernel_launch(void* const* d_in, const int* in_sizes, int n_in, void* d_out, int out_size, void* d_ws, size_t ws_size, hipStream_t stream) {
    static int grid = 0;
    if (grid == 0) {
        if (n_in != 13 || out_size != M * D || ws_size < WS_END) { fprintf(stderr, "kernel_launch: unexpected problem (n_in %d out %d ws %zu)\n", n_in, out_size, ws_size); grid = -1; return; }
        int dev = 0, cus = 0, per_cu = 0;
        (void)hipGetDevice(&dev); (void)hipDeviceGetAttribute(&cus, hipDeviceAttributeMultiprocessorCount, dev);
        if (hipFuncSetAttribute((const void*)mk, hipFuncAttributeMaxDynamicSharedMemorySize, LDS_BYTES) != hipSuccess) { fprintf(stderr, "kernel_launch: hipFuncSetAttribute failed\n"); grid = -1; return; }
        if (hipOccupancyMaxActiveBlocksPerMultiprocessor(&per_cu, (const void*)mk, NWAVES * 64, LDS_BYTES) != hipSuccess || per_cu < 1) { fprintf(stderr, "kernel_launch: occupancy query says %d\n", per_cu); (void)hipGetLastError(); grid = -1; return; }
        grid = cus;
        if (grid != 256) fprintf(stderr, "kernel_launch: note: %d CUs\n", grid);
    }
    if (grid < 0) return;
    Args a{};
    a.x = (const float*)d_in[0]; a.norm_mix = (const float*)d_in[1]; a.norm_ffn = (const float*)d_in[2]; a.hgrn_w_in = (const float*)d_in[3]; a.lb_logits = (const float*)d_in[4];
    a.hgrn_out_norm = (const float*)d_in[5]; a.hgrn_w_out = (const float*)d_in[6]; a.moba_w_in = (const float*)d_in[7]; a.moba_w_out = (const float*)d_in[8]; a.rel_table = (const float*)d_in[9];
    a.ffn_w13 = (const float*)d_in[10]; a.ffn_w2 = (const float*)d_in[11]; a.final_norm = (const float*)d_in[12];
    a.out = (float*)d_out; a.ws = (unsigned char*)d_ws;
    a.ph_lo = 0; a.ph_hi = 15;
    void* args[] = {&a};
    hipError_t e = hipLaunchCooperativeKernel((const void*)mk, dim3(grid), dim3(NWAVES * 64), args, LDS_BYTES, stream);
    if (e != hipSuccess) fprintf(stderr, "kernel_launch: cooperative launch failed: %s (grid %d)\n", hipGetErrorString(e), grid);
}
```

```cpp
#include <hip/hip_runtime.h>
#include <hip/hip_cooperative_groups.h>
#include <cstdio>
#include <cstdint>
#include <cmath>
namespace pg8 {
#define PG8_LAS __attribute__((address_space(3)))
typedef unsigned short bf16_t;
typedef short bf16x8 __attribute__((ext_vector_type(8)));
typedef float f32x4 __attribute__((ext_vector_type(4)));
typedef unsigned u32x4 __attribute__((ext_vector_type(4)));
constexpr int BM = 256, BK = 64, HALF = 128, HTB = HALF * BK * 2  , STAGE_BYTES = 8 * HTB, NXCD = 8, WGM = 8;

__host__ __device__ __forceinline__ int lds_byte(int r, int c) { const int st = (r >> 4) * 2 + (c >> 5), rr = r & 15, cc = c & 31, ob = rr * 64 + cc * 2; return st * 1024 + (ob ^ (((ob >> 9) & 1) << 5)); }
__host__ __device__ __forceinline__ void stage_rc(int b, int& R, int& C) { const int st = b / 1024, sb = b % 1024, swz = sb ^ (((sb >> 9) & 1) << 5); R = (st >> 1) * 16 + swz / 64; C = (st & 1) * 32 + (swz % 64) / 2; }
__host__ __device__ __forceinline__ int perm32(int rho) { const int n = rho >> 4, i = rho & 15; return 8 * (i >> 2) + 4 * n + (i & 3); }

struct Unit { int pm, pn; };
struct Gemm { const bf16_t* A; const bf16_t* Bt; int M, N, K; };

struct StaticOrder {
    int nM, nN, nwg, G, c;
    __host__ __device__ void init(int M, int N, int G_, int c_) { nM = M / BM; nN = N / BM; nwg = nM * nN; G = G_; c = c_; }
    __host__ __device__ bool next(int i, Unit& u) const {
        const long L = (long)i * G + c; if (L >= nwg) return false;
        int wgid = (int)L; { const int q = nwg / NXCD, r = nwg % NXCD, xcd = wgid % NXCD, off = wgid / NXCD; wgid = (xcd < r ? xcd * (q + 1) : r * (q + 1) + (xcd - r) * q) + off; }
        const int nig = WGM * nN, gid = wgid / nig, fm = gid * WGM, gsz = (nM - fm) < WGM ? (nM - fm) : WGM;
        u.pm = fm + ((wgid % nig) % gsz); u.pn = (wgid % nig) / gsz; return true;
    }
    __device__ __forceinline__ void a_ready(const Unit&) const {}
    __device__ __forceinline__ void done(const Unit&) const {}
};
typedef float f32x2 __attribute__((ext_vector_type(2)));
typedef __bf16 bf16x2_cv __attribute__((ext_vector_type(2)));
__device__ __forceinline__ unsigned cvt_pk_bf16(float lo, float hi) { f32x2 v = {lo, hi}; bf16x2_cv b = __builtin_convertvector(v, bf16x2_cv); return __builtin_bit_cast(unsigned, b); }
#ifndef WT_STORES
#define WT_STORES 0
#endif
__device__ __forceinline__ void st16_wt(void* p, u32x4 v) {
#if WT_STORES
    asm volatile("global_store_dwordx4 %0, %1, off sc1\n\ts_nop 1" :: "v"(p), "v"(v) : "memory");
#else
    *(u32x4*)p = v;
#endif
}

typedef unsigned u32x2 __attribute__((ext_vector_type(2)));
__device__ __forceinline__ float sigm(float x) { return __builtin_amdgcn_rcpf(1.f + __expf(-x)); }
__device__ __forceinline__ float bf2f_lo(unsigned w) { return __uint_as_float(w << 16); }
__device__ __forceinline__ float bf2f_hi(unsigned w) { return __uint_as_float(w & 0xffff0000u); }
__device__ __forceinline__ float rstd_from16(const float* p) {
    const f32x4 a = *(const f32x4*)p, b = *(const f32x4*)(p + 4), c = *(const f32x4*)(p + 8), d = *(const f32x4*)(p + 12);
    const float s = ((a[0] + a[1]) + (a[2] + a[3])) + ((b[0] + b[1]) + (b[2] + b[3])) + ((c[0] + c[1]) + (c[2] + c[3])) + ((d[0] + d[1]) + (d[2] + d[3]));
    return rsqrtf(s * (1.f / 1024.f) + 1e-6f);
}
__device__ __forceinline__ float rstd_from8(const float* p) {
    const f32x4 a = *(const f32x4*)p, b = *(const f32x4*)(p + 4);
    const float s = ((a[0] + a[1]) + (a[2] + a[3])) + ((b[0] + b[1]) + (b[2] + b[3]));
    return rsqrtf(s * (1.f / 1024.f) + 1e-6f);
}

struct EpiHgrnIn {
    static constexpr bool PERM = true, AFTER_DRAIN = false;
    bf16_t* QS; float* LF; bf16_t* IN; bf16_t* OG; const float* lb;
    __device__ __forceinline__ void operator()(const f32x4 (&acc)[2][2][4][2], const Unit& u, int wr, int wc, int fr, int fq) const {
        const int type = u.pn >> 2;
        const int row0 = u.pm * BM + wr * 64 + fr;
        const int col0 = (u.pn & 3) * BM + wc * 32 + 8 * fq;
#pragma unroll
        for (int bj = 0; bj < 2; ++bj) {
            const int c = col0 + bj * HALF;
            f32x4 l0 = (f32x4){0.f, 0.f, 0.f, 0.f}, l1 = l0;
            if (type == 1) { l0 = *(const f32x4*)(lb + c); l1 = *(const f32x4*)(lb + c + 4); }
#pragma unroll
            for (int ai = 0; ai < 2; ++ai)
#pragma unroll
                for (int m = 0; m < 4; ++m) {
                    const size_t off = (size_t)(row0 + ai * HALF + m * 16) * 1024 + c;
                    f32x4 v0 = acc[ai][bj][m][0], v1 = acc[ai][bj][m][1];
                    if (type == 1) {
#pragma unroll
                        for (int i = 0; i < 4; ++i) { v0[i] = logf(l0[i] + (1.f - l0[i]) * sigm(v0[i])); v1[i] = logf(l1[i] + (1.f - l1[i]) * sigm(v1[i])); }
                        st16_wt(LF + off, __builtin_bit_cast(u32x4, v0)); st16_wt(LF + off + 4, __builtin_bit_cast(u32x4, v1));
                    } else {
                        if (type == 0) {
#pragma unroll
                            for (int i = 0; i < 4; ++i) { v0[i] = v0[i] * sigm(v0[i]); v1[i] = v1[i] * sigm(v1[i]); }
                        } else if (type == 3) {
#pragma unroll
                            for (int i = 0; i < 4; ++i) { v0[i] = sigm(v0[i]); v1[i] = sigm(v1[i]); }
                        }
                        u32x4 w; w.x = cvt_pk_bf16(v0[0], v0[1]); w.y = cvt_pk_bf16(v0[2], v0[3]); w.z = cvt_pk_bf16(v1[0], v1[1]); w.w = cvt_pk_bf16(v1[2], v1[3]);
                        if (type == 0) st16_wt(QS + off, w);
                        else if (type == 2) st16_wt(IN + off, w);
                        else st16_wt(OG + off, w);
                    }
                }
        }
    }
};

template <int SCALE, bool RF32>
struct EpiResid {
    static constexpr bool PERM = true, AFTER_DRAIN = false;
    const void* R; bf16_t* HB; float* SSQ; const float* SSQIN;
    __device__ __forceinline__ void operator()(const f32x4 (&acc)[2][2][4][2], const Unit& u, int wr, int wc, int fr, int fq) const {
        const int col0 = u.pn * BM + wc * 32 + 8 * fq;
#pragma unroll
        for (int ai = 0; ai < 2; ++ai)
#pragma unroll
            for (int m = 0; m < 4; ++m) {
                const int row = u.pm * BM + ai * HALF + wr * 64 + m * 16 + fr;
                float sc = 1.f;
                if (SCALE == 1) sc = rstd_from8(SSQIN + (size_t)row * 8);
                const size_t off = (size_t)row * 1024 + col0;
                float ss = 0.f;
#pragma unroll
                for (int bj = 0; bj < 2; ++bj) {
                    const size_t o2 = off + bj * HALF;
                    f32x4 r0, r1;
                    if (RF32) { r0 = *(const f32x4*)((const float*)R + o2); r1 = *(const f32x4*)((const float*)R + o2 + 4); }
                    else { const u32x4 rw = *(const u32x4*)((const bf16_t*)R + o2);
                        r0 = (f32x4){bf2f_lo(rw.x), bf2f_hi(rw.x), bf2f_lo(rw.y), bf2f_hi(rw.y)}; r1 = (f32x4){bf2f_lo(rw.z), bf2f_hi(rw.z), bf2f_lo(rw.w), bf2f_hi(rw.w)}; }
                    const f32x4 v0 = r0 + acc[ai][bj][m][0] * sc, v1 = r1 + acc[ai][bj][m][1] * sc;
                    ss += ((v0[0] * v0[0] + v0[1] * v0[1]) + (v0[2] * v0[2] + v0[3] * v0[3])) + ((v1[0] * v1[0] + v1[1] * v1[1]) + (v1[2] * v1[2] + v1[3] * v1[3]));
                    u32x4 w; w.x = cvt_pk_bf16(v0[0], v0[1]); w.y = cvt_pk_bf16(v0[2], v0[3]); w.z = cvt_pk_bf16(v1[0], v1[1]); w.w = cvt_pk_bf16(v1[2], v1[3]);
                    st16_wt(HB + o2, w);
                }
                ss += __shfl_xor(ss, 16); ss += __shfl_xor(ss, 32);
                if (fq == 0) SSQ[(size_t)row * 16 + u.pn * 4 + wc] = ss;
                if (m & 1) asm volatile("" ::: "memory");
            }
    }
};

struct EpiSwiglu {
    static constexpr bool PERM = true, AFTER_DRAIN = false;
    bf16_t* HID; int ldh; const float* SSQIN;
    __device__ __forceinline__ void operator()(const f32x4 (&acc)[2][2][4][2], const Unit& u, int wr, int wc, int fr, int fq) const {
        const int col0 = u.pn * HALF + wc * 32 + 8 * fq;
#pragma unroll
        for (int ai = 0; ai < 2; ++ai)
#pragma unroll
            for (int m = 0; m < 4; ++m) {
                const int row = u.pm * BM + ai * HALF + wr * 64 + m * 16 + fr;
                const float sc = rstd_from16(SSQIN + (size_t)row * 16);
                f32x4 g0 = acc[ai][0][m][0] * sc, g1 = acc[ai][0][m][1] * sc, u0 = acc[ai][1][m][0] * sc, u1 = acc[ai][1][m][1] * sc;
#pragma unroll
                for (int i = 0; i < 4; ++i) { g0[i] = g0[i] * sigm(g0[i]) * u0[i]; g1[i] = g1[i] * sigm(g1[i]) * u1[i]; }
                u32x4 w; w.x = cvt_pk_bf16(g0[0], g0[1]); w.y = cvt_pk_bf16(g0[2], g0[3]); w.z = cvt_pk_bf16(g1[0], g1[1]); w.w = cvt_pk_bf16(g1[2], g1[3]);
                st16_wt(HID + (size_t)row * ldh + col0, w);
            }
    }
};

struct EpiQKV {
    static constexpr bool PERM = true, AFTER_DRAIN = false;
    bf16_t* O; size_t split_stride; const float* SSQIN; float* KMEAN;
    __device__ __forceinline__ void operator()(const f32x4 (&acc)[2][2][4][2], const Unit& u, int wr, int wc, int fr, int fq) const {
        const int t = u.pn >> 2;
        bf16_t* base = O + (size_t)t * split_stride;
        const int col0 = (u.pn & 3) * BM + wc * 32 + 8 * fq;
        f32x4 cs[2][2];
#pragma unroll
        for (int bj = 0; bj < 2; ++bj) { cs[bj][0] = (f32x4){0.f, 0.f, 0.f, 0.f}; cs[bj][1] = cs[bj][0]; }
#pragma unroll
        for (int ai = 0; ai < 2; ++ai)
#pragma unroll
            for (int m = 0; m < 4; ++m) {
                const int row = u.pm * BM + ai * HALF + wr * 64 + m * 16 + fr;
                const float sc = rstd_from16(SSQIN + (size_t)row * 16);
#pragma unroll
                for (int bj = 0; bj < 2; ++bj) {
                    const f32x4 v0 = acc[ai][bj][m][0] * sc, v1 = acc[ai][bj][m][1] * sc;
                    cs[bj][0] += v0; cs[bj][1] += v1;
                    u32x4 w; w.x = cvt_pk_bf16(v0[0], v0[1]); w.y = cvt_pk_bf16(v0[2], v0[3]); w.z = cvt_pk_bf16(v1[0], v1[1]); w.w = cvt_pk_bf16(v1[2], v1[3]);
                    st16_wt(base + (size_t)row * 1024 + col0 + bj * HALF, w);
                }
            }
        if (t == 1) {
#pragma unroll
            for (int bj = 0; bj < 2; ++bj)
#pragma unroll
                for (int n = 0; n < 2; ++n)
#pragma unroll
                    for (int i = 0; i < 4; ++i) {
                        float s = cs[bj][n][i];
                        s += __shfl_xor(s, 1); s += __shfl_xor(s, 2); s += __shfl_xor(s, 4); s += __shfl_xor(s, 8);
                        if (fr == 0) atomicAdd(KMEAN + (size_t)u.pm * 1024 + col0 + bj * HALF + 4 * n + i, s * (1.f / 256.f));
                    }
        }
    }
};

#ifdef PROBE_GEMM_EPI
#define PG8_PS_B() do { __builtin_amdgcn_sched_barrier(0); psec -= __builtin_amdgcn_s_memrealtime(); __builtin_amdgcn_sched_barrier(0); } while (0)
#define PG8_PS_E() do { __builtin_amdgcn_sched_barrier(0); psec += __builtin_amdgcn_s_memrealtime(); __builtin_amdgcn_sched_barrier(0); } while (0)
#else
#define PG8_PS_B() do { } while (0)
#define PG8_PS_E() do { } while (0)
#endif
template <class Epi, class Sched, bool ALIGN_EPI = false, bool SP2 = false>
__device__ __forceinline__ void gemm_phase(PG8_LAS unsigned char* lds, const Gemm g, const Sched& S, const Epi& E, unsigned long long& psec) {
    const int tid = threadIdx.x, wid = __builtin_amdgcn_readfirstlane(tid >> 6), lane = tid & 63, wr = wid >> 2, wc = wid & 3, fr = lane & 15, fq = lane >> 4;
    const int K = g.K, nt = K / BK;
    unsigned voffA[2], voffB[2];
#pragma unroll
    for (int i = 0; i < 2; ++i) { int R, C; stage_rc(tid * 16 + i * 8192, R, C); const int Rb = Epi::PERM ? ((R & ~31) + perm32(R & 31)) : R;
        voffA[i] = (unsigned)(R * K + C) * 2u; voffB[i] = (unsigned)(Rb * K + C) * 2u; }
    const size_t kstep = (size_t)(BK * 2);
    const size_t hstep = (size_t)HALF * K * 2;
    const size_t tstep = 2 * hstep;
    const unsigned ldsw = (unsigned)wid * 1024u;
    const int aoff = lds_byte(wr * 64 + fr, fq * 8), boff = lds_byte(wc * 32 + fr, fq * 8);
#define PG8_SA(b, h) (((b) * 2 + (h)) * HTB)
#define PG8_SB(b, h) ((4 + (b) * 2 + (h)) * HTB)
#define PG8_STAGE(bufoff, gbase, voff) do { _Pragma("unroll") for (int _i = 0; _i < 2; ++_i) \
        __builtin_amdgcn_global_load_lds((const unsigned*)((const char*)(gbase) + (voff)[_i]), (PG8_LAS unsigned*)(lds + (bufoff) + ldsw + _i * 8192), 16, 0, 0); } while (0)
#define PG8_LDA(dst, b, h) do { _Pragma("unroll") for (int m = 0; m < 4; ++m) _Pragma("unroll") for (int k = 0; k < 2; ++k) dst[m][k] = *(const PG8_LAS bf16x8*)(lds + PG8_SA(b, h) + aoff + m * 2048 + k * 1024); } while (0)
#define PG8_LDB(dst, b, h) do { _Pragma("unroll") for (int n = 0; n < 2; ++n) _Pragma("unroll") for (int k = 0; k < 2; ++k) dst[n][k] = *(const PG8_LAS bf16x8*)(lds + PG8_SB(b, h) + boff + n * 2048 + k * 1024); } while (0)
#define PG8_MMA(ai, bj, At, Bt) do { __builtin_amdgcn_s_setprio(1); _Pragma("unroll") for (int m = 0; m < 4; ++m) _Pragma("unroll") for (int n = 0; n < 2; ++n) _Pragma("unroll") for (int k = 0; k < 2; ++k) \
        acc[ai][bj][m][n] = __builtin_amdgcn_mfma_f32_16x16x32_bf16(Bt[n][k], At[m][k], acc[ai][bj][m][n], 0, 0, 0); __builtin_amdgcn_s_setprio(0); } while (0)
#define PG8_WAIT_V(n) asm volatile("s_waitcnt vmcnt(" #n ")" ::: "memory")
#define PG8_WAIT_L(n) asm volatile("s_waitcnt lgkmcnt(" #n ")" ::: "memory")
#define PG8_BAR __builtin_amdgcn_s_barrier()
#define PG8_SCHED __builtin_amdgcn_sched_barrier(0)
    Unit cur, nxt; int ui = 0;
    if (!S.next(0, cur)) return;
    f32x4 acc[2][2][4][2];
#pragma unroll
    for (int a = 0; a < 2; ++a)
#pragma unroll
        for (int b = 0; b < 2; ++b)
#pragma unroll
            for (int m = 0; m < 4; ++m)
#pragma unroll
                for (int n = 0; n < 2; ++n) acc[a][b][m][n] = (f32x4){0.f, 0.f, 0.f, 0.f};
    bf16x8 At[4][2], B0[2][2], B1[2][2];
    const char* cA = (const char*)g.A + (size_t)cur.pm * tstep; const char* cB = (const char*)g.Bt + (size_t)cur.pn * tstep;
    S.a_ready(cur);
    if constexpr (SP2) {
        PG8_STAGE(PG8_SB(0, 0), cB, voffB); PG8_STAGE(PG8_SB(0, 1), cB + hstep, voffB); PG8_STAGE(PG8_SA(0, 0), cA, voffA); PG8_STAGE(PG8_SA(0, 1), cA + hstep, voffA);
        if (wr == 1) PG8_BAR;
        PG8_WAIT_V(2); PG8_BAR;
        PG8_STAGE(PG8_SB(1, 0), cB + kstep, voffB); PG8_STAGE(PG8_SA(1, 0), cA + kstep, voffA); PG8_STAGE(PG8_SB(1, 1), cB + hstep + kstep, voffB);
        PG8_WAIT_V(6); PG8_BAR;
    } else {
        PG8_STAGE(PG8_SB(0, 0), cB, voffB); PG8_STAGE(PG8_SA(0, 0), cA, voffA); PG8_STAGE(PG8_SB(0, 1), cB + hstep, voffB); PG8_STAGE(PG8_SA(0, 1), cA + hstep, voffA);
        if (wr == 1) PG8_BAR;
        PG8_WAIT_V(4); PG8_BAR;
        PG8_STAGE(PG8_SB(1, 0), cB + kstep, voffB); PG8_STAGE(PG8_SA(1, 0), cA + kstep, voffA); PG8_STAGE(PG8_SB(1, 1), cB + hstep + kstep, voffB);
        PG8_WAIT_V(6); PG8_BAR;
    }
    for (;;) {
        const bool has_next = S.next(ui + 1, nxt);
        const char* nA = has_next ? (const char*)g.A + (size_t)nxt.pm * tstep : cA; const char* nB = has_next ? (const char*)g.Bt + (size_t)nxt.pn * tstep : cB;
        for (int t = 0; t < nt; t += 2) {
            const bool last = (t == nt - 2);
            const char* a1 = cA + (size_t)(t + 1) * kstep;
            const char* a2 = last ? nA : cA + (size_t)(t + 2) * kstep; const char* b2 = last ? nB : cB + (size_t)(t + 2) * kstep;
            const char* a3 = a2 + kstep; const char* b3 = b2 + kstep;
            if (last && has_next) S.a_ready(nxt);
            if constexpr (SP2) {
            PG8_LDB(B0, 0, 0); PG8_LDB(B1, 0, 1); PG8_SCHED; PG8_LDA(At, 0, 0); PG8_STAGE(PG8_SA(1, 1), a1 + hstep, voffA);
            PG8_WAIT_V(8); PG8_WAIT_L(0); PG8_BAR; PG8_MMA(0, 0, At, B0); PG8_MMA(0, 1, At, B1); PG8_BAR; PG8_SCHED;
            PG8_LDA(At, 0, 1); PG8_STAGE(PG8_SB(0, 0), b2, voffB); PG8_STAGE(PG8_SB(0, 1), b2 + hstep, voffB); PG8_STAGE(PG8_SA(0, 0), a2, voffA);
            PG8_WAIT_V(8); PG8_WAIT_L(0); PG8_BAR; PG8_MMA(1, 0, At, B0); PG8_MMA(1, 1, At, B1); PG8_BAR; PG8_SCHED;
            PG8_LDB(B0, 1, 0); PG8_LDB(B1, 1, 1); PG8_SCHED; PG8_LDA(At, 1, 0); PG8_STAGE(PG8_SA(0, 1), a2 + hstep, voffA);
            PG8_WAIT_V(8); PG8_WAIT_L(0); PG8_BAR; PG8_MMA(0, 0, At, B0); PG8_MMA(0, 1, At, B1); PG8_BAR; PG8_SCHED;
            PG8_LDA(At, 1, 1); PG8_STAGE(PG8_SB(1, 0), b3, voffB); PG8_STAGE(PG8_SB(1, 1), b3 + hstep, voffB); PG8_STAGE(PG8_SA(1, 0), a3, voffA);
            PG8_WAIT_V(8); PG8_WAIT_L(0); PG8_BAR; PG8_MMA(1, 0, At, B0); PG8_MMA(1, 1, At, B1); PG8_BAR; PG8_SCHED;
            } else {
            PG8_LDB(B0, 0, 0); PG8_SCHED; PG8_LDA(At, 0, 0); PG8_STAGE(PG8_SA(1, 1), a1 + hstep, voffA);
            PG8_WAIT_L(8); PG8_BAR; PG8_WAIT_L(0); PG8_MMA(0, 0, At, B0); PG8_BAR; PG8_SCHED;
            PG8_LDB(B1, 0, 1); PG8_STAGE(PG8_SB(0, 0), b2, voffB);
            PG8_BAR; PG8_WAIT_L(0); PG8_MMA(0, 1, At, B1); PG8_BAR;
            PG8_LDA(At, 0, 1); PG8_STAGE(PG8_SA(0, 0), a2, voffA);
            PG8_BAR; PG8_WAIT_L(0); PG8_MMA(1, 0, At, B0); PG8_BAR; PG8_SCHED;
            PG8_STAGE(PG8_SB(0, 1), b2 + hstep, voffB);
            PG8_WAIT_V(6); PG8_BAR; PG8_MMA(1, 1, At, B1); PG8_BAR;
            PG8_LDB(B0, 1, 0); PG8_SCHED; PG8_LDA(At, 1, 0); PG8_STAGE(PG8_SA(0, 1), a2 + hstep, voffA);
            PG8_WAIT_L(8); PG8_BAR; PG8_WAIT_L(0); PG8_MMA(0, 0, At, B0); PG8_BAR; PG8_SCHED;
            PG8_LDB(B1, 1, 1); PG8_STAGE(PG8_SB(1, 0), b3, voffB);
            PG8_BAR; PG8_WAIT_L(0); PG8_MMA(0, 1, At, B1); PG8_BAR;
            PG8_LDA(At, 1, 1); PG8_STAGE(PG8_SA(1, 0), a3, voffA);
            PG8_BAR; PG8_WAIT_L(0); PG8_MMA(1, 0, At, B0); PG8_BAR; PG8_SCHED;
            PG8_STAGE(PG8_SB(1, 1), b3 + hstep, voffB);
            PG8_WAIT_V(6); PG8_BAR; PG8_MMA(1, 1, At, B1); PG8_BAR;
            }
        }
        if constexpr (ALIGN_EPI) { if (wr == 0) PG8_BAR; }
        if constexpr (!Epi::AFTER_DRAIN) { PG8_PS_B(); E(acc, cur, wr, wc, fr, fq); S.done(cur); PG8_PS_E(); }
        if (!has_next) break;
#pragma unroll
        for (int a = 0; a < 2; ++a)
#pragma unroll
            for (int b = 0; b < 2; ++b)
#pragma unroll
                for (int m = 0; m < 4; ++m)
#pragma unroll
                    for (int n = 0; n < 2; ++n) acc[a][b][m][n] = (f32x4){0.f, 0.f, 0.f, 0.f};
        cur = nxt; cA = nA; cB = nB; ++ui;
        if constexpr (ALIGN_EPI) { if (wr == 1) PG8_BAR; }
    }
    PG8_WAIT_V(0);
    if constexpr (!ALIGN_EPI) { if (wr == 0) PG8_BAR; }
    PG8_BAR;
    if constexpr (Epi::AFTER_DRAIN) { E.fused(acc, cur, wr, wc, fr, fq, lds, wid, lane); S.done(cur); }
#undef PG8_SA
#undef PG8_SB
#undef PG8_STAGE
#undef PG8_LDA
#undef PG8_LDB
#undef PG8_MMA
#undef PG8_WAIT_V
#undef PG8_WAIT_L
#undef PG8_BAR
#undef PG8_SCHED
}
}

namespace cg = cooperative_groups;
constexpr int NWAVES = 8;
constexpr int BATCH = 2, T = 8192, D = 1024, H = 8, DH = 128, DFF = 2816, NB = 32, BLK = 256;
constexpr int M = BATCH * T;
constexpr float EPS = 1e-6f;
constexpr size_t MiB = 1u << 20;
constexpr size_t WS_CTL = 0;
constexpr size_t WS_WQKV = 1 * MiB, WS_WOUT1 = 7 * MiB, WS_W13_1 = 9 * MiB, WS_W2_1 = 20 * MiB;
constexpr size_t WS_WIN0 = 26 * MiB, WS_WOUT0 = 34 * MiB, WS_W13_0 = 36 * MiB, WS_W2_0 = 47 * MiB;
constexpr size_t WS_SSQ = 53 * MiB;
constexpr size_t WS_SSQH = 54 * MiB;
constexpr size_t WS_LB = 54 * MiB + 512 * 1024;
constexpr size_t WS_BKT = WS_LB + 4096;
constexpr size_t WS_YMEAN = WS_BKT + 32768;
constexpr size_t WS_KMEAN = WS_YMEAN + 262144;
constexpr size_t WS_SEL = 55 * MiB + 512 * 1024;
constexpr size_t WS_G = 56 * MiB;
constexpr size_t WS_A0 = 60 * MiB;
constexpr size_t WS_A1 = 92 * MiB;
constexpr size_t WS_A2 = 124 * MiB;
constexpr size_t WS_A3 = 188 * MiB;
constexpr size_t WS_A4 = 220 * MiB;
constexpr size_t WS_END = 256 * MiB;
static_assert(WS_W2_0 + (size_t)D * DFF * 2 <= WS_SSQ && WS_G + 2 * MiB <= WS_A0 && WS_A4 + 32 * MiB <= WS_END, "ws map");

constexpr int LDS_BYTES = 163840;
constexpr int LDS_MISC = 163584;
constexpr size_t WS_BAR = 65536;

#define GAS __attribute__((address_space(1)))
#define LAS __attribute__((address_space(3)))
typedef unsigned short bf16;
typedef unsigned v4u __attribute__((ext_vector_type(4)));
typedef float f32x4 __attribute__((ext_vector_type(4)));
#define LDS_WAIT() asm volatile("s_waitcnt lgkmcnt(0)" ::: "memory")
__device__ __forceinline__ unsigned f2bf(float f) { unsigned u = __builtin_bit_cast(unsigned, f); return (u + 0x7fffu + ((u >> 16) & 1u)) >> 16; }
__device__ __forceinline__ unsigned pk2(float lo, float hi) { return f2bf(lo) | (f2bf(hi) << 16); }
__device__ __forceinline__ float bf2f(unsigned short b) { return __uint_as_float((unsigned)b << 16); }
__device__ __forceinline__ float wave_sum(float v) {
#pragma unroll
    for (int o = 1; o < 64; o <<= 1) v += __shfl_xor(v, o);
    return v;
}

struct Args {
    const float* x; const float* norm_mix; const float* norm_ffn; const float* hgrn_w_in; const float* lb_logits; const float* hgrn_out_norm; const float* hgrn_w_out;
    const float* moba_w_in; const float* moba_w_out; const float* rel_table; const float* ffn_w13; const float* ffn_w2; const float* final_norm;
    float* out; unsigned char* ws; int ph_lo, ph_hi;
};

__device__ __forceinline__ void tr_item(const float* W, int ldw, int K, bf16* WT, int Ndst, const float* gain, int mode, LAS float* scr, int item, int lane) {
    const int nblk = Ndst / 64, kb = item / nblk, nb = item % nblk, k0 = 64 * kb, n0 = 64 * nb;
    int s0 = n0;
    if (mode == 1) { const int t = n0 >> 8, c = n0 & 255; s0 = (c < 128) ? (128 * t + c) : (DFF + 128 * t + (c - 128)); }
    f32x4 wv[16];
#pragma unroll
    for (int i = 0; i < 16; ++i) wv[i] = *(const GAS f32x4*)(W + (size_t)(k0 + 4 * i + (lane >> 4)) * ldw + s0 + (lane & 15) * 4);
#pragma unroll
    for (int i = 0; i < 16; ++i) { const int kk = 4 * i + (lane >> 4);
        f32x4 w = wv[i];
        if (gain) w = w * gain[k0 + kk];
        LAS float* d = scr + kk * 65 + (lane & 15) * 4; d[0] = w.x; d[1] = w.y; d[2] = w.z; d[3] = w.w; }
    LDS_WAIT(); asm volatile("" ::: "memory");
    const int c = lane & 7;
#pragma unroll
    for (int j = 0; j < 8; ++j) { const int n = (lane >> 3) + 8 * j; const LAS float* s = scr + (8 * c) * 65 + n;
        v4u o; o.x = pk2(s[0 * 65], s[1 * 65]); o.y = pk2(s[2 * 65], s[3 * 65]); o.z = pk2(s[4 * 65], s[5 * 65]); o.w = pk2(s[6 * 65], s[7 * 65]);
        *(GAS v4u*)(WT + (size_t)(n0 + n) * K + k0 + 8 * c) = o; }
    LDS_WAIT(); asm volatile("" ::: "memory");
}

__device__ __forceinline__ void prologue(const Args& a, LAS unsigned char* lds, int tid, int lane, int wave) {
    unsigned char* ws = a.ws;
    LAS float* scr = (LAS float*)(lds + wave * 16640);
    const int gw = blockIdx.x * NWAVES + wave, NGW = gridDim.x * NWAVES;
    constexpr int I_IN0 = (D / 64) * (4096 / 64), I_O = (D / 64) * (D / 64), I_13 = (D / 64) * (2 * DFF / 64), I_2 = (DFF / 64) * (D / 64);
    constexpr int NITEMS = I_IN0 + I_O + I_13 + I_2;
    for (int it = gw; it < NITEMS; it += NGW) {
        int r = it;
        if (r < I_IN0) { tr_item(a.hgrn_w_in, 4096, D, (bf16*)(ws + WS_WIN0), 4096, nullptr, 0, scr, r, lane); continue; } r -= I_IN0;
        if (r < I_O) { tr_item(a.hgrn_w_out, D, D, (bf16*)(ws + WS_WOUT0), D, a.hgrn_out_norm, 0, scr, r, lane); continue; } r -= I_O;
        if (r < I_13) { tr_item(a.ffn_w13, 2 * DFF, D, (bf16*)(ws + WS_W13_0), 2 * DFF, a.norm_ffn, 1, scr, r, lane); continue; } r -= I_13;
        tr_item(a.ffn_w2, D, DFF, (bf16*)(ws + WS_W2_0), D, nullptr, 0, scr, r, lane);
    }
    bf16* XN0 = (bf16*)(ws + WS_A0);
    for (int m = 2 * gw; m < M; m += 2 * NGW) {
        const GAS f32x4* xr = (const GAS f32x4*)(a.x + (size_t)m * D) + lane;
        f32x4 v[8]; float s0 = 0.f, s1 = 0.f;
#pragma unroll
        for (int j = 0; j < 8; ++j) v[j] = xr[64 * j];
#pragma unroll
        for (int j = 0; j < 4; ++j) { s0 += (v[j].x * v[j].x + v[j].y * v[j].y) + (v[j].z * v[j].z + v[j].w * v[j].w); s1 += (v[4 + j].x * v[4 + j].x + v[4 + j].y * v[4 + j].y) + (v[4 + j].z * v[4 + j].z + v[4 + j].w * v[4 + j].w); }
        const float r0 = rsqrtf(wave_sum(s0) * (1.f / D) + EPS), r1 = rsqrtf(wave_sum(s1) * (1.f / D) + EPS);
        GAS unsigned long long* o8 = (GAS unsigned long long*)(XN0 + (size_t)m * D) + lane;
#pragma unroll
        for (int j = 0; j < 8; ++j) { const f32x4 g = *((const GAS f32x4*)a.norm_mix + lane + 64 * (j & 3)); const float rs = j < 4 ? r0 : r1;
            o8[64 * j] = (unsigned long long)pk2(v[j].x * rs * g.x, v[j].y * rs * g.y) | ((unsigned long long)pk2(v[j].z * rs * g.z, v[j].w * rs * g.w) << 32); }
    }
    for (int i = blockIdx.x * (NWAVES * 64) + tid; i < 64 * D; i += gridDim.x * NWAVES * 64) ((float*)(ws + WS_KMEAN))[i] = 0.f;
    if (blockIdx.x == 0) {
        float* lb = (float*)(ws + WS_LB); int* bkt = (int*)(ws + WS_BKT);
        for (int i = tid; i < 1024; i += NWAVES * 64) { const float l0 = a.lb_logits[i], l1 = a.lb_logits[1024 + i]; const float mx = fmaxf(l0, l1); const float e0 = expf(l0 - mx), e1 = expf(l1 - mx); lb[i] = e0 / (e0 + e1); }
        for (int i = tid; i < T; i += NWAVES * 64) {
            int bk;
            if (i < 16) bk = i;
            else { const float nf = (float)i; const float v = logf(nf / 16.f) / 4.1588830833596715f * 16.f; bk = 16 + (int)v; if (bk > 31) bk = 31; }
            bkt[i] = bk;
            if (i < 1024) { float* tab2 = (float*)(ws + WS_YMEAN);
#pragma unroll
                for (int hh = 0; hh < 8; ++hh) tab2[hh * 1024 + i] = a.rel_table[bk * 8 + hh] * 1.4426950408889634f; }
        }
        for (int i = tid; i < 1024; i += NWAVES * 64) ((unsigned*)(ws + 4096))[i] = 0u;
        for (int i = tid; i < 3456; i += NWAVES * 64) ((unsigned*)(ws + WS_BAR))[i] = 0u;
    }
}

__device__ __forceinline__ void convert_l1_weights(const Args& a, LAS unsigned char* lds, int lane, int wave, int rank, int nrank) {
    unsigned char* ws = a.ws;
    LAS float* scr = (LAS float*)(lds + wave * 16640);
    const int gw = rank * NWAVES + wave, NGW = nrank * NWAVES;
    constexpr int I_O = (D / 64) * (D / 64), I_13 = (D / 64) * (2 * DFF / 64), I_2 = (DFF / 64) * (D / 64), I_QKV = (D / 64) * (3072 / 64);
    constexpr int NITEMS = I_QKV + I_O + I_13 + I_2;
    for (int it = gw; it < NITEMS; it += NGW) {
        int r = it;
        if (r < I_QKV) { tr_item(a.moba_w_in, 3072, D, (bf16*)(ws + WS_WQKV), 3072, a.norm_mix + D, 0, scr, r, lane); continue; } r -= I_QKV;
        if (r < I_O) { tr_item(a.moba_w_out, D, D, (bf16*)(ws + WS_WOUT1), D, nullptr, 0, scr, r, lane); continue; } r -= I_O;
        if (r < I_13) { tr_item(a.ffn_w13 + (size_t)D * 2 * DFF, 2 * DFF, D, (bf16*)(ws + WS_W13_1), 2 * DFF, a.norm_ffn + D, 1, scr, r, lane); continue; } r -= I_13;
        tr_item(a.ffn_w2 + (size_t)DFF * D, D, DFF, (bf16*)(ws + WS_W2_1), D, nullptr, 0, scr, r, lane);
    }
}

__device__ __forceinline__ void final_norm_phase(const Args& a, int lane, int wave) {
    const int gw = blockIdx.x * NWAVES + wave, NGW = gridDim.x * NWAVES;
    const float* SSQ = (const float*)(a.ws + WS_SSQ); const bf16* HB = (const bf16*)(a.ws + WS_A1);
    for (int m = gw; m < M; m += NGW) {
        const float rstd = pg8::rstd_from16(SSQ + (size_t)m * 16);
        const GAS v4u* hr = (const GAS v4u*)(HB + (size_t)m * D) + lane;
        GAS f32x4* orow = (GAS f32x4*)(a.out + (size_t)m * D);
#pragma unroll
        for (int j = 0; j < 2; ++j) {
            const v4u w = hr[64 * j]; const int c = (64 * j + lane) * 8;
            const f32x4 g0 = *(const GAS f32x4*)(a.final_norm + c), g1 = *(const GAS f32x4*)(a.final_norm + c + 4);
            f32x4 o0, o1;
            o0.x = __uint_as_float(w.x << 16) * rstd * g0.x; o0.y = __uint_as_float(w.x & 0xffff0000u) * rstd * g0.y; o0.z = __uint_as_float(w.y << 16) * rstd * g0.z; o0.w = __uint_as_float(w.y & 0xffff0000u) * rstd * g0.w;
            o1.x = __uint_as_float(w.z << 16) * rstd * g1.x; o1.y = __uint_as_float(w.z & 0xffff0000u) * rstd * g1.y; o1.z = __uint_as_float(w.w << 16) * rstd * g1.z; o1.w = __uint_as_float(w.w & 0xffff0000u) * rstd * g1.w;
            orow[c / 4] = o0; orow[c / 4 + 1] = o1;
        }
    }
}

__device__ __forceinline__ float sigmoidf_(float x) { return 1.f / (1.f + __expf(-x)); }

namespace moba {
using bf16x8 = __attribute__((ext_vector_type(8))) short;
using s16x4 = __attribute__((ext_vector_type(4))) short;
using f32x16 = __attribute__((ext_vector_type(16))) float;
using u32x4 = __attribute__((ext_vector_type(4))) unsigned;
#define KSWZ(row, colB) ((row) * 256 + ((colB) ^ (((row) & 7) << 4)))
#define SBAR() __builtin_amdgcn_sched_barrier(0)
constexpr float C2 = 0.08838834764831845f * 1.4426950408889634f;
constexpr float LOG2E = 1.4426950408889634f;
__device__ __forceinline__ int crow(int r, int hi) { return (r & 3) + 8 * (r >> 2) + 4 * hi; }
__device__ __forceinline__ unsigned cvtpk(float lo, float hi) { return pg8::cvt_pk_bf16(lo, hi); }
__device__ __forceinline__ int v_st(int k, int c) { const int kk = (k & ~0xC) | ((k & 4) << 1) | ((k & 8) >> 1); return ((kk >> 3) * 4 + (c >> 5)) * 512 + ((kk & 7) * 32 + (c & 31)) * 2; }
__device__ __forceinline__ int v_rd_base(int lane) { return ((lane & 3) << 3) | (((lane >> 2) & 3) << 6) | (((lane >> 4) & 1) << 5) | (((lane >> 5) & 1) << 8); }
constexpr int v_rd_off(int d0, int ks, int half) { return d0 * 512 + ks * 4096 + half * 2048; }
template <int OFF> __device__ __forceinline__ s16x4 tr_read(int vb) {
    s16x4 r; asm volatile("ds_read_b64_tr_b16 %0, %1 offset:%2" : "=&v"(r) : "v"(vb), "i"(OFF) : "memory"); return r;
}
template <int D0> __device__ __forceinline__ void pv_one(f32x16& od, int vb, bf16x8 pa0, bf16x8 pa1, bf16x8 pa2, bf16x8 pa3) {
    const s16x4 l0 = tr_read<v_rd_off(D0, 0, 0)>(vb), h0 = tr_read<v_rd_off(D0, 0, 1)>(vb), l1 = tr_read<v_rd_off(D0, 1, 0)>(vb), h1 = tr_read<v_rd_off(D0, 1, 1)>(vb);
    const s16x4 l2 = tr_read<v_rd_off(D0, 2, 0)>(vb), h2 = tr_read<v_rd_off(D0, 2, 1)>(vb), l3 = tr_read<v_rd_off(D0, 3, 0)>(vb), h3 = tr_read<v_rd_off(D0, 3, 1)>(vb);
    asm volatile("s_waitcnt lgkmcnt(0)" ::: "memory"); SBAR();
#define PK(L, Hh) (bf16x8){L[0], L[1], L[2], L[3], Hh[0], Hh[1], Hh[2], Hh[3]}
    od = __builtin_amdgcn_mfma_f32_32x32x16_bf16(pa0, PK(l0, h0), od, 0, 0, 0);
    od = __builtin_amdgcn_mfma_f32_32x32x16_bf16(pa1, PK(l1, h1), od, 0, 0, 0);
    od = __builtin_amdgcn_mfma_f32_32x32x16_bf16(pa2, PK(l2, h2), od, 0, 0, 0);
    od = __builtin_amdgcn_mfma_f32_32x32x16_bf16(pa3, PK(l3, h3), od, 0, 0, 0);
#undef PK
}
__device__ __forceinline__ void qkt(f32x16& p0, f32x16& p1, const LAS unsigned char* Ks, const bf16x8 (&qr)[8], int r32, int hi) {
    p0 = f32x16{}; p1 = f32x16{};
#pragma unroll
    for (int d0 = 0; d0 < 8; ++d0) { const int cb = (d0 * 16 + hi * 8) * 2;
        const bf16x8 b0 = *(const LAS bf16x8*)(Ks + KSWZ(r32, cb));
        const bf16x8 b1 = *(const LAS bf16x8*)(Ks + KSWZ(32 + r32, cb));
        p0 = __builtin_amdgcn_mfma_f32_32x32x16_bf16(b0, qr[d0], p0, 0, 0, 0);
        p1 = __builtin_amdgcn_mfma_f32_32x32x16_bf16(b1, qr[d0], p1, 0, 0, 0); }
}
}

constexpr size_t WS_CNT = 4096;
constexpr size_t WS_TAB2 = WS_YMEAN;
constexpr size_t WS_LIST = WS_WIN0;
constexpr size_t WS_LSE = WS_G;
constexpr size_t WS_PO0 = WS_A0, WS_PO2 = WS_A4;

__device__ __forceinline__ void topk_phase(const Args& a, LAS unsigned char* lds, int tid, int lane, int wid) {
    using namespace moba;
    const bf16* Q = (const bf16*)(a.ws + WS_A2); const float* kmean = (const float*)(a.ws + WS_KMEAN);
    unsigned* cnt = (unsigned*)(a.ws + WS_CNT); unsigned short* lists = (unsigned short*)(a.ws + WS_LIST);
    LAS unsigned* lcnt = (LAS unsigned*)lds;
    const int r32 = lane & 31, hi = lane >> 5;
    for (int it = blockIdx.x; it < 512; it += gridDim.x) {
        const int bh = it >> 5, j = it & 31, b = bh >> 3, h = bh & 7;
        if (j == 0) continue;
        __syncthreads();
        if (tid < 64) lcnt[tid] = 0u;
        __syncthreads();
        bf16x8 ahi[8], alo[8];
        const float* kp = kmean + (size_t)(b * 32 + r32) * D + h * 128 + hi * 8;
#pragma unroll
        for (int ks = 0; ks < 8; ++ks) {
            const f32x4 v0 = *(const f32x4*)(kp + 16 * ks), v1 = *(const f32x4*)(kp + 16 * ks + 4);
            const unsigned h0 = pk2(v0[0], v0[1]), h1 = pk2(v0[2], v0[3]), h2 = pk2(v1[0], v1[1]), h3 = pk2(v1[2], v1[3]);
            const unsigned l0 = pk2(v0[0] - __uint_as_float(h0 << 16), v0[1] - __uint_as_float(h0 & 0xffff0000u)), l1 = pk2(v0[2] - __uint_as_float(h1 << 16), v0[3] - __uint_as_float(h1 & 0xffff0000u));
            const unsigned l2 = pk2(v1[0] - __uint_as_float(h2 << 16), v1[1] - __uint_as_float(h2 & 0xffff0000u)), l3 = pk2(v1[2] - __uint_as_float(h3 << 16), v1[3] - __uint_as_float(h3 & 0xffff0000u));
            u32x4 wh = {h0, h1, h2, h3}, wl = {l0, l1, l2, l3};
            ahi[ks] = *reinterpret_cast<bf16x8*>(&wh); alo[ks] = *reinterpret_cast<bf16x8*>(&wl);
        }
        const int qpos = j * 256 + wid * 32 + r32, m = b * T + qpos;
        const bf16* Qw = Q + (size_t)m * D + h * 128 + hi * 8;
        f32x16 gacc = {};
#pragma unroll
        for (int ks = 0; ks < 8; ++ks) { const bf16x8 qv = *(const bf16x8*)(Qw + 16 * ks);
            gacc = __builtin_amdgcn_mfma_f32_32x32x16_bf16(ahi[ks], qv, gacc, 0, 0, 0);
            gacc = __builtin_amdgcn_mfma_f32_32x32x16_bf16(alo[ks], qv, gacc, 0, 0, 0); }
        float cv[6]; int ci[6];
        unsigned usedm = 0u;
#pragma unroll
        for (int s = 0; s < 3; ++s) { int best = 0; float val = -INFINITY; bool have = false;
#pragma unroll
            for (int r = 0; r < 16; ++r) { const float gv = (crow(r, hi) < j) ? gacc[r] : -INFINITY; const bool free_ = !((usedm >> r) & 1u); if (free_ && (!have || gv > val)) { best = r; val = gv; have = true; } }
            usedm |= 1u << best; cv[s] = val; ci[s] = crow(best, hi); }
#pragma unroll
        for (int s = 0; s < 3; ++s) { cv[3 + s] = __shfl_xor(cv[s], 32); ci[3 + s] = __shfl_xor(ci[s], 32); }
        int selv[3]; unsigned um = 0u;
#pragma unroll
        for (int s = 0; s < 3; ++s) { int best = 0; float val = 0.f; int bidx = 0; bool have = false;
#pragma unroll
            for (int c = 0; c < 6; ++c) { const bool free_ = !((um >> c) & 1u); if (free_ && (!have || cv[c] > val || (cv[c] == val && ci[c] < bidx))) { best = c; val = cv[c]; bidx = ci[c]; have = true; } }
            um |= 1u << best; selv[s] = bidx; }
        unsigned lpos[3] = {0u, 0u, 0u};
        if (hi == 0) {
#pragma unroll
            for (int s = 0; s < 3; ++s) if (s < j) lpos[s] = atomicAdd((unsigned*)&lcnt[selv[s]], 1u);
        }
        __syncthreads();
        if (tid < 32) { const unsigned c = lcnt[tid]; const int near = (j - tid <= 4) ? 1 : 0; unsigned base = 0u; if (c) base = atomicAdd(&cnt[(bh * 32 + tid) * 2 + near], c); lcnt[32 + tid] = base + (near ? 7168u : 0u); }
        __syncthreads();
        if (hi == 0) {
#pragma unroll
            for (int s = 0; s < 3; ++s)
                if (s < j) lists[(size_t)(bh * 32 + selv[s]) * 8192 + lcnt[32 + selv[s]] + lpos[s]] = (unsigned short)(qpos | (s << 13));
        }
    }
}

#ifdef PROBE_SEC_ATT
#define PS_B(id) do { if ((id) == PROBE_SEC_ATT && (OWN ? 1 : 0) == PROBE_OWN) { __builtin_amdgcn_sched_barrier(0); psec -= __builtin_amdgcn_s_memrealtime(); __builtin_amdgcn_sched_barrier(0); } } while (0)
#define PS_E(id) do { if ((id) == PROBE_SEC_ATT && (OWN ? 1 : 0) == PROBE_OWN) { __builtin_amdgcn_sched_barrier(0); psec += __builtin_amdgcn_s_memrealtime(); __builtin_amdgcn_sched_barrier(0); } } while (0)
#else
#define PS_B(id) do { } while (0)
#define PS_E(id) do { } while (0)
#endif
namespace moba {
constexpr int E_K0 = 0, E_V0 = 16384, E_K1 = 32768, E_V1 = 49152, E_TAB = 65536, E_WSCR = 73728, E_SCHED = 81920, E_STG = 86272;

constexpr float THR2 = 11.5f;
template <bool CAUSAL>
__device__ __forceinline__ void tile_step(const LAS unsigned char* Kb, int vb, const LAS float* tab2, LAS float* al_l, const bf16x8 (&qr)[8], int qpos_rel, int kt, bool near, int r32, int hi,
                                          f32x16 (&o)[4], float& m_reg, float& l_reg) {
    f32x16 p0, p1;
    qkt(p0, p1, Kb, qr, r32, hi);
    float sc = C2, cadd = tab2[1023];
    if (CAUSAL || near) {
        int dbase = qpos_rel - kt * 64 - 4 * hi; asm volatile("" : "+v"(dbase));
#pragma unroll
        for (int r = 0; r < 16; ++r) {
            const int d0_ = dbase - ((r & 3) + 8 * (r >> 2)), d1_ = d0_ - 32;
            float t0, t1;
            if (!CAUSAL) { t0 = fmaf(p0[r], C2, tab2[min(d0_, 1023)]); t1 = fmaf(p1[r], C2, tab2[min(d1_, 1023)]); }
            else { t0 = fmaf(p0[r], C2, tab2[max(d0_, 0)]); t1 = fmaf(p1[r], C2, tab2[max(d1_, 0)]); if (d0_ < 0) t0 = -1e30f; if (d1_ < 0) t1 = -1e30f; }
            p0[r] = t0; p1[r] = t1;
        }
        sc = 1.f; cadd = 0.f;
    }
    float pmax = p0[0];
#pragma unroll
    for (int r = 1; r < 16; ++r) pmax = fmaxf(pmax, p0[r]);
#pragma unroll
    for (int r = 0; r < 16; ++r) pmax = fmaxf(pmax, p1[r]);
    { auto rr = __builtin_amdgcn_permlane32_swap(__float_as_uint(pmax), __float_as_uint(pmax), false, false);
      pmax = fmaxf(__uint_as_float(rr[0]), __uint_as_float(rr[1])); }
    pmax = fmaf(pmax, sc, cadd);
    const bool raise = (pmax - m_reg) > THR2;
    const float mn = raise ? pmax : m_reg;
    const float alpha = raise ? __builtin_amdgcn_exp2f(m_reg - mn) : 1.f;
    m_reg = mn;
    if (__any(raise)) {
        if (hi == 0) al_l[r32] = alpha;
        asm volatile("s_waitcnt lgkmcnt(0)" ::: "memory");
#pragma unroll
        for (int r = 0; r < 16; ++r) { const float av = al_l[crow(r, hi)];
#pragma unroll
            for (int d = 0; d < 4; ++d) o[d][r] *= av; }
    }
    const float off = cadd - m_reg;
#pragma unroll
    for (int r = 0; r < 16; ++r) { p0[r] = __builtin_amdgcn_exp2f(fmaf(p0[r], sc, off)); p1[r] = __builtin_amdgcn_exp2f(fmaf(p1[r], sc, off)); }
    float ps = 0.f;
#pragma unroll
    for (int r = 0; r < 16; ++r) ps += p0[r];
#pragma unroll
    for (int r = 0; r < 16; ++r) ps += p1[r];
    { auto rr = __builtin_amdgcn_permlane32_swap(__float_as_uint(ps), __float_as_uint(ps), false, false);
      ps = __uint_as_float(rr[0]) + __uint_as_float(rr[1]); }
    l_reg = l_reg * alpha + ps;
    bf16x8 pa0, pa1, pa2, pa3;
#define PK4(P, BASE, OUT) do { unsigned a0 = cvtpk(P[BASE + 0], P[BASE + 1]), a1 = cvtpk(P[BASE + 2], P[BASE + 3]);   \
    unsigned b0 = cvtpk(P[BASE + 4], P[BASE + 5]), b1 = cvtpk(P[BASE + 6], P[BASE + 7]);                              \
    auto r0 = __builtin_amdgcn_permlane32_swap(a0, b0, false, false); auto r1 = __builtin_amdgcn_permlane32_swap(a1, b1, false, false); \
    u32x4 w = {r0[0], r1[0], r0[1], r1[1]}; OUT = *reinterpret_cast<bf16x8*>(&w); } while (0)
    PK4(p0, 0, pa0); PK4(p0, 8, pa1); PK4(p1, 0, pa2); PK4(p1, 8, pa3);
#undef PK4
    pv_one<0>(o[0], vb, pa0, pa1, pa2, pa3); pv_one<1>(o[1], vb, pa0, pa1, pa2, pa3); pv_one<2>(o[2], vb, pa0, pa1, pa2, pa3); pv_one<3>(o[3], vb, pa0, pa1, pa2, pa3);
}
}

template <bool OWN>
__device__ __forceinline__ void attn_engine(const Args& a, LAS unsigned char* lds, int tid, int lane, int wid, unsigned long long& psec) {
    using namespace moba;
    PS_B(4); PS_B(5);
    bf16* Q = (bf16*)(a.ws + WS_A2); const bf16* K = Q + (size_t)M * D; const bf16* V = K + (size_t)M * D;
    const unsigned* cnt = (const unsigned*)(a.ws + WS_CNT); const unsigned short* lists = (const unsigned short*)(a.ws + WS_LIST);
    const float* tab2g = (const float*)(a.ws + WS_TAB2); float* LSE = (float*)(a.ws + WS_LSE);
    const long po1off = (long)((const unsigned char*)a.out - a.ws);
    const int r32 = lane & 31, hi = lane >> 5, sr = tid >> 4, sc = (tid & 15) * 8;
    LAS int* P = (LAS int*)(lds + E_SCHED);
    int TR = 512;
    if (!OWN) {
        const int c0_ = ((int)cnt[2 * tid] + 255) >> 8, c1_ = ((int)cnt[2 * tid + 1] + 255) >> 8;
        int v = c0_ + c1_;
#pragma unroll
        for (int o_ = 1; o_ < 64; o_ <<= 1) { const int t_ = __shfl_up(v, o_); if (lane >= o_) v += t_; }
        LAS int* wt = (LAS int*)(lds + E_WSCR);
        if (lane == 63) wt[wid] = v;
        __syncthreads();
        int off = 0;
        for (int w = 0; w < wid; ++w) off += wt[w];
        P[2 * tid + 2] = off + v; P[2 * tid + 1] = off + v - c1_;
        if (tid == 0) P[0] = 0;
        __syncthreads();
        TR = P[1024];
    }
    const int R0 = (int)(((long)blockIdx.x * TR) / gridDim.x), R1 = (int)(((long)(blockIdx.x + 1) * TR) / gridDim.x);
    if (R0 >= R1) return;
#define AE_LOC(rd_, li_, r_) do { if (OWN) { li_ = (rd_); r_ = 0; } else { int a_ = 0, b_ = 1024; while (b_ - a_ > 1) { const int mid_ = (a_ + b_) >> 1; if (P[mid_] <= (rd_)) a_ = mid_; else b_ = mid_; } li_ = a_; r_ = (rd_) - P[a_]; } } while (0)
#define AE_TLOAD(Kt_, Vt_) do { ks0 = *(const bf16x8*)((Kt_) + (size_t)sr * D + sc); ks1 = *(const bf16x8*)((Kt_) + (size_t)(32 + sr) * D + sc);                 \
        vs0 = *(const bf16x8*)((Vt_) + (size_t)sr * D + sc); vs1 = *(const bf16x8*)((Vt_) + (size_t)(32 + sr) * D + sc); } while (0)
#define AE_TWRITE(bi_) do { *(LAS bf16x8*)(lds + ((bi_) ? E_K1 : E_K0) + KSWZ(sr, sc * 2)) = ks0; *(LAS bf16x8*)(lds + ((bi_) ? E_K1 : E_K0) + KSWZ(32 + sr, sc * 2)) = ks1;   \
        *(LAS bf16x8*)(lds + ((bi_) ? E_V1 : E_V0) + v_st(sr, sc)) = vs0; *(LAS bf16x8*)(lds + ((bi_) ? E_V1 : E_V0) + v_st(32 + sr, sc)) = vs1; } while (0)
    bf16x8 ks0, ks1, vs0, vs1;
    int li, rr; AE_LOC(R0, li, rr);
    int b = (OWN ? li : (li >> 1)) >> 8, h = ((OWN ? li : (li >> 1)) >> 5) & 7, n = (OWN ? li : (li >> 1)) & 31;
    int L = OWN ? 256 : (int)cnt[li];
    const bf16* Kt = K + (size_t)(b * T + n * 256) * D + h * 128; const bf16* Vt = V + (size_t)(b * T + n * 256) * D + h * 128;
    AE_TLOAD(Kt, Vt);
    int tabsel = 0;
    for (int e = tid; e < 1024; e += 512) ((LAS float*)(lds + E_TAB))[e] = tab2g[h * 1024 + e];
    int ent, qpos, slot; bool valid;
    {
        const int e = rr * 256 + wid * 32 + r32; valid = e < L;
        if (OWN) ent = n * 256 + wid * 32 + r32; else ent = lists[(size_t)(li >> 1) * 8192 + (li & 1) * 7168 + (valid ? e : (L - 1))];
    }
    bf16x8 qr[8];
    {
        const bf16* Qw = Q + (size_t)(b * T + (ent & 8191)) * D + h * 128 + hi * 8;
#pragma unroll
        for (int d0 = 0; d0 < 8; ++d0) qr[d0] = *(const bf16x8*)(Qw + d0 * 16);
    }
    AE_TWRITE(0);
    __syncthreads();
    int step = 0;
    PS_E(4);
    LAS float* al_l = (LAS float*)(lds + E_WSCR + wid * 1024);
    for (int rd = R0; rd < R1; ++rd) {
        const bool has_next = rd + 1 < R1;
        int nli = li, nrr = rr; if (has_next) AE_LOC(rd + 1, nli, nrr);
        const int nl2_ = OWN ? nli : (nli >> 1); const int nb_ = nl2_ >> 8, nh = (nl2_ >> 5) & 7, nn = nl2_ & 31;
        const int nL = OWN ? 256 : (has_next ? (int)cnt[nli] : L);
        const bf16* Ktn = K + (size_t)(nb_ * T + nn * 256) * D + nh * 128; const bf16* Vtn = V + (size_t)(nb_ * T + nn * 256) * D + nh * 128;
        qpos = ent & 8191; slot = ent >> 13;
        const int m = b * T + qpos, qrel = qpos - n * 256;
        const bool wave_on = OWN ? true : ((rr * 256 + wid * 32) < L);
        const bool near_ = !OWN && (li & 1);
        const LAS float* tab2 = (const LAS float*)(lds + E_TAB + tabsel * 4096);
        f32x16 o[4] = {}; float m_reg = -1e30f, l_reg = 0.f;
        float ls0 = -1e30f, ls1 = -1e30f, ls2 = -1e30f;
        const int nsel = n < 3 ? n : 3;
        int nent = ent; bool nvalid = valid;
#pragma unroll 1
        for (int kt = 0; kt < 4; ++kt) {
            const bool more = (kt < 3) || has_next;
            if (more) { if (kt < 3) AE_TLOAD(Kt + (size_t)(kt + 1) * 64 * D, Vt + (size_t)(kt + 1) * 64 * D); else AE_TLOAD(Ktn, Vtn); }
            const int bi = step & 1;
            PS_B(1);
            if (OWN && kt == 3) {
                if (nsel > 0) ls0 = LSE[((size_t)0 * M + m) * 8 + h];
                if (nsel > 1) ls1 = LSE[((size_t)1 * M + m) * 8 + h];
                if (nsel > 2) ls2 = LSE[((size_t)2 * M + m) * 8 + h];
            }
            if (wave_on && (!OWN || kt <= (wid >> 1))) {
                const LAS unsigned char* Kb_ = lds + (bi ? E_K1 : E_K0); const int vb_ = (int)(unsigned long)(lds + (bi ? E_V1 : E_V0)) + v_rd_base(lane);
                tile_step<OWN>(Kb_, vb_, tab2, al_l, qr, qrel, kt, near_, r32, hi, o, m_reg, l_reg);
            }
            PS_E(1); PS_B(2);
            if (has_next && kt == 1) {
                const int e = nrr * 256 + wid * 32 + r32; nvalid = e < nL;
                if (OWN) nent = nn * 256 + wid * 32 + r32; else nent = lists[(size_t)(nli >> 1) * 8192 + (nli & 1) * 7168 + (nvalid ? e : (nL - 1))];
            }
            if (!OWN && has_next && kt == 3) {
                const bf16* Qw = Q + (size_t)(nb_ * T + (nent & 8191)) * D + nh * 128 + hi * 8;
#pragma unroll
                for (int d0 = 0; d0 < 8; ++d0) qr[d0] = *(const bf16x8*)(Qw + d0 * 16);
            }
            if (more) AE_TWRITE(bi ^ 1);
            if (kt == 3 && has_next && nh != h) { for (int e = tid; e < 1024; e += 512) ((LAS float*)(lds + E_TAB + (tabsel ^ 1) * 4096))[e] = tab2g[nh * 1024 + e]; }
            __syncthreads();
            PS_E(2);
            ++step;
        }
        PS_B(3);
        if (wave_on) {
            LAS unsigned char* stg = lds + E_STG + wid * 8192;
            if (!OWN) {
                LAS float* li_l = (LAS float*)(lds + E_WSCR + wid * 1024 + 128);
                LAS int* row_l = (LAS int*)(lds + E_WSCR + wid * 1024 + 256);
                if (hi == 0) { li_l[r32] = __builtin_amdgcn_rcpf(l_reg); row_l[r32] = valid ? ((slot << 20) | m) : -1;
                    if (valid) LSE[((size_t)slot * M + m) * 8 + h] = m_reg + __builtin_amdgcn_logf(l_reg); }
                asm volatile("s_waitcnt lgkmcnt(0)" ::: "memory");
                float rl[16];
#pragma unroll
                for (int r = 0; r < 16; ++r) rl[r] = li_l[crow(r, hi)];
#pragma unroll
                for (int d0 = 0; d0 < 4; ++d0)
#pragma unroll
                    for (int r = 0; r < 16; ++r) *(LAS unsigned short*)(stg + crow(r, hi) * 256 + (d0 * 32 + r32) * 2) = (unsigned short)f2bf(o[d0][r] * rl[r]);
#pragma unroll
                for (int it = 0; it < 8; ++it) {
                    const int row = 4 * it + (lane >> 4);
                    const u32x4 v = *(const LAS u32x4*)(stg + row * 256 + (lane & 15) * 16);
                    const int rm = row_l[row];
                    if (rm >= 0) {
                        const int sl = rm >> 20, mm = rm & 0xfffff;
                        *(u32x4*)((bf16*)(a.ws + (sl == 0 ? (long)WS_PO0 : (sl == 1 ? po1off : (long)WS_PO2))) + (size_t)mm * D + h * 128 + (lane & 15) * 8) = v;
                    }
                }
            } else {
                const float lown = m_reg + __builtin_amdgcn_logf(l_reg);
                const float Mx = fmaxf(fmaxf(lown, ls0), fmaxf(ls1, ls2));
                const float e0 = __builtin_amdgcn_exp2f(ls0 - Mx), e1 = __builtin_amdgcn_exp2f(ls1 - Mx), e2 = __builtin_amdgcn_exp2f(ls2 - Mx), eo = __builtin_amdgcn_exp2f(lown - Mx);
                const float iz = __builtin_amdgcn_rcpf((eo + e0) + (e1 + e2));
                LAS float* cf = (LAS float*)(lds + E_WSCR + wid * 1024 + 128);
                if (hi == 0) { cf[r32] = eo * iz * __builtin_amdgcn_rcpf(l_reg); cf[32 + r32] = e0 * iz; cf[64 + r32] = e1 * iz; cf[96 + r32] = e2 * iz; }
                asm volatile("s_waitcnt lgkmcnt(0)" ::: "memory");
                const bf16* P0 = (const bf16*)(a.ws + WS_PO0); const bf16* P1 = (const bf16*)a.out; const bf16* P2 = (const bf16*)(a.ws + WS_PO2);
                float co[16];
#pragma unroll
                for (int r = 0; r < 16; ++r) co[r] = cf[crow(r, hi)];
#pragma unroll
                for (int d0 = 0; d0 < 4; ++d0)
#pragma unroll
                    for (int r = 0; r < 16; ++r) *(LAS unsigned short*)(stg + crow(r, hi) * 256 + (d0 * 32 + r32) * 2) = (unsigned short)f2bf(o[d0][r] * co[r]);
                asm volatile("" ::: "memory"); __builtin_amdgcn_sched_barrier(0);
                const size_t offb = (size_t)(b * T + n * 256 + wid * 32 + (lane >> 4)) * D + h * 128 + (lane & 15) * 8;
                u32x4 pv0[8], pv1[8], pv2[8];
#pragma unroll
                for (int it = 0; it < 8; ++it) {
                    const size_t off = offb + (size_t)it * 4 * D;
                    pv0[it] = *(const u32x4*)(P0 + off); pv1[it] = *(const u32x4*)(P1 + off); pv2[it] = *(const u32x4*)(P2 + off);
                }
                const u32x4 z4 = {0u, 0u, 0u, 0u};
#pragma unroll
                for (int it = 0; it < 8; ++it) {
                    const int row = 4 * it + (lane >> 4);
                    const u32x4 ov = *(const LAS u32x4*)(stg + row * 256 + (lane & 15) * 16);
                    float acc[8];
                    acc[0] = __uint_as_float(ov.x << 16); acc[1] = __uint_as_float(ov.x & 0xffff0000u); acc[2] = __uint_as_float(ov.y << 16); acc[3] = __uint_as_float(ov.y & 0xffff0000u);
                    acc[4] = __uint_as_float(ov.z << 16); acc[5] = __uint_as_float(ov.z & 0xffff0000u); acc[6] = __uint_as_float(ov.w << 16); acc[7] = __uint_as_float(ov.w & 0xffff0000u);
#define ADDP(PV, CI) do { const u32x4 pv = (PV); const float cc = cf[(CI) * 32 + row];                                                        \
    acc[0] = fmaf(cc, __uint_as_float(pv.x << 16), acc[0]); acc[1] = fmaf(cc, __uint_as_float(pv.x & 0xffff0000u), acc[1]);                     \
    acc[2] = fmaf(cc, __uint_as_float(pv.y << 16), acc[2]); acc[3] = fmaf(cc, __uint_as_float(pv.y & 0xffff0000u), acc[3]);                     \
    acc[4] = fmaf(cc, __uint_as_float(pv.z << 16), acc[4]); acc[5] = fmaf(cc, __uint_as_float(pv.z & 0xffff0000u), acc[5]);                     \
    acc[6] = fmaf(cc, __uint_as_float(pv.w << 16), acc[6]); acc[7] = fmaf(cc, __uint_as_float(pv.w & 0xffff0000u), acc[7]); } while (0)
                    ADDP(nsel > 0 ? pv0[it] : z4, 1);
                    ADDP(nsel > 1 ? pv1[it] : z4, 2);
                    ADDP(nsel > 2 ? pv2[it] : z4, 3);
#undef ADDP
                    *(u32x4*)(Q + offb + (size_t)it * 4 * D) = (u32x4){pk2(acc[0], acc[1]), pk2(acc[2], acc[3]), pk2(acc[4], acc[5]), pk2(acc[6], acc[7])};
                }
            }
        }
        PS_E(3);
        if (OWN && has_next) {
            const bf16* Qw = Q + (size_t)(nb_ * T + (nent & 8191)) * D + nh * 128 + hi * 8;
#pragma unroll
            for (int d0 = 0; d0 < 8; ++d0) qr[d0] = *(const bf16x8*)(Qw + d0 * 16);
        }
        if (nh != h) tabsel ^= 1;
        li = nli; rr = nrr; b = nb_; h = nh; n = nn; L = nL; Kt = Ktn; Vt = Vtn; ent = nent; valid = nvalid;
    }
    __syncthreads();
    PS_E(5);
#undef AE_LOC
#undef AE_TLOAD
#undef AE_TWRITE
}

#ifndef PROBE_BLK
#define PROBE_BLK 0
#endif
#ifdef PROBE_HG
#define HS_B(id) do { if ((id) == PROBE_HG && PASS_B == (PROBE_HG_B != 0)) { __builtin_amdgcn_sched_barrier(0); psec -= __builtin_amdgcn_s_memrealtime(); __builtin_amdgcn_sched_barrier(0); } } while (0)
#define HS_E(id) do { if ((id) == PROBE_HG && PASS_B == (PROBE_HG_B != 0)) { __builtin_amdgcn_sched_barrier(0); psec += __builtin_amdgcn_s_memrealtime(); __builtin_amdgcn_sched_barrier(0); } } while (0)
#else
#define HS_B(id) do { } while (0)
#define HS_E(id) do { } while (0)
#endif
namespace hg {
using namespace moba;
#ifndef HG_NEW_SIMG
#define HG_NEW_SIMG 1
#endif
constexpr int H_TQ = 0, H_TK = 16384, H_TKT = 32768, H_TI = 49152, H_SIMG = 65536, H_OST = 98304, H_EL = 132096;
constexpr int OST_LD = 132;
typedef float f32x2_t __attribute__((ext_vector_type(2))); typedef __bf16 bf16x2_t __attribute__((ext_vector_type(2)));
__device__ __forceinline__ unsigned cvtpk_s(float lo, float hi) { f32x2_t v = {lo, hi}; bf16x2_t b = __builtin_convertvector(v, bf16x2_t); return __builtin_bit_cast(unsigned, b); }
__device__ __forceinline__ int v_st64(int k, int c) { const int kk = (k & ~0xC) | ((k & 4) << 1) | ((k & 8) >> 1); return ((kk >> 3) * 2 + (c >> 5)) * 512 + ((kk & 7) * 32 + (c & 31)) * 2; }
constexpr int v_rd_off64(int tile, int cb, int ks, int half) { return tile * 8192 + cb * 512 + ks * 2048 + half * 1024; }
__device__ __forceinline__ void simg_store(LAS unsigned char* lds, int img_off, const f32x16& S, int nb, int d, int hi) {
#pragma unroll
    for (int q4 = 0; q4 < 4; ++q4) { const int n = 32 * nb + 8 * q4 + 4 * hi;
        typedef unsigned u32x2_ __attribute__((ext_vector_type(2)));
        *(LAS u32x2_*)(lds + img_off + KSWZ(d, 2 * n)) = (u32x2_){cvtpk_s(S[4 * q4 + 0], S[4 * q4 + 1]), cvtpk_s(S[4 * q4 + 2], S[4 * q4 + 3])}; }
}
__device__ __forceinline__ int kt_off(int n, int s) { return n * 128 + ((((s >> 3) ^ ((n >> 1) & 7))) << 4) + (s & 7) * 2; }

template <bool PASS_B>
__device__ __forceinline__ void hgrn_unit(const Args& a, LAS unsigned char* lds, int u, int tid, int lane, int wid, unsigned long long& psec) {
    unsigned char* ws = a.ws;
    const bf16* QS = (const bf16*)(ws + WS_A1); const float* LF = (const float*)(ws + WS_A2); const bf16* INP = (const bf16*)(ws + WS_A3); const bf16* OG = (const bf16*)(ws + WS_A4);
    bf16* OGATED = (bf16*)(ws + WS_A0); float* SSQH = (float*)(ws + WS_SSQH);
    float* TG = a.out;
    float* DG = a.out + (size_t)256 * 128 * 128;
    const int bh = u >> 4, g = u & 15, b = bh >> 3, h = bh & 7;
    const int r32 = lane & 31, hi = lane >> 5, tb = wid >> 2, db = wid & 3;
    const int nl = lane & 15, tq = lane >> 4, npre = 16 * wid + nl;
    f32x16 Sacc[2] = {};
    float dg = 1.f;
#if HG_NEW_SIMG
#define HG_SIMG_WRITE() do { simg_store(lds, H_SIMG, Sacc[0], 2 * tb, 32 * db + r32, hi); simg_store(lds, H_SIMG, Sacc[1], 2 * tb + 1, 32 * db + r32, hi); } while (0)
#else
#define HG_SIMG_WRITE() do { _Pragma("unroll") for (int i = 0; i < 2; ++i) { const int nb = 2 * tb + i; _Pragma("unroll") for (int r = 0; r < 16; ++r) { const int n = 32 * nb + crow(r, hi); \
        *(LAS unsigned short*)(lds + H_SIMG + (nb >> 1) * 16384 + v_st(n & 63, 32 * db + r32)) = (unsigned short)f2bf(Sacc[i][r]); } } } while (0)
#endif
    if (PASS_B) {
        HS_B(1);
        {
            LAS float* dl = (LAS float*)(lds + H_OST);
            for (int e = tid; e < g * 128; e += NWAVES * 64) dl[e] = DG[(size_t)(bh * 16) * 128 + e];
            __syncthreads();
            for (int gp0 = 0; gp0 < g; gp0 += 4) {
                int lo_ = (wid * 8 * 64 + lane) * 4; asm volatile("" : "+v"(lo_));
                const float* tg = TG + (size_t)(bh * 16 + gp0) * 16384 + lo_;
                f32x4 tv[4][8];
#pragma unroll
                for (int k = 0; k < 4; ++k) if (gp0 + k < g) {
#pragma unroll
                    for (int j = 0; j < 8; ++j) tv[k][j] = *(const f32x4*)(tg + (size_t)k * 16384 + j * 256);
                }
#pragma unroll
                for (int k = 0; k < 4; ++k) if (gp0 + k < g) {
#pragma unroll
                    for (int i = 0; i < 2; ++i)
#pragma unroll
                        for (int r = 0; r < 16; ++r) Sacc[i][r] = fmaf(Sacc[i][r], dl[(gp0 + k) * 128 + 32 * (2 * tb + i) + crow(r, hi)], tv[k][i * 4 + (r >> 2)][r & 3]);
                }
            }
            __syncthreads();
        }
        HG_SIMG_WRITE();
        HS_E(1);
    }
    float lfn[16]; unsigned short qn[16]; bf16x8 in0, in1; u32x4 gn0, gn1;
    const int sr = tid >> 4, sc = (tid & 15) * 8;
    const int pt = tid >> 3, pseg = tid & 7;
#define HG_LOAD(cc) do { const size_t m0_ = (size_t)b * T + g * 512 + (cc) * 64; const size_t off0_ = (m0_ + 16 * tq) * D + h * 128 + npre;                       \
        _Pragma("unroll") for (int i = 0; i < 16; ++i) { lfn[i] = LF[off0_ + (size_t)i * D]; if (PASS_B) qn[i] = QS[off0_ + (size_t)i * D]; }                      \
        in0 = *(const bf16x8*)(INP + (m0_ + sr) * D + h * 128 + sc); in1 = *(const bf16x8*)(INP + (m0_ + 32 + sr) * D + h * 128 + sc);                          \
        if (PASS_B) { const size_t go_ = (m0_ + pt) * D + h * 128 + 16 * pseg; gn0 = *(const u32x4*)(OG + go_); gn1 = *(const u32x4*)(OG + go_ + 8); } } while (0)
    HG_LOAD(0);
    for (int c = 0; c < 8; ++c) {
        const size_t m0 = (size_t)b * T + g * 512 + c * 64;
        u32x4 g0 = {}, g1 = {};
        HS_B(2);
        {
            float lf[16], qv[16];
#pragma unroll
            for (int i = 0; i < 16; ++i) { lf[i] = lfn[i]; if (PASS_B) qv[i] = bf2f(qn[i]); }
            if (PASS_B) { g0 = gn0; g1 = gn1; }
            float cs[16]; float run = 0.f;
#pragma unroll
            for (int i = 0; i < 16; ++i) { run += lf[i]; cs[i] = run; }
            const float s0 = __shfl(run, nl), s1 = __shfl(run, nl + 16), s2 = __shfl(run, nl + 32), s3 = __shfl(run, nl + 48);
            const float pre = (tq > 0 ? s0 : 0.f) + (tq > 1 ? s1 : 0.f) + (tq > 2 ? s2 : 0.f);
            const float last = (s0 + s1) + (s2 + s3);
            unsigned kh[8], qw[8], kw[8];
#pragma unroll
            for (int i = 0; i < 16; i += 2) {
                float khv[2], qtv[2], ktv[2];
#pragma unroll
                for (int e = 0; e < 2; ++e) {
                    const float cum = pre + cs[i + e];
                    const float kk = 1.f - __expf(lf[i + e]);
                    khv[e] = kk * __expf(last - cum);
                    if (PASS_B) { qtv[e] = qv[i + e] * __expf(cum); ktv[e] = kk * __expf(-cum); }
                }
                kh[i >> 1] = cvtpk(khv[0], khv[1]);
                if (PASS_B) { qw[i >> 1] = cvtpk(qtv[0], qtv[1]); kw[i >> 1] = cvtpk(ktv[0], ktv[1]); }
            }
            if (PASS_B) {
                const int io = (npre >> 6) * 8192 + v_st64(npre & 63, 16 * tq);
                *(LAS u32x4*)(lds + H_TQ + io) = (u32x4){qw[0], qw[1], qw[2], qw[3]}; *(LAS u32x4*)(lds + H_TQ + io + 16) = (u32x4){qw[4], qw[5], qw[6], qw[7]};
                *(LAS u32x4*)(lds + H_TK + io) = (u32x4){kw[0], kw[1], kw[2], kw[3]}; *(LAS u32x4*)(lds + H_TK + io + 16) = (u32x4){kw[4], kw[5], kw[6], kw[7]};
            }
            *(LAS u32x4*)(lds + H_TKT + kt_off(npre, 16 * tq)) = (u32x4){kh[0], kh[1], kh[2], kh[3]};
            *(LAS u32x4*)(lds + H_TKT + kt_off(npre, 16 * tq + 8)) = (u32x4){kh[4], kh[5], kh[6], kh[7]};
            const float el = __expf(last);
            if (tq == 0) *(LAS float*)(lds + H_EL + npre * 4) = el;
            dg *= el;
            *(LAS bf16x8*)(lds + H_TI + v_st(sr, sc)) = in0;
            *(LAS bf16x8*)(lds + H_TI + v_st(32 + sr, sc)) = in1;
        }
        __syncthreads();
        HS_E(2); HS_B(3);
        {
#define PK(L, Hh) (bf16x8){L[0], L[1], L[2], L[3], Hh[0], Hh[1], Hh[2], Hh[3]}
            bf16x8 pa0, pa1, pa2, pa3; bf16x8 qr[8];
            if (PASS_B) {
                const int t = 32 * tb + r32;
                const int vbQ = (int)(unsigned long)(lds + H_TQ) + v_rd_base(lane) + tb * 512, vbK = (int)(unsigned long)(lds + H_TK) + v_rd_base(lane);
                {
                    s16x4 ql[8], qh[8];
#define HG_QRD(d0_) ql[d0_] = tr_read<v_rd_off64((d0_) >> 2, 0, (d0_) & 3, 0)>(vbQ); qh[d0_] = tr_read<v_rd_off64((d0_) >> 2, 0, (d0_) & 3, 1)>(vbQ);
                    HG_QRD(0) HG_QRD(1) HG_QRD(2) HG_QRD(3) HG_QRD(4) HG_QRD(5) HG_QRD(6) HG_QRD(7)
#undef HG_QRD
                    asm volatile("s_waitcnt lgkmcnt(0)" ::: "memory"); SBAR();
#pragma unroll
                    for (int d0 = 0; d0 < 8; ++d0) qr[d0] = PK(ql[d0], qh[d0]);
                }
                f32x16 p0 = {}, p1 = {};
                s16x4 ka[8], kb[8];
#define HG_KRD(dst_, da_, db2_) do { \
                    dst_[0] = tr_read<v_rd_off64((da_) >> 2, 0, (da_) & 3, 0)>(vbK); dst_[1] = tr_read<v_rd_off64((da_) >> 2, 0, (da_) & 3, 1)>(vbK);     \
                    dst_[2] = tr_read<v_rd_off64((da_) >> 2, 1, (da_) & 3, 0)>(vbK); dst_[3] = tr_read<v_rd_off64((da_) >> 2, 1, (da_) & 3, 1)>(vbK);     \
                    dst_[4] = tr_read<v_rd_off64((db2_) >> 2, 0, (db2_) & 3, 0)>(vbK); dst_[5] = tr_read<v_rd_off64((db2_) >> 2, 0, (db2_) & 3, 1)>(vbK); \
                    dst_[6] = tr_read<v_rd_off64((db2_) >> 2, 1, (db2_) & 3, 0)>(vbK); dst_[7] = tr_read<v_rd_off64((db2_) >> 2, 1, (db2_) & 3, 1)>(vbK); } while (0)
#define HG_KMM(src_, da_, db2_) do { \
                    p0 = __builtin_amdgcn_mfma_f32_32x32x16_bf16(PK(src_[0], src_[1]), qr[da_], p0, 0, 0, 0); p1 = __builtin_amdgcn_mfma_f32_32x32x16_bf16(PK(src_[2], src_[3]), qr[da_], p1, 0, 0, 0);     \
                    p0 = __builtin_amdgcn_mfma_f32_32x32x16_bf16(PK(src_[4], src_[5]), qr[db2_], p0, 0, 0, 0); p1 = __builtin_amdgcn_mfma_f32_32x32x16_bf16(PK(src_[6], src_[7]), qr[db2_], p1, 0, 0, 0); } while (0)
                HG_KRD(ka, 0, 1); HG_KRD(kb, 2, 3);
                asm volatile("s_waitcnt lgkmcnt(8)" ::: "memory"); SBAR(); HG_KMM(ka, 0, 1); SBAR();
                HG_KRD(ka, 4, 5);
                asm volatile("s_waitcnt lgkmcnt(8)" ::: "memory"); SBAR(); HG_KMM(kb, 2, 3); SBAR();
                HG_KRD(kb, 6, 7);
                asm volatile("s_waitcnt lgkmcnt(8)" ::: "memory"); SBAR(); HG_KMM(ka, 4, 5); SBAR();
                asm volatile("s_waitcnt lgkmcnt(0)" ::: "memory"); SBAR(); HG_KMM(kb, 6, 7);
#undef HG_KRD
#undef HG_KMM
#pragma unroll
                for (int r = 0; r < 16; ++r) { const int s0_ = crow(r, hi); if (s0_ > t) p0[r] = 0.f; if (s0_ + 32 > t) p1[r] = 0.f; }
#define PK4(P, BASE, OUT) do { unsigned a0 = cvtpk(P[BASE + 0], P[BASE + 1]), a1 = cvtpk(P[BASE + 2], P[BASE + 3]);   \
    unsigned b0 = cvtpk(P[BASE + 4], P[BASE + 5]), b1 = cvtpk(P[BASE + 6], P[BASE + 7]);                              \
    auto r0 = __builtin_amdgcn_permlane32_swap(a0, b0, false, false); auto r1 = __builtin_amdgcn_permlane32_swap(a1, b1, false, false); \
    u32x4 w = {r0[0], r1[0], r0[1], r1[1]}; OUT = *reinterpret_cast<bf16x8*>(&w); } while (0)
                PK4(p0, 0, pa0); PK4(p0, 8, pa1); PK4(p1, 0, pa2); PK4(p1, 8, pa3);
#undef PK4
            }
            if (c < 7) HG_LOAD(c + 1);
            const int vbI = (int)(unsigned long)(lds + H_TI) + v_rd_base(lane) + db * 512;
            bf16x8 bI[4];
            {
                const s16x4 l0 = tr_read<v_rd_off(0, 0, 0)>(vbI), h0 = tr_read<v_rd_off(0, 0, 1)>(vbI), l1 = tr_read<v_rd_off(0, 1, 0)>(vbI), h1 = tr_read<v_rd_off(0, 1, 1)>(vbI);
                const s16x4 l2 = tr_read<v_rd_off(0, 2, 0)>(vbI), h2 = tr_read<v_rd_off(0, 2, 1)>(vbI), l3 = tr_read<v_rd_off(0, 3, 0)>(vbI), h3 = tr_read<v_rd_off(0, 3, 1)>(vbI);
                asm volatile("s_waitcnt lgkmcnt(0)" ::: "memory"); SBAR();
                bI[0] = PK(l0, h0); bI[1] = PK(l1, h1); bI[2] = PK(l2, h2); bI[3] = PK(l3, h3);
            }
            if (PASS_B) {
                f32x16 od = {};
                od = __builtin_amdgcn_mfma_f32_32x32x16_bf16(pa0, bI[0], od, 0, 0, 0);
                od = __builtin_amdgcn_mfma_f32_32x32x16_bf16(pa1, bI[1], od, 0, 0, 0);
                od = __builtin_amdgcn_mfma_f32_32x32x16_bf16(pa2, bI[2], od, 0, 0, 0);
                od = __builtin_amdgcn_mfma_f32_32x32x16_bf16(pa3, bI[3], od, 0, 0, 0);
#if HG_NEW_SIMG
#pragma unroll
                for (int ks = 0; ks < 8; ++ks) {
                    const bf16x8 bs = *(const LAS bf16x8*)(lds + H_SIMG + KSWZ(32 * db + r32, (16 * ks + 8 * hi) * 2));
                    od = __builtin_amdgcn_mfma_f32_32x32x16_bf16(qr[ks], bs, od, 0, 0, 0);
                }
#else
#pragma unroll
                for (int hf = 0; hf < 2; ++hf) {
                    const int vbS = (int)(unsigned long)(lds + H_SIMG) + hf * 16384 + v_rd_base(lane) + db * 512;
                    const s16x4 l0 = tr_read<v_rd_off(0, 0, 0)>(vbS), h0 = tr_read<v_rd_off(0, 0, 1)>(vbS), l1 = tr_read<v_rd_off(0, 1, 0)>(vbS), h1 = tr_read<v_rd_off(0, 1, 1)>(vbS);
                    const s16x4 l2 = tr_read<v_rd_off(0, 2, 0)>(vbS), h2 = tr_read<v_rd_off(0, 2, 1)>(vbS), l3 = tr_read<v_rd_off(0, 3, 0)>(vbS), h3 = tr_read<v_rd_off(0, 3, 1)>(vbS);
                    asm volatile("s_waitcnt lgkmcnt(0)" ::: "memory"); SBAR();
                    od = __builtin_amdgcn_mfma_f32_32x32x16_bf16(qr[hf * 4 + 0], PK(l0, h0), od, 0, 0, 0);
                    od = __builtin_amdgcn_mfma_f32_32x32x16_bf16(qr[hf * 4 + 1], PK(l1, h1), od, 0, 0, 0);
                    od = __builtin_amdgcn_mfma_f32_32x32x16_bf16(qr[hf * 4 + 2], PK(l2, h2), od, 0, 0, 0);
                    od = __builtin_amdgcn_mfma_f32_32x32x16_bf16(qr[hf * 4 + 3], PK(l3, h3), od, 0, 0, 0);
                }
#endif
#undef PK
                LAS float* ost = (LAS float*)(lds + H_OST);
#pragma unroll
                for (int r = 0; r < 16; ++r) ost[(32 * tb + crow(r, hi)) * OST_LD + 32 * db + r32] = od[r];
            }
            const LAS float* el = (const LAS float*)(lds + H_EL);
#pragma unroll
            for (int i = 0; i < 2; ++i) { const int nb = 2 * tb + i;
#pragma unroll
                for (int r = 0; r < 16; ++r) Sacc[i][r] *= el[32 * nb + crow(r, hi)];
#pragma unroll
                for (int ks = 0; ks < 4; ++ks) {
                    const bf16x8 af = *(const LAS bf16x8*)(lds + H_TKT + kt_off(32 * nb + r32, 16 * ks + 8 * hi));
                    Sacc[i] = __builtin_amdgcn_mfma_f32_32x32x16_bf16(af, bI[ks], Sacc[i], 0, 0, 0);
                } }
        }
        HS_E(3); HS_B(4);
        __syncthreads();
        if (PASS_B) {
            HG_SIMG_WRITE();
            const int t = pt, seg = pseg; const size_t go = (m0 + t) * D + h * 128 + 16 * seg;
            const LAS float* orow = (const LAS float*)(lds + H_OST) + t * OST_LD + 16 * seg;
            const unsigned gw[8] = {g0.x, g0.y, g0.z, g0.w, g1.x, g1.y, g1.z, g1.w};
            float ssq = 0.f; unsigned ow[8];
#pragma unroll
            for (int e = 0; e < 8; ++e) { const float o0 = orow[2 * e], o1 = orow[2 * e + 1]; ssq = fmaf(o0, o0, ssq); ssq = fmaf(o1, o1, ssq);
                ow[e] = pk2(o0 * __uint_as_float(gw[e] << 16), o1 * __uint_as_float(gw[e] & 0xffff0000u)); }
            *(u32x4*)(OGATED + go) = (u32x4){ow[0], ow[1], ow[2], ow[3]}; *(u32x4*)(OGATED + go + 8) = (u32x4){ow[4], ow[5], ow[6], ow[7]};
            ssq += __shfl_xor(ssq, 1); ssq += __shfl_xor(ssq, 2); ssq += __shfl_xor(ssq, 4);
            if (seg == 0) SSQH[(m0 + t) * 8 + h] = ssq;
        }
        HS_E(4);
    }
    if (!PASS_B) {
        int lo_ = (wid * 8 * 64 + lane) * 4; asm volatile("" : "+v"(lo_));
        float* tg = TG + (size_t)u * 16384 + lo_;
#pragma unroll
        for (int i = 0; i < 2; ++i)
#pragma unroll
            for (int q4 = 0; q4 < 4; ++q4) *(f32x4*)(tg + (i * 4 + q4) * 256) = (f32x4){Sacc[i][4 * q4], Sacc[i][4 * q4 + 1], Sacc[i][4 * q4 + 2], Sacc[i][4 * q4 + 3]};
        if (tq == 0) DG[(size_t)u * 128 + npre] = dg;
    }
    __syncthreads();
#undef HG_LOAD
#undef HG_SIMG_WRITE
}
}

#define XB_TMO      128
#define XB_XCNT(j)  (256  + 64 * (j))
#define XB_XSUB(j)  (1280 + 64 * (j))
#define XB_XGEN(j)  (2304 + 64 * (j))
#define XB_TOP      3328
#define XB_TOPGEN   3392
#define XCD_BAR_WORDS 3456
#define XB_SPIN_CAP (1u << 18)

__device__ __forceinline__ unsigned xb_ld(unsigned* p)              { return __hip_atomic_load(p, __ATOMIC_RELAXED, __HIP_MEMORY_SCOPE_AGENT); }
__device__ __forceinline__ unsigned xb_add(unsigned* p, unsigned v) { return __hip_atomic_fetch_add(p, v, __ATOMIC_RELAXED, __HIP_MEMORY_SCOPE_AGENT); }
__device__ __forceinline__ unsigned xb_xcc_id() { return (unsigned)__builtin_amdgcn_s_getreg((3 << 11) | 20) & 0xFu; }
#define XB_SPIN(cond, bar) do { unsigned _sp = 0; while (cond) { __builtin_amdgcn_s_sleep(1); \
    if ((++_sp & 255u) == 0u) { if (xb_ld(&(bar)[XB_TMO])) break; if (_sp > XB_SPIN_CAP) { atomicAdd(&(bar)[XB_TMO], 1u); break; } } } } while (0)

struct XcdBarrier {
    unsigned* bar; unsigned x;
    volatile LAS unsigned* st;
};

__device__ __forceinline__ XcdBarrier xcd_barrier_post(unsigned* bar, volatile LAS unsigned* st) {
    XcdBarrier b; b.bar = bar; b.x = xb_xcc_id(); b.st = st;
    if (threadIdx.x == 0) (void)xb_add(&bar[XB_XCNT(b.x)], 1u);
    return b;
}
__device__ __forceinline__ void xcd_barrier_complete(unsigned* bar, unsigned x, unsigned& nloc, unsigned& nx) {
    const unsigned G = gridDim.x * gridDim.y * gridDim.z;
    unsigned sum, cnt, mine, sp = 0u;
    for (;;) {
        sum = 0u; cnt = 0u; mine = 0u;
#pragma unroll
        for (unsigned j = 0; j < 16; ++j) { const unsigned c = xb_ld(&bar[XB_XCNT(j)]); sum += c; cnt += (c > 0u) ? 1u : 0u; mine = (j == x) ? c : mine; }
        if (sum == G) break;
        __builtin_amdgcn_s_sleep(1);
        if ((++sp & 255u) == 0u) { if (xb_ld(&bar[XB_TMO])) break; if (sp > XB_SPIN_CAP) { atomicAdd(&bar[XB_TMO], 1u); break; } }
    }
    nloc = mine > 0u ? mine : 1u; nx = cnt > 0u ? cnt : 1u;
}

__device__ __forceinline__ void xcd_barrier(const XcdBarrier& b) {
    asm volatile("s_waitcnt vmcnt(0)" ::: "memory");
    __syncthreads();
    if (threadIdx.x == 0) {
        unsigned* bar = b.bar;
        __builtin_amdgcn_s_waitcnt(0);
        unsigned nloc = b.st[0], nx = b.st[1];
        if (nloc == 0u) { xcd_barrier_complete(bar, b.x, nloc, nx); b.st[0] = nloc; b.st[1] = nx; }
        const unsigned old = xb_add(&bar[XB_XSUB(b.x)], 1u);
        const unsigned gen = old / nloc;
        if (old + 1u == (gen + 1u) * nloc) {
            __builtin_amdgcn_fence(__ATOMIC_RELEASE, "agent");
            asm volatile("s_waitcnt vmcnt(0)" ::: "memory");
            const unsigned og = xb_add(&bar[XB_TOP], 1u);
            const unsigned tg = og / nx;
            if (og + 1u == (tg + 1u) * nx) xb_add(&bar[XB_TOPGEN], 1u);
            else XB_SPIN(xb_ld(&bar[XB_TOPGEN]) == tg, bar);
            __builtin_amdgcn_fence(__ATOMIC_ACQUIRE, "agent");
            xb_add(&bar[XB_XGEN(b.x)], 1u);
            asm volatile("s_waitcnt vmcnt(0)" ::: "memory");
        } else {
            XB_SPIN(xb_ld(&bar[XB_XGEN(b.x)]) == gen, bar);
            __builtin_amdgcn_fence(__ATOMIC_ACQUIRE, "agent");
            asm volatile("s_waitcnt vmcnt(0)" ::: "memory");
        }
    }
    __syncthreads();
}

__global__ void __launch_bounds__(NWAVES * 64, 2) mk(Args a) {
    extern __shared__ __attribute__((aligned(16))) unsigned char lds_raw[];
    LAS unsigned char* lds = (LAS unsigned char*)lds_raw;
    const int tid = threadIdx.x, lane = tid & 63, wave = __builtin_amdgcn_readfirstlane(tid >> 6);
    unsigned char* ws = a.ws;
    const int lo = a.ph_lo, hi = a.ph_hi;
    const int G = gridDim.x;
    cg::grid_group grid = cg::this_grid();
#ifdef PROBE_SEAMS
#define SEAM_PS_B() do { __builtin_amdgcn_sched_barrier(0); psec -= __builtin_amdgcn_s_memrealtime(); __builtin_amdgcn_sched_barrier(0); } while (0)
#define SEAM_PS_E() do { __builtin_amdgcn_sched_barrier(0); psec += __builtin_amdgcn_s_memrealtime(); __builtin_amdgcn_sched_barrier(0); } while (0)
#else
#define SEAM_PS_B() do { } while (0)
#define SEAM_PS_E() do { } while (0)
#endif
#define IN(k) (lo <= (k) && (k) < hi)
#define SEAM(k) do { if (IN(k) && IN((k) + 1)) { if ((k) == 0) { grid.sync(); bar = xcd_barrier_post((unsigned*)(ws + WS_BAR), MISC); } else { SEAM_PS_B(); xcd_barrier(bar); SEAM_PS_E(); } } } while (0)
    float* SSQ = (float*)(ws + WS_SSQ);
    volatile LAS unsigned* MISC = (volatile LAS unsigned*)(lds + LDS_MISC);
    if (tid < 2) MISC[tid] = 0u;
    __syncthreads();
    XcdBarrier bar; bar.bar = (unsigned*)(ws + WS_BAR); bar.x = 0; bar.st = MISC;
    int ph = 0;
    unsigned long long psec = 0ull, pdummy = 0ull;
#ifdef PROBE_GEMM_EPI
#define PSE_SEL(k) (((k) == PROBE_GEMM_EPI) ? psec : pdummy)
#else
#define PSE_SEL(k) pdummy
#endif
#ifdef PROBE_LO
    unsigned long long pt0 = 0, pt1 = 0;
#define PMARK(k) do { if (blockIdx.x == PROBE_BLK) { if ((k) == PROBE_LO) pt0 = __builtin_amdgcn_s_memrealtime(); if ((k) == PROBE_HI + 1) pt1 = __builtin_amdgcn_s_memrealtime(); } } while (0)
#else
#define PMARK(k) do { } while (0)
#endif
    PMARK(ph);
    if (IN(ph)) { prologue(a, lds, tid, lane, wave); }
    SEAM(ph); ++ph; PMARK(ph);
    if (IN(ph)) {
        pg8::Gemm g{(const bf16*)(ws + WS_A0), (const bf16*)(ws + WS_WIN0), M, 4096, D}; pg8::StaticOrder S; S.init(M, 4096, G, (int)blockIdx.x);
        pg8::EpiHgrnIn E{(bf16*)(ws + WS_A1), (float*)(ws + WS_A2), (bf16*)(ws + WS_A3), (bf16*)(ws + WS_A4), (const float*)(ws + WS_LB)};
        pg8::gemm_phase<pg8::EpiHgrnIn, pg8::StaticOrder, true, true>(lds, g, S, E, PSE_SEL(ph));
    }
    SEAM(ph); ++ph; PMARK(ph);
    if (IN(ph)) { for (int v = blockIdx.x; v < 256; v += G) { const int u = (G == 256) ? (((v & 7) * 2 + (v >> 7)) * 16 + ((v >> 3) & 15)) : v; hg::hgrn_unit<false>(a, lds, u, tid, lane, wave, psec); } }
    SEAM(ph); ++ph; PMARK(ph);
    if (IN(ph)) { for (int v = blockIdx.x; v < 256; v += G) { const int u = (G == 256) ? (((v & 7) * 2 + (v >> 7)) * 16 + ((v >> 3) & 15)) : v; hg::hgrn_unit<true>(a, lds, u, tid, lane, wave, psec); } }
    SEAM(ph); ++ph; PMARK(ph);
    if (IN(ph)) {
        pg8::Gemm g{(const bf16*)(ws + WS_A0), (const bf16*)(ws + WS_WOUT0), M, D, D}; pg8::StaticOrder S; S.init(M, D, G, (int)blockIdx.x);
        pg8::EpiResid<1, true> E{a.x, (bf16*)(ws + WS_A1), SSQ, (const float*)(ws + WS_SSQH)};
        pg8::gemm_phase<pg8::EpiResid<1, true>, pg8::StaticOrder, true, true>(lds, g, S, E, PSE_SEL(ph));
    }
    SEAM(ph); ++ph; PMARK(ph);
    if (IN(ph)) {
        pg8::Gemm g{(const bf16*)(ws + WS_A1), (const bf16*)(ws + WS_W13_0), M, 2 * DFF, D}; pg8::StaticOrder S; S.init(M, 2 * DFF, G, (int)blockIdx.x);
        pg8::EpiSwiglu E{(bf16*)(ws + WS_A2), DFF, SSQ};
        pg8::gemm_phase<pg8::EpiSwiglu, pg8::StaticOrder, true, true>(lds, g, S, E, PSE_SEL(ph));
        { const int nun = (M / 256) * (2 * DFF / 256), rem = nun % G; const int idle0 = rem ? rem : 0, nidle = rem ? G - rem : G;
          if ((int)blockIdx.x >= idle0) { __syncthreads(); convert_l1_weights(a, lds, lane, wave, (int)blockIdx.x - idle0, nidle); } }
    }
    SEAM(ph); ++ph; PMARK(ph);
    if (IN(ph)) {
        pg8::Gemm g{(const bf16*)(ws + WS_A2), (const bf16*)(ws + WS_W2_0), M, D, DFF}; pg8::StaticOrder S; S.init(M, D, G, (int)blockIdx.x);
        pg8::EpiResid<0, false> E{(const void*)(ws + WS_A1), (bf16*)(ws + WS_A1), SSQ, nullptr};
        pg8::gemm_phase<pg8::EpiResid<0, false>, pg8::StaticOrder, true, true>(lds, g, S, E, PSE_SEL(ph));
    }
    SEAM(ph); ++ph; PMARK(ph);
    if (IN(ph)) {
        pg8::Gemm g{(const bf16*)(ws + WS_A1), (const bf16*)(ws + WS_WQKV), M, 3072, D}; pg8::StaticOrder S; S.init(M, 3072, G, (int)blockIdx.x);
        pg8::EpiQKV E{(bf16*)(ws + WS_A2), (size_t)M * D, SSQ, (float*)(ws + WS_KMEAN)};
        pg8::gemm_phase<pg8::EpiQKV, pg8::StaticOrder, true, true>(lds, g, S, E, PSE_SEL(ph));
    }
    SEAM(ph); ++ph; PMARK(ph);
    if (IN(ph)) topk_phase(a, lds, tid, lane, wave);
    SEAM(ph); ++ph; PMARK(ph);
    if (IN(ph)) attn_engine<false>(a, lds, tid, lane, wave, psec);
    SEAM(ph); ++ph; PMARK(ph);
    if (IN(ph)) attn_engine<true>(a, lds, tid, lane, wave, psec);
    SEAM(ph); ++ph; PMARK(ph);
    if (IN(ph)) {
        pg8::Gemm g{(const bf16*)(ws + WS_A2), (const bf16*)(ws + WS_WOUT1), M, D, D}; pg8::StaticOrder S; S.init(M, D, G, (int)blockIdx.x);
        pg8::EpiResid<0, false> E{(const void*)(ws + WS_A1), (bf16*)(ws + WS_A1), SSQ, nullptr};
        pg8::gemm_phase<pg8::EpiResid<0, false>, pg8::StaticOrder, true, true>(lds, g, S, E, PSE_SEL(ph));
    }
    SEAM(ph); ++ph; PMARK(ph);
    if (IN(ph)) {
        pg8::Gemm g{(const bf16*)(ws + WS_A1), (const bf16*)(ws + WS_W13_1), M, 2 * DFF, D}; pg8::StaticOrder S; S.init(M, 2 * DFF, G, (int)blockIdx.x);
        pg8::EpiSwiglu E{(bf16*)(ws + WS_A2), DFF, SSQ};
        pg8::gemm_phase<pg8::EpiSwiglu, pg8::StaticOrder, true, true>(lds, g, S, E, PSE_SEL(ph));
    }
    SEAM(ph); ++ph; PMARK(ph);
    if (IN(ph)) {
        pg8::Gemm g{(const bf16*)(ws + WS_A2), (const bf16*)(ws + WS_W2_1), M, D, DFF}; pg8::StaticOrder S; S.init(M, D, G, (int)blockIdx.x);
        pg8::EpiResid<0, false> E{(const void*)(ws + WS_A1), (bf16*)(ws + WS_A1), SSQ, nullptr};
        pg8::gemm_phase<pg8::EpiResid<0, false>, pg8::StaticOrder, true, true>(lds, g, S, E, PSE_SEL(ph));
    }
    SEAM(ph); ++ph; PMARK(ph);
    if (IN(ph)) final_norm_phase(a, lane, wave);
    ++ph; PMARK(ph);
#ifdef PROBE_LO
    if (blockIdx.x == PROBE_BLK) { const unsigned long long te = __builtin_amdgcn_s_memrealtime(); unsigned long long w = 4ull * (pt1 - pt0);
#if defined(PROBE_SEC_ATT) || defined(PROBE_HG) || defined(PROBE_GEMM_EPI) || defined(PROBE_SEAMS)
        w = 4ull * psec;
#endif
        while (__builtin_amdgcn_s_memrealtime() - te < w) __builtin_amdgcn_s_sleep(8); }
#endif
#undef IN
#undef SEAM
#undef GEMM_PHASE
}

extern "C" void kernel_launch(void* const* d_in, const int* in_sizes, int n_in, void* d_out, int out_size, void* d_ws, size_t ws_size, hipStream_t stream) {
    static int grid = 0;
    if (grid == 0) {
        if (n_in != 13 || out_size != M * D || ws_size < WS_END) { fprintf(stderr, "kernel_launch: unexpected problem (n_in %d out %d ws %zu)\n", n_in, out_size, ws_size); grid = -1; return; }
        int dev = 0, cus = 0, per_cu = 0;
        (void)hipGetDevice(&dev); (void)hipDeviceGetAttribute(&cus, hipDeviceAttributeMultiprocessorCount, dev);
        if (hipFuncSetAttribute((const void*)mk, hipFuncAttributeMaxDynamicSharedMemorySize, LDS_BYTES) != hipSuccess) { fprintf(stderr, "kernel_launch: hipFuncSetAttribute failed\n"); grid = -1; return; }
        if (hipOccupancyMaxActiveBlocksPerMultiprocessor(&per_cu, (const void*)mk, NWAVES * 64, LDS_BYTES) != hipSuccess || per_cu < 1) { fprintf(stderr, "kernel_launch: occupancy query says %d\n", per_cu); (void)hipGetLastError(); grid = -1; return; }
        grid = cus;
        if (grid != 256) fprintf(stderr, "kernel_launch: note: %d CUs\n", grid);
    }
    if (grid < 0) return;
    Args a{};
    a.x = (const float*)d_in[0]; a.norm_mix = (const float*)d_in[1]; a.norm_ffn = (const float*)d_in[2]; a.hgrn_w_in = (const float*)d_in[3]; a.lb_logits = (const float*)d_in[4];
    a.hgrn_out_norm = (const float*)d_in[5]; a.hgrn_w_out = (const float*)d_in[6]; a.moba_w_in = (const float*)d_in[7]; a.moba_w_out = (const float*)d_in[8]; a.rel_table = (const float*)d_in[9];
    a.ffn_w13 = (const float*)d_in[10]; a.ffn_w2 = (const float*)d_in[11]; a.final_norm = (const float*)d_in[12];
    a.out = (float*)d_out; a.ws = (unsigned char*)d_ws;
    a.ph_lo = 0; a.ph_hi = 15;
    void* args[] = {&a};
    hipError_t e = hipLaunchCooperativeKernel((const void*)mk, dim3(grid), dim3(NWAVES * 64), args, LDS_BYTES, stream);
    if (e != hipSuccess) fprintf(stderr, "kernel_launch: cooperative launch failed: %s (grid %d)\n", hipGetErrorString(e), grid);
}
```

```cpp
#define CG_SEAM0 0
#include <hip/hip_runtime.h>
#include <hip/hip_cooperative_groups.h>
#include <cstdio>
#include <cstdint>
#include <cmath>
namespace pg8 {
#define PG8_LAS __attribute__((address_space(3)))
typedef unsigned short bf16_t;
typedef short bf16x8 __attribute__((ext_vector_type(8)));
typedef float f32x4 __attribute__((ext_vector_type(4)));
typedef unsigned u32x4 __attribute__((ext_vector_type(4)));
constexpr int BM = 256, BK = 64, HALF = 128, HTB = HALF * BK * 2  , STAGE_BYTES = 8 * HTB, NXCD = 8, WGM = 8;

__host__ __device__ __forceinline__ int lds_byte(int r, int c) { const int st = (r >> 4) * 2 + (c >> 5), rr = r & 15, cc = c & 31, ob = rr * 64 + cc * 2; return st * 1024 + (ob ^ (((ob >> 9) & 1) << 5)); }
__host__ __device__ __forceinline__ void stage_rc(int b, int& R, int& C) { const int st = b / 1024, sb = b % 1024, swz = sb ^ (((sb >> 9) & 1) << 5); R = (st >> 1) * 16 + swz / 64; C = (st & 1) * 32 + (swz % 64) / 2; }
__host__ __device__ __forceinline__ int perm32(int rho) { const int n = rho >> 4, i = rho & 15; return 8 * (i >> 2) + 4 * n + (i & 3); }

struct Unit { int pm, pn; };
struct Gemm { const bf16_t* A; const bf16_t* Bt; int M, N, K; };

struct StaticOrder {
    int nM, nN, nwg, G, c;
    __host__ __device__ void init(int M, int N, int G_, int c_) { nM = M / BM; nN = N / BM; nwg = nM * nN; G = G_; c = c_; }
    __host__ __device__ bool next(int i, Unit& u) const {
        const long L = (long)i * G + c; if (L >= nwg) return false;
        int wgid = (int)L; { const int q = nwg / NXCD, r = nwg % NXCD, xcd = wgid % NXCD, off = wgid / NXCD; wgid = (xcd < r ? xcd * (q + 1) : r * (q + 1) + (xcd - r) * q) + off; }
        const int nig = WGM * nN, gid = wgid / nig, fm = gid * WGM, gsz = (nM - fm) < WGM ? (nM - fm) : WGM;
        u.pm = fm + ((wgid % nig) % gsz); u.pn = (wgid % nig) / gsz; return true;
    }
    __device__ __forceinline__ void a_ready(const Unit&) const {}
    __device__ __forceinline__ void done(const Unit&) const {}
};
typedef float f32x2 __attribute__((ext_vector_type(2)));
typedef __bf16 bf16x2_cv __attribute__((ext_vector_type(2)));
__device__ __forceinline__ unsigned cvt_pk_bf16(float lo, float hi) { f32x2 v = {lo, hi}; bf16x2_cv b = __builtin_convertvector(v, bf16x2_cv); return __builtin_bit_cast(unsigned, b); }
#ifndef WT_STORES
#define WT_STORES 0
#endif
__device__ __forceinline__ void st16_wt(void* p, u32x4 v) {
#if WT_STORES
    asm volatile("global_store_dwordx4 %0, %1, off sc1\n\ts_nop 1" :: "v"(p), "v"(v) : "memory");
#else
    *(u32x4*)p = v;
#endif
}

typedef unsigned u32x2 __attribute__((ext_vector_type(2)));
__device__ __forceinline__ float sigm(float x) { return __builtin_amdgcn_rcpf(1.f + __expf(-x)); }
__device__ __forceinline__ float bf2f_lo(unsigned w) { return __uint_as_float(w << 16); }
__device__ __forceinline__ float bf2f_hi(unsigned w) { return __uint_as_float(w & 0xffff0000u); }
__device__ __forceinline__ float rstd_from16(const float* p) {
    const f32x4 a = *(const f32x4*)p, b = *(const f32x4*)(p + 4), c = *(const f32x4*)(p + 8), d = *(const f32x4*)(p + 12);
    const float s = ((a[0] + a[1]) + (a[2] + a[3])) + ((b[0] + b[1]) + (b[2] + b[3])) + ((c[0] + c[1]) + (c[2] + c[3])) + ((d[0] + d[1]) + (d[2] + d[3]));
    return rsqrtf(s * (1.f / 1024.f) + 1e-6f);
}
__device__ __forceinline__ float rstd_from8(const float* p) {
    const f32x4 a = *(const f32x4*)p, b = *(const f32x4*)(p + 4);
    const float s = ((a[0] + a[1]) + (a[2] + a[3])) + ((b[0] + b[1]) + (b[2] + b[3]));
    return rsqrtf(s * (1.f / 1024.f) + 1e-6f);
}

struct EpiHgrnIn {
    static constexpr bool PERM = true, AFTER_DRAIN = false;
    bf16_t* QS; float* LF; bf16_t* IN; bf16_t* OG; const float* lb;
    __device__ __forceinline__ void operator()(const f32x4 (&acc)[2][2][4][2], const Unit& u, int wr, int wc, int fr, int fq) const {
        const int type = u.pn >> 2;
        const int row0 = u.pm * BM + wr * 64 + fr;
        const int col0 = (u.pn & 3) * BM + wc * 32 + 8 * fq;
#pragma unroll
        for (int bj = 0; bj < 2; ++bj) {
            const int c = col0 + bj * HALF;
            f32x4 l0 = (f32x4){0.f, 0.f, 0.f, 0.f}, l1 = l0;
            if (type == 1) { l0 = *(const f32x4*)(lb + c); l1 = *(const f32x4*)(lb + c + 4); }
#pragma unroll
            for (int ai = 0; ai < 2; ++ai)
#pragma unroll
                for (int m = 0; m < 4; ++m) {
                    const size_t off = (size_t)(row0 + ai * HALF + m * 16) * 1024 + c;
                    f32x4 v0 = acc[ai][bj][m][0], v1 = acc[ai][bj][m][1];
                    if (type == 1) {
#pragma unroll
                        for (int i = 0; i < 4; ++i) { v0[i] = logf(l0[i] + (1.f - l0[i]) * sigm(v0[i])); v1[i] = logf(l1[i] + (1.f - l1[i]) * sigm(v1[i])); }
                        st16_wt(LF + off, __builtin_bit_cast(u32x4, v0)); st16_wt(LF + off + 4, __builtin_bit_cast(u32x4, v1));
                    } else {
                        if (type == 0) {
#pragma unroll
                            for (int i = 0; i < 4; ++i) { v0[i] = v0[i] * sigm(v0[i]); v1[i] = v1[i] * sigm(v1[i]); }
                        } else if (type == 3) {
#pragma unroll
                            for (int i = 0; i < 4; ++i) { v0[i] = sigm(v0[i]); v1[i] = sigm(v1[i]); }
                        }
                        u32x4 w; w.x = cvt_pk_bf16(v0[0], v0[1]); w.y = cvt_pk_bf16(v0[2], v0[3]); w.z = cvt_pk_bf16(v1[0], v1[1]); w.w = cvt_pk_bf16(v1[2], v1[3]);
                        if (type == 0) st16_wt(QS + off, w);
                        else if (type == 2) st16_wt(IN + off, w);
                        else st16_wt(OG + off, w);
                    }
                }
        }
    }
};

template <int SCALE, bool RF32>
struct EpiResid {
    static constexpr bool PERM = true, AFTER_DRAIN = false;
    const void* R; bf16_t* HB; float* SSQ; const float* SSQIN;
    __device__ __forceinline__ void operator()(const f32x4 (&acc)[2][2][4][2], const Unit& u, int wr, int wc, int fr, int fq) const {
        const int col0 = u.pn * BM + wc * 32 + 8 * fq;
#pragma unroll
        for (int ai = 0; ai < 2; ++ai)
#pragma unroll
            for (int m = 0; m < 4; ++m) {
                const int row = u.pm * BM + ai * HALF + wr * 64 + m * 16 + fr;
                float sc = 1.f;
                if (SCALE == 1) sc = rstd_from8(SSQIN + (size_t)row * 8);
                const size_t off = (size_t)row * 1024 + col0;
                float ss = 0.f;
#pragma unroll
                for (int bj = 0; bj < 2; ++bj) {
                    const size_t o2 = off + bj * HALF;
                    f32x4 r0, r1;
                    if (RF32) { r0 = *(const f32x4*)((const float*)R + o2); r1 = *(const f32x4*)((const float*)R + o2 + 4); }
                    else { const u32x4 rw = *(const u32x4*)((const bf16_t*)R + o2);
                        r0 = (f32x4){bf2f_lo(rw.x), bf2f_hi(rw.x), bf2f_lo(rw.y), bf2f_hi(rw.y)}; r1 = (f32x4){bf2f_lo(rw.z), bf2f_hi(rw.z), bf2f_lo(rw.w), bf2f_hi(rw.w)}; }
                    const f32x4 v0 = r0 + acc[ai][bj][m][0] * sc, v1 = r1 + acc[ai][bj][m][1] * sc;
                    ss += ((v0[0] * v0[0] + v0[1] * v0[1]) + (v0[2] * v0[2] + v0[3] * v0[3])) + ((v1[0] * v1[0] + v1[1] * v1[1]) + (v1[2] * v1[2] + v1[3] * v1[3]));
                    u32x4 w; w.x = cvt_pk_bf16(v0[0], v0[1]); w.y = cvt_pk_bf16(v0[2], v0[3]); w.z = cvt_pk_bf16(v1[0], v1[1]); w.w = cvt_pk_bf16(v1[2], v1[3]);
                    st16_wt(HB + o2, w);
                }
                ss += __shfl_xor(ss, 16); ss += __shfl_xor(ss, 32);
                if (fq == 0) SSQ[(size_t)row * 16 + u.pn * 4 + wc] = ss;
                if (m & 1) asm volatile("" ::: "memory");
            }
    }
};

struct EpiSwiglu {
    static constexpr bool PERM = true, AFTER_DRAIN = false;
    bf16_t* HID; int ldh; const float* SSQIN;
    __device__ __forceinline__ void operator()(const f32x4 (&acc)[2][2][4][2], const Unit& u, int wr, int wc, int fr, int fq) const {
        const int col0 = u.pn * HALF + wc * 32 + 8 * fq;
#pragma unroll
        for (int ai = 0; ai < 2; ++ai)
#pragma unroll
            for (int m = 0; m < 4; ++m) {
                const int row = u.pm * BM + ai * HALF + wr * 64 + m * 16 + fr;
                const float sc = rstd_from16(SSQIN + (size_t)row * 16);
                f32x4 g0 = acc[ai][0][m][0] * sc, g1 = acc[ai][0][m][1] * sc, u0 = acc[ai][1][m][0] * sc, u1 = acc[ai][1][m][1] * sc;
#pragma unroll
                for (int i = 0; i < 4; ++i) { g0[i] = g0[i] * sigm(g0[i]) * u0[i]; g1[i] = g1[i] * sigm(g1[i]) * u1[i]; }
                u32x4 w; w.x = cvt_pk_bf16(g0[0], g0[1]); w.y = cvt_pk_bf16(g0[2], g0[3]); w.z = cvt_pk_bf16(g1[0], g1[1]); w.w = cvt_pk_bf16(g1[2], g1[3]);
                st16_wt(HID + (size_t)row * ldh + col0, w);
            }
    }
};

struct EpiQKV {
    static constexpr bool PERM = true, AFTER_DRAIN = false;
    bf16_t* O; size_t split_stride; const float* SSQIN; float* KMEAN;
    __device__ __forceinline__ void operator()(const f32x4 (&acc)[2][2][4][2], const Unit& u, int wr, int wc, int fr, int fq) const {
        const int t = u.pn >> 2;
        bf16_t* base = O + (size_t)t * split_stride;
        const int col0 = (u.pn & 3) * BM + wc * 32 + 8 * fq;
        f32x4 cs[2][2];
#pragma unroll
        for (int bj = 0; bj < 2; ++bj) { cs[bj][0] = (f32x4){0.f, 0.f, 0.f, 0.f}; cs[bj][1] = cs[bj][0]; }
#pragma unroll
        for (int ai = 0; ai < 2; ++ai)
#pragma unroll
            for (int m = 0; m < 4; ++m) {
                const int row = u.pm * BM + ai * HALF + wr * 64 + m * 16 + fr;
                const float sc = rstd_from16(SSQIN + (size_t)row * 16);
#pragma unroll
                for (int bj = 0; bj < 2; ++bj) {
                    const f32x4 v0 = acc[ai][bj][m][0] * sc, v1 = acc[ai][bj][m][1] * sc;
                    cs[bj][0] += v0; cs[bj][1] += v1;
                    u32x4 w; w.x = cvt_pk_bf16(v0[0], v0[1]); w.y = cvt_pk_bf16(v0[2], v0[3]); w.z = cvt_pk_bf16(v1[0], v1[1]); w.w = cvt_pk_bf16(v1[2], v1[3]);
                    st16_wt(base + (size_t)row * 1024 + col0 + bj * HALF, w);
                }
            }
        if (t == 1) {
#pragma unroll
            for (int bj = 0; bj < 2; ++bj)
#pragma unroll
                for (int n = 0; n < 2; ++n)
#pragma unroll
                    for (int i = 0; i < 4; ++i) {
                        float s = cs[bj][n][i];
                        s += __shfl_xor(s, 1); s += __shfl_xor(s, 2); s += __shfl_xor(s, 4); s += __shfl_xor(s, 8);
                        if (fr == 0) atomicAdd(KMEAN + (size_t)u.pm * 1024 + col0 + bj * HALF + 4 * n + i, s * (1.f / 256.f));
                    }
        }
    }
};

#ifdef PROBE_GEMM_EPI
#define PG8_PS_B() do { __builtin_amdgcn_sched_barrier(0); psec -= __builtin_amdgcn_s_memrealtime(); __builtin_amdgcn_sched_barrier(0); } while (0)
#define PG8_PS_E() do { __builtin_amdgcn_sched_barrier(0); psec += __builtin_amdgcn_s_memrealtime(); __builtin_amdgcn_sched_barrier(0); } while (0)
#else
#define PG8_PS_B() do { } while (0)
#define PG8_PS_E() do { } while (0)
#endif
template <class Epi, class Sched, bool ALIGN_EPI = false, bool SP2 = false>
__device__ __forceinline__ void gemm_phase(PG8_LAS unsigned char* lds, const Gemm g, const Sched& S, const Epi& E, unsigned long long& psec) {
    const int tid = threadIdx.x, wid = __builtin_amdgcn_readfirstlane(tid >> 6), lane = tid & 63, wr = wid >> 2, wc = wid & 3, fr = lane & 15, fq = lane >> 4;
    const int K = g.K, nt = K / BK;
    unsigned voffA[2], voffB[2];
#pragma unroll
    for (int i = 0; i < 2; ++i) { int R, C; stage_rc(tid * 16 + i * 8192, R, C); const int Rb = Epi::PERM ? ((R & ~31) + perm32(R & 31)) : R;
        voffA[i] = (unsigned)(R * K + C) * 2u; voffB[i] = (unsigned)(Rb * K + C) * 2u; }
    const size_t kstep = (size_t)(BK * 2);
    const size_t hstep = (size_t)HALF * K * 2;
    const size_t tstep = 2 * hstep;
    const unsigned ldsw = (unsigned)wid * 1024u;
    const int aoff = lds_byte(wr * 64 + fr, fq * 8), boff = lds_byte(wc * 32 + fr, fq * 8);
#define PG8_SA(b, h) (((b) * 2 + (h)) * HTB)
#define PG8_SB(b, h) ((4 + (b) * 2 + (h)) * HTB)
#define PG8_STAGE(bufoff, gbase, voff) do { _Pragma("unroll") for (int _i = 0; _i < 2; ++_i) \
        __builtin_amdgcn_global_load_lds((const unsigned*)((const char*)(gbase) + (voff)[_i]), (PG8_LAS unsigned*)(lds + (bufoff) + ldsw + _i * 8192), 16, 0, 0); } while (0)
#define PG8_LDA(dst, b, h) do { _Pragma("unroll") for (int m = 0; m < 4; ++m) _Pragma("unroll") for (int k = 0; k < 2; ++k) dst[m][k] = *(const PG8_LAS bf16x8*)(lds + PG8_SA(b, h) + aoff + m * 2048 + k * 1024); } while (0)
#define PG8_LDB(dst, b, h) do { _Pragma("unroll") for (int n = 0; n < 2; ++n) _Pragma("unroll") for (int k = 0; k < 2; ++k) dst[n][k] = *(const PG8_LAS bf16x8*)(lds + PG8_SB(b, h) + boff + n * 2048 + k * 1024); } while (0)
#define PG8_MMA(ai, bj, At, Bt) do { __builtin_amdgcn_s_setprio(1); _Pragma("unroll") for (int m = 0; m < 4; ++m) _Pragma("unroll") for (int n = 0; n < 2; ++n) _Pragma("unroll") for (int k = 0; k < 2; ++k) \
        acc[ai][bj][m][n] = __builtin_amdgcn_mfma_f32_16x16x32_bf16(Bt[n][k], At[m][k], acc[ai][bj][m][n], 0, 0, 0); __builtin_amdgcn_s_setprio(0); } while (0)
#define PG8_WAIT_V(n) asm volatile("s_waitcnt vmcnt(" #n ")" ::: "memory")
#define PG8_WAIT_L(n) asm volatile("s_waitcnt lgkmcnt(" #n ")" ::: "memory")
#define PG8_BAR __builtin_amdgcn_s_barrier()
#define PG8_SCHED __builtin_amdgcn_sched_barrier(0)
    Unit cur, nxt; int ui = 0;
    if (!S.next(0, cur)) return;
    f32x4 acc[2][2][4][2];
#pragma unroll
    for (int a = 0; a < 2; ++a)
#pragma unroll
        for (int b = 0; b < 2; ++b)
#pragma unroll
            for (int m = 0; m < 4; ++m)
#pragma unroll
                for (int n = 0; n < 2; ++n) acc[a][b][m][n] = (f32x4){0.f, 0.f, 0.f, 0.f};
    bf16x8 At[4][2], B0[2][2], B1[2][2];
    const char* cA = (const char*)g.A + (size_t)cur.pm * tstep; const char* cB = (const char*)g.Bt + (size_t)cur.pn * tstep;
    S.a_ready(cur);
    if constexpr (SP2) {
        PG8_STAGE(PG8_SB(0, 0), cB, voffB); PG8_STAGE(PG8_SB(0, 1), cB + hstep, voffB); PG8_STAGE(PG8_SA(0, 0), cA, voffA); PG8_STAGE(PG8_SA(0, 1), cA + hstep, voffA);
        if (wr == 1) PG8_BAR;
        PG8_WAIT_V(2); PG8_BAR;
        PG8_STAGE(PG8_SB(1, 0), cB + kstep, voffB); PG8_STAGE(PG8_SA(1, 0), cA + kstep, voffA); PG8_STAGE(PG8_SB(1, 1), cB + hstep + kstep, voffB);
        PG8_WAIT_V(6); PG8_BAR;
    } else {
        PG8_STAGE(PG8_SB(0, 0), cB, voffB); PG8_STAGE(PG8_SA(0, 0), cA, voffA); PG8_STAGE(PG8_SB(0, 1), cB + hstep, voffB); PG8_STAGE(PG8_SA(0, 1), cA + hstep, voffA);
        if (wr == 1) PG8_BAR;
        PG8_WAIT_V(4); PG8_BAR;
        PG8_STAGE(PG8_SB(1, 0), cB + kstep, voffB); PG8_STAGE(PG8_SA(1, 0), cA + kstep, voffA); PG8_STAGE(PG8_SB(1, 1), cB + hstep + kstep, voffB);
        PG8_WAIT_V(6); PG8_BAR;
    }
    for (;;) {
        const bool has_next = S.next(ui + 1, nxt);
        const char* nA = has_next ? (const char*)g.A + (size_t)nxt.pm * tstep : cA; const char* nB = has_next ? (const char*)g.Bt + (size_t)nxt.pn * tstep : cB;
        for (int t = 0; t < nt; t += 2) {
            const bool last = (t == nt - 2);
            const char* a1 = cA + (size_t)(t + 1) * kstep;
            const char* a2 = last ? nA : cA + (size_t)(t + 2) * kstep; const char* b2 = last ? nB : cB + (size_t)(t + 2) * kstep;
            const char* a3 = a2 + kstep; const char* b3 = b2 + kstep;
            if (last && has_next) S.a_ready(nxt);
            if constexpr (SP2) {
            PG8_LDB(B0, 0, 0); PG8_LDB(B1, 0, 1); PG8_SCHED; PG8_LDA(At, 0, 0); PG8_STAGE(PG8_SA(1, 1), a1 + hstep, voffA);
            PG8_WAIT_V(8); PG8_WAIT_L(0); PG8_BAR; PG8_MMA(0, 0, At, B0); PG8_MMA(0, 1, At, B1); PG8_BAR; PG8_SCHED;
            PG8_LDA(At, 0, 1); PG8_STAGE(PG8_SB(0, 0), b2, voffB); PG8_STAGE(PG8_SB(0, 1), b2 + hstep, voffB); PG8_STAGE(PG8_SA(0, 0), a2, voffA);
            PG8_WAIT_V(8); PG8_WAIT_L(0); PG8_BAR; PG8_MMA(1, 0, At, B0); PG8_MMA(1, 1, At, B1); PG8_BAR; PG8_SCHED;
            PG8_LDB(B0, 1, 0); PG8_LDB(B1, 1, 1); PG8_SCHED; PG8_LDA(At, 1, 0); PG8_STAGE(PG8_SA(0, 1), a2 + hstep, voffA);
            PG8_WAIT_V(8); PG8_WAIT_L(0); PG8_BAR; PG8_MMA(0, 0, At, B0); PG8_MMA(0, 1, At, B1); PG8_BAR; PG8_SCHED;
            PG8_LDA(At, 1, 1); PG8_STAGE(PG8_SB(1, 0), b3, voffB); PG8_STAGE(PG8_SB(1, 1), b3 + hstep, voffB); PG8_STAGE(PG8_SA(1, 0), a3, voffA);
            PG8_WAIT_V(8); PG8_WAIT_L(0); PG8_BAR; PG8_MMA(1, 0, At, B0); PG8_MMA(1, 1, At, B1); PG8_BAR; PG8_SCHED;
            } else {
            PG8_LDB(B0, 0, 0); PG8_SCHED; PG8_LDA(At, 0, 0); PG8_STAGE(PG8_SA(1, 1), a1 + hstep, voffA);
            PG8_WAIT_L(8); PG8_BAR; PG8_WAIT_L(0); PG8_MMA(0, 0, At, B0); PG8_BAR; PG8_SCHED;
            PG8_LDB(B1, 0, 1); PG8_STAGE(PG8_SB(0, 0), b2, voffB);
            PG8_BAR; PG8_WAIT_L(0); PG8_MMA(0, 1, At, B1); PG8_BAR;
            PG8_LDA(At, 0, 1); PG8_STAGE(PG8_SA(0, 0), a2, voffA);
            PG8_BAR; PG8_WAIT_L(0); PG8_MMA(1, 0, At, B0); PG8_BAR; PG8_SCHED;
            PG8_STAGE(PG8_SB(0, 1), b2 + hstep, voffB);
            PG8_WAIT_V(6); PG8_BAR; PG8_MMA(1, 1, At, B1); PG8_BAR;
            PG8_LDB(B0, 1, 0); PG8_SCHED; PG8_LDA(At, 1, 0); PG8_STAGE(PG8_SA(0, 1), a2 + hstep, voffA);
            PG8_WAIT_L(8); PG8_BAR; PG8_WAIT_L(0); PG8_MMA(0, 0, At, B0); PG8_BAR; PG8_SCHED;
            PG8_LDB(B1, 1, 1); PG8_STAGE(PG8_SB(1, 0), b3, voffB);
            PG8_BAR; PG8_WAIT_L(0); PG8_MMA(0, 1, At, B1); PG8_BAR;
            PG8_LDA(At, 1, 1); PG8_STAGE(PG8_SA(1, 0), a3, voffA);
            PG8_BAR; PG8_WAIT_L(0); PG8_MMA(1, 0, At, B0); PG8_BAR; PG8_SCHED;
            PG8_STAGE(PG8_SB(1, 1), b3 + hstep, voffB);
            PG8_WAIT_V(6); PG8_BAR; PG8_MMA(1, 1, At, B1); PG8_BAR;
            }
        }
        if constexpr (ALIGN_EPI) { if (wr == 0) PG8_BAR; }
        if constexpr (!Epi::AFTER_DRAIN) { PG8_PS_B(); E(acc, cur, wr, wc, fr, fq); S.done(cur); PG8_PS_E(); }
        if (!has_next) break;
#pragma unroll
        for (int a = 0; a < 2; ++a)
#pragma unroll
            for (int b = 0; b < 2; ++b)
#pragma unroll
                for (int m = 0; m < 4; ++m)
#pragma unroll
                    for (int n = 0; n < 2; ++n) acc[a][b][m][n] = (f32x4){0.f, 0.f, 0.f, 0.f};
        cur = nxt; cA = nA; cB = nB; ++ui;
        if constexpr (ALIGN_EPI) { if (wr == 1) PG8_BAR; }
    }
    PG8_WAIT_V(0);
    if constexpr (!ALIGN_EPI) { if (wr == 0) PG8_BAR; }
    PG8_BAR;
    if constexpr (Epi::AFTER_DRAIN) { E.fused(acc, cur, wr, wc, fr, fq, lds, wid, lane); S.done(cur); }
#undef PG8_SA
#undef PG8_SB
#undef PG8_STAGE
#undef PG8_LDA
#undef PG8_LDB
#undef PG8_MMA
#undef PG8_WAIT_V
#undef PG8_WAIT_L
#undef PG8_BAR
#undef PG8_SCHED
}
}

namespace cg = cooperative_groups;
constexpr int NWAVES = 8;
constexpr int BATCH = 2, T = 8192, D = 1024, H = 8, DH = 128, DFF = 2816, NB = 32, BLK = 256;
constexpr int M = BATCH * T;
constexpr float EPS = 1e-6f;
constexpr size_t MiB = 1u << 20;
constexpr size_t WS_CTL = 0;
constexpr size_t WS_WQKV = 1 * MiB, WS_WOUT1 = 7 * MiB, WS_W13_1 = 9 * MiB, WS_W2_1 = 20 * MiB;
constexpr size_t WS_WIN0 = 26 * MiB, WS_WOUT0 = 34 * MiB, WS_W13_0 = 36 * MiB, WS_W2_0 = 47 * MiB;
constexpr size_t WS_SSQ = 53 * MiB;
constexpr size_t WS_SSQH = 54 * MiB;
constexpr size_t WS_LB = 54 * MiB + 512 * 1024;
constexpr size_t WS_BKT = WS_LB + 4096;
constexpr size_t WS_YMEAN = WS_BKT + 32768;
constexpr size_t WS_KMEAN = WS_YMEAN + 262144;
constexpr size_t WS_SEL = 55 * MiB + 512 * 1024;
constexpr size_t WS_G = 56 * MiB;
constexpr size_t WS_A0 = 60 * MiB;
constexpr size_t WS_A1 = 92 * MiB;
constexpr size_t WS_A2 = 124 * MiB;
constexpr size_t WS_A3 = 188 * MiB;
constexpr size_t WS_A4 = 220 * MiB;
constexpr size_t WS_END = 256 * MiB;
static_assert(WS_W2_0 + (size_t)D * DFF * 2 <= WS_SSQ && WS_G + 2 * MiB <= WS_A0 && WS_A4 + 32 * MiB <= WS_END, "ws map");

#ifndef CG_SEAM0
#define CG_SEAM0 1
#endif
constexpr int LDS_BYTES = 163840;
constexpr int LDS_MISC = 163584;
constexpr size_t WS_BAR = 65536;

#define GAS __attribute__((address_space(1)))
#define LAS __attribute__((address_space(3)))
typedef unsigned short bf16;
typedef unsigned v4u __attribute__((ext_vector_type(4)));
typedef float f32x4 __attribute__((ext_vector_type(4)));
#define LDS_WAIT() asm volatile("s_waitcnt lgkmcnt(0)" ::: "memory")
__device__ __forceinline__ unsigned f2bf(float f) { unsigned u = __builtin_bit_cast(unsigned, f); return (u + 0x7fffu + ((u >> 16) & 1u)) >> 16; }
__device__ __forceinline__ unsigned pk2(float lo, float hi) { return f2bf(lo) | (f2bf(hi) << 16); }
__device__ __forceinline__ float bf2f(unsigned short b) { return __uint_as_float((unsigned)b << 16); }
__device__ __forceinline__ float wave_sum(float v) {
#pragma unroll
    for (int o = 1; o < 64; o <<= 1) v += __shfl_xor(v, o);
    return v;
}

struct Args {
    const float* x; const float* norm_mix; const float* norm_ffn; const float* hgrn_w_in; const float* lb_logits; const float* hgrn_out_norm; const float* hgrn_w_out;
    const float* moba_w_in; const float* moba_w_out; const float* rel_table; const float* ffn_w13; const float* ffn_w2; const float* final_norm;
    float* out; unsigned char* ws; int ph_lo, ph_hi;
};

__device__ __forceinline__ void tr_item(const float* W, int ldw, int K, bf16* WT, int Ndst, const float* gain, int mode, LAS float* scr, int item, int lane) {
    const int nblk = Ndst / 64, kb = item / nblk, nb = item % nblk, k0 = 64 * kb, n0 = 64 * nb;
    int s0 = n0;
    if (mode == 1) { const int t = n0 >> 8, c = n0 & 255; s0 = (c < 128) ? (128 * t + c) : (DFF + 128 * t + (c - 128)); }
    f32x4 wv[16];
#pragma unroll
    for (int i = 0; i < 16; ++i) wv[i] = *(const GAS f32x4*)(W + (size_t)(k0 + 4 * i + (lane >> 4)) * ldw + s0 + (lane & 15) * 4);
#pragma unroll
    for (int i = 0; i < 16; ++i) { const int kk = 4 * i + (lane >> 4);
        f32x4 w = wv[i];
        if (gain) w = w * gain[k0 + kk];
        LAS float* d = scr + kk * 65 + (lane & 15) * 4; d[0] = w.x; d[1] = w.y; d[2] = w.z; d[3] = w.w; }
    LDS_WAIT(); asm volatile("" ::: "memory");
    const int c = lane & 7;
#pragma unroll
    for (int j = 0; j < 8; ++j) { const int n = (lane >> 3) + 8 * j; const LAS float* s = scr + (8 * c) * 65 + n;
        v4u o; o.x = pk2(s[0 * 65], s[1 * 65]); o.y = pk2(s[2 * 65], s[3 * 65]); o.z = pk2(s[4 * 65], s[5 * 65]); o.w = pk2(s[6 * 65], s[7 * 65]);
        *(GAS v4u*)(WT + (size_t)(n0 + n) * K + k0 + 8 * c) = o; }
    LDS_WAIT(); asm volatile("" ::: "memory");
}

__device__ __forceinline__ void prologue(const Args& a, LAS unsigned char* lds, int tid, int lane, int wave) {
    unsigned char* ws = a.ws;
    LAS float* scr = (LAS float*)(lds + wave * 16640);
    const int gw = blockIdx.x * NWAVES + wave, NGW = gridDim.x * NWAVES;
    constexpr int I_IN0 = (D / 64) * (4096 / 64), I_O = (D / 64) * (D / 64), I_13 = (D / 64) * (2 * DFF / 64), I_2 = (DFF / 64) * (D / 64);
    constexpr int NITEMS = I_IN0 + I_O + I_13 + I_2;
    for (int it = gw; it < NITEMS; it += NGW) {
        int r = it;
        if (r < I_IN0) { tr_item(a.hgrn_w_in, 4096, D, (bf16*)(ws + WS_WIN0), 4096, nullptr, 0, scr, r, lane); continue; } r -= I_IN0;
        if (r < I_O) { tr_item(a.hgrn_w_out, D, D, (bf16*)(ws + WS_WOUT0), D, a.hgrn_out_norm, 0, scr, r, lane); continue; } r -= I_O;
        if (r < I_13) { tr_item(a.ffn_w13, 2 * DFF, D, (bf16*)(ws + WS_W13_0), 2 * DFF, a.norm_ffn, 1, scr, r, lane); continue; } r -= I_13;
        tr_item(a.ffn_w2, D, DFF, (bf16*)(ws + WS_W2_0), D, nullptr, 0, scr, r, lane);
    }
    bf16* XN0 = (bf16*)(ws + WS_A0);
    for (int m = 2 * gw; m < M; m += 2 * NGW) {
        const GAS f32x4* xr = (const GAS f32x4*)(a.x + (size_t)m * D) + lane;
        f32x4 v[8]; float s0 = 0.f, s1 = 0.f;
#pragma unroll
        for (int j = 0; j < 8; ++j) v[j] = xr[64 * j];
#pragma unroll
        for (int j = 0; j < 4; ++j) { s0 += (v[j].x * v[j].x + v[j].y * v[j].y) + (v[j].z * v[j].z + v[j].w * v[j].w); s1 += (v[4 + j].x * v[4 + j].x + v[4 + j].y * v[4 + j].y) + (v[4 + j].z * v[4 + j].z + v[4 + j].w * v[4 + j].w); }
        const float r0 = rsqrtf(wave_sum(s0) * (1.f / D) + EPS), r1 = rsqrtf(wave_sum(s1) * (1.f / D) + EPS);
        GAS unsigned long long* o8 = (GAS unsigned long long*)(XN0 + (size_t)m * D) + lane;
#pragma unroll
        for (int j = 0; j < 8; ++j) { const f32x4 g = *((const GAS f32x4*)a.norm_mix + lane + 64 * (j & 3)); const float rs = j < 4 ? r0 : r1;
            o8[64 * j] = (unsigned long long)pk2(v[j].x * rs * g.x, v[j].y * rs * g.y) | ((unsigned long long)pk2(v[j].z * rs * g.z, v[j].w * rs * g.w) << 32); }
    }
    for (int i = blockIdx.x * (NWAVES * 64) + tid; i < 64 * D; i += gridDim.x * NWAVES * 64) ((float*)(ws + WS_KMEAN))[i] = 0.f;
    if (blockIdx.x == 0) {
        float* lb = (float*)(ws + WS_LB); int* bkt = (int*)(ws + WS_BKT);
        for (int i = tid; i < 1024; i += NWAVES * 64) { const float l0 = a.lb_logits[i], l1 = a.lb_logits[1024 + i]; const float mx = fmaxf(l0, l1); const float e0 = expf(l0 - mx), e1 = expf(l1 - mx); lb[i] = e0 / (e0 + e1); }
        for (int i = tid; i < T; i += NWAVES * 64) {
            int bk;
            if (i < 16) bk = i;
            else { const float nf = (float)i; const float v = logf(nf / 16.f) / 4.1588830833596715f * 16.f; bk = 16 + (int)v; if (bk > 31) bk = 31; }
            bkt[i] = bk;
            if (i < 1024) { float* tab2 = (float*)(ws + WS_YMEAN);
#pragma unroll
                for (int hh = 0; hh < 8; ++hh) tab2[hh * 1024 + i] = a.rel_table[bk * 8 + hh] * 1.4426950408889634f; }
        }
        for (int i = tid; i < 1024; i += NWAVES * 64) ((unsigned*)(ws + 4096))[i] = 0u;
#if CG_SEAM0
        for (int i = tid; i < 3456; i += NWAVES * 64) ((unsigned*)(ws + WS_BAR))[i] = 0u;
#endif
    }
}

__device__ __forceinline__ void convert_l1_weights(const Args& a, LAS unsigned char* lds, int lane, int wave, int rank, int nrank) {
    unsigned char* ws = a.ws;
    LAS float* scr = (LAS float*)(lds + wave * 16640);
    const int gw = rank * NWAVES + wave, NGW = nrank * NWAVES;
    constexpr int I_O = (D / 64) * (D / 64), I_13 = (D / 64) * (2 * DFF / 64), I_2 = (DFF / 64) * (D / 64), I_QKV = (D / 64) * (3072 / 64);
    constexpr int NITEMS = I_QKV + I_O + I_13 + I_2;
    for (int it = gw; it < NITEMS; it += NGW) {
        int r = it;
        if (r < I_QKV) { tr_item(a.moba_w_in, 3072, D, (bf16*)(ws + WS_WQKV), 3072, a.norm_mix + D, 0, scr, r, lane); continue; } r -= I_QKV;
        if (r < I_O) { tr_item(a.moba_w_out, D, D, (bf16*)(ws + WS_WOUT1), D, nullptr, 0, scr, r, lane); continue; } r -= I_O;
        if (r < I_13) { tr_item(a.ffn_w13 + (size_t)D * 2 * DFF, 2 * DFF, D, (bf16*)(ws + WS_W13_1), 2 * DFF, a.norm_ffn + D, 1, scr, r, lane); continue; } r -= I_13;
        tr_item(a.ffn_w2 + (size_t)DFF * D, D, DFF, (bf16*)(ws + WS_W2_1), D, nullptr, 0, scr, r, lane);
    }
}

__device__ __forceinline__ void final_norm_phase(const Args& a, int lane, int wave) {
    const int gw = blockIdx.x * NWAVES + wave, NGW = gridDim.x * NWAVES;
    const float* SSQ = (const float*)(a.ws + WS_SSQ); const bf16* HB = (const bf16*)(a.ws + WS_A1);
    for (int m = gw; m < M; m += NGW) {
        const float rstd = pg8::rstd_from16(SSQ + (size_t)m * 16);
        const GAS v4u* hr = (const GAS v4u*)(HB + (size_t)m * D) + lane;
        GAS f32x4* orow = (GAS f32x4*)(a.out + (size_t)m * D);
#pragma unroll
        for (int j = 0; j < 2; ++j) {
            const v4u w = hr[64 * j]; const int c = (64 * j + lane) * 8;
            const f32x4 g0 = *(const GAS f32x4*)(a.final_norm + c), g1 = *(const GAS f32x4*)(a.final_norm + c + 4);
            f32x4 o0, o1;
            o0.x = __uint_as_float(w.x << 16) * rstd * g0.x; o0.y = __uint_as_float(w.x & 0xffff0000u) * rstd * g0.y; o0.z = __uint_as_float(w.y << 16) * rstd * g0.z; o0.w = __uint_as_float(w.y & 0xffff0000u) * rstd * g0.w;
            o1.x = __uint_as_float(w.z << 16) * rstd * g1.x; o1.y = __uint_as_float(w.z & 0xffff0000u) * rstd * g1.y; o1.z = __uint_as_float(w.w << 16) * rstd * g1.z; o1.w = __uint_as_float(w.w & 0xffff0000u) * rstd * g1.w;
            orow[c / 4] = o0; orow[c / 4 + 1] = o1;
        }
    }
}

__device__ __forceinline__ float sigmoidf_(float x) { return 1.f / (1.f + __expf(-x)); }

namespace moba {
using bf16x8 = __attribute__((ext_vector_type(8))) short;
using s16x4 = __attribute__((ext_vector_type(4))) short;
using f32x16 = __attribute__((ext_vector_type(16))) float;
using u32x4 = __attribute__((ext_vector_type(4))) unsigned;
#define KSWZ(row, colB) ((row) * 256 + ((colB) ^ (((row) & 7) << 4)))
#define SBAR() __builtin_amdgcn_sched_barrier(0)
constexpr float C2 = 0.08838834764831845f * 1.4426950408889634f;
constexpr float LOG2E = 1.4426950408889634f;
__device__ __forceinline__ int crow(int r, int hi) { return (r & 3) + 8 * (r >> 2) + 4 * hi; }
__device__ __forceinline__ unsigned cvtpk(float lo, float hi) { return pg8::cvt_pk_bf16(lo, hi); }
__device__ __forceinline__ int v_st(int k, int c) { const int kk = (k & ~0xC) | ((k & 4) << 1) | ((k & 8) >> 1); return ((kk >> 3) * 4 + (c >> 5)) * 512 + ((kk & 7) * 32 + (c & 31)) * 2; }
__device__ __forceinline__ int v_rd_base(int lane) { return ((lane & 3) << 3) | (((lane >> 2) & 3) << 6) | (((lane >> 4) & 1) << 5) | (((lane >> 5) & 1) << 8); }
constexpr int v_rd_off(int d0, int ks, int half) { return d0 * 512 + ks * 4096 + half * 2048; }
template <int OFF> __device__ __forceinline__ s16x4 tr_read(int vb) {
    s16x4 r; asm volatile("ds_read_b64_tr_b16 %0, %1 offset:%2" : "=&v"(r) : "v"(vb), "i"(OFF) : "memory"); return r;
}
template <int D0> __device__ __forceinline__ void pv_one(f32x16& od, int vb, bf16x8 pa0, bf16x8 pa1, bf16x8 pa2, bf16x8 pa3) {
    const s16x4 l0 = tr_read<v_rd_off(D0, 0, 0)>(vb), h0 = tr_read<v_rd_off(D0, 0, 1)>(vb), l1 = tr_read<v_rd_off(D0, 1, 0)>(vb), h1 = tr_read<v_rd_off(D0, 1, 1)>(vb);
    const s16x4 l2 = tr_read<v_rd_off(D0, 2, 0)>(vb), h2 = tr_read<v_rd_off(D0, 2, 1)>(vb), l3 = tr_read<v_rd_off(D0, 3, 0)>(vb), h3 = tr_read<v_rd_off(D0, 3, 1)>(vb);
    asm volatile("s_waitcnt lgkmcnt(0)" ::: "memory"); SBAR();
#define PK(L, Hh) (bf16x8){L[0], L[1], L[2], L[3], Hh[0], Hh[1], Hh[2], Hh[3]}
    od = __builtin_amdgcn_mfma_f32_32x32x16_bf16(pa0, PK(l0, h0), od, 0, 0, 0);
    od = __builtin_amdgcn_mfma_f32_32x32x16_bf16(pa1, PK(l1, h1), od, 0, 0, 0);
    od = __builtin_amdgcn_mfma_f32_32x32x16_bf16(pa2, PK(l2, h2), od, 0, 0, 0);
    od = __builtin_amdgcn_mfma_f32_32x32x16_bf16(pa3, PK(l3, h3), od, 0, 0, 0);
#undef PK
}
__device__ __forceinline__ void qkt(f32x16& p0, f32x16& p1, const LAS unsigned char* Ks, const bf16x8 (&qr)[8], int r32, int hi) {
    p0 = f32x16{}; p1 = f32x16{};
#pragma unroll
    for (int d0 = 0; d0 < 8; ++d0) { const int cb = (d0 * 16 + hi * 8) * 2;
        const bf16x8 b0 = *(const LAS bf16x8*)(Ks + KSWZ(r32, cb));
        const bf16x8 b1 = *(const LAS bf16x8*)(Ks + KSWZ(32 + r32, cb));
        p0 = __builtin_amdgcn_mfma_f32_32x32x16_bf16(b0, qr[d0], p0, 0, 0, 0);
        p1 = __builtin_amdgcn_mfma_f32_32x32x16_bf16(b1, qr[d0], p1, 0, 0, 0); }
}
}

constexpr size_t WS_CNT = 4096;
constexpr size_t WS_TAB2 = WS_YMEAN;
constexpr size_t WS_LIST = WS_WIN0;
constexpr size_t WS_LSE = WS_G;
constexpr size_t WS_PO0 = WS_A0, WS_PO2 = WS_A4;

__device__ __forceinline__ void topk_phase(const Args& a, LAS unsigned char* lds, int tid, int lane, int wid) {
    using namespace moba;
    const bf16* Q = (const bf16*)(a.ws + WS_A2); const float* kmean = (const float*)(a.ws + WS_KMEAN);
    unsigned* cnt = (unsigned*)(a.ws + WS_CNT); unsigned short* lists = (unsigned short*)(a.ws + WS_LIST);
    LAS unsigned* lcnt = (LAS unsigned*)lds;
    const int r32 = lane & 31, hi = lane >> 5;
    for (int it = blockIdx.x; it < 512; it += gridDim.x) {
        const int bh = it >> 5, j = it & 31, b = bh >> 3, h = bh & 7;
        if (j == 0) continue;
        __syncthreads();
        if (tid < 64) lcnt[tid] = 0u;
        __syncthreads();
        bf16x8 ahi[8], alo[8];
        const float* kp = kmean + (size_t)(b * 32 + r32) * D + h * 128 + hi * 8;
#pragma unroll
        for (int ks = 0; ks < 8; ++ks) {
            const f32x4 v0 = *(const f32x4*)(kp + 16 * ks), v1 = *(const f32x4*)(kp + 16 * ks + 4);
            const unsigned h0 = pk2(v0[0], v0[1]), h1 = pk2(v0[2], v0[3]), h2 = pk2(v1[0], v1[1]), h3 = pk2(v1[2], v1[3]);
            const unsigned l0 = pk2(v0[0] - __uint_as_float(h0 << 16), v0[1] - __uint_as_float(h0 & 0xffff0000u)), l1 = pk2(v0[2] - __uint_as_float(h1 << 16), v0[3] - __uint_as_float(h1 & 0xffff0000u));
            const unsigned l2 = pk2(v1[0] - __uint_as_float(h2 << 16), v1[1] - __uint_as_float(h2 & 0xffff0000u)), l3 = pk2(v1[2] - __uint_as_float(h3 << 16), v1[3] - __uint_as_float(h3 & 0xffff0000u));
            u32x4 wh = {h0, h1, h2, h3}, wl = {l0, l1, l2, l3};
            ahi[ks] = *reinterpret_cast<bf16x8*>(&wh); alo[ks] = *reinterpret_cast<bf16x8*>(&wl);
        }
        const int qpos = j * 256 + wid * 32 + r32, m = b * T + qpos;
        const bf16* Qw = Q + (size_t)m * D + h * 128 + hi * 8;
        f32x16 gacc = {};
#pragma unroll
        for (int ks = 0; ks < 8; ++ks) { const bf16x8 qv = *(const bf16x8*)(Qw + 16 * ks);
            gacc = __builtin_amdgcn_mfma_f32_32x32x16_bf16(ahi[ks], qv, gacc, 0, 0, 0);
            gacc = __builtin_amdgcn_mfma_f32_32x32x16_bf16(alo[ks], qv, gacc, 0, 0, 0); }
        float cv[6]; int ci[6];
        unsigned usedm = 0u;
#pragma unroll
        for (int s = 0; s < 3; ++s) { int best = 0; float val = -INFINITY; bool have = false;
#pragma unroll
            for (int r = 0; r < 16; ++r) { const float gv = (crow(r, hi) < j) ? gacc[r] : -INFINITY; const bool free_ = !((usedm >> r) & 1u); if (free_ && (!have || gv > val)) { best = r; val = gv; have = true; } }
            usedm |= 1u << best; cv[s] = val; ci[s] = crow(best, hi); }
#pragma unroll
        for (int s = 0; s < 3; ++s) { cv[3 + s] = __shfl_xor(cv[s], 32); ci[3 + s] = __shfl_xor(ci[s], 32); }
        int selv[3]; unsigned um = 0u;
#pragma unroll
        for (int s = 0; s < 3; ++s) { int best = 0; float val = 0.f; int bidx = 0; bool have = false;
#pragma unroll
            for (int c = 0; c < 6; ++c) { const bool free_ = !((um >> c) & 1u); if (free_ && (!have || cv[c] > val || (cv[c] == val && ci[c] < bidx))) { best = c; val = cv[c]; bidx = ci[c]; have = true; } }
            um |= 1u << best; selv[s] = bidx; }
        unsigned lpos[3] = {0u, 0u, 0u};
        if (hi == 0) {
#pragma unroll
            for (int s = 0; s < 3; ++s) if (s < j) lpos[s] = atomicAdd((unsigned*)&lcnt[selv[s]], 1u);
        }
        __syncthreads();
        if (tid < 32) { const unsigned c = lcnt[tid]; const int near = (j - tid <= 4) ? 1 : 0; unsigned base = 0u; if (c) base = atomicAdd(&cnt[(bh * 32 + tid) * 2 + near], c); lcnt[32 + tid] = base + (near ? 7168u : 0u); }
        __syncthreads();
        if (hi == 0) {
#pragma unroll
            for (int s = 0; s < 3; ++s)
                if (s < j) lists[(size_t)(bh * 32 + selv[s]) * 8192 + lcnt[32 + selv[s]] + lpos[s]] = (unsigned short)(qpos | (s << 13));
        }
    }
}

#ifdef PROBE_SEC_ATT
#define PS_B(id) do { if ((id) == PROBE_SEC_ATT && (OWN ? 1 : 0) == PROBE_OWN) { __builtin_amdgcn_sched_barrier(0); psec -= __builtin_amdgcn_s_memrealtime(); __builtin_amdgcn_sched_barrier(0); } } while (0)
#define PS_E(id) do { if ((id) == PROBE_SEC_ATT && (OWN ? 1 : 0) == PROBE_OWN) { __builtin_amdgcn_sched_barrier(0); psec += __builtin_amdgcn_s_memrealtime(); __builtin_amdgcn_sched_barrier(0); } } while (0)
#else
#define PS_B(id) do { } while (0)
#define PS_E(id) do { } while (0)
#endif
namespace moba {
constexpr int E_K0 = 0, E_V0 = 16384, E_K1 = 32768, E_V1 = 49152, E_TAB = 65536, E_WSCR = 73728, E_SCHED = 81920, E_STG = 86272;

constexpr float THR2 = 11.5f;
template <bool CAUSAL>
__device__ __forceinline__ void tile_step(const LAS unsigned char* Kb, int vb, const LAS float* tab2, LAS float* al_l, const bf16x8 (&qr)[8], int qpos_rel, int kt, bool near, int r32, int hi,
                                          f32x16 (&o)[4], float& m_reg, float& l_reg) {
    f32x16 p0, p1;
    qkt(p0, p1, Kb, qr, r32, hi);
    float sc = C2, cadd = tab2[1023];
    if (CAUSAL || near) {
        int dbase = qpos_rel - kt * 64 - 4 * hi; asm volatile("" : "+v"(dbase));
#pragma unroll
        for (int r = 0; r < 16; ++r) {
            const int d0_ = dbase - ((r & 3) + 8 * (r >> 2)), d1_ = d0_ - 32;
            float t0, t1;
            if (!CAUSAL) { t0 = fmaf(p0[r], C2, tab2[min(d0_, 1023)]); t1 = fmaf(p1[r], C2, tab2[min(d1_, 1023)]); }
            else { t0 = fmaf(p0[r], C2, tab2[max(d0_, 0)]); t1 = fmaf(p1[r], C2, tab2[max(d1_, 0)]); if (d0_ < 0) t0 = -1e30f; if (d1_ < 0) t1 = -1e30f; }
            p0[r] = t0; p1[r] = t1;
        }
        sc = 1.f; cadd = 0.f;
    }
    float pmax = p0[0];
#pragma unroll
    for (int r = 1; r < 16; ++r) pmax = fmaxf(pmax, p0[r]);
#pragma unroll
    for (int r = 0; r < 16; ++r) pmax = fmaxf(pmax, p1[r]);
    { auto rr = __builtin_amdgcn_permlane32_swap(__float_as_uint(pmax), __float_as_uint(pmax), false, false);
      pmax = fmaxf(__uint_as_float(rr[0]), __uint_as_float(rr[1])); }
    pmax = fmaf(pmax, sc, cadd);
    const bool raise = (pmax - m_reg) > THR2;
    const float mn = raise ? pmax : m_reg;
    const float alpha = raise ? __builtin_amdgcn_exp2f(m_reg - mn) : 1.f;
    m_reg = mn;
    if (__any(raise)) {
        if (hi == 0) al_l[r32] = alpha;
        asm volatile("s_waitcnt lgkmcnt(0)" ::: "memory");
#pragma unroll
        for (int r = 0; r < 16; ++r) { const float av = al_l[crow(r, hi)];
#pragma unroll
            for (int d = 0; d < 4; ++d) o[d][r] *= av; }
    }
    const float off = cadd - m_reg;
#pragma unroll
    for (int r = 0; r < 16; ++r) { p0[r] = __builtin_amdgcn_exp2f(fmaf(p0[r], sc, off)); p1[r] = __builtin_amdgcn_exp2f(fmaf(p1[r], sc, off)); }
    float ps = 0.f;
#pragma unroll
    for (int r = 0; r < 16; ++r) ps += p0[r];
#pragma unroll
    for (int r = 0; r < 16; ++r) ps += p1[r];
    { auto rr = __builtin_amdgcn_permlane32_swap(__float_as_uint(ps), __float_as_uint(ps), false, false);
      ps = __uint_as_float(rr[0]) + __uint_as_float(rr[1]); }
    l_reg = l_reg * alpha + ps;
    bf16x8 pa0, pa1, pa2, pa3;
#define PK4(P, BASE, OUT) do { unsigned a0 = cvtpk(P[BASE + 0], P[BASE + 1]), a1 = cvtpk(P[BASE + 2], P[BASE + 3]);   \
    unsigned b0 = cvtpk(P[BASE + 4], P[BASE + 5]), b1 = cvtpk(P[BASE + 6], P[BASE + 7]);                              \
    auto r0 = __builtin_amdgcn_permlane32_swap(a0, b0, false, false); auto r1 = __builtin_amdgcn_permlane32_swap(a1, b1, false, false); \
    u32x4 w = {r0[0], r1[0], r0[1], r1[1]}; OUT = *reinterpret_cast<bf16x8*>(&w); } while (0)
    PK4(p0, 0, pa0); PK4(p0, 8, pa1); PK4(p1, 0, pa2); PK4(p1, 8, pa3);
#undef PK4
    pv_one<0>(o[0], vb, pa0, pa1, pa2, pa3); pv_one<1>(o[1], vb, pa0, pa1, pa2, pa3); pv_one<2>(o[2], vb, pa0, pa1, pa2, pa3); pv_one<3>(o[3], vb, pa0, pa1, pa2, pa3);
}
}

template <bool OWN>
__device__ __forceinline__ void attn_engine(const Args& a, LAS unsigned char* lds, int tid, int lane, int wid, unsigned long long& psec) {
    using namespace moba;
    PS_B(4); PS_B(5);
    bf16* Q = (bf16*)(a.ws + WS_A2); const bf16* K = Q + (size_t)M * D; const bf16* V = K + (size_t)M * D;
    const unsigned* cnt = (const unsigned*)(a.ws + WS_CNT); const unsigned short* lists = (const unsigned short*)(a.ws + WS_LIST);
    const float* tab2g = (const float*)(a.ws + WS_TAB2); float* LSE = (float*)(a.ws + WS_LSE);
    const long po1off = (long)((const unsigned char*)a.out - a.ws);
    const int r32 = lane & 31, hi = lane >> 5, sr = tid >> 4, sc = (tid & 15) * 8;
    LAS int* P = (LAS int*)(lds + E_SCHED);
    int TR = 512;
    if (!OWN) {
        const int c0_ = ((int)cnt[2 * tid] + 255) >> 8, c1_ = ((int)cnt[2 * tid + 1] + 255) >> 8;
        int v = c0_ + c1_;
#pragma unroll
        for (int o_ = 1; o_ < 64; o_ <<= 1) { const int t_ = __shfl_up(v, o_); if (lane >= o_) v += t_; }
        LAS int* wt = (LAS int*)(lds + E_WSCR);
        if (lane == 63) wt[wid] = v;
        __syncthreads();
        int off = 0;
        for (int w = 0; w < wid; ++w) off += wt[w];
        P[2 * tid + 2] = off + v; P[2 * tid + 1] = off + v - c1_;
        if (tid == 0) P[0] = 0;
        __syncthreads();
        TR = P[1024];
    }
    const int R0 = (int)(((long)blockIdx.x * TR) / gridDim.x), R1 = (int)(((long)(blockIdx.x + 1) * TR) / gridDim.x);
    if (R0 >= R1) return;
#define AE_LOC(rd_, li_, r_) do { if (OWN) { li_ = (rd_); r_ = 0; } else { int a_ = 0, b_ = 1024; while (b_ - a_ > 1) { const int mid_ = (a_ + b_) >> 1; if (P[mid_] <= (rd_)) a_ = mid_; else b_ = mid_; } li_ = a_; r_ = (rd_) - P[a_]; } } while (0)
#define AE_TLOAD(Kt_, Vt_) do { ks0 = *(const bf16x8*)((Kt_) + (size_t)sr * D + sc); ks1 = *(const bf16x8*)((Kt_) + (size_t)(32 + sr) * D + sc);                 \
        vs0 = *(const bf16x8*)((Vt_) + (size_t)sr * D + sc); vs1 = *(const bf16x8*)((Vt_) + (size_t)(32 + sr) * D + sc); } while (0)
#define AE_TWRITE(bi_) do { *(LAS bf16x8*)(lds + ((bi_) ? E_K1 : E_K0) + KSWZ(sr, sc * 2)) = ks0; *(LAS bf16x8*)(lds + ((bi_) ? E_K1 : E_K0) + KSWZ(32 + sr, sc * 2)) = ks1;   \
        *(LAS bf16x8*)(lds + ((bi_) ? E_V1 : E_V0) + v_st(sr, sc)) = vs0; *(LAS bf16x8*)(lds + ((bi_) ? E_V1 : E_V0) + v_st(32 + sr, sc)) = vs1; } while (0)
    bf16x8 ks0, ks1, vs0, vs1;
    int li, rr; AE_LOC(R0, li, rr);
    int b = (OWN ? li : (li >> 1)) >> 8, h = ((OWN ? li : (li >> 1)) >> 5) & 7, n = (OWN ? li : (li >> 1)) & 31;
    int L = OWN ? 256 : (int)cnt[li];
    const bf16* Kt = K + (size_t)(b * T + n * 256) * D + h * 128; const bf16* Vt = V + (size_t)(b * T + n * 256) * D + h * 128;
    AE_TLOAD(Kt, Vt);
    int tabsel = 0;
    for (int e = tid; e < 1024; e += 512) ((LAS float*)(lds + E_TAB))[e] = tab2g[h * 1024 + e];
    int ent, qpos, slot; bool valid;
    {
        const int e = rr * 256 + wid * 32 + r32; valid = e < L;
        if (OWN) ent = n * 256 + wid * 32 + r32; else ent = lists[(size_t)(li >> 1) * 8192 + (li & 1) * 7168 + (valid ? e : (L - 1))];
    }
    bf16x8 qr[8];
    {
        const bf16* Qw = Q + (size_t)(b * T + (ent & 8191)) * D + h * 128 + hi * 8;
#pragma unroll
        for (int d0 = 0; d0 < 8; ++d0) qr[d0] = *(const bf16x8*)(Qw + d0 * 16);
    }
    AE_TWRITE(0);
    __syncthreads();
    int step = 0;
    PS_E(4);
    LAS float* al_l = (LAS float*)(lds + E_WSCR + wid * 1024);
    for (int rd = R0; rd < R1; ++rd) {
        const bool has_next = rd + 1 < R1;
        int nli = li, nrr = rr; if (has_next) AE_LOC(rd + 1, nli, nrr);
        const int nl2_ = OWN ? nli : (nli >> 1); const int nb_ = nl2_ >> 8, nh = (nl2_ >> 5) & 7, nn = nl2_ & 31;
        const int nL = OWN ? 256 : (has_next ? (int)cnt[nli] : L);
        const bf16* Ktn = K + (size_t)(nb_ * T + nn * 256) * D + nh * 128; const bf16* Vtn = V + (size_t)(nb_ * T + nn * 256) * D + nh * 128;
        qpos = ent & 8191; slot = ent >> 13;
        const int m = b * T + qpos, qrel = qpos - n * 256;
        const bool wave_on = OWN ? true : ((rr * 256 + wid * 32) < L);
        const bool near_ = !OWN && (li & 1);
        const LAS float* tab2 = (const LAS float*)(lds + E_TAB + tabsel * 4096);
        f32x16 o[4] = {}; float m_reg = -1e30f, l_reg = 0.f;
        float ls0 = -1e30f, ls1 = -1e30f, ls2 = -1e30f;
        const int nsel = n < 3 ? n : 3;
        int nent = ent; bool nvalid = valid;
#pragma unroll 1
        for (int kt = 0; kt < 4; ++kt) {
            const bool more = (kt < 3) || has_next;
            if (more) { if (kt < 3) AE_TLOAD(Kt + (size_t)(kt + 1) * 64 * D, Vt + (size_t)(kt + 1) * 64 * D); else AE_TLOAD(Ktn, Vtn); }
            const int bi = step & 1;
            PS_B(1);
            if (OWN && kt == 3) {
                if (nsel > 0) ls0 = LSE[((size_t)0 * M + m) * 8 + h];
                if (nsel > 1) ls1 = LSE[((size_t)1 * M + m) * 8 + h];
                if (nsel > 2) ls2 = LSE[((size_t)2 * M + m) * 8 + h];
            }
            if (wave_on && (!OWN || kt <= (wid >> 1))) {
                const LAS unsigned char* Kb_ = lds + (bi ? E_K1 : E_K0); const int vb_ = (int)(unsigned long)(lds + (bi ? E_V1 : E_V0)) + v_rd_base(lane);
                tile_step<OWN>(Kb_, vb_, tab2, al_l, qr, qrel, kt, near_, r32, hi, o, m_reg, l_reg);
            }
            PS_E(1); PS_B(2);
            if (has_next && kt == 1) {
                const int e = nrr * 256 + wid * 32 + r32; nvalid = e < nL;
                if (OWN) nent = nn * 256 + wid * 32 + r32; else nent = lists[(size_t)(nli >> 1) * 8192 + (nli & 1) * 7168 + (nvalid ? e : (nL - 1))];
            }
            if (!OWN && has_next && kt == 3) {
                const bf16* Qw = Q + (size_t)(nb_ * T + (nent & 8191)) * D + nh * 128 + hi * 8;
#pragma unroll
                for (int d0 = 0; d0 < 8; ++d0) qr[d0] = *(const bf16x8*)(Qw + d0 * 16);
            }
            if (more) AE_TWRITE(bi ^ 1);
            if (kt == 3 && has_next && nh != h) { for (int e = tid; e < 1024; e += 512) ((LAS float*)(lds + E_TAB + (tabsel ^ 1) * 4096))[e] = tab2g[nh * 1024 + e]; }
            __syncthreads();
            PS_E(2);
            ++step;
        }
        PS_B(3);
        if (wave_on) {
            LAS unsigned char* stg = lds + E_STG + wid * 8192;
            if (!OWN) {
                LAS float* li_l = (LAS float*)(lds + E_WSCR + wid * 1024 + 128);
                LAS int* row_l = (LAS int*)(lds + E_WSCR + wid * 1024 + 256);
                if (hi == 0) { li_l[r32] = __builtin_amdgcn_rcpf(l_reg); row_l[r32] = valid ? ((slot << 20) | m) : -1;
                    if (valid) LSE[((size_t)slot * M + m) * 8 + h] = m_reg + __builtin_amdgcn_logf(l_reg); }
                asm volatile("s_waitcnt lgkmcnt(0)" ::: "memory");
                float rl[16];
#pragma unroll
                for (int r = 0; r < 16; ++r) rl[r] = li_l[crow(r, hi)];
#pragma unroll
                for (int d0 = 0; d0 < 4; ++d0)
#pragma unroll
                    for (int r = 0; r < 16; ++r) *(LAS unsigned short*)(stg + crow(r, hi) * 256 + (d0 * 32 + r32) * 2) = (unsigned short)f2bf(o[d0][r] * rl[r]);
#pragma unroll
                for (int it = 0; it < 8; ++it) {
                    const int row = 4 * it + (lane >> 4);
                    const u32x4 v = *(const LAS u32x4*)(stg + row * 256 + (lane & 15) * 16);
                    const int rm = row_l[row];
                    if (rm >= 0) {
                        const int sl = rm >> 20, mm = rm & 0xfffff;
                        *(u32x4*)((bf16*)(a.ws + (sl == 0 ? (long)WS_PO0 : (sl == 1 ? po1off : (long)WS_PO2))) + (size_t)mm * D + h * 128 + (lane & 15) * 8) = v;
                    }
                }
            } else {
                const float lown = m_reg + __builtin_amdgcn_logf(l_reg);
                const float Mx = fmaxf(fmaxf(lown, ls0), fmaxf(ls1, ls2));
                const float e0 = __builtin_amdgcn_exp2f(ls0 - Mx), e1 = __builtin_amdgcn_exp2f(ls1 - Mx), e2 = __builtin_amdgcn_exp2f(ls2 - Mx), eo = __builtin_amdgcn_exp2f(lown - Mx);
                const float iz = __builtin_amdgcn_rcpf((eo + e0) + (e1 + e2));
                LAS float* cf = (LAS float*)(lds + E_WSCR + wid * 1024 + 128);
                if (hi == 0) { cf[r32] = eo * iz * __builtin_amdgcn_rcpf(l_reg); cf[32 + r32] = e0 * iz; cf[64 + r32] = e1 * iz; cf[96 + r32] = e2 * iz; }
                asm volatile("s_waitcnt lgkmcnt(0)" ::: "memory");
                const bf16* P0 = (const bf16*)(a.ws + WS_PO0); const bf16* P1 = (const bf16*)a.out; const bf16* P2 = (const bf16*)(a.ws + WS_PO2);
                float co[16];
#pragma unroll
                for (int r = 0; r < 16; ++r) co[r] = cf[crow(r, hi)];
#pragma unroll
                for (int d0 = 0; d0 < 4; ++d0)
#pragma unroll
                    for (int r = 0; r < 16; ++r) *(LAS unsigned short*)(stg + crow(r, hi) * 256 + (d0 * 32 + r32) * 2) = (unsigned short)f2bf(o[d0][r] * co[r]);
                asm volatile("" ::: "memory"); __builtin_amdgcn_sched_barrier(0);
                const size_t offb = (size_t)(b * T + n * 256 + wid * 32 + (lane >> 4)) * D + h * 128 + (lane & 15) * 8;
                u32x4 pv0[8], pv1[8], pv2[8];
#pragma unroll
                for (int it = 0; it < 8; ++it) {
                    const size_t off = offb + (size_t)it * 4 * D;
                    pv0[it] = *(const u32x4*)(P0 + off); pv1[it] = *(const u32x4*)(P1 + off); pv2[it] = *(const u32x4*)(P2 + off);
                }
                const u32x4 z4 = {0u, 0u, 0u, 0u};
#pragma unroll
                for (int it = 0; it < 8; ++it) {
                    const int row = 4 * it + (lane >> 4);
                    const u32x4 ov = *(const LAS u32x4*)(stg + row * 256 + (lane & 15) * 16);
                    float acc[8];
                    acc[0] = __uint_as_float(ov.x << 16); acc[1] = __uint_as_float(ov.x & 0xffff0000u); acc[2] = __uint_as_float(ov.y << 16); acc[3] = __uint_as_float(ov.y & 0xffff0000u);
                    acc[4] = __uint_as_float(ov.z << 16); acc[5] = __uint_as_float(ov.z & 0xffff0000u); acc[6] = __uint_as_float(ov.w << 16); acc[7] = __uint_as_float(ov.w & 0xffff0000u);
#define ADDP(PV, CI) do { const u32x4 pv = (PV); const float cc = cf[(CI) * 32 + row];                                                        \
    acc[0] = fmaf(cc, __uint_as_float(pv.x << 16), acc[0]); acc[1] = fmaf(cc, __uint_as_float(pv.x & 0xffff0000u), acc[1]);                     \
    acc[2] = fmaf(cc, __uint_as_float(pv.y << 16), acc[2]); acc[3] = fmaf(cc, __uint_as_float(pv.y & 0xffff0000u), acc[3]);                     \
    acc[4] = fmaf(cc, __uint_as_float(pv.z << 16), acc[4]); acc[5] = fmaf(cc, __uint_as_float(pv.z & 0xffff0000u), acc[5]);                     \
    acc[6] = fmaf(cc, __uint_as_float(pv.w << 16), acc[6]); acc[7] = fmaf(cc, __uint_as_float(pv.w & 0xffff0000u), acc[7]); } while (0)
                    ADDP(nsel > 0 ? pv0[it] : z4, 1);
                    ADDP(nsel > 1 ? pv1[it] : z4, 2);
                    ADDP(nsel > 2 ? pv2[it] : z4, 3);
#undef ADDP
                    *(u32x4*)(Q + offb + (size_t)it * 4 * D) = (u32x4){pk2(acc[0], acc[1]), pk2(acc[2], acc[3]), pk2(acc[4], acc[5]), pk2(acc[6], acc[7])};
                }
            }
        }
        PS_E(3);
        if (OWN && has_next) {
            const bf16* Qw = Q + (size_t)(nb_ * T + (nent & 8191)) * D + nh * 128 + hi * 8;
#pragma unroll
            for (int d0 = 0; d0 < 8; ++d0) qr[d0] = *(const bf16x8*)(Qw + d0 * 16);
        }
        if (nh != h) tabsel ^= 1;
        li = nli; rr = nrr; b = nb_; h = nh; n = nn; L = nL; Kt = Ktn; Vt = Vtn; ent = nent; valid = nvalid;
    }
    __syncthreads();
    PS_E(5);
#undef AE_LOC
#undef AE_TLOAD
#undef AE_TWRITE
}

#ifndef PROBE_BLK
#define PROBE_BLK 0
#endif
#ifdef PROBE_HG
#define HS_B(id) do { if ((id) == PROBE_HG && PASS_B == (PROBE_HG_B != 0)) { __builtin_amdgcn_sched_barrier(0); psec -= __builtin_amdgcn_s_memrealtime(); __builtin_amdgcn_sched_barrier(0); } } while (0)
#define HS_E(id) do { if ((id) == PROBE_HG && PASS_B == (PROBE_HG_B != 0)) { __builtin_amdgcn_sched_barrier(0); psec += __builtin_amdgcn_s_memrealtime(); __builtin_amdgcn_sched_barrier(0); } } while (0)
#else
#define HS_B(id) do { } while (0)
#define HS_E(id) do { } while (0)
#endif
namespace hg {
using namespace moba;
#ifndef HG_NEW_SIMG
#define HG_NEW_SIMG 1
#endif
constexpr int H_TQ = 0, H_TK = 16384, H_TKT = 32768, H_TI = 49152, H_SIMG = 65536, H_OST = 98304, H_EL = 132096;
constexpr int OST_LD = 132;
typedef float f32x2_t __attribute__((ext_vector_type(2))); typedef __bf16 bf16x2_t __attribute__((ext_vector_type(2)));
__device__ __forceinline__ unsigned cvtpk_s(float lo, float hi) { f32x2_t v = {lo, hi}; bf16x2_t b = __builtin_convertvector(v, bf16x2_t); return __builtin_bit_cast(unsigned, b); }
__device__ __forceinline__ int v_st64(int k, int c) { const int kk = (k & ~0xC) | ((k & 4) << 1) | ((k & 8) >> 1); return ((kk >> 3) * 2 + (c >> 5)) * 512 + ((kk & 7) * 32 + (c & 31)) * 2; }
constexpr int v_rd_off64(int tile, int cb, int ks, int half) { return tile * 8192 + cb * 512 + ks * 2048 + half * 1024; }
__device__ __forceinline__ void simg_store(LAS unsigned char* lds, int img_off, const f32x16& S, int nb, int d, int hi) {
#pragma unroll
    for (int q4 = 0; q4 < 4; ++q4) { const int n = 32 * nb + 8 * q4 + 4 * hi;
        typedef unsigned u32x2_ __attribute__((ext_vector_type(2)));
        *(LAS u32x2_*)(lds + img_off + KSWZ(d, 2 * n)) = (u32x2_){cvtpk_s(S[4 * q4 + 0], S[4 * q4 + 1]), cvtpk_s(S[4 * q4 + 2], S[4 * q4 + 3])}; }
}
__device__ __forceinline__ int kt_off(int n, int s) { return n * 128 + ((((s >> 3) ^ ((n >> 1) & 7))) << 4) + (s & 7) * 2; }

template <bool PASS_B>
__device__ __forceinline__ void hgrn_unit(const Args& a, LAS unsigned char* lds, int u, int tid, int lane, int wid, unsigned long long& psec) {
    unsigned char* ws = a.ws;
    const bf16* QS = (const bf16*)(ws + WS_A1); const float* LF = (const float*)(ws + WS_A2); const bf16* INP = (const bf16*)(ws + WS_A3); const bf16* OG = (const bf16*)(ws + WS_A4);
    bf16* OGATED = (bf16*)(ws + WS_A0); float* SSQH = (float*)(ws + WS_SSQH);
    float* TG = a.out;
    float* DG = a.out + (size_t)256 * 128 * 128;
    const int bh = u >> 4, g = u & 15, b = bh >> 3, h = bh & 7;
    const int r32 = lane & 31, hi = lane >> 5, tb = wid >> 2, db = wid & 3;
    const int nl = lane & 15, tq = lane >> 4, npre = 16 * wid + nl;
    f32x16 Sacc[2] = {};
    float dg = 1.f;
#if HG_NEW_SIMG
#define HG_SIMG_WRITE() do { simg_store(lds, H_SIMG, Sacc[0], 2 * tb, 32 * db + r32, hi); simg_store(lds, H_SIMG, Sacc[1], 2 * tb + 1, 32 * db + r32, hi); } while (0)
#else
#define HG_SIMG_WRITE() do { _Pragma("unroll") for (int i = 0; i < 2; ++i) { const int nb = 2 * tb + i; _Pragma("unroll") for (int r = 0; r < 16; ++r) { const int n = 32 * nb + crow(r, hi); \
        *(LAS unsigned short*)(lds + H_SIMG + (nb >> 1) * 16384 + v_st(n & 63, 32 * db + r32)) = (unsigned short)f2bf(Sacc[i][r]); } } } while (0)
#endif
    if (PASS_B) {
        HS_B(1);
        {
            LAS float* dl = (LAS float*)(lds + H_OST);
            for (int e = tid; e < g * 128; e += NWAVES * 64) dl[e] = DG[(size_t)(bh * 16) * 128 + e];
            __syncthreads();
            for (int gp0 = 0; gp0 < g; gp0 += 4) {
                int lo_ = (wid * 8 * 64 + lane) * 4; asm volatile("" : "+v"(lo_));
                const float* tg = TG + (size_t)(bh * 16 + gp0) * 16384 + lo_;
                f32x4 tv[4][8];
#pragma unroll
                for (int k = 0; k < 4; ++k) if (gp0 + k < g) {
#pragma unroll
                    for (int j = 0; j < 8; ++j) tv[k][j] = *(const f32x4*)(tg + (size_t)k * 16384 + j * 256);
                }
#pragma unroll
                for (int k = 0; k < 4; ++k) if (gp0 + k < g) {
#pragma unroll
                    for (int i = 0; i < 2; ++i)
#pragma unroll
                        for (int r = 0; r < 16; ++r) Sacc[i][r] = fmaf(Sacc[i][r], dl[(gp0 + k) * 128 + 32 * (2 * tb + i) + crow(r, hi)], tv[k][i * 4 + (r >> 2)][r & 3]);
                }
            }
            __syncthreads();
        }
        HG_SIMG_WRITE();
        HS_E(1);
    }
    float lfn[16]; unsigned short qn[16]; bf16x8 in0, in1; u32x4 gn0, gn1;
    const int sr = tid >> 4, sc = (tid & 15) * 8;
    const int pt = tid >> 3, pseg = tid & 7;
#define HG_LOAD(cc) do { const size_t m0_ = (size_t)b * T + g * 512 + (cc) * 64; const size_t off0_ = (m0_ + 16 * tq) * D + h * 128 + npre;                       \
        _Pragma("unroll") for (int i = 0; i < 16; ++i) { lfn[i] = LF[off0_ + (size_t)i * D]; if (PASS_B) qn[i] = QS[off0_ + (size_t)i * D]; }                      \
        in0 = *(const bf16x8*)(INP + (m0_ + sr) * D + h * 128 + sc); in1 = *(const bf16x8*)(INP + (m0_ + 32 + sr) * D + h * 128 + sc);                          \
        if (PASS_B) { const size_t go_ = (m0_ + pt) * D + h * 128 + 16 * pseg; gn0 = *(const u32x4*)(OG + go_); gn1 = *(const u32x4*)(OG + go_ + 8); } } while (0)
    HG_LOAD(0);
    for (int c = 0; c < 8; ++c) {
        const size_t m0 = (size_t)b * T + g * 512 + c * 64;
        u32x4 g0 = {}, g1 = {};
        HS_B(2);
        {
            float lf[16], qv[16];
#pragma unroll
            for (int i = 0; i < 16; ++i) { lf[i] = lfn[i]; if (PASS_B) qv[i] = bf2f(qn[i]); }
            if (PASS_B) { g0 = gn0; g1 = gn1; }
            float cs[16]; float run = 0.f;
#pragma unroll
            for (int i = 0; i < 16; ++i) { run += lf[i]; cs[i] = run; }
            const float s0 = __shfl(run, nl), s1 = __shfl(run, nl + 16), s2 = __shfl(run, nl + 32), s3 = __shfl(run, nl + 48);
            const float pre = (tq > 0 ? s0 : 0.f) + (tq > 1 ? s1 : 0.f) + (tq > 2 ? s2 : 0.f);
            const float last = (s0 + s1) + (s2 + s3);
            unsigned kh[8], qw[8], kw[8];
#pragma unroll
            for (int i = 0; i < 16; i += 2) {
                float khv[2], qtv[2], ktv[2];
#pragma unroll
                for (int e = 0; e < 2; ++e) {
                    const float cum = pre + cs[i + e];
                    const float kk = 1.f - __expf(lf[i + e]);
                    khv[e] = kk * __expf(last - cum);
                    if (PASS_B) { qtv[e] = qv[i + e] * __expf(cum); ktv[e] = kk * __expf(-cum); }
                }
                kh[i >> 1] = cvtpk(khv[0], khv[1]);
                if (PASS_B) { qw[i >> 1] = cvtpk(qtv[0], qtv[1]); kw[i >> 1] = cvtpk(ktv[0], ktv[1]); }
            }
            if (PASS_B) {
                const int io = (npre >> 6) * 8192 + v_st64(npre & 63, 16 * tq);
                *(LAS u32x4*)(lds + H_TQ + io) = (u32x4){qw[0], qw[1], qw[2], qw[3]}; *(LAS u32x4*)(lds + H_TQ + io + 16) = (u32x4){qw[4], qw[5], qw[6], qw[7]};
                *(LAS u32x4*)(lds + H_TK + io) = (u32x4){kw[0], kw[1], kw[2], kw[3]}; *(LAS u32x4*)(lds + H_TK + io + 16) = (u32x4){kw[4], kw[5], kw[6], kw[7]};
            }
            *(LAS u32x4*)(lds + H_TKT + kt_off(npre, 16 * tq)) = (u32x4){kh[0], kh[1], kh[2], kh[3]};
            *(LAS u32x4*)(lds + H_TKT + kt_off(npre, 16 * tq + 8)) = (u32x4){kh[4], kh[5], kh[6], kh[7]};
            const float el = __expf(last);
            if (tq == 0) *(LAS float*)(lds + H_EL + npre * 4) = el;
            dg *= el;
            *(LAS bf16x8*)(lds + H_TI + v_st(sr, sc)) = in0;
            *(LAS bf16x8*)(lds + H_TI + v_st(32 + sr, sc)) = in1;
        }
        __syncthreads();
        HS_E(2); HS_B(3);
        {
#define PK(L, Hh) (bf16x8){L[0], L[1], L[2], L[3], Hh[0], Hh[1], Hh[2], Hh[3]}
            bf16x8 pa0, pa1, pa2, pa3; bf16x8 qr[8];
            if (PASS_B) {
                const int t = 32 * tb + r32;
                const int vbQ = (int)(unsigned long)(lds + H_TQ) + v_rd_base(lane) + tb * 512, vbK = (int)(unsigned long)(lds + H_TK) + v_rd_base(lane);
                {
                    s16x4 ql[8], qh[8];
#define HG_QRD(d0_) ql[d0_] = tr_read<v_rd_off64((d0_) >> 2, 0, (d0_) & 3, 0)>(vbQ); qh[d0_] = tr_read<v_rd_off64((d0_) >> 2, 0, (d0_) & 3, 1)>(vbQ);
                    HG_QRD(0) HG_QRD(1) HG_QRD(2) HG_QRD(3) HG_QRD(4) HG_QRD(5) HG_QRD(6) HG_QRD(7)
#undef HG_QRD
                    asm volatile("s_waitcnt lgkmcnt(0)" ::: "memory"); SBAR();
#pragma unroll
                    for (int d0 = 0; d0 < 8; ++d0) qr[d0] = PK(ql[d0], qh[d0]);
                }
                f32x16 p0 = {}, p1 = {};
                s16x4 ka[8], kb[8];
#define HG_KRD(dst_, da_, db2_) do { \
                    dst_[0] = tr_read<v_rd_off64((da_) >> 2, 0, (da_) & 3, 0)>(vbK); dst_[1] = tr_read<v_rd_off64((da_) >> 2, 0, (da_) & 3, 1)>(vbK);     \
                    dst_[2] = tr_read<v_rd_off64((da_) >> 2, 1, (da_) & 3, 0)>(vbK); dst_[3] = tr_read<v_rd_off64((da_) >> 2, 1, (da_) & 3, 1)>(vbK);     \
                    dst_[4] = tr_read<v_rd_off64((db2_) >> 2, 0, (db2_) & 3, 0)>(vbK); dst_[5] = tr_read<v_rd_off64((db2_) >> 2, 0, (db2_) & 3, 1)>(vbK); \
                    dst_[6] = tr_read<v_rd_off64((db2_) >> 2, 1, (db2_) & 3, 0)>(vbK); dst_[7] = tr_read<v_rd_off64((db2_) >> 2, 1, (db2_) & 3, 1)>(vbK); } while (0)
#define HG_KMM(src_, da_, db2_) do { \
                    p0 = __builtin_amdgcn_mfma_f32_32x32x16_bf16(PK(src_[0], src_[1]), qr[da_], p0, 0, 0, 0); p1 = __builtin_amdgcn_mfma_f32_32x32x16_bf16(PK(src_[2], src_[3]), qr[da_], p1, 0, 0, 0);     \
                    p0 = __builtin_amdgcn_mfma_f32_32x32x16_bf16(PK(src_[4], src_[5]), qr[db2_], p0, 0, 0, 0); p1 = __builtin_amdgcn_mfma_f32_32x32x16_bf16(PK(src_[6], src_[7]), qr[db2_], p1, 0, 0, 0); } while (0)
                HG_KRD(ka, 0, 1); HG_KRD(kb, 2, 3);
                asm volatile("s_waitcnt lgkmcnt(8)" ::: "memory"); SBAR(); HG_KMM(ka, 0, 1); SBAR();
                HG_KRD(ka, 4, 5);
                asm volatile("s_waitcnt lgkmcnt(8)" ::: "memory"); SBAR(); HG_KMM(kb, 2, 3); SBAR();
                HG_KRD(kb, 6, 7);
                asm volatile("s_waitcnt lgkmcnt(8)" ::: "memory"); SBAR(); HG_KMM(ka, 4, 5); SBAR();
                asm volatile("s_waitcnt lgkmcnt(0)" ::: "memory"); SBAR(); HG_KMM(kb, 6, 7);
#undef HG_KRD
#undef HG_KMM
#pragma unroll
                for (int r = 0; r < 16; ++r) { const int s0_ = crow(r, hi); if (s0_ > t) p0[r] = 0.f; if (s0_ + 32 > t) p1[r] = 0.f; }
#define PK4(P, BASE, OUT) do { unsigned a0 = cvtpk(P[BASE + 0], P[BASE + 1]), a1 = cvtpk(P[BASE + 2], P[BASE + 3]);   \
    unsigned b0 = cvtpk(P[BASE + 4], P[BASE + 5]), b1 = cvtpk(P[BASE + 6], P[BASE + 7]);                              \
    auto r0 = __builtin_amdgcn_permlane32_swap(a0, b0, false, false); auto r1 = __builtin_amdgcn_permlane32_swap(a1, b1, false, false); \
    u32x4 w = {r0[0], r1[0], r0[1], r1[1]}; OUT = *reinterpret_cast<bf16x8*>(&w); } while (0)
                PK4(p0, 0, pa0); PK4(p0, 8, pa1); PK4(p1, 0, pa2); PK4(p1, 8, pa3);
#undef PK4
            }
            if (c < 7) HG_LOAD(c + 1);
            const int vbI = (int)(unsigned long)(lds + H_TI) + v_rd_base(lane) + db * 512;
            bf16x8 bI[4];
            {
                const s16x4 l0 = tr_read<v_rd_off(0, 0, 0)>(vbI), h0 = tr_read<v_rd_off(0, 0, 1)>(vbI), l1 = tr_read<v_rd_off(0, 1, 0)>(vbI), h1 = tr_read<v_rd_off(0, 1, 1)>(vbI);
                const s16x4 l2 = tr_read<v_rd_off(0, 2, 0)>(vbI), h2 = tr_read<v_rd_off(0, 2, 1)>(vbI), l3 = tr_read<v_rd_off(0, 3, 0)>(vbI), h3 = tr_read<v_rd_off(0, 3, 1)>(vbI);
                asm volatile("s_waitcnt lgkmcnt(0)" ::: "memory"); SBAR();
                bI[0] = PK(l0, h0); bI[1] = PK(l1, h1); bI[2] = PK(l2, h2); bI[3] = PK(l3, h3);
            }
            if (PASS_B) {
                f32x16 od = {};
                od = __builtin_amdgcn_mfma_f32_32x32x16_bf16(pa0, bI[0], od, 0, 0, 0);
                od = __builtin_amdgcn_mfma_f32_32x32x16_bf16(pa1, bI[1], od, 0, 0, 0);
                od = __builtin_amdgcn_mfma_f32_32x32x16_bf16(pa2, bI[2], od, 0, 0, 0);
                od = __builtin_amdgcn_mfma_f32_32x32x16_bf16(pa3, bI[3], od, 0, 0, 0);
#if HG_NEW_SIMG
#pragma unroll
                for (int ks = 0; ks < 8; ++ks) {
                    const bf16x8 bs = *(const LAS bf16x8*)(lds + H_SIMG + KSWZ(32 * db + r32, (16 * ks + 8 * hi) * 2));
                    od = __builtin_amdgcn_mfma_f32_32x32x16_bf16(qr[ks], bs, od, 0, 0, 0);
                }
#else
#pragma unroll
                for (int hf = 0; hf < 2; ++hf) {
                    const int vbS = (int)(unsigned long)(lds + H_SIMG) + hf * 16384 + v_rd_base(lane) + db * 512;
                    const s16x4 l0 = tr_read<v_rd_off(0, 0, 0)>(vbS), h0 = tr_read<v_rd_off(0, 0, 1)>(vbS), l1 = tr_read<v_rd_off(0, 1, 0)>(vbS), h1 = tr_read<v_rd_off(0, 1, 1)>(vbS);
                    const s16x4 l2 = tr_read<v_rd_off(0, 2, 0)>(vbS), h2 = tr_read<v_rd_off(0, 2, 1)>(vbS), l3 = tr_read<v_rd_off(0, 3, 0)>(vbS), h3 = tr_read<v_rd_off(0, 3, 1)>(vbS);
                    asm volatile("s_waitcnt lgkmcnt(0)" ::: "memory"); SBAR();
                    od = __builtin_amdgcn_mfma_f32_32x32x16_bf16(qr[hf * 4 + 0], PK(l0, h0), od, 0, 0, 0);
                    od = __builtin_amdgcn_mfma_f32_32x32x16_bf16(qr[hf * 4 + 1], PK(l1, h1), od, 0, 0, 0);
                    od = __builtin_amdgcn_mfma_f32_32x32x16_bf16(qr[hf * 4 + 2], PK(l2, h2), od, 0, 0, 0);
                    od = __builtin_amdgcn_mfma_f32_32x32x16_bf16(qr[hf * 4 + 3], PK(l3, h3), od, 0, 0, 0);
                }
#endif
#undef PK
                LAS float* ost = (LAS float*)(lds + H_OST);
#pragma unroll
                for (int r = 0; r < 16; ++r) ost[(32 * tb + crow(r, hi)) * OST_LD + 32 * db + r32] = od[r];
            }
            const LAS float* el = (const LAS float*)(lds + H_EL);
#pragma unroll
            for (int i = 0; i < 2; ++i) { const int nb = 2 * tb + i;
#pragma unroll
                for (int r = 0; r < 16; ++r) Sacc[i][r] *= el[32 * nb + crow(r, hi)];
#pragma unroll
                for (int ks = 0; ks < 4; ++ks) {
                    const bf16x8 af = *(const LAS bf16x8*)(lds + H_TKT + kt_off(32 * nb + r32, 16 * ks + 8 * hi));
                    Sacc[i] = __builtin_amdgcn_mfma_f32_32x32x16_bf16(af, bI[ks], Sacc[i], 0, 0, 0);
                } }
        }
        HS_E(3); HS_B(4);
        __syncthreads();
        if (PASS_B) {
            HG_SIMG_WRITE();
            const int t = pt, seg = pseg; const size_t go = (m0 + t) * D + h * 128 + 16 * seg;
            const LAS float* orow = (const LAS float*)(lds + H_OST) + t * OST_LD + 16 * seg;
            const unsigned gw[8] = {g0.x, g0.y, g0.z, g0.w, g1.x, g1.y, g1.z, g1.w};
            float ssq = 0.f; unsigned ow[8];
#pragma unroll
            for (int e = 0; e < 8; ++e) { const float o0 = orow[2 * e], o1 = orow[2 * e + 1]; ssq = fmaf(o0, o0, ssq); ssq = fmaf(o1, o1, ssq);
                ow[e] = pk2(o0 * __uint_as_float(gw[e] << 16), o1 * __uint_as_float(gw[e] & 0xffff0000u)); }
            *(u32x4*)(OGATED + go) = (u32x4){ow[0], ow[1], ow[2], ow[3]}; *(u32x4*)(OGATED + go + 8) = (u32x4){ow[4], ow[5], ow[6], ow[7]};
            ssq += __shfl_xor(ssq, 1); ssq += __shfl_xor(ssq, 2); ssq += __shfl_xor(ssq, 4);
            if (seg == 0) SSQH[(m0 + t) * 8 + h] = ssq;
        }
        HS_E(4);
    }
    if (!PASS_B) {
        int lo_ = (wid * 8 * 64 + lane) * 4; asm volatile("" : "+v"(lo_));
        float* tg = TG + (size_t)u * 16384 + lo_;
#pragma unroll
        for (int i = 0; i < 2; ++i)
#pragma unroll
            for (int q4 = 0; q4 < 4; ++q4) *(f32x4*)(tg + (i * 4 + q4) * 256) = (f32x4){Sacc[i][4 * q4], Sacc[i][4 * q4 + 1], Sacc[i][4 * q4 + 2], Sacc[i][4 * q4 + 3]};
        if (tq == 0) DG[(size_t)u * 128 + npre] = dg;
    }
    __syncthreads();
#undef HG_LOAD
#undef HG_SIMG_WRITE
}
}

#define XB_TMO      128
#define XB_XCNT(j)  (256  + 64 * (j))
#define XB_XSUB(j)  (1280 + 64 * (j))
#define XB_XGEN(j)  (2304 + 64 * (j))
#define XB_TOP      3328
#define XB_TOPGEN   3392
#define XCD_BAR_WORDS 3456
#define XB_SPIN_CAP (1u << 18)

__device__ __forceinline__ unsigned xb_ld(unsigned* p)              { return __hip_atomic_load(p, __ATOMIC_RELAXED, __HIP_MEMORY_SCOPE_AGENT); }
__device__ __forceinline__ unsigned xb_add(unsigned* p, unsigned v) { return __hip_atomic_fetch_add(p, v, __ATOMIC_RELAXED, __HIP_MEMORY_SCOPE_AGENT); }
__device__ __forceinline__ unsigned xb_xcc_id() { return (unsigned)__builtin_amdgcn_s_getreg((3 << 11) | 20) & 0xFu; }
#define XB_SPIN(cond, bar) do { unsigned _sp = 0; while (cond) { __builtin_amdgcn_s_sleep(1); \
    if ((++_sp & 255u) == 0u) { if (xb_ld(&(bar)[XB_TMO])) break; if (_sp > XB_SPIN_CAP) { atomicAdd(&(bar)[XB_TMO], 1u); break; } } } } while (0)

struct XcdBarrier {
    unsigned* bar; unsigned x;
    volatile LAS unsigned* st;
};

__device__ __forceinline__ XcdBarrier xcd_barrier_post(unsigned* bar, volatile LAS unsigned* st) {
    XcdBarrier b; b.bar = bar; b.x = xb_xcc_id(); b.st = st;
    if (threadIdx.x == 0) (void)xb_add(&bar[XB_XCNT(b.x)], 1u);
    return b;
}
__device__ __forceinline__ void xcd_barrier_complete(unsigned* bar, unsigned x, unsigned& nloc, unsigned& nx) {
    const unsigned G = gridDim.x * gridDim.y * gridDim.z;
    unsigned sum, cnt, mine, sp = 0u;
    for (;;) {
        sum = 0u; cnt = 0u; mine = 0u;
#pragma unroll
        for (unsigned j = 0; j < 16; ++j) { const unsigned c = xb_ld(&bar[XB_XCNT(j)]); sum += c; cnt += (c > 0u) ? 1u : 0u; mine = (j == x) ? c : mine; }
        if (sum == G) break;
        __builtin_amdgcn_s_sleep(1);
        if ((++sp & 255u) == 0u) { if (xb_ld(&bar[XB_TMO])) break; if (sp > XB_SPIN_CAP) { atomicAdd(&bar[XB_TMO], 1u); break; } }
    }
    nloc = mine > 0u ? mine : 1u; nx = cnt > 0u ? cnt : 1u;
}

__device__ __forceinline__ void xcd_barrier(const XcdBarrier& b) {
    asm volatile("s_waitcnt vmcnt(0)" ::: "memory");
    __syncthreads();
    if (threadIdx.x == 0) {
        unsigned* bar = b.bar;
        __builtin_amdgcn_s_waitcnt(0);
        unsigned nloc = b.st[0], nx = b.st[1];
        if (nloc == 0u) { xcd_barrier_complete(bar, b.x, nloc, nx); b.st[0] = nloc; b.st[1] = nx; }
        const unsigned old = xb_add(&bar[XB_XSUB(b.x)], 1u);
        const unsigned gen = old / nloc;
        if (old + 1u == (gen + 1u) * nloc) {
            __builtin_amdgcn_fence(__ATOMIC_RELEASE, "agent");
            asm volatile("s_waitcnt vmcnt(0)" ::: "memory");
            const unsigned og = xb_add(&bar[XB_TOP], 1u);
            const unsigned tg = og / nx;
            if (og + 1u == (tg + 1u) * nx) xb_add(&bar[XB_TOPGEN], 1u);
            else XB_SPIN(xb_ld(&bar[XB_TOPGEN]) == tg, bar);
            __builtin_amdgcn_fence(__ATOMIC_ACQUIRE, "agent");
            xb_add(&bar[XB_XGEN(b.x)], 1u);
            asm volatile("s_waitcnt vmcnt(0)" ::: "memory");
        } else {
            XB_SPIN(xb_ld(&bar[XB_XGEN(b.x)]) == gen, bar);
            __builtin_amdgcn_fence(__ATOMIC_ACQUIRE, "agent");
            asm volatile("s_waitcnt vmcnt(0)" ::: "memory");
        }
    }
    __syncthreads();
}

__global__ void __launch_bounds__(NWAVES * 64, 2) mk(Args a) {
    extern __shared__ __attribute__((aligned(16))) unsigned char lds_raw[];
    LAS unsigned char* lds = (LAS unsigned char*)lds_raw;
    const int tid = threadIdx.x, lane = tid & 63, wave = __builtin_amdgcn_readfirstlane(tid >> 6);
    unsigned char* ws = a.ws;
    const int lo = a.ph_lo, hi = a.ph_hi;
    const int G = gridDim.x;
    cg::grid_group grid = cg::this_grid();
#ifdef PROBE_SEAMS
#define SEAM_PS_B() do { __builtin_amdgcn_sched_barrier(0); psec -= __builtin_amdgcn_s_memrealtime(); __builtin_amdgcn_sched_barrier(0); } while (0)
#define SEAM_PS_E() do { __builtin_amdgcn_sched_barrier(0); psec += __builtin_amdgcn_s_memrealtime(); __builtin_amdgcn_sched_barrier(0); } while (0)
#else
#define SEAM_PS_B() do { } while (0)
#define SEAM_PS_E() do { } while (0)
#endif
#define IN(k) (lo <= (k) && (k) < hi)
#if CG_SEAM0
#define SEAM(k) do { if (IN(k) && IN((k) + 1)) { if ((k) == 0) { grid.sync(); bar = xcd_barrier_post((unsigned*)(ws + WS_BAR), MISC); } else { SEAM_PS_B(); xcd_barrier(bar); SEAM_PS_E(); } } } while (0)
#else
#define SEAM(k) do { if (IN(k) && IN((k) + 1)) { SEAM_PS_B(); xcd_barrier(bar); SEAM_PS_E(); } } while (0)
#endif
    float* SSQ = (float*)(ws + WS_SSQ);
    volatile LAS unsigned* MISC = (volatile LAS unsigned*)(lds + LDS_MISC);
    if (tid < 2) MISC[tid] = 0u;
    __syncthreads();
    XcdBarrier bar; bar.bar = (unsigned*)(ws + WS_BAR); bar.x = 0; bar.st = MISC;
#if !CG_SEAM0
    if (a.ph_lo < 0) grid.sync();
    bar = xcd_barrier_post((unsigned*)(ws + WS_BAR), MISC);
#endif
    int ph = 0;
    unsigned long long psec = 0ull, pdummy = 0ull;
#ifdef PROBE_GEMM_EPI
#define PSE_SEL(k) (((k) == PROBE_GEMM_EPI) ? psec : pdummy)
#else
#define PSE_SEL(k) pdummy
#endif
#ifdef PROBE_LO
    unsigned long long pt0 = 0, pt1 = 0;
#define PMARK(k) do { if (blockIdx.x == PROBE_BLK) { if ((k) == PROBE_LO) pt0 = __builtin_amdgcn_s_memrealtime(); if ((k) == PROBE_HI + 1) pt1 = __builtin_amdgcn_s_memrealtime(); } } while (0)
#else
#define PMARK(k) do { } while (0)
#endif
    PMARK(ph);
    if (IN(ph)) { prologue(a, lds, tid, lane, wave); }
    SEAM(ph); ++ph; PMARK(ph);
    if (IN(ph)) {
        pg8::Gemm g{(const bf16*)(ws + WS_A0), (const bf16*)(ws + WS_WIN0), M, 4096, D}; pg8::StaticOrder S; S.init(M, 4096, G, (int)blockIdx.x);
        pg8::EpiHgrnIn E{(bf16*)(ws + WS_A1), (float*)(ws + WS_A2), (bf16*)(ws + WS_A3), (bf16*)(ws + WS_A4), (const float*)(ws + WS_LB)};
        pg8::gemm_phase<pg8::EpiHgrnIn, pg8::StaticOrder, true, true>(lds, g, S, E, PSE_SEL(ph));
    }
    SEAM(ph); ++ph; PMARK(ph);
    if (IN(ph)) { for (int v = blockIdx.x; v < 256; v += G) { const int u = (G == 256) ? (((v & 7) * 2 + (v >> 7)) * 16 + ((v >> 3) & 15)) : v; hg::hgrn_unit<false>(a, lds, u, tid, lane, wave, psec); } }
    SEAM(ph); ++ph; PMARK(ph);
    if (IN(ph)) { for (int v = blockIdx.x; v < 256; v += G) { const int u = (G == 256) ? (((v & 7) * 2 + (v >> 7)) * 16 + ((v >> 3) & 15)) : v; hg::hgrn_unit<true>(a, lds, u, tid, lane, wave, psec); } }
    SEAM(ph); ++ph; PMARK(ph);
    if (IN(ph)) {
        pg8::Gemm g{(const bf16*)(ws + WS_A0), (const bf16*)(ws + WS_WOUT0), M, D, D}; pg8::StaticOrder S; S.init(M, D, G, (int)blockIdx.x);
        pg8::EpiResid<1, true> E{a.x, (bf16*)(ws + WS_A1), SSQ, (const float*)(ws + WS_SSQH)};
        pg8::gemm_phase<pg8::EpiResid<1, true>, pg8::StaticOrder, true, true>(lds, g, S, E, PSE_SEL(ph));
    }
    SEAM(ph); ++ph; PMARK(ph);
    if (IN(ph)) {
        pg8::Gemm g{(const bf16*)(ws + WS_A1), (const bf16*)(ws + WS_W13_0), M, 2 * DFF, D}; pg8::StaticOrder S; S.init(M, 2 * DFF, G, (int)blockIdx.x);
        pg8::EpiSwiglu E{(bf16*)(ws + WS_A2), DFF, SSQ};
        pg8::gemm_phase<pg8::EpiSwiglu, pg8::StaticOrder, true, true>(lds, g, S, E, PSE_SEL(ph));
        { const int nun = (M / 256) * (2 * DFF / 256), rem = nun % G; const int idle0 = rem ? rem : 0, nidle = rem ? G - rem : G;
          if ((int)blockIdx.x >= idle0) { __syncthreads(); convert_l1_weights(a, lds, lane, wave, (int)blockIdx.x - idle0, nidle); } }
    }
    SEAM(ph); ++ph; PMARK(ph);
    if (IN(ph)) {
        pg8::Gemm g{(const bf16*)(ws + WS_A2), (const bf16*)(ws + WS_W2_0), M, D, DFF}; pg8::StaticOrder S; S.init(M, D, G, (int)blockIdx.x);
        pg8::EpiResid<0, false> E{(const void*)(ws + WS_A1), (bf16*)(ws + WS_A1), SSQ, nullptr};
        pg8::gemm_phase<pg8::EpiResid<0, false>, pg8::StaticOrder, true, true>(lds, g, S, E, PSE_SEL(ph));
    }
    SEAM(ph); ++ph; PMARK(ph);
    if (IN(ph)) {
        pg8::Gemm g{(const bf16*)(ws + WS_A1), (const bf16*)(ws + WS_WQKV), M, 3072, D}; pg8::StaticOrder S; S.init(M, 3072, G, (int)blockIdx.x);
        pg8::EpiQKV E{(bf16*)(ws + WS_A2), (size_t)M * D, SSQ, (float*)(ws + WS_KMEAN)};
        pg8::gemm_phase<pg8::EpiQKV, pg8::StaticOrder, true, true>(lds, g, S, E, PSE_SEL(ph));
    }
    SEAM(ph); ++ph; PMARK(ph);
    if (IN(ph)) topk_phase(a, lds, tid, lane, wave);
    SEAM(ph); ++ph; PMARK(ph);
    if (IN(ph)) attn_engine<false>(a, lds, tid, lane, wave, psec);
    SEAM(ph); ++ph; PMARK(ph);
    if (IN(ph)) attn_engine<true>(a, lds, tid, lane, wave, psec);
    SEAM(ph); ++ph; PMARK(ph);
    if (IN(ph)) {
        pg8::Gemm g{(const bf16*)(ws + WS_A2), (const bf16*)(ws + WS_WOUT1), M, D, D}; pg8::StaticOrder S; S.init(M, D, G, (int)blockIdx.x);
        pg8::EpiResid<0, false> E{(const void*)(ws + WS_A1), (bf16*)(ws + WS_A1), SSQ, nullptr};
        pg8::gemm_phase<pg8::EpiResid<0, false>, pg8::StaticOrder, true, true>(lds, g, S, E, PSE_SEL(ph));
    }
    SEAM(ph); ++ph; PMARK(ph);
    if (IN(ph)) {
        pg8::Gemm g{(const bf16*)(ws + WS_A1), (const bf16*)(ws + WS_W13_1), M, 2 * DFF, D}; pg8::StaticOrder S; S.init(M, 2 * DFF, G, (int)blockIdx.x);
        pg8::EpiSwiglu E{(bf16*)(ws + WS_A2), DFF, SSQ};
        pg8::gemm_phase<pg8::EpiSwiglu, pg8::StaticOrder, true, true>(lds, g, S, E, PSE_SEL(ph));
    }
    SEAM(ph); ++ph; PMARK(ph);
    if (IN(ph)) {
        pg8::Gemm g{(const bf16*)(ws + WS_A2), (const bf16*)(ws + WS_W2_1), M, D, DFF}; pg8::StaticOrder S; S.init(M, D, G, (int)blockIdx.x);
        pg8::EpiResid<0, false> E{(const void*)(ws + WS_A1), (bf16*)(ws + WS_A1), SSQ, nullptr};
        pg8::gemm_phase<pg8::EpiResid<0, false>, pg8::StaticOrder, true, true>(lds, g, S, E, PSE_SEL(ph));
    }
    SEAM(ph); ++ph; PMARK(ph);
    if (IN(ph)) final_norm_phase(a, lane, wave);
    ++ph; PMARK(ph);
#ifdef PROBE_LO
    if (blockIdx.x == PROBE_BLK) { const unsigned long long te = __builtin_amdgcn_s_memrealtime(); unsigned long long w = 4ull * (pt1 - pt0);
#if defined(PROBE_SEC_ATT) || defined(PROBE_HG) || defined(PROBE_GEMM_EPI) || defined(PROBE_SEAMS)
        w = 4ull * psec;
#endif
        while (__builtin_amdgcn_s_memrealtime() - te < w) __builtin_amdgcn_s_sleep(8); }
#endif
#undef IN
#undef SEAM
#undef GEMM_PHASE
}

extern "C" void kernel_launch(void* const* d_in, const int* in_sizes, int n_in, void* d_out, int out_size, void* d_ws, size_t ws_size, hipStream_t stream) {
    static int grid = 0;
    if (grid == 0) {
        if (n_in != 13 || out_size != M * D || ws_size < WS_END) { fprintf(stderr, "kernel_launch: unexpected problem (n_in %d out %d ws %zu)\n", n_in, out_size, ws_size); grid = -1; return; }
        int dev = 0, cus = 0, per_cu = 0;
        (void)hipGetDevice(&dev); (void)hipDeviceGetAttribute(&cus, hipDeviceAttributeMultiprocessorCount, dev);
        if (hipFuncSetAttribute((const void*)mk, hipFuncAttributeMaxDynamicSharedMemorySize, LDS_BYTES) != hipSuccess) { fprintf(stderr, "kernel_launch: hipFuncSetAttribute failed\n"); grid = -1; return; }
        if (hipOccupancyMaxActiveBlocksPerMultiprocessor(&per_cu, (const void*)mk, NWAVES * 64, LDS_BYTES) != hipSuccess || per_cu < 1) { fprintf(stderr, "kernel_launch: occupancy query says %d\n", per_cu); (void)hipGetLastError(); grid = -1; return; }
        grid = cus;
        if (grid != 256) fprintf(stderr, "kernel_launch: note: %d CUs\n", grid);
    }
    if (grid < 0) return;
    Args a{};
    a.x = (const float*)d_in[0]; a.norm_mix = (const float*)d_in[1]; a.norm_ffn = (const float*)d_in[2]; a.hgrn_w_in = (const float*)d_in[3]; a.lb_logits = (const float*)d_in[4];
    a.hgrn_out_norm = (const float*)d_in[5]; a.hgrn_w_out = (const float*)d_in[6]; a.moba_w_in = (const float*)d_in[7]; a.moba_w_out = (const float*)d_in[8]; a.rel_table = (const float*)d_in[9];
    a.ffn_w13 = (const float*)d_in[10]; a.ffn_w2 = (const float*)d_in[11]; a.final_norm = (const float*)d_in[12];
    a.out = (float*)d_out; a.ws = (unsigned char*)d_ws;
    a.ph_lo = 0; a.ph_hi = 15;
    void* args[] = {&a};
#if !CG_SEAM0
    if (hipMemsetAsync((char*)d_ws + WS_BAR, 0, 3456 * 4, stream) != hipSuccess) { fprintf(stderr, "kernel_launch: hipMemsetAsync of the barrier words failed\n"); return; }
#endif
    hipError_t e = hipLaunchCooperativeKernel((const void*)mk, dim3(grid), dim3(NWAVES * 64), args, LDS_BYTES, stream);
    if (e != hipSuccess) fprintf(stderr, "kernel_launch: cooperative launch failed: %s (grid %d)\n", hipGetErrorString(e), grid);
}
```

```cpp
#define CG_SEAM0 0
#include <hip/hip_runtime.h>
#include <hip/hip_cooperative_groups.h>
#include <cstdio>
#include <cstdint>
#include <cmath>
namespace pg8 {
#define PG8_LAS __attribute__((address_space(3)))
typedef unsigned short bf16_t;
typedef short bf16x8 __attribute__((ext_vector_type(8)));
typedef float f32x4 __attribute__((ext_vector_type(4)));
typedef unsigned u32x4 __attribute__((ext_vector_type(4)));
constexpr int BM = 256, BK = 64, HALF = 128, HTB = HALF * BK * 2  , STAGE_BYTES = 8 * HTB, NXCD = 8, WGM = 8;

__host__ __device__ __forceinline__ int lds_byte(int r, int c) { const int st = (r >> 4) * 2 + (c >> 5), rr = r & 15, cc = c & 31, ob = rr * 64 + cc * 2; return st * 1024 + (ob ^ (((ob >> 9) & 1) << 5)); }
__host__ __device__ __forceinline__ void stage_rc(int b, int& R, int& C) { const int st = b / 1024, sb = b % 1024, swz = sb ^ (((sb >> 9) & 1) << 5); R = (st >> 1) * 16 + swz / 64; C = (st & 1) * 32 + (swz % 64) / 2; }
__host__ __device__ __forceinline__ int perm32(int rho) { const int n = rho >> 4, i = rho & 15; return 8 * (i >> 2) + 4 * n + (i & 3); }

struct Unit { int pm, pn; };
struct Gemm { const bf16_t* A; const bf16_t* Bt; int M, N, K; };

struct StaticOrder {
    int nM, nN, nwg, G, c;
    __host__ __device__ void init(int M, int N, int G_, int c_) { nM = M / BM; nN = N / BM; nwg = nM * nN; G = G_; c = c_; }
    __host__ __device__ bool next(int i, Unit& u) const {
        const long L = (long)i * G + c; if (L >= nwg) return false;
        int wgid = (int)L; { const int q = nwg / NXCD, r = nwg % NXCD, xcd = wgid % NXCD, off = wgid / NXCD; wgid = (xcd < r ? xcd * (q + 1) : r * (q + 1) + (xcd - r) * q) + off; }
        const int nig = WGM * nN, gid = wgid / nig, fm = gid * WGM, gsz = (nM - fm) < WGM ? (nM - fm) : WGM;
        u.pm = fm + ((wgid % nig) % gsz); u.pn = (wgid % nig) / gsz; return true;
    }
    __device__ __forceinline__ void a_ready(const Unit&) const {}
    __device__ __forceinline__ void done(const Unit&) const {}
};
typedef float f32x2 __attribute__((ext_vector_type(2)));
typedef __bf16 bf16x2_cv __attribute__((ext_vector_type(2)));
__device__ __forceinline__ unsigned cvt_pk_bf16(float lo, float hi) { f32x2 v = {lo, hi}; bf16x2_cv b = __builtin_convertvector(v, bf16x2_cv); return __builtin_bit_cast(unsigned, b); }
#ifndef WT_STORES
#define WT_STORES 0
#endif
__device__ __forceinline__ void st16_wt(void* p, u32x4 v) {
#if WT_STORES
    asm volatile("global_store_dwordx4 %0, %1, off sc1\n\ts_nop 1" :: "v"(p), "v"(v) : "memory");
#else
    *(u32x4*)p = v;
#endif
}

typedef unsigned u32x2 __attribute__((ext_vector_type(2)));
__device__ __forceinline__ float sigm(float x) { return __builtin_amdgcn_rcpf(1.f + __expf(-x)); }
__device__ __forceinline__ float bf2f_lo(unsigned w) { return __uint_as_float(w << 16); }
__device__ __forceinline__ float bf2f_hi(unsigned w) { return __uint_as_float(w & 0xffff0000u); }
__device__ __forceinline__ float rstd_from16(const float* p) {
    const f32x4 a = *(const f32x4*)p, b = *(const f32x4*)(p + 4), c = *(const f32x4*)(p + 8), d = *(const f32x4*)(p + 12);
    const float s = ((a[0] + a[1]) + (a[2] + a[3])) + ((b[0] + b[1]) + (b[2] + b[3])) + ((c[0] + c[1]) + (c[2] + c[3])) + ((d[0] + d[1]) + (d[2] + d[3]));
    return rsqrtf(s * (1.f / 1024.f) + 1e-6f);
}
__device__ __forceinline__ float rstd_from8(const float* p) {
    const f32x4 a = *(const f32x4*)p, b = *(const f32x4*)(p + 4);
    const float s = ((a[0] + a[1]) + (a[2] + a[3])) + ((b[0] + b[1]) + (b[2] + b[3]));
    return rsqrtf(s * (1.f / 1024.f) + 1e-6f);
}

struct EpiHgrnIn {
    static constexpr bool PERM = true, AFTER_DRAIN = false;
    bf16_t* QS; float* LF; bf16_t* IN; bf16_t* OG; const float* lb;
    __device__ __forceinline__ void operator()(const f32x4 (&acc)[2][2][4][2], const Unit& u, int wr, int wc, int fr, int fq) const {
        const int type = u.pn >> 2;
        const int row0 = u.pm * BM + wr * 64 + fr;
        const int col0 = (u.pn & 3) * BM + wc * 32 + 8 * fq;
#pragma unroll
        for (int bj = 0; bj < 2; ++bj) {
            const int c = col0 + bj * HALF;
            f32x4 l0 = (f32x4){0.f, 0.f, 0.f, 0.f}, l1 = l0;
            if (type == 1) { l0 = *(const f32x4*)(lb + c); l1 = *(const f32x4*)(lb + c + 4); }
#pragma unroll
            for (int ai = 0; ai < 2; ++ai)
#pragma unroll
                for (int m = 0; m < 4; ++m) {
                    const size_t off = (size_t)(row0 + ai * HALF + m * 16) * 1024 + c;
                    f32x4 v0 = acc[ai][bj][m][0], v1 = acc[ai][bj][m][1];
                    if (type == 1) {
#pragma unroll
                        for (int i = 0; i < 4; ++i) { v0[i] = logf(l0[i] + (1.f - l0[i]) * sigm(v0[i])); v1[i] = logf(l1[i] + (1.f - l1[i]) * sigm(v1[i])); }
                        st16_wt(LF + off, __builtin_bit_cast(u32x4, v0)); st16_wt(LF + off + 4, __builtin_bit_cast(u32x4, v1));
                    } else {
                        if (type == 0) {
#pragma unroll
                            for (int i = 0; i < 4; ++i) { v0[i] = v0[i] * sigm(v0[i]); v1[i] = v1[i] * sigm(v1[i]); }
                        } else if (type == 3) {
#pragma unroll
                            for (int i = 0; i < 4; ++i) { v0[i] = sigm(v0[i]); v1[i] = sigm(v1[i]); }
                        }
                        u32x4 w; w.x = cvt_pk_bf16(v0[0], v0[1]); w.y = cvt_pk_bf16(v0[2], v0[3]); w.z = cvt_pk_bf16(v1[0], v1[1]); w.w = cvt_pk_bf16(v1[2], v1[3]);
                        if (type == 0) st16_wt(QS + off, w);
                        else if (type == 2) st16_wt(IN + off, w);
                        else st16_wt(OG + off, w);
                    }
                }
        }
    }
};

template <int SCALE, bool RF32>
struct EpiResid {
    static constexpr bool PERM = true, AFTER_DRAIN = false;
    const void* R; bf16_t* HB; float* SSQ; const float* SSQIN;
    __device__ __forceinline__ void operator()(const f32x4 (&acc)[2][2][4][2], const Unit& u, int wr, int wc, int fr, int fq) const {
        const int col0 = u.pn * BM + wc * 32 + 8 * fq;
#pragma unroll
        for (int ai = 0; ai < 2; ++ai)
#pragma unroll
            for (int m = 0; m < 4; ++m) {
                const int row = u.pm * BM + ai * HALF + wr * 64 + m * 16 + fr;
                float sc = 1.f;
                if (SCALE == 1) sc = rstd_from8(SSQIN + (size_t)row * 8);
                const size_t off = (size_t)row * 1024 + col0;
                float ss = 0.f;
#pragma unroll
                for (int bj = 0; bj < 2; ++bj) {
                    const size_t o2 = off + bj * HALF;
                    f32x4 r0, r1;
                    if (RF32) { r0 = *(const f32x4*)((const float*)R + o2); r1 = *(const f32x4*)((const float*)R + o2 + 4); }
                    else { const u32x4 rw = *(const u32x4*)((const bf16_t*)R + o2);
                        r0 = (f32x4){bf2f_lo(rw.x), bf2f_hi(rw.x), bf2f_lo(rw.y), bf2f_hi(rw.y)}; r1 = (f32x4){bf2f_lo(rw.z), bf2f_hi(rw.z), bf2f_lo(rw.w), bf2f_hi(rw.w)}; }
                    const f32x4 v0 = r0 + acc[ai][bj][m][0] * sc, v1 = r1 + acc[ai][bj][m][1] * sc;
                    ss += ((v0[0] * v0[0] + v0[1] * v0[1]) + (v0[2] * v0[2] + v0[3] * v0[3])) + ((v1[0] * v1[0] + v1[1] * v1[1]) + (v1[2] * v1[2] + v1[3] * v1[3]));
                    u32x4 w; w.x = cvt_pk_bf16(v0[0], v0[1]); w.y = cvt_pk_bf16(v0[2], v0[3]); w.z = cvt_pk_bf16(v1[0], v1[1]); w.w = cvt_pk_bf16(v1[2], v1[3]);
                    st16_wt(HB + o2, w);
                }
                ss += __shfl_xor(ss, 16); ss += __shfl_xor(ss, 32);
                if (fq == 0) SSQ[(size_t)row * 16 + u.pn * 4 + wc] = ss;
                if (m & 1) asm volatile("" ::: "memory");
            }
    }
};

struct EpiSwiglu {
    static constexpr bool PERM = true, AFTER_DRAIN = false;
    bf16_t* HID; int ldh; const float* SSQIN;
    __device__ __forceinline__ void operator()(const f32x4 (&acc)[2][2][4][2], const Unit& u, int wr, int wc, int fr, int fq) const {
        const int col0 = u.pn * HALF + wc * 32 + 8 * fq;
#pragma unroll
        for (int ai = 0; ai < 2; ++ai)
#pragma unroll
            for (int m = 0; m < 4; ++m) {
                const int row = u.pm * BM + ai * HALF + wr * 64 + m * 16 + fr;
                const float sc = rstd_from16(SSQIN + (size_t)row * 16);
                f32x4 g0 = acc[ai][0][m][0] * sc, g1 = acc[ai][0][m][1] * sc, u0 = acc[ai][1][m][0] * sc, u1 = acc[ai][1][m][1] * sc;
#pragma unroll
                for (int i = 0; i < 4; ++i) { g0[i] = g0[i] * sigm(g0[i]) * u0[i]; g1[i] = g1[i] * sigm(g1[i]) * u1[i]; }
                u32x4 w; w.x = cvt_pk_bf16(g0[0], g0[1]); w.y = cvt_pk_bf16(g0[2], g0[3]); w.z = cvt_pk_bf16(g1[0], g1[1]); w.w = cvt_pk_bf16(g1[2], g1[3]);
                st16_wt(HID + (size_t)row * ldh + col0, w);
            }
    }
};

struct EpiQKV {
    static constexpr bool PERM = true, AFTER_DRAIN = false;
    bf16_t* O; size_t split_stride; const float* SSQIN; float* KMEAN;
    __device__ __forceinline__ void operator()(const f32x4 (&acc)[2][2][4][2], const Unit& u, int wr, int wc, int fr, int fq) const {
        const int t = u.pn >> 2;
        bf16_t* base = O + (size_t)t * split_stride;
        const int col0 = (u.pn & 3) * BM + wc * 32 + 8 * fq;
        f32x4 cs[2][2];
#pragma unroll
        for (int bj = 0; bj < 2; ++bj) { cs[bj][0] = (f32x4){0.f, 0.f, 0.f, 0.f}; cs[bj][1] = cs[bj][0]; }
#pragma unroll
        for (int ai = 0; ai < 2; ++ai)
#pragma unroll
            for (int m = 0; m < 4; ++m) {
                const int row = u.pm * BM + ai * HALF + wr * 64 + m * 16 + fr;
                const float sc = rstd_from16(SSQIN + (size_t)row * 16);
#pragma unroll
                for (int bj = 0; bj < 2; ++bj) {
                    const f32x4 v0 = acc[ai][bj][m][0] * sc, v1 = acc[ai][bj][m][1] * sc;
                    cs[bj][0] += v0; cs[bj][1] += v1;
                    u32x4 w; w.x = cvt_pk_bf16(v0[0], v0[1]); w.y = cvt_pk_bf16(v0[2], v0[3]); w.z = cvt_pk_bf16(v1[0], v1[1]); w.w = cvt_pk_bf16(v1[2], v1[3]);
                    st16_wt(base + (size_t)row * 1024 + col0 + bj * HALF, w);
                }
            }
        if (t == 1) {
#pragma unroll
            for (int bj = 0; bj < 2; ++bj)
#pragma unroll
                for (int n = 0; n < 2; ++n)
#pragma unroll
                    for (int i = 0; i < 4; ++i) {
                        float s = cs[bj][n][i];
                        s += __shfl_xor(s, 1); s += __shfl_xor(s, 2); s += __shfl_xor(s, 4); s += __shfl_xor(s, 8);
                        if (fr == 0) atomicAdd(KMEAN + (size_t)u.pm * 1024 + col0 + bj * HALF + 4 * n + i, s * (1.f / 256.f));
                    }
        }
    }
};

#ifdef PROBE_GEMM_EPI
#define PG8_PS_B() do { __builtin_amdgcn_sched_barrier(0); psec -= __builtin_amdgcn_s_memrealtime(); __builtin_amdgcn_sched_barrier(0); } while (0)
#define PG8_PS_E() do { __builtin_amdgcn_sched_barrier(0); psec += __builtin_amdgcn_s_memrealtime(); __builtin_amdgcn_sched_barrier(0); } while (0)
#else
#define PG8_PS_B() do { } while (0)
#define PG8_PS_E() do { } while (0)
#endif
template <class Epi, class Sched, bool ALIGN_EPI = false, bool SP2 = false>
__device__ __forceinline__ void gemm_phase(PG8_LAS unsigned char* lds, const Gemm g, const Sched& S, const Epi& E, unsigned long long& psec) {
    const int tid = threadIdx.x, wid = __builtin_amdgcn_readfirstlane(tid >> 6), lane = tid & 63, wr = wid >> 2, wc = wid & 3, fr = lane & 15, fq = lane >> 4;
    const int K = g.K, nt = K / BK;
    unsigned voffA[2], voffB[2];
#pragma unroll
    for (int i = 0; i < 2; ++i) { int R, C; stage_rc(tid * 16 + i * 8192, R, C); const int Rb = Epi::PERM ? ((R & ~31) + perm32(R & 31)) : R;
        voffA[i] = (unsigned)(R * K + C) * 2u; voffB[i] = (unsigned)(Rb * K + C) * 2u; }
    const size_t kstep = (size_t)(BK * 2);
    const size_t hstep = (size_t)HALF * K * 2;
    const size_t tstep = 2 * hstep;
    const unsigned ldsw = (unsigned)wid * 1024u;
    const int aoff = lds_byte(wr * 64 + fr, fq * 8), boff = lds_byte(wc * 32 + fr, fq * 8);
#define PG8_SA(b, h) (((b) * 2 + (h)) * HTB)
#define PG8_SB(b, h) ((4 + (b) * 2 + (h)) * HTB)
#define PG8_STAGE(bufoff, gbase, voff) do { _Pragma("unroll") for (int _i = 0; _i < 2; ++_i) \
        __builtin_amdgcn_global_load_lds((const unsigned*)((const char*)(gbase) + (voff)[_i]), (PG8_LAS unsigned*)(lds + (bufoff) + ldsw + _i * 8192), 16, 0, 0); } while (0)
#define PG8_LDA(dst, b, h) do { _Pragma("unroll") for (int m = 0; m < 4; ++m) _Pragma("unroll") for (int k = 0; k < 2; ++k) dst[m][k] = *(const PG8_LAS bf16x8*)(lds + PG8_SA(b, h) + aoff + m * 2048 + k * 1024); } while (0)
#define PG8_LDB(dst, b, h) do { _Pragma("unroll") for (int n = 0; n < 2; ++n) _Pragma("unroll") for (int k = 0; k < 2; ++k) dst[n][k] = *(const PG8_LAS bf16x8*)(lds + PG8_SB(b, h) + boff + n * 2048 + k * 1024); } while (0)
#define PG8_MMA(ai, bj, At, Bt) do { __builtin_amdgcn_s_setprio(1); _Pragma("unroll") for (int m = 0; m < 4; ++m) _Pragma("unroll") for (int n = 0; n < 2; ++n) _Pragma("unroll") for (int k = 0; k < 2; ++k) \
        acc[ai][bj][m][n] = __builtin_amdgcn_mfma_f32_16x16x32_bf16(Bt[n][k], At[m][k], acc[ai][bj][m][n], 0, 0, 0); __builtin_amdgcn_s_setprio(0); } while (0)
#define PG8_WAIT_V(n) asm volatile("s_waitcnt vmcnt(" #n ")" ::: "memory")
#define PG8_WAIT_L(n) asm volatile("s_waitcnt lgkmcnt(" #n ")" ::: "memory")
#define PG8_BAR __builtin_amdgcn_s_barrier()
#define PG8_SCHED __builtin_amdgcn_sched_barrier(0)
    Unit cur, nxt; int ui = 0;
    if (!S.next(0, cur)) return;
    f32x4 acc[2][2][4][2];
#pragma unroll
    for (int a = 0; a < 2; ++a)
#pragma unroll
        for (int b = 0; b < 2; ++b)
#pragma unroll
            for (int m = 0; m < 4; ++m)
#pragma unroll
                for (int n = 0; n < 2; ++n) acc[a][b][m][n] = (f32x4){0.f, 0.f, 0.f, 0.f};
    bf16x8 At[4][2], B0[2][2], B1[2][2];
    const char* cA = (const char*)g.A + (size_t)cur.pm * tstep; const char* cB = (const char*)g.Bt + (size_t)cur.pn * tstep;
    S.a_ready(cur);
    if constexpr (SP2) {
        PG8_STAGE(PG8_SB(0, 0), cB, voffB); PG8_STAGE(PG8_SB(0, 1), cB + hstep, voffB); PG8_STAGE(PG8_SA(0, 0), cA, voffA); PG8_STAGE(PG8_SA(0, 1), cA + hstep, voffA);
        if (wr == 1) PG8_BAR;
        PG8_WAIT_V(2); PG8_BAR;
        PG8_STAGE(PG8_SB(1, 0), cB + kstep, voffB); PG8_STAGE(PG8_SA(1, 0), cA + kstep, voffA); PG8_STAGE(PG8_SB(1, 1), cB + hstep + kstep, voffB);
        PG8_WAIT_V(6); PG8_BAR;
    } else {
        PG8_STAGE(PG8_SB(0, 0), cB, voffB); PG8_STAGE(PG8_SA(0, 0), cA, voffA); PG8_STAGE(PG8_SB(0, 1), cB + hstep, voffB); PG8_STAGE(PG8_SA(0, 1), cA + hstep, voffA);
        if (wr == 1) PG8_BAR;
        PG8_WAIT_V(4); PG8_BAR;
        PG8_STAGE(PG8_SB(1, 0), cB + kstep, voffB); PG8_STAGE(PG8_SA(1, 0), cA + kstep, voffA); PG8_STAGE(PG8_SB(1, 1), cB + hstep + kstep, voffB);
        PG8_WAIT_V(6); PG8_BAR;
    }
    for (;;) {
        const bool has_next = S.next(ui + 1, nxt);
        const char* nA = has_next ? (const char*)g.A + (size_t)nxt.pm * tstep : cA; const char* nB = has_next ? (const char*)g.Bt + (size_t)nxt.pn * tstep : cB;
        for (int t = 0; t < nt; t += 2) {
            const bool last = (t == nt - 2);
            const char* a1 = cA + (size_t)(t + 1) * kstep;
            const char* a2 = last ? nA : cA + (size_t)(t + 2) * kstep; const char* b2 = last ? nB : cB + (size_t)(t + 2) * kstep;
            const char* a3 = a2 + kstep; const char* b3 = b2 + kstep;
            if (last && has_next) S.a_ready(nxt);
            if constexpr (SP2) {
            PG8_LDB(B0, 0, 0); PG8_LDB(B1, 0, 1); PG8_SCHED; PG8_LDA(At, 0, 0); PG8_STAGE(PG8_SA(1, 1), a1 + hstep, voffA);
            PG8_WAIT_V(8); PG8_WAIT_L(0); PG8_BAR; PG8_MMA(0, 0, At, B0); PG8_MMA(0, 1, At, B1); PG8_BAR; PG8_SCHED;
            PG8_LDA(At, 0, 1); PG8_STAGE(PG8_SB(0, 0), b2, voffB); PG8_STAGE(PG8_SB(0, 1), b2 + hstep, voffB); PG8_STAGE(PG8_SA(0, 0), a2, voffA);
            PG8_WAIT_V(8); PG8_WAIT_L(0); PG8_BAR; PG8_MMA(1, 0, At, B0); PG8_MMA(1, 1, At, B1); PG8_BAR; PG8_SCHED;
            PG8_LDB(B0, 1, 0); PG8_LDB(B1, 1, 1); PG8_SCHED; PG8_LDA(At, 1, 0); PG8_STAGE(PG8_SA(0, 1), a2 + hstep, voffA);
            PG8_WAIT_V(8); PG8_WAIT_L(0); PG8_BAR; PG8_MMA(0, 0, At, B0); PG8_MMA(0, 1, At, B1); PG8_BAR; PG8_SCHED;
            PG8_LDA(At, 1, 1); PG8_STAGE(PG8_SB(1, 0), b3, voffB); PG8_STAGE(PG8_SB(1, 1), b3 + hstep, voffB); PG8_STAGE(PG8_SA(1, 0), a3, voffA);
            PG8_WAIT_V(8); PG8_WAIT_L(0); PG8_BAR; PG8_MMA(1, 0, At, B0); PG8_MMA(1, 1, At, B1); PG8_BAR; PG8_SCHED;
            } else {
            PG8_LDB(B0, 0, 0); PG8_SCHED; PG8_LDA(At, 0, 0); PG8_STAGE(PG8_SA(1, 1), a1 + hstep, voffA);
            PG8_WAIT_L(8); PG8_BAR; PG8_WAIT_L(0); PG8_MMA(0, 0, At, B0); PG8_BAR; PG8_SCHED;
            PG8_LDB(B1, 0, 1); PG8_STAGE(PG8_SB(0, 0), b2, voffB);
            PG8_BAR; PG8_WAIT_L(0); PG8_MMA(0, 1, At, B1); PG8_BAR;
            PG8_LDA(At, 0, 1); PG8_STAGE(PG8_SA(0, 0), a2, voffA);
            PG8_BAR; PG8_WAIT_L(0); PG8_MMA(1, 0, At, B0); PG8_BAR; PG8_SCHED;
            PG8_STAGE(PG8_SB(0, 1), b2 + hstep, voffB);
            PG8_WAIT_V(6); PG8_BAR; PG8_MMA(1, 1, At, B1); PG8_BAR;
            PG8_LDB(B0, 1, 0); PG8_SCHED; PG8_LDA(At, 1, 0); PG8_STAGE(PG8_SA(0, 1), a2 + hstep, voffA);
            PG8_WAIT_L(8); PG8_BAR; PG8_WAIT_L(0); PG8_MMA(0, 0, At, B0); PG8_BAR; PG8_SCHED;
            PG8_LDB(B1, 1, 1); PG8_STAGE(PG8_SB(1, 0), b3, voffB);
            PG8_BAR; PG8_WAIT_L(0); PG8_MMA(0, 1, At, B1); PG8_BAR;
            PG8_LDA(At, 1, 1); PG8_STAGE(PG8_SA(1, 0), a3, voffA);
            PG8_BAR; PG8_WAIT_L(0); PG8_MMA(1, 0, At, B0); PG8_BAR; PG8_SCHED;
            PG8_STAGE(PG8_SB(1, 1), b3 + hstep, voffB);
            PG8_WAIT_V(6); PG8_BAR; PG8_MMA(1, 1, At, B1); PG8_BAR;
            }
        }
        if constexpr (ALIGN_EPI) { if (wr == 0) PG8_BAR; }
        if constexpr (!Epi::AFTER_DRAIN) { PG8_PS_B(); E(acc, cur, wr, wc, fr, fq); S.done(cur); PG8_PS_E(); }
        if (!has_next) break;
#pragma unroll
        for (int a = 0; a < 2; ++a)
#pragma unroll
            for (int b = 0; b < 2; ++b)
#pragma unroll
                for (int m = 0; m < 4; ++m)
#pragma unroll
                    for (int n = 0; n < 2; ++n) acc[a][b][m][n] = (f32x4){0.f, 0.f, 0.f, 0.f};
        cur = nxt; cA = nA; cB = nB; ++ui;
        if constexpr (ALIGN_EPI) { if (wr == 1) PG8_BAR; }
    }
    PG8_WAIT_V(0);
    if constexpr (!ALIGN_EPI) { if (wr == 0) PG8_BAR; }
    PG8_BAR;
    if constexpr (Epi::AFTER_DRAIN) { E.fused(acc, cur, wr, wc, fr, fq, lds, wid, lane); S.done(cur); }
#undef PG8_SA
#undef PG8_SB
#undef PG8_STAGE
#undef PG8_LDA
#undef PG8_LDB
#undef PG8_MMA
#undef PG8_WAIT_V
#undef PG8_WAIT_L
#undef PG8_BAR
#undef PG8_SCHED
}
}

namespace cg = cooperative_groups;
constexpr int NWAVES = 8;
constexpr int BATCH = 2, T = 8192, D = 1024, H = 8, DH = 128, DFF = 2816, NB = 32, BLK = 256;
constexpr int M = BATCH * T;
constexpr float EPS = 1e-6f;
constexpr size_t MiB = 1u << 20;
constexpr size_t WS_CTL = 0;
constexpr size_t WS_WQKV = 1 * MiB, WS_WOUT1 = 7 * MiB, WS_W13_1 = 9 * MiB, WS_W2_1 = 20 * MiB;
constexpr size_t WS_WIN0 = 26 * MiB, WS_WOUT0 = 34 * MiB, WS_W13_0 = 36 * MiB, WS_W2_0 = 47 * MiB;
constexpr size_t WS_SSQ = 53 * MiB;
constexpr size_t WS_SSQH = 54 * MiB;
constexpr size_t WS_LB = 54 * MiB + 512 * 1024;
constexpr size_t WS_BKT = WS_LB + 4096;
constexpr size_t WS_YMEAN = WS_BKT + 32768;
constexpr size_t WS_KMEAN = WS_YMEAN + 262144;
constexpr size_t WS_SEL = 55 * MiB + 512 * 1024;
constexpr size_t WS_G = 56 * MiB;
constexpr size_t WS_A0 = 60 * MiB;
constexpr size_t WS_A1 = 92 * MiB;
constexpr size_t WS_A2 = 124 * MiB;
constexpr size_t WS_A3 = 188 * MiB;
constexpr size_t WS_A4 = 220 * MiB;
constexpr size_t WS_END = 256 * MiB;
static_assert(WS_W2_0 + (size_t)D * DFF * 2 <= WS_SSQ && WS_G + 2 * MiB <= WS_A0 && WS_A4 + 32 * MiB <= WS_END, "ws map");

#ifndef ATT_RESIDENT
#define ATT_RESIDENT 1
#endif
#ifndef ATT_RESIDENT_OWN
#define ATT_RESIDENT_OWN 0
#endif
#ifndef CG_SEAM0
#define CG_SEAM0 1
#endif
constexpr int LDS_BYTES = 163840;
constexpr int LDS_MISC = 163584;
constexpr size_t WS_BAR = 65536;

#define GAS __attribute__((address_space(1)))
#define LAS __attribute__((address_space(3)))
typedef unsigned short bf16;
typedef unsigned v4u __attribute__((ext_vector_type(4)));
typedef float f32x4 __attribute__((ext_vector_type(4)));
#define LDS_WAIT() asm volatile("s_waitcnt lgkmcnt(0)" ::: "memory")
__device__ __forceinline__ unsigned f2bf(float f) { unsigned u = __builtin_bit_cast(unsigned, f); return (u + 0x7fffu + ((u >> 16) & 1u)) >> 16; }
__device__ __forceinline__ unsigned pk2(float lo, float hi) { return f2bf(lo) | (f2bf(hi) << 16); }
__device__ __forceinline__ float bf2f(unsigned short b) { return __uint_as_float((unsigned)b << 16); }
__device__ __forceinline__ float wave_sum(float v) {
#pragma unroll
    for (int o = 1; o < 64; o <<= 1) v += __shfl_xor(v, o);
    return v;
}

struct Args {
    const float* x; const float* norm_mix; const float* norm_ffn; const float* hgrn_w_in; const float* lb_logits; const float* hgrn_out_norm; const float* hgrn_w_out;
    const float* moba_w_in; const float* moba_w_out; const float* rel_table; const float* ffn_w13; const float* ffn_w2; const float* final_norm;
    float* out; unsigned char* ws; int ph_lo, ph_hi;
};

__device__ __forceinline__ void tr_item(const float* W, int ldw, int K, bf16* WT, int Ndst, const float* gain, int mode, LAS float* scr, int item, int lane) {
    const int nblk = Ndst / 64, kb = item / nblk, nb = item % nblk, k0 = 64 * kb, n0 = 64 * nb;
    int s0 = n0;
    if (mode == 1) { const int t = n0 >> 8, c = n0 & 255; s0 = (c < 128) ? (128 * t + c) : (DFF + 128 * t + (c - 128)); }
    f32x4 wv[16];
#pragma unroll
    for (int i = 0; i < 16; ++i) wv[i] = *(const GAS f32x4*)(W + (size_t)(k0 + 4 * i + (lane >> 4)) * ldw + s0 + (lane & 15) * 4);
#pragma unroll
    for (int i = 0; i < 16; ++i) { const int kk = 4 * i + (lane >> 4);
        f32x4 w = wv[i];
        if (gain) w = w * gain[k0 + kk];
        LAS float* d = scr + kk * 65 + (lane & 15) * 4; d[0] = w.x; d[1] = w.y; d[2] = w.z; d[3] = w.w; }
    LDS_WAIT(); asm volatile("" ::: "memory");
    const int c = lane & 7;
#pragma unroll
    for (int j = 0; j < 8; ++j) { const int n = (lane >> 3) + 8 * j; const LAS float* s = scr + (8 * c) * 65 + n;
        v4u o; o.x = pk2(s[0 * 65], s[1 * 65]); o.y = pk2(s[2 * 65], s[3 * 65]); o.z = pk2(s[4 * 65], s[5 * 65]); o.w = pk2(s[6 * 65], s[7 * 65]);
        *(GAS v4u*)(WT + (size_t)(n0 + n) * K + k0 + 8 * c) = o; }
    LDS_WAIT(); asm volatile("" ::: "memory");
}

__device__ __forceinline__ void prologue(const Args& a, LAS unsigned char* lds, int tid, int lane, int wave) {
    unsigned char* ws = a.ws;
    LAS float* scr = (LAS float*)(lds + wave * 16640);
    const int gw = blockIdx.x * NWAVES + wave, NGW = gridDim.x * NWAVES;
    constexpr int I_IN0 = (D / 64) * (4096 / 64), I_O = (D / 64) * (D / 64), I_13 = (D / 64) * (2 * DFF / 64), I_2 = (DFF / 64) * (D / 64);
    constexpr int NITEMS = I_IN0 + I_O + I_13 + I_2;
    for (int it = gw; it < NITEMS; it += NGW) {
        int r = it;
        if (r < I_IN0) { tr_item(a.hgrn_w_in, 4096, D, (bf16*)(ws + WS_WIN0), 4096, nullptr, 0, scr, r, lane); continue; } r -= I_IN0;
        if (r < I_O) { tr_item(a.hgrn_w_out, D, D, (bf16*)(ws + WS_WOUT0), D, a.hgrn_out_norm, 0, scr, r, lane); continue; } r -= I_O;
        if (r < I_13) { tr_item(a.ffn_w13, 2 * DFF, D, (bf16*)(ws + WS_W13_0), 2 * DFF, a.norm_ffn, 1, scr, r, lane); continue; } r -= I_13;
        tr_item(a.ffn_w2, D, DFF, (bf16*)(ws + WS_W2_0), D, nullptr, 0, scr, r, lane);
    }
    bf16* XN0 = (bf16*)(ws + WS_A0);
    for (int m = 2 * gw; m < M; m += 2 * NGW) {
        const GAS f32x4* xr = (const GAS f32x4*)(a.x + (size_t)m * D) + lane;
        f32x4 v[8]; float s0 = 0.f, s1 = 0.f;
#pragma unroll
        for (int j = 0; j < 8; ++j) v[j] = xr[64 * j];
#pragma unroll
        for (int j = 0; j < 4; ++j) { s0 += (v[j].x * v[j].x + v[j].y * v[j].y) + (v[j].z * v[j].z + v[j].w * v[j].w); s1 += (v[4 + j].x * v[4 + j].x + v[4 + j].y * v[4 + j].y) + (v[4 + j].z * v[4 + j].z + v[4 + j].w * v[4 + j].w); }
        const float r0 = rsqrtf(wave_sum(s0) * (1.f / D) + EPS), r1 = rsqrtf(wave_sum(s1) * (1.f / D) + EPS);
        GAS unsigned long long* o8 = (GAS unsigned long long*)(XN0 + (size_t)m * D) + lane;
#pragma unroll
        for (int j = 0; j < 8; ++j) { const f32x4 g = *((const GAS f32x4*)a.norm_mix + lane + 64 * (j & 3)); const float rs = j < 4 ? r0 : r1;
            o8[64 * j] = (unsigned long long)pk2(v[j].x * rs * g.x, v[j].y * rs * g.y) | ((unsigned long long)pk2(v[j].z * rs * g.z, v[j].w * rs * g.w) << 32); }
    }
    for (int i = blockIdx.x * (NWAVES * 64) + tid; i < 64 * D; i += gridDim.x * NWAVES * 64) ((float*)(ws + WS_KMEAN))[i] = 0.f;
    if (blockIdx.x == 0) {
        float* lb = (float*)(ws + WS_LB); int* bkt = (int*)(ws + WS_BKT);
        for (int i = tid; i < 1024; i += NWAVES * 64) { const float l0 = a.lb_logits[i], l1 = a.lb_logits[1024 + i]; const float mx = fmaxf(l0, l1); const float e0 = expf(l0 - mx), e1 = expf(l1 - mx); lb[i] = e0 / (e0 + e1); }
        for (int i = tid; i < T; i += NWAVES * 64) {
            int bk;
            if (i < 16) bk = i;
            else { const float nf = (float)i; const float v = logf(nf / 16.f) / 4.1588830833596715f * 16.f; bk = 16 + (int)v; if (bk > 31) bk = 31; }
            bkt[i] = bk;
            if (i < 1024) { float* tab2 = (float*)(ws + WS_YMEAN);
#pragma unroll
                for (int hh = 0; hh < 8; ++hh) tab2[hh * 1024 + i] = a.rel_table[bk * 8 + hh] * 1.4426950408889634f; }
        }
        for (int i = tid; i < 1024; i += NWAVES * 64) ((unsigned*)(ws + 4096))[i] = 0u;
#if CG_SEAM0
        for (int i = tid; i < 3456; i += NWAVES * 64) ((unsigned*)(ws + WS_BAR))[i] = 0u;
#endif
    }
}

__device__ __forceinline__ void convert_l1_weights(const Args& a, LAS unsigned char* lds, int lane, int wave, int rank, int nrank) {
    unsigned char* ws = a.ws;
    LAS float* scr = (LAS float*)(lds + wave * 16640);
    const int gw = rank * NWAVES + wave, NGW = nrank * NWAVES;
    constexpr int I_O = (D / 64) * (D / 64), I_13 = (D / 64) * (2 * DFF / 64), I_2 = (DFF / 64) * (D / 64), I_QKV = (D / 64) * (3072 / 64);
    constexpr int NITEMS = I_QKV + I_O + I_13 + I_2;
    for (int it = gw; it < NITEMS; it += NGW) {
        int r = it;
        if (r < I_QKV) { tr_item(a.moba_w_in, 3072, D, (bf16*)(ws + WS_WQKV), 3072, a.norm_mix + D, 0, scr, r, lane); continue; } r -= I_QKV;
        if (r < I_O) { tr_item(a.moba_w_out, D, D, (bf16*)(ws + WS_WOUT1), D, nullptr, 0, scr, r, lane); continue; } r -= I_O;
        if (r < I_13) { tr_item(a.ffn_w13 + (size_t)D * 2 * DFF, 2 * DFF, D, (bf16*)(ws + WS_W13_1), 2 * DFF, a.norm_ffn + D, 1, scr, r, lane); continue; } r -= I_13;
        tr_item(a.ffn_w2 + (size_t)DFF * D, D, DFF, (bf16*)(ws + WS_W2_1), D, nullptr, 0, scr, r, lane);
    }
}

__device__ __forceinline__ void final_norm_phase(const Args& a, int lane, int wave) {
    const int gw = blockIdx.x * NWAVES + wave, NGW = gridDim.x * NWAVES;
    const float* SSQ = (const float*)(a.ws + WS_SSQ); const bf16* HB = (const bf16*)(a.ws + WS_A1);
    for (int m = gw; m < M; m += NGW) {
        const float rstd = pg8::rstd_from16(SSQ + (size_t)m * 16);
        const GAS v4u* hr = (const GAS v4u*)(HB + (size_t)m * D) + lane;
        GAS f32x4* orow = (GAS f32x4*)(a.out + (size_t)m * D);
#pragma unroll
        for (int j = 0; j < 2; ++j) {
            const v4u w = hr[64 * j]; const int c = (64 * j + lane) * 8;
            const f32x4 g0 = *(const GAS f32x4*)(a.final_norm + c), g1 = *(const GAS f32x4*)(a.final_norm + c + 4);
            f32x4 o0, o1;
            o0.x = __uint_as_float(w.x << 16) * rstd * g0.x; o0.y = __uint_as_float(w.x & 0xffff0000u) * rstd * g0.y; o0.z = __uint_as_float(w.y << 16) * rstd * g0.z; o0.w = __uint_as_float(w.y & 0xffff0000u) * rstd * g0.w;
            o1.x = __uint_as_float(w.z << 16) * rstd * g1.x; o1.y = __uint_as_float(w.z & 0xffff0000u) * rstd * g1.y; o1.z = __uint_as_float(w.w << 16) * rstd * g1.z; o1.w = __uint_as_float(w.w & 0xffff0000u) * rstd * g1.w;
            orow[c / 4] = o0; orow[c / 4 + 1] = o1;
        }
    }
}

__device__ __forceinline__ float sigmoidf_(float x) { return 1.f / (1.f + __expf(-x)); }

namespace moba {
using bf16x8 = __attribute__((ext_vector_type(8))) short;
using s16x4 = __attribute__((ext_vector_type(4))) short;
using f32x16 = __attribute__((ext_vector_type(16))) float;
using u32x4 = __attribute__((ext_vector_type(4))) unsigned;
#define KSWZ(row, colB) ((row) * 256 + ((colB) ^ (((row) & 7) << 4)))
#define SBAR() __builtin_amdgcn_sched_barrier(0)
constexpr float C2 = 0.08838834764831845f * 1.4426950408889634f;
constexpr float LOG2E = 1.4426950408889634f;
__device__ __forceinline__ int crow(int r, int hi) { return (r & 3) + 8 * (r >> 2) + 4 * hi; }
__device__ __forceinline__ unsigned cvtpk(float lo, float hi) { return pg8::cvt_pk_bf16(lo, hi); }
__device__ __forceinline__ int v_st(int k, int c) { const int kk = (k & ~0xC) | ((k & 4) << 1) | ((k & 8) >> 1); return ((kk >> 3) * 4 + (c >> 5)) * 512 + ((kk & 7) * 32 + (c & 31)) * 2; }
__device__ __forceinline__ int v_rd_base(int lane) { return ((lane & 3) << 3) | (((lane >> 2) & 3) << 6) | (((lane >> 4) & 1) << 5) | (((lane >> 5) & 1) << 8); }
constexpr int v_rd_off(int d0, int ks, int half) { return d0 * 512 + ks * 4096 + half * 2048; }
template <int OFF> __device__ __forceinline__ s16x4 tr_read(int vb) {
    s16x4 r; asm volatile("ds_read_b64_tr_b16 %0, %1 offset:%2" : "=&v"(r) : "v"(vb), "i"(OFF) : "memory"); return r;
}
template <int D0> __device__ __forceinline__ void pv_one(f32x16& od, int vb, bf16x8 pa0, bf16x8 pa1, bf16x8 pa2, bf16x8 pa3) {
    const s16x4 l0 = tr_read<v_rd_off(D0, 0, 0)>(vb), h0 = tr_read<v_rd_off(D0, 0, 1)>(vb), l1 = tr_read<v_rd_off(D0, 1, 0)>(vb), h1 = tr_read<v_rd_off(D0, 1, 1)>(vb);
    const s16x4 l2 = tr_read<v_rd_off(D0, 2, 0)>(vb), h2 = tr_read<v_rd_off(D0, 2, 1)>(vb), l3 = tr_read<v_rd_off(D0, 3, 0)>(vb), h3 = tr_read<v_rd_off(D0, 3, 1)>(vb);
    asm volatile("s_waitcnt lgkmcnt(0)" ::: "memory"); SBAR();
#define PK(L, Hh) (bf16x8){L[0], L[1], L[2], L[3], Hh[0], Hh[1], Hh[2], Hh[3]}
    od = __builtin_amdgcn_mfma_f32_32x32x16_bf16(pa0, PK(l0, h0), od, 0, 0, 0);
    od = __builtin_amdgcn_mfma_f32_32x32x16_bf16(pa1, PK(l1, h1), od, 0, 0, 0);
    od = __builtin_amdgcn_mfma_f32_32x32x16_bf16(pa2, PK(l2, h2), od, 0, 0, 0);
    od = __builtin_amdgcn_mfma_f32_32x32x16_bf16(pa3, PK(l3, h3), od, 0, 0, 0);
#undef PK
}
__device__ __forceinline__ void qkt(f32x16& p0, f32x16& p1, const LAS unsigned char* Ks, const bf16x8 (&qr)[8], int r32, int hi) {
    p0 = f32x16{}; p1 = f32x16{};
#pragma unroll
    for (int d0 = 0; d0 < 8; ++d0) { const int cb = (d0 * 16 + hi * 8) * 2;
        const bf16x8 b0 = *(const LAS bf16x8*)(Ks + KSWZ(r32, cb));
        const bf16x8 b1 = *(const LAS bf16x8*)(Ks + KSWZ(32 + r32, cb));
        p0 = __builtin_amdgcn_mfma_f32_32x32x16_bf16(b0, qr[d0], p0, 0, 0, 0);
        p1 = __builtin_amdgcn_mfma_f32_32x32x16_bf16(b1, qr[d0], p1, 0, 0, 0); }
}
}

constexpr size_t WS_CNT = 4096;
constexpr size_t WS_TAB2 = WS_YMEAN;
constexpr size_t WS_LIST = WS_WIN0;
constexpr size_t WS_LSE = WS_G;
constexpr size_t WS_PO0 = WS_A0, WS_PO2 = WS_A4;

__device__ __forceinline__ void topk_phase(const Args& a, LAS unsigned char* lds, int tid, int lane, int wid) {
    using namespace moba;
    const bf16* Q = (const bf16*)(a.ws + WS_A2); const float* kmean = (const float*)(a.ws + WS_KMEAN);
    unsigned* cnt = (unsigned*)(a.ws + WS_CNT); unsigned short* lists = (unsigned short*)(a.ws + WS_LIST);
    LAS unsigned* lcnt = (LAS unsigned*)lds;
    const int r32 = lane & 31, hi = lane >> 5;
    for (int it = blockIdx.x; it < 512; it += gridDim.x) {
        const int bh = it >> 5, j = it & 31, b = bh >> 3, h = bh & 7;
        if (j == 0) continue;
        __syncthreads();
        if (tid < 64) lcnt[tid] = 0u;
        __syncthreads();
        bf16x8 ahi[8], alo[8];
        const float* kp = kmean + (size_t)(b * 32 + r32) * D + h * 128 + hi * 8;
#pragma unroll
        for (int ks = 0; ks < 8; ++ks) {
            const f32x4 v0 = *(const f32x4*)(kp + 16 * ks), v1 = *(const f32x4*)(kp + 16 * ks + 4);
            const unsigned h0 = pk2(v0[0], v0[1]), h1 = pk2(v0[2], v0[3]), h2 = pk2(v1[0], v1[1]), h3 = pk2(v1[2], v1[3]);
            const unsigned l0 = pk2(v0[0] - __uint_as_float(h0 << 16), v0[1] - __uint_as_float(h0 & 0xffff0000u)), l1 = pk2(v0[2] - __uint_as_float(h1 << 16), v0[3] - __uint_as_float(h1 & 0xffff0000u));
            const unsigned l2 = pk2(v1[0] - __uint_as_float(h2 << 16), v1[1] - __uint_as_float(h2 & 0xffff0000u)), l3 = pk2(v1[2] - __uint_as_float(h3 << 16), v1[3] - __uint_as_float(h3 & 0xffff0000u));
            u32x4 wh = {h0, h1, h2, h3}, wl = {l0, l1, l2, l3};
            ahi[ks] = *reinterpret_cast<bf16x8*>(&wh); alo[ks] = *reinterpret_cast<bf16x8*>(&wl);
        }
        const int qpos = j * 256 + wid * 32 + r32, m = b * T + qpos;
        const bf16* Qw = Q + (size_t)m * D + h * 128 + hi * 8;
        f32x16 gacc = {};
#pragma unroll
        for (int ks = 0; ks < 8; ++ks) { const bf16x8 qv = *(const bf16x8*)(Qw + 16 * ks);
            gacc = __builtin_amdgcn_mfma_f32_32x32x16_bf16(ahi[ks], qv, gacc, 0, 0, 0);
            gacc = __builtin_amdgcn_mfma_f32_32x32x16_bf16(alo[ks], qv, gacc, 0, 0, 0); }
        float cv[6]; int ci[6];
        unsigned usedm = 0u;
#pragma unroll
        for (int s = 0; s < 3; ++s) { int best = 0; float val = -INFINITY; bool have = false;
#pragma unroll
            for (int r = 0; r < 16; ++r) { const float gv = (crow(r, hi) < j) ? gacc[r] : -INFINITY; const bool free_ = !((usedm >> r) & 1u); if (free_ && (!have || gv > val)) { best = r; val = gv; have = true; } }
            usedm |= 1u << best; cv[s] = val; ci[s] = crow(best, hi); }
#pragma unroll
        for (int s = 0; s < 3; ++s) { cv[3 + s] = __shfl_xor(cv[s], 32); ci[3 + s] = __shfl_xor(ci[s], 32); }
        int selv[3]; unsigned um = 0u;
#pragma unroll
        for (int s = 0; s < 3; ++s) { int best = 0; float val = 0.f; int bidx = 0; bool have = false;
#pragma unroll
            for (int c = 0; c < 6; ++c) { const bool free_ = !((um >> c) & 1u); if (free_ && (!have || cv[c] > val || (cv[c] == val && ci[c] < bidx))) { best = c; val = cv[c]; bidx = ci[c]; have = true; } }
            um |= 1u << best; selv[s] = bidx; }
        unsigned lpos[3] = {0u, 0u, 0u};
        if (hi == 0) {
#pragma unroll
            for (int s = 0; s < 3; ++s) if (s < j) lpos[s] = atomicAdd((unsigned*)&lcnt[selv[s]], 1u);
        }
        __syncthreads();
        if (tid < 32) { const unsigned c = lcnt[tid]; const int near = (j - tid <= 4) ? 1 : 0; unsigned base = 0u; if (c) base = atomicAdd(&cnt[(bh * 32 + tid) * 2 + near], c); lcnt[32 + tid] = base + (near ? 7168u : 0u); }
        __syncthreads();
        if (hi == 0) {
#pragma unroll
            for (int s = 0; s < 3; ++s)
                if (s < j) lists[(size_t)(bh * 32 + selv[s]) * 8192 + lcnt[32 + selv[s]] + lpos[s]] = (unsigned short)(qpos | (s << 13));
        }
    }
}

#ifdef PROBE_SEC_ATT
#define PS_B(id) do { if ((id) == PROBE_SEC_ATT && (OWN ? 1 : 0) == PROBE_OWN) { __builtin_amdgcn_sched_barrier(0); psec -= __builtin_amdgcn_s_memrealtime(); __builtin_amdgcn_sched_barrier(0); } } while (0)
#define PS_E(id) do { if ((id) == PROBE_SEC_ATT && (OWN ? 1 : 0) == PROBE_OWN) { __builtin_amdgcn_sched_barrier(0); psec += __builtin_amdgcn_s_memrealtime(); __builtin_amdgcn_sched_barrier(0); } } while (0)
#else
#define PS_B(id) do { } while (0)
#define PS_E(id) do { } while (0)
#endif
namespace moba {
constexpr int E_K0 = 0, E_V0 = 16384, E_K1 = 32768, E_V1 = 49152, E_TAB = 65536, E_WSCR = 73728, E_SCHED = 81920, E_STG = 86272;

constexpr float THR2 = 11.5f;
template <bool CAUSAL>
__device__ __forceinline__ void tile_step(const LAS unsigned char* Kb, int vb, const LAS float* tab2, LAS float* al_l, const bf16x8 (&qr)[8], int qpos_rel, int kt, bool near, int r32, int hi,
                                          f32x16 (&o)[4], float& m_reg, float& l_reg) {
    f32x16 p0, p1;
    qkt(p0, p1, Kb, qr, r32, hi);
    float sc = C2, cadd = tab2[1023];
    if (CAUSAL || near) {
        int dbase = qpos_rel - kt * 64 - 4 * hi; asm volatile("" : "+v"(dbase));
#pragma unroll
        for (int r = 0; r < 16; ++r) {
            const int d0_ = dbase - ((r & 3) + 8 * (r >> 2)), d1_ = d0_ - 32;
            float t0, t1;
            if (!CAUSAL) { t0 = fmaf(p0[r], C2, tab2[min(d0_, 1023)]); t1 = fmaf(p1[r], C2, tab2[min(d1_, 1023)]); }
            else { t0 = fmaf(p0[r], C2, tab2[max(d0_, 0)]); t1 = fmaf(p1[r], C2, tab2[max(d1_, 0)]); if (d0_ < 0) t0 = -1e30f; if (d1_ < 0) t1 = -1e30f; }
            p0[r] = t0; p1[r] = t1;
        }
        sc = 1.f; cadd = 0.f;
    }
    float pmax = p0[0];
#pragma unroll
    for (int r = 1; r < 16; ++r) pmax = fmaxf(pmax, p0[r]);
#pragma unroll
    for (int r = 0; r < 16; ++r) pmax = fmaxf(pmax, p1[r]);
    { auto rr = __builtin_amdgcn_permlane32_swap(__float_as_uint(pmax), __float_as_uint(pmax), false, false);
      pmax = fmaxf(__uint_as_float(rr[0]), __uint_as_float(rr[1])); }
    pmax = fmaf(pmax, sc, cadd);
    const bool raise = (pmax - m_reg) > THR2;
    const float mn = raise ? pmax : m_reg;
    const float alpha = raise ? __builtin_amdgcn_exp2f(m_reg - mn) : 1.f;
    m_reg = mn;
    if (__any(raise)) {
        if (hi == 0) al_l[r32] = alpha;
        asm volatile("s_waitcnt lgkmcnt(0)" ::: "memory");
#pragma unroll
        for (int r = 0; r < 16; ++r) { const float av = al_l[crow(r, hi)];
#pragma unroll
            for (int d = 0; d < 4; ++d) o[d][r] *= av; }
    }
    const float off = cadd - m_reg;
#pragma unroll
    for (int r = 0; r < 16; ++r) { p0[r] = __builtin_amdgcn_exp2f(fmaf(p0[r], sc, off)); p1[r] = __builtin_amdgcn_exp2f(fmaf(p1[r], sc, off)); }
    float ps = 0.f;
#pragma unroll
    for (int r = 0; r < 16; ++r) ps += p0[r];
#pragma unroll
    for (int r = 0; r < 16; ++r) ps += p1[r];
    { auto rr = __builtin_amdgcn_permlane32_swap(__float_as_uint(ps), __float_as_uint(ps), false, false);
      ps = __uint_as_float(rr[0]) + __uint_as_float(rr[1]); }
    l_reg = l_reg * alpha + ps;
    bf16x8 pa0, pa1, pa2, pa3;
#define PK4(P, BASE, OUT) do { unsigned a0 = cvtpk(P[BASE + 0], P[BASE + 1]), a1 = cvtpk(P[BASE + 2], P[BASE + 3]);   \
    unsigned b0 = cvtpk(P[BASE + 4], P[BASE + 5]), b1 = cvtpk(P[BASE + 6], P[BASE + 7]);                              \
    auto r0 = __builtin_amdgcn_permlane32_swap(a0, b0, false, false); auto r1 = __builtin_amdgcn_permlane32_swap(a1, b1, false, false); \
    u32x4 w = {r0[0], r1[0], r0[1], r1[1]}; OUT = *reinterpret_cast<bf16x8*>(&w); } while (0)
    PK4(p0, 0, pa0); PK4(p0, 8, pa1); PK4(p1, 0, pa2); PK4(p1, 8, pa3);
#undef PK4
    pv_one<0>(o[0], vb, pa0, pa1, pa2, pa3); pv_one<1>(o[1], vb, pa0, pa1, pa2, pa3); pv_one<2>(o[2], vb, pa0, pa1, pa2, pa3); pv_one<3>(o[3], vb, pa0, pa1, pa2, pa3);
}
}

template <bool OWN>
__device__ __forceinline__ void attn_engine(const Args& a, LAS unsigned char* lds, int tid, int lane, int wid, unsigned long long& psec) {
    using namespace moba;
    PS_B(4); PS_B(5);
    bf16* Q = (bf16*)(a.ws + WS_A2); const bf16* K = Q + (size_t)M * D; const bf16* V = K + (size_t)M * D;
    const unsigned* cnt = (const unsigned*)(a.ws + WS_CNT); const unsigned short* lists = (const unsigned short*)(a.ws + WS_LIST);
    const float* tab2g = (const float*)(a.ws + WS_TAB2); float* LSE = (float*)(a.ws + WS_LSE);
    const long po1off = (long)((const unsigned char*)a.out - a.ws);
    const int r32 = lane & 31, hi = lane >> 5, sr = tid >> 4, sc = (tid & 15) * 8;
    LAS int* P = (LAS int*)(lds + E_SCHED);
    int TR = 512;
    if (!OWN) {
        const int c0_ = ((int)cnt[2 * tid] + 255) >> 8, c1_ = ((int)cnt[2 * tid + 1] + 255) >> 8;
        int v = c0_ + c1_;
#pragma unroll
        for (int o_ = 1; o_ < 64; o_ <<= 1) { const int t_ = __shfl_up(v, o_); if (lane >= o_) v += t_; }
        LAS int* wt = (LAS int*)(lds + E_WSCR);
        if (lane == 63) wt[wid] = v;
        __syncthreads();
        int off = 0;
        for (int w = 0; w < wid; ++w) off += wt[w];
        P[2 * tid + 2] = off + v; P[2 * tid + 1] = off + v - c1_;
        if (tid == 0) P[0] = 0;
        __syncthreads();
        TR = P[1024];
    }
    const int R0 = (int)(((long)blockIdx.x * TR) / gridDim.x), R1 = (int)(((long)(blockIdx.x + 1) * TR) / gridDim.x);
    if (R0 >= R1) return;
#define AE_LOC(rd_, li_, r_) do { if (OWN) { li_ = (rd_); r_ = 0; } else { int a_ = 0, b_ = 1024; while (b_ - a_ > 1) { const int mid_ = (a_ + b_) >> 1; if (P[mid_] <= (rd_)) a_ = mid_; else b_ = mid_; } li_ = a_; r_ = (rd_) - P[a_]; } } while (0)
#define AE_TLOAD(Kt_, Vt_) do { ks0 = *(const bf16x8*)((Kt_) + (size_t)sr * D + sc); ks1 = *(const bf16x8*)((Kt_) + (size_t)(32 + sr) * D + sc);                 \
        vs0 = *(const bf16x8*)((Vt_) + (size_t)sr * D + sc); vs1 = *(const bf16x8*)((Vt_) + (size_t)(32 + sr) * D + sc); } while (0)
#define AE_TWRITE(bi_) do { *(LAS bf16x8*)(lds + ((bi_) ? E_K1 : E_K0) + KSWZ(sr, sc * 2)) = ks0; *(LAS bf16x8*)(lds + ((bi_) ? E_K1 : E_K0) + KSWZ(32 + sr, sc * 2)) = ks1;   \
        *(LAS bf16x8*)(lds + ((bi_) ? E_V1 : E_V0) + v_st(sr, sc)) = vs0; *(LAS bf16x8*)(lds + ((bi_) ? E_V1 : E_V0) + v_st(32 + sr, sc)) = vs1; } while (0)
    bf16x8 ks0, ks1, vs0, vs1;
    int li, rr; AE_LOC(R0, li, rr);
    int b = (OWN ? li : (li >> 1)) >> 8, h = ((OWN ? li : (li >> 1)) >> 5) & 7, n = (OWN ? li : (li >> 1)) & 31;
    int L = OWN ? 256 : (int)cnt[li];
    const bf16* Kt = K + (size_t)(b * T + n * 256) * D + h * 128; const bf16* Vt = V + (size_t)(b * T + n * 256) * D + h * 128;
    AE_TLOAD(Kt, Vt);
    int tabsel = 0;
    for (int e = tid; e < 1024; e += 512) ((LAS float*)(lds + E_TAB))[e] = tab2g[h * 1024 + e];
    int ent, qpos, slot; bool valid;
    {
        const int e = rr * 256 + wid * 32 + r32; valid = e < L;
        if (OWN) ent = n * 256 + wid * 32 + r32; else ent = lists[(size_t)(li >> 1) * 8192 + (li & 1) * 7168 + (valid ? e : (L - 1))];
    }
    bf16x8 qr[8];
    {
        const bf16* Qw = Q + (size_t)(b * T + (ent & 8191)) * D + h * 128 + hi * 8;
#pragma unroll
        for (int d0 = 0; d0 < 8; ++d0) qr[d0] = *(const bf16x8*)(Qw + d0 * 16);
    }
    AE_TWRITE(0);
    __syncthreads();
    int step = 0;
    PS_E(4);
    LAS float* al_l = (LAS float*)(lds + E_WSCR + wid * 1024);
    for (int rd = R0; rd < R1; ++rd) {
        const bool has_next = rd + 1 < R1;
        int nli = li, nrr = rr; if (has_next) AE_LOC(rd + 1, nli, nrr);
        const int nl2_ = OWN ? nli : (nli >> 1); const int nb_ = nl2_ >> 8, nh = (nl2_ >> 5) & 7, nn = nl2_ & 31;
        const int nL = OWN ? 256 : (has_next ? (int)cnt[nli] : L);
        const bf16* Ktn = K + (size_t)(nb_ * T + nn * 256) * D + nh * 128; const bf16* Vtn = V + (size_t)(nb_ * T + nn * 256) * D + nh * 128;
        qpos = ent & 8191; slot = ent >> 13;
        const int m = b * T + qpos, qrel = qpos - n * 256;
        const bool wave_on = OWN ? true : ((rr * 256 + wid * 32) < L);
        const bool near_ = !OWN && (li & 1);
        const LAS float* tab2 = (const LAS float*)(lds + E_TAB + tabsel * 4096);
        f32x16 o[4] = {}; float m_reg = -1e30f, l_reg = 0.f;
        float ls0 = -1e30f, ls1 = -1e30f, ls2 = -1e30f;
        const int nsel = n < 3 ? n : 3;
        int nent = ent; bool nvalid = valid;
#pragma unroll 1
        for (int kt = 0; kt < 4; ++kt) {
            const bool more = (kt < 3) || has_next;
            if (more) { if (kt < 3) AE_TLOAD(Kt + (size_t)(kt + 1) * 64 * D, Vt + (size_t)(kt + 1) * 64 * D); else AE_TLOAD(Ktn, Vtn); }
            const int bi = step & 1;
            PS_B(1);
            if (OWN && kt == 3) {
                if (nsel > 0) ls0 = LSE[((size_t)0 * M + m) * 8 + h];
                if (nsel > 1) ls1 = LSE[((size_t)1 * M + m) * 8 + h];
                if (nsel > 2) ls2 = LSE[((size_t)2 * M + m) * 8 + h];
            }
            if (wave_on && (!OWN || kt <= (wid >> 1))) {
                const LAS unsigned char* Kb_ = lds + (bi ? E_K1 : E_K0); const int vb_ = (int)(unsigned long)(lds + (bi ? E_V1 : E_V0)) + v_rd_base(lane);
                tile_step<OWN>(Kb_, vb_, tab2, al_l, qr, qrel, kt, near_, r32, hi, o, m_reg, l_reg);
            }
            PS_E(1); PS_B(2);
            if (has_next && kt == 1) {
                const int e = nrr * 256 + wid * 32 + r32; nvalid = e < nL;
                if (OWN) nent = nn * 256 + wid * 32 + r32; else nent = lists[(size_t)(nli >> 1) * 8192 + (nli & 1) * 7168 + (nvalid ? e : (nL - 1))];
            }
            if (!OWN && has_next && kt == 3) {
                const bf16* Qw = Q + (size_t)(nb_ * T + (nent & 8191)) * D + nh * 128 + hi * 8;
#pragma unroll
                for (int d0 = 0; d0 < 8; ++d0) qr[d0] = *(const bf16x8*)(Qw + d0 * 16);
            }
            if (more) AE_TWRITE(bi ^ 1);
            if (kt == 3 && has_next && nh != h) { for (int e = tid; e < 1024; e += 512) ((LAS float*)(lds + E_TAB + (tabsel ^ 1) * 4096))[e] = tab2g[nh * 1024 + e]; }
            __syncthreads();
            PS_E(2);
            ++step;
        }
        PS_B(3);
        if (wave_on) {
            LAS unsigned char* stg = lds + E_STG + wid * 8192;
            if (!OWN) {
                LAS float* li_l = (LAS float*)(lds + E_WSCR + wid * 1024 + 128);
                LAS int* row_l = (LAS int*)(lds + E_WSCR + wid * 1024 + 256);
                if (hi == 0) { li_l[r32] = __builtin_amdgcn_rcpf(l_reg); row_l[r32] = valid ? ((slot << 20) | m) : -1;
                    if (valid) LSE[((size_t)slot * M + m) * 8 + h] = m_reg + __builtin_amdgcn_logf(l_reg); }
                asm volatile("s_waitcnt lgkmcnt(0)" ::: "memory");
                float rl[16];
#pragma unroll
                for (int r = 0; r < 16; ++r) rl[r] = li_l[crow(r, hi)];
#pragma unroll
                for (int d0 = 0; d0 < 4; ++d0)
#pragma unroll
                    for (int r = 0; r < 16; ++r) *(LAS unsigned short*)(stg + crow(r, hi) * 256 + (d0 * 32 + r32) * 2) = (unsigned short)f2bf(o[d0][r] * rl[r]);
#pragma unroll
                for (int it = 0; it < 8; ++it) {
                    const int row = 4 * it + (lane >> 4);
                    const u32x4 v = *(const LAS u32x4*)(stg + row * 256 + (lane & 15) * 16);
                    const int rm = row_l[row];
                    if (rm >= 0) {
                        const int sl = rm >> 20, mm = rm & 0xfffff;
                        *(u32x4*)((bf16*)(a.ws + (sl == 0 ? (long)WS_PO0 : (sl == 1 ? po1off : (long)WS_PO2))) + (size_t)mm * D + h * 128 + (lane & 15) * 8) = v;
                    }
                }
            } else {
                const float lown = m_reg + __builtin_amdgcn_logf(l_reg);
                const float Mx = fmaxf(fmaxf(lown, ls0), fmaxf(ls1, ls2));
                const float e0 = __builtin_amdgcn_exp2f(ls0 - Mx), e1 = __builtin_amdgcn_exp2f(ls1 - Mx), e2 = __builtin_amdgcn_exp2f(ls2 - Mx), eo = __builtin_amdgcn_exp2f(lown - Mx);
                const float iz = __builtin_amdgcn_rcpf((eo + e0) + (e1 + e2));
                LAS float* cf = (LAS float*)(lds + E_WSCR + wid * 1024 + 128);
                if (hi == 0) { cf[r32] = eo * iz * __builtin_amdgcn_rcpf(l_reg); cf[32 + r32] = e0 * iz; cf[64 + r32] = e1 * iz; cf[96 + r32] = e2 * iz; }
                asm volatile("s_waitcnt lgkmcnt(0)" ::: "memory");
                const bf16* P0 = (const bf16*)(a.ws + WS_PO0); const bf16* P1 = (const bf16*)a.out; const bf16* P2 = (const bf16*)(a.ws + WS_PO2);
                float co[16];
#pragma unroll
                for (int r = 0; r < 16; ++r) co[r] = cf[crow(r, hi)];
#pragma unroll
                for (int d0 = 0; d0 < 4; ++d0)
#pragma unroll
                    for (int r = 0; r < 16; ++r) *(LAS unsigned short*)(stg + crow(r, hi) * 256 + (d0 * 32 + r32) * 2) = (unsigned short)f2bf(o[d0][r] * co[r]);
                asm volatile("" ::: "memory"); __builtin_amdgcn_sched_barrier(0);
                const size_t offb = (size_t)(b * T + n * 256 + wid * 32 + (lane >> 4)) * D + h * 128 + (lane & 15) * 8;
                u32x4 pv0[8], pv1[8], pv2[8];
#pragma unroll
                for (int it = 0; it < 8; ++it) {
                    const size_t off = offb + (size_t)it * 4 * D;
                    pv0[it] = *(const u32x4*)(P0 + off); pv1[it] = *(const u32x4*)(P1 + off); pv2[it] = *(const u32x4*)(P2 + off);
                }
                const u32x4 z4 = {0u, 0u, 0u, 0u};
#pragma unroll
                for (int it = 0; it < 8; ++it) {
                    const int row = 4 * it + (lane >> 4);
                    const u32x4 ov = *(const LAS u32x4*)(stg + row * 256 + (lane & 15) * 16);
                    float acc[8];
                    acc[0] = __uint_as_float(ov.x << 16); acc[1] = __uint_as_float(ov.x & 0xffff0000u); acc[2] = __uint_as_float(ov.y << 16); acc[3] = __uint_as_float(ov.y & 0xffff0000u);
                    acc[4] = __uint_as_float(ov.z << 16); acc[5] = __uint_as_float(ov.z & 0xffff0000u); acc[6] = __uint_as_float(ov.w << 16); acc[7] = __uint_as_float(ov.w & 0xffff0000u);
#define ADDP(PV, CI) do { const u32x4 pv = (PV); const float cc = cf[(CI) * 32 + row];                                                        \
    acc[0] = fmaf(cc, __uint_as_float(pv.x << 16), acc[0]); acc[1] = fmaf(cc, __uint_as_float(pv.x & 0xffff0000u), acc[1]);                     \
    acc[2] = fmaf(cc, __uint_as_float(pv.y << 16), acc[2]); acc[3] = fmaf(cc, __uint_as_float(pv.y & 0xffff0000u), acc[3]);                     \
    acc[4] = fmaf(cc, __uint_as_float(pv.z << 16), acc[4]); acc[5] = fmaf(cc, __uint_as_float(pv.z & 0xffff0000u), acc[5]);                     \
    acc[6] = fmaf(cc, __uint_as_float(pv.w << 16), acc[6]); acc[7] = fmaf(cc, __uint_as_float(pv.w & 0xffff0000u), acc[7]); } while (0)
                    ADDP(nsel > 0 ? pv0[it] : z4, 1);
                    ADDP(nsel > 1 ? pv1[it] : z4, 2);
                    ADDP(nsel > 2 ? pv2[it] : z4, 3);
#undef ADDP
                    *(u32x4*)(Q + offb + (size_t)it * 4 * D) = (u32x4){pk2(acc[0], acc[1]), pk2(acc[2], acc[3]), pk2(acc[4], acc[5]), pk2(acc[6], acc[7])};
                }
            }
        }
        PS_E(3);
        if (OWN && has_next) {
            const bf16* Qw = Q + (size_t)(nb_ * T + (nent & 8191)) * D + nh * 128 + hi * 8;
#pragma unroll
            for (int d0 = 0; d0 < 8; ++d0) qr[d0] = *(const bf16x8*)(Qw + d0 * 16);
        }
        if (nh != h) tabsel ^= 1;
        li = nli; rr = nrr; b = nb_; h = nh; n = nn; L = nL; Kt = Ktn; Vt = Vtn; ent = nent; valid = nvalid;
    }
    __syncthreads();
    PS_E(5);
#undef AE_LOC
#undef AE_TLOAD
#undef AE_TWRITE
}

namespace moba {
constexpr int R_V = 0, R_K = 65536, R_TAB = 131072, R_WSCR = 135168, R_STG = 141312, R_SEG = 157696;
}
template <bool OWN>
__device__ __forceinline__ void attn_resident(const Args& a, LAS unsigned char* lds, int tid, int lane, int wid) {
    using namespace moba;
    bf16* Q = (bf16*)(a.ws + WS_A2); const bf16* K = Q + (size_t)M * D; const bf16* V = K + (size_t)M * D;
    const unsigned* cnt = (const unsigned*)(a.ws + WS_CNT); const unsigned short* lists = (const unsigned short*)(a.ws + WS_LIST);
    const float* tab2g = (const float*)(a.ws + WS_TAB2); float* LSE = (float*)(a.ws + WS_LSE);
    const long po1off = (long)((const unsigned char*)a.out - a.ws);
    const int r32 = lane & 31, hi = lane >> 5;
    LAS int* SEG = (LAS int*)(lds + R_SEG);
    if (!OWN) {
        LAS int* P = (LAS int*)lds;
        const int n0_ = ((int)cnt[2 * tid] + 31) >> 5, n1_ = ((int)cnt[2 * tid + 1] + 31) >> 5;
        const int c0_ = n0_ ? 8 * ((n0_ + 7) >> 3) + 4 : 0, c1_ = n1_ ? 8 * ((n1_ + 7) >> 3) + 4 : 0;
        int v = c0_ + c1_;
#pragma unroll
        for (int o_ = 1; o_ < 64; o_ <<= 1) { const int t_ = __shfl_up(v, o_); if (lane >= o_) v += t_; }
        LAS int* wt = (LAS int*)(lds + R_WSCR);
        if (lane == 63) wt[wid] = v;
        __syncthreads();
        int off = 0;
        for (int w = 0; w < wid; ++w) off += wt[w];
        P[2 * tid + 2] = off + v; P[2 * tid + 1] = off + v - c1_;
        if (tid == 0) P[0] = 0;
        __syncthreads();
        if (tid == 0) {
            const int total = P[1024];
            const int lo = (int)(((long)blockIdx.x * total) / gridDim.x), hiE = (int)(((long)(blockIdx.x + 1) * total) / gridDim.x);
            int li; { int a_ = 0, b_ = 1024; while (b_ - a_ > 1) { const int mid = (a_ + b_) >> 1; if (P[mid] <= lo) a_ = mid; else b_ = mid; } li = a_; }
            int ns = 0;
            for (; li < 1024 && P[li] < hiE && ns < 60; ++li) {
                const int p0_ = P[li], p1_ = P[li + 1];
                if (p1_ <= lo || p1_ == p0_) continue;
                const int L = (int)cnt[li], nsub = (L + 31) >> 5, cst = p1_ - p0_;
                const int x0 = max(lo, p0_) - p0_, x1 = min(hiE, p1_) - p0_;
                const int slo = x0 <= 0 ? 0 : (x0 >= cst ? nsub : min(nsub, 8 * (max(x0 - 4, 0) >> 3)));
                const int shi = x1 <= 0 ? 0 : (x1 >= cst ? nsub : min(nsub, 8 * (max(x1 - 4, 0) >> 3)));
                if (slo >= shi) continue;
                SEG[1 + 4 * ns] = li; SEG[2 + 4 * ns] = slo; SEG[3 + 4 * ns] = shi; SEG[4 + 4 * ns] = L; ++ns;
            }
            SEG[0] = ns;
        }
        __syncthreads();
    } else {
        if (tid == 0) {
            int ns = 0;
            for (int u = blockIdx.x; u < 512; u += gridDim.x) { SEG[1 + 4 * ns] = u; SEG[2 + 4 * ns] = 0; SEG[3 + 4 * ns] = 8; SEG[4 + 4 * ns] = 256; ++ns; }
            SEG[0] = ns;
        }
        __syncthreads();
    }
    const int nseg = SEG[0];
    LAS float* al_l = (LAS float*)(lds + R_WSCR + wid * 768);
    LAS unsigned char* stg = lds + R_STG + wid * 2048;
    const int vb0 = (int)(unsigned long)(lds + R_V) + v_rd_base(lane);
    const LAS float* tab2 = (const LAS float*)(lds + R_TAB);
    for (int s = 0; s < nseg; ++s) {
        const int li = SEG[1 + 4 * s], slo = SEG[2 + 4 * s], shi = SEG[3 + 4 * s], L = SEG[4 + 4 * s];
        const int l2_ = OWN ? li : (li >> 1);
        const int b = l2_ >> 8, h = (l2_ >> 5) & 7, n = l2_ & 31;
        const bool near_ = !OWN && (li & 1);
        const unsigned short* lp = lists + (size_t)l2_ * 8192 + (near_ ? 7168 : 0);
        __syncthreads();
        {
            const bf16* Kh = K + (size_t)(b * T + n * 256) * D + h * 128; const bf16* Vh = V + (size_t)(b * T + n * 256) * D + h * 128;
            const int sr = tid >> 4, sc = (tid & 15) * 8;
#pragma unroll
            for (int kt = 0; kt < 4; ++kt) {
                const bf16x8 k0 = *(const bf16x8*)(Kh + (size_t)(kt * 64 + sr) * D + sc), k1 = *(const bf16x8*)(Kh + (size_t)(kt * 64 + 32 + sr) * D + sc);
                const bf16x8 v0 = *(const bf16x8*)(Vh + (size_t)(kt * 64 + sr) * D + sc), v1 = *(const bf16x8*)(Vh + (size_t)(kt * 64 + 32 + sr) * D + sc);
                *(LAS bf16x8*)(lds + R_K + kt * 16384 + KSWZ(sr, sc * 2)) = k0;
                *(LAS bf16x8*)(lds + R_K + kt * 16384 + KSWZ(32 + sr, sc * 2)) = k1;
                *(LAS bf16x8*)(lds + R_V + kt * 16384 + v_st(sr, sc)) = v0;
                *(LAS bf16x8*)(lds + R_V + kt * 16384 + v_st(32 + sr, sc)) = v1;
                if (kt == 1) asm volatile("" ::: "memory");
            }
            for (int e = tid; e < 1024; e += 512) ((LAS float*)(lds + R_TAB))[e] = tab2g[h * 1024 + e];
        }
        __syncthreads();
        int st = slo + wid;
        if (st >= shi) continue;
        int ent; bool valid;
        { const int e = st * 32 + r32; valid = e < L; ent = OWN ? (n * 256 + e) : (int)lp[valid ? e : (L - 1)]; }
        bf16x8 qr[8];
        { const bf16* Qw = Q + (size_t)(b * T + (ent & 8191)) * D + h * 128 + hi * 8;
#pragma unroll
          for (int d0 = 0; d0 < 8; ++d0) qr[d0] = *(const bf16x8*)(Qw + d0 * 16); }
        for (; st < shi; st += 8) {
            const int qpos = ent & 8191, slot = ent >> 13, m = b * T + qpos, qrel = qpos - n * 256;
            const bool has_next = !OWN && (st + 8 < shi);
            int nent = ent; bool nvalid = valid;
            if (has_next) { const int e = (st + 8) * 32 + r32; nvalid = e < L; nent = (int)lp[nvalid ? e : (L - 1)]; }
            f32x16 o[4] = {}; float m_reg = -1e30f, l_reg = 0.f;
            const int ntile = OWN ? ((wid >> 1) + 1) : 4;
            for (int kt = 0; kt < ntile; ++kt)
                tile_step<OWN>(lds + R_K + kt * 16384, vb0 + kt * 16384, tab2, al_l, qr, qrel, kt, near_, r32, hi, o, m_reg, l_reg);
            if (has_next) {
                const bf16* Qw = Q + (size_t)(b * T + (nent & 8191)) * D + h * 128 + hi * 8;
#pragma unroll
                for (int d0 = 0; d0 < 8; ++d0) qr[d0] = *(const bf16x8*)(Qw + d0 * 16);
            }
            if (!OWN) {
                LAS float* li_l = (LAS float*)(lds + R_WSCR + wid * 768 + 128);
                LAS int* row_l = (LAS int*)(lds + R_WSCR + wid * 768 + 256);
                if (hi == 0) { li_l[r32] = __builtin_amdgcn_rcpf(l_reg); row_l[r32] = valid ? ((slot << 20) | m) : -1;
                    if (valid) LSE[((size_t)slot * M + m) * 8 + h] = m_reg + __builtin_amdgcn_logf(l_reg); }
                asm volatile("s_waitcnt lgkmcnt(0)" ::: "memory");
                float rl[16];
#pragma unroll
                for (int r = 0; r < 16; ++r) rl[r] = li_l[crow(r, hi)];
#pragma unroll
                for (int d0 = 0; d0 < 4; ++d0) {
#pragma unroll
                    for (int r = 0; r < 16; ++r) *(LAS unsigned short*)(stg + crow(r, hi) * 64 + r32 * 2) = (unsigned short)f2bf(o[d0][r] * rl[r]);
#pragma unroll
                    for (int t2 = 0; t2 < 2; ++t2) {
                        const int id = t2 * 64 + lane, row = id >> 2, ch = id & 3;
                        const u32x4 v = *(const LAS u32x4*)(stg + row * 64 + ch * 16);
                        const int rm = row_l[row];
                        if (rm >= 0) {
                            const int sl = rm >> 20, mm = rm & 0xfffff;
                            *(u32x4*)((bf16*)(a.ws + (sl == 0 ? (long)WS_PO0 : (sl == 1 ? po1off : (long)WS_PO2))) + (size_t)mm * D + h * 128 + d0 * 32 + ch * 8) = v;
                        }
                    }
                }
            } else {
                const int nsel = n < 3 ? n : 3;
                float ls0 = -1e30f, ls1 = -1e30f, ls2 = -1e30f;
                if (nsel > 0) ls0 = LSE[((size_t)0 * M + m) * 8 + h];
                if (nsel > 1) ls1 = LSE[((size_t)1 * M + m) * 8 + h];
                if (nsel > 2) ls2 = LSE[((size_t)2 * M + m) * 8 + h];
                const bf16* P0 = (const bf16*)(a.ws + WS_PO0); const bf16* P1 = (const bf16*)a.out; const bf16* P2 = (const bf16*)(a.ws + WS_PO2);
                const size_t offb = (size_t)(b * T + n * 256 + wid * 32 + (lane >> 2)) * D + h * 128 + (lane & 3) * 8;
                const float lown = m_reg + __builtin_amdgcn_logf(l_reg);
                const float Mx = fmaxf(fmaxf(lown, ls0), fmaxf(ls1, ls2));
                const float e0 = __builtin_amdgcn_exp2f(ls0 - Mx), e1 = __builtin_amdgcn_exp2f(ls1 - Mx), e2 = __builtin_amdgcn_exp2f(ls2 - Mx), eo = __builtin_amdgcn_exp2f(lown - Mx);
                const float iz = __builtin_amdgcn_rcpf((eo + e0) + (e1 + e2));
                LAS float* cf = (LAS float*)(lds + R_WSCR + wid * 768 + 128);
                if (hi == 0) { cf[r32] = eo * iz * __builtin_amdgcn_rcpf(l_reg); cf[32 + r32] = e0 * iz; cf[64 + r32] = e1 * iz; cf[96 + r32] = e2 * iz; }
                asm volatile("s_waitcnt lgkmcnt(0)" ::: "memory");
                const u32x4 z4 = {0u, 0u, 0u, 0u};
#pragma unroll
                for (int dh = 0; dh < 2; ++dh) {
                    u32x4 pv0[4], pv1[4], pv2[4];
#pragma unroll
                    for (int it = 0; it < 4; ++it) { const size_t off = offb + (size_t)(it & 1) * 16 * D + (dh * 2 + (it >> 1)) * 32;
                        pv0[it] = *(const u32x4*)(P0 + off); pv1[it] = *(const u32x4*)(P1 + off); pv2[it] = *(const u32x4*)(P2 + off); }
#pragma unroll
                    for (int dl = 0; dl < 2; ++dl) {
                        const int d0 = dh * 2 + dl;
#pragma unroll
                        for (int r = 0; r < 16; ++r) *(LAS unsigned short*)(stg + crow(r, hi) * 64 + r32 * 2) = (unsigned short)f2bf(o[d0][r] * cf[crow(r, hi)]);
#pragma unroll
                        for (int t2 = 0; t2 < 2; ++t2) {
                            const int id = t2 * 64 + lane, row = id >> 2, ch = id & 3, it = dl * 2 + t2;
                            const u32x4 ov = *(const LAS u32x4*)(stg + row * 64 + ch * 16);
                            float acc[8];
                            acc[0] = __uint_as_float(ov.x << 16); acc[1] = __uint_as_float(ov.x & 0xffff0000u); acc[2] = __uint_as_float(ov.y << 16); acc[3] = __uint_as_float(ov.y & 0xffff0000u);
                            acc[4] = __uint_as_float(ov.z << 16); acc[5] = __uint_as_float(ov.z & 0xffff0000u); acc[6] = __uint_as_float(ov.w << 16); acc[7] = __uint_as_float(ov.w & 0xffff0000u);
#define ADDP(PV, CI) do { const u32x4 pv = (PV); const float cc = cf[(CI) * 32 + row];                                                        \
    acc[0] = fmaf(cc, __uint_as_float(pv.x << 16), acc[0]); acc[1] = fmaf(cc, __uint_as_float(pv.x & 0xffff0000u), acc[1]);                     \
    acc[2] = fmaf(cc, __uint_as_float(pv.y << 16), acc[2]); acc[3] = fmaf(cc, __uint_as_float(pv.y & 0xffff0000u), acc[3]);                     \
    acc[4] = fmaf(cc, __uint_as_float(pv.z << 16), acc[4]); acc[5] = fmaf(cc, __uint_as_float(pv.z & 0xffff0000u), acc[5]);                     \
    acc[6] = fmaf(cc, __uint_as_float(pv.w << 16), acc[6]); acc[7] = fmaf(cc, __uint_as_float(pv.w & 0xffff0000u), acc[7]); } while (0)
                            ADDP(nsel > 0 ? pv0[it] : z4, 1);
                            ADDP(nsel > 1 ? pv1[it] : z4, 2);
                            ADDP(nsel > 2 ? pv2[it] : z4, 3);
#undef ADDP
                            (void)ch;
                            *(u32x4*)(Q + offb + (size_t)t2 * 16 * D + d0 * 32) = (u32x4){pk2(acc[0], acc[1]), pk2(acc[2], acc[3]), pk2(acc[4], acc[5]), pk2(acc[6], acc[7])};
                        }
                    }
                }
            }
            ent = nent; valid = nvalid;
        }
    }
    __syncthreads();
}

#ifndef PROBE_BLK
#define PROBE_BLK 0
#endif
#ifdef PROBE_HG
#define HS_B(id) do { if ((id) == PROBE_HG && PASS_B == (PROBE_HG_B != 0)) { __builtin_amdgcn_sched_barrier(0); psec -= __builtin_amdgcn_s_memrealtime(); __builtin_amdgcn_sched_barrier(0); } } while (0)
#define HS_E(id) do { if ((id) == PROBE_HG && PASS_B == (PROBE_HG_B != 0)) { __builtin_amdgcn_sched_barrier(0); psec += __builtin_amdgcn_s_memrealtime(); __builtin_amdgcn_sched_barrier(0); } } while (0)
#else
#define HS_B(id) do { } while (0)
#define HS_E(id) do { } while (0)
#endif
namespace hg {
using namespace moba;
#ifndef HG_NEW_SIMG
#define HG_NEW_SIMG 1
#endif
constexpr int H_TQ = 0, H_TK = 16384, H_TKT = 32768, H_TI = 49152, H_SIMG = 65536, H_OST = 98304, H_EL = 132096;
constexpr int OST_LD = 132;
typedef float f32x2_t __attribute__((ext_vector_type(2))); typedef __bf16 bf16x2_t __attribute__((ext_vector_type(2)));
__device__ __forceinline__ unsigned cvtpk_s(float lo, float hi) { f32x2_t v = {lo, hi}; bf16x2_t b = __builtin_convertvector(v, bf16x2_t); return __builtin_bit_cast(unsigned, b); }
__device__ __forceinline__ int v_st64(int k, int c) { const int kk = (k & ~0xC) | ((k & 4) << 1) | ((k & 8) >> 1); return ((kk >> 3) * 2 + (c >> 5)) * 512 + ((kk & 7) * 32 + (c & 31)) * 2; }
constexpr int v_rd_off64(int tile, int cb, int ks, int half) { return tile * 8192 + cb * 512 + ks * 2048 + half * 1024; }
__device__ __forceinline__ void simg_store(LAS unsigned char* lds, int img_off, const f32x16& S, int nb, int d, int hi) {
#pragma unroll
    for (int q4 = 0; q4 < 4; ++q4) { const int n = 32 * nb + 8 * q4 + 4 * hi;
        typedef unsigned u32x2_ __attribute__((ext_vector_type(2)));
        *(LAS u32x2_*)(lds + img_off + KSWZ(d, 2 * n)) = (u32x2_){cvtpk_s(S[4 * q4 + 0], S[4 * q4 + 1]), cvtpk_s(S[4 * q4 + 2], S[4 * q4 + 3])}; }
}
__device__ __forceinline__ int kt_off(int n, int s) { return n * 128 + ((((s >> 3) ^ ((n >> 1) & 7))) << 4) + (s & 7) * 2; }

template <bool PASS_B>
__device__ __forceinline__ void hgrn_unit(const Args& a, LAS unsigned char* lds, int u, int tid, int lane, int wid, unsigned long long& psec) {
    unsigned char* ws = a.ws;
    const bf16* QS = (const bf16*)(ws + WS_A1); const float* LF = (const float*)(ws + WS_A2); const bf16* INP = (const bf16*)(ws + WS_A3); const bf16* OG = (const bf16*)(ws + WS_A4);
    bf16* OGATED = (bf16*)(ws + WS_A0); float* SSQH = (float*)(ws + WS_SSQH);
    float* TG = a.out;
    float* DG = a.out + (size_t)256 * 128 * 128;
    const int bh = u >> 4, g = u & 15, b = bh >> 3, h = bh & 7;
    const int r32 = lane & 31, hi = lane >> 5, tb = wid >> 2, db = wid & 3;
    const int nl = lane & 15, tq = lane >> 4, npre = 16 * wid + nl;
    f32x16 Sacc[2] = {};
    float dg = 1.f;
#if HG_NEW_SIMG
#define HG_SIMG_WRITE() do { simg_store(lds, H_SIMG, Sacc[0], 2 * tb, 32 * db + r32, hi); simg_store(lds, H_SIMG, Sacc[1], 2 * tb + 1, 32 * db + r32, hi); } while (0)
#else
#define HG_SIMG_WRITE() do { _Pragma("unroll") for (int i = 0; i < 2; ++i) { const int nb = 2 * tb + i; _Pragma("unroll") for (int r = 0; r < 16; ++r) { const int n = 32 * nb + crow(r, hi); \
        *(LAS unsigned short*)(lds + H_SIMG + (nb >> 1) * 16384 + v_st(n & 63, 32 * db + r32)) = (unsigned short)f2bf(Sacc[i][r]); } } } while (0)
#endif
    if (PASS_B) {
        HS_B(1);
        {
            LAS float* dl = (LAS float*)(lds + H_OST);
            for (int e = tid; e < g * 128; e += NWAVES * 64) dl[e] = DG[(size_t)(bh * 16) * 128 + e];
            __syncthreads();
            for (int gp0 = 0; gp0 < g; gp0 += 4) {
                int lo_ = (wid * 8 * 64 + lane) * 4; asm volatile("" : "+v"(lo_));
                const float* tg = TG + (size_t)(bh * 16 + gp0) * 16384 + lo_;
                f32x4 tv[4][8];
#pragma unroll
                for (int k = 0; k < 4; ++k) if (gp0 + k < g) {
#pragma unroll
                    for (int j = 0; j < 8; ++j) tv[k][j] = *(const f32x4*)(tg + (size_t)k * 16384 + j * 256);
                }
#pragma unroll
                for (int k = 0; k < 4; ++k) if (gp0 + k < g) {
#pragma unroll
                    for (int i = 0; i < 2; ++i)
#pragma unroll
                        for (int r = 0; r < 16; ++r) Sacc[i][r] = fmaf(Sacc[i][r], dl[(gp0 + k) * 128 + 32 * (2 * tb + i) + crow(r, hi)], tv[k][i * 4 + (r >> 2)][r & 3]);
                }
            }
            __syncthreads();
        }
        HG_SIMG_WRITE();
        HS_E(1);
    }
    float lfn[16]; unsigned short qn[16]; bf16x8 in0, in1; u32x4 gn0, gn1;
    const int sr = tid >> 4, sc = (tid & 15) * 8;
    const int pt = tid >> 3, pseg = tid & 7;
#define HG_LOAD(cc) do { const size_t m0_ = (size_t)b * T + g * 512 + (cc) * 64; const size_t off0_ = (m0_ + 16 * tq) * D + h * 128 + npre;                       \
        _Pragma("unroll") for (int i = 0; i < 16; ++i) { lfn[i] = LF[off0_ + (size_t)i * D]; if (PASS_B) qn[i] = QS[off0_ + (size_t)i * D]; }                      \
        in0 = *(const bf16x8*)(INP + (m0_ + sr) * D + h * 128 + sc); in1 = *(const bf16x8*)(INP + (m0_ + 32 + sr) * D + h * 128 + sc);                          \
        if (PASS_B) { const size_t go_ = (m0_ + pt) * D + h * 128 + 16 * pseg; gn0 = *(const u32x4*)(OG + go_); gn1 = *(const u32x4*)(OG + go_ + 8); } } while (0)
    HG_LOAD(0);
    for (int c = 0; c < 8; ++c) {
        const size_t m0 = (size_t)b * T + g * 512 + c * 64;
        u32x4 g0 = {}, g1 = {};
        HS_B(2);
        {
            float lf[16], qv[16];
#pragma unroll
            for (int i = 0; i < 16; ++i) { lf[i] = lfn[i]; if (PASS_B) qv[i] = bf2f(qn[i]); }
            if (PASS_B) { g0 = gn0; g1 = gn1; }
            float cs[16]; float run = 0.f;
#pragma unroll
            for (int i = 0; i < 16; ++i) { run += lf[i]; cs[i] = run; }
            const float s0 = __shfl(run, nl), s1 = __shfl(run, nl + 16), s2 = __shfl(run, nl + 32), s3 = __shfl(run, nl + 48);
            const float pre = (tq > 0 ? s0 : 0.f) + (tq > 1 ? s1 : 0.f) + (tq > 2 ? s2 : 0.f);
            const float last = (s0 + s1) + (s2 + s3);
            unsigned kh[8], qw[8], kw[8];
#pragma unroll
            for (int i = 0; i < 16; i += 2) {
                float khv[2], qtv[2], ktv[2];
#pragma unroll
                for (int e = 0; e < 2; ++e) {
                    const float cum = pre + cs[i + e];
                    const float kk = 1.f - __expf(lf[i + e]);
                    khv[e] = kk * __expf(last - cum);
                    if (PASS_B) { qtv[e] = qv[i + e] * __expf(cum); ktv[e] = kk * __expf(-cum); }
                }
                kh[i >> 1] = cvtpk(khv[0], khv[1]);
                if (PASS_B) { qw[i >> 1] = cvtpk(qtv[0], qtv[1]); kw[i >> 1] = cvtpk(ktv[0], ktv[1]); }
            }
            if (PASS_B) {
                const int io = (npre >> 6) * 8192 + v_st64(npre & 63, 16 * tq);
                *(LAS u32x4*)(lds + H_TQ + io) = (u32x4){qw[0], qw[1], qw[2], qw[3]}; *(LAS u32x4*)(lds + H_TQ + io + 16) = (u32x4){qw[4], qw[5], qw[6], qw[7]};
                *(LAS u32x4*)(lds + H_TK + io) = (u32x4){kw[0], kw[1], kw[2], kw[3]}; *(LAS u32x4*)(lds + H_TK + io + 16) = (u32x4){kw[4], kw[5], kw[6], kw[7]};
            }
            *(LAS u32x4*)(lds + H_TKT + kt_off(npre, 16 * tq)) = (u32x4){kh[0], kh[1], kh[2], kh[3]};
            *(LAS u32x4*)(lds + H_TKT + kt_off(npre, 16 * tq + 8)) = (u32x4){kh[4], kh[5], kh[6], kh[7]};
            const float el = __expf(last);
            if (tq == 0) *(LAS float*)(lds + H_EL + npre * 4) = el;
            dg *= el;
            *(LAS bf16x8*)(lds + H_TI + v_st(sr, sc)) = in0;
            *(LAS bf16x8*)(lds + H_TI + v_st(32 + sr, sc)) = in1;
        }
        __syncthreads();
        HS_E(2); HS_B(3);
        {
#define PK(L, Hh) (bf16x8){L[0], L[1], L[2], L[3], Hh[0], Hh[1], Hh[2], Hh[3]}
            bf16x8 pa0, pa1, pa2, pa3; bf16x8 qr[8];
            if (PASS_B) {
                const int t = 32 * tb + r32;
                const int vbQ = (int)(unsigned long)(lds + H_TQ) + v_rd_base(lane) + tb * 512, vbK = (int)(unsigned long)(lds + H_TK) + v_rd_base(lane);
                {
                    s16x4 ql[8], qh[8];
#define HG_QRD(d0_) ql[d0_] = tr_read<v_rd_off64((d0_) >> 2, 0, (d0_) & 3, 0)>(vbQ); qh[d0_] = tr_read<v_rd_off64((d0_) >> 2, 0, (d0_) & 3, 1)>(vbQ);
                    HG_QRD(0) HG_QRD(1) HG_QRD(2) HG_QRD(3) HG_QRD(4) HG_QRD(5) HG_QRD(6) HG_QRD(7)
#undef HG_QRD
                    asm volatile("s_waitcnt lgkmcnt(0)" ::: "memory"); SBAR();
#pragma unroll
                    for (int d0 = 0; d0 < 8; ++d0) qr[d0] = PK(ql[d0], qh[d0]);
                }
                f32x16 p0 = {}, p1 = {};
                s16x4 ka[8], kb[8];
#define HG_KRD(dst_, da_, db2_) do { \
                    dst_[0] = tr_read<v_rd_off64((da_) >> 2, 0, (da_) & 3, 0)>(vbK); dst_[1] = tr_read<v_rd_off64((da_) >> 2, 0, (da_) & 3, 1)>(vbK);     \
                    dst_[2] = tr_read<v_rd_off64((da_) >> 2, 1, (da_) & 3, 0)>(vbK); dst_[3] = tr_read<v_rd_off64((da_) >> 2, 1, (da_) & 3, 1)>(vbK);     \
                    dst_[4] = tr_read<v_rd_off64((db2_) >> 2, 0, (db2_) & 3, 0)>(vbK); dst_[5] = tr_read<v_rd_off64((db2_) >> 2, 0, (db2_) & 3, 1)>(vbK); \
                    dst_[6] = tr_read<v_rd_off64((db2_) >> 2, 1, (db2_) & 3, 0)>(vbK); dst_[7] = tr_read<v_rd_off64((db2_) >> 2, 1, (db2_) & 3, 1)>(vbK); } while (0)
#define HG_KMM(src_, da_, db2_) do { \
                    p0 = __builtin_amdgcn_mfma_f32_32x32x16_bf16(PK(src_[0], src_[1]), qr[da_], p0, 0, 0, 0); p1 = __builtin_amdgcn_mfma_f32_32x32x16_bf16(PK(src_[2], src_[3]), qr[da_], p1, 0, 0, 0);     \
                    p0 = __builtin_amdgcn_mfma_f32_32x32x16_bf16(PK(src_[4], src_[5]), qr[db2_], p0, 0, 0, 0); p1 = __builtin_amdgcn_mfma_f32_32x32x16_bf16(PK(src_[6], src_[7]), qr[db2_], p1, 0, 0, 0); } while (0)
                HG_KRD(ka, 0, 1); HG_KRD(kb, 2, 3);
                asm volatile("s_waitcnt lgkmcnt(8)" ::: "memory"); SBAR(); HG_KMM(ka, 0, 1); SBAR();
                HG_KRD(ka, 4, 5);
                asm volatile("s_waitcnt lgkmcnt(8)" ::: "memory"); SBAR(); HG_KMM(kb, 2, 3); SBAR();
                HG_KRD(kb, 6, 7);
                asm volatile("s_waitcnt lgkmcnt(8)" ::: "memory"); SBAR(); HG_KMM(ka, 4, 5); SBAR();
                asm volatile("s_waitcnt lgkmcnt(0)" ::: "memory"); SBAR(); HG_KMM(kb, 6, 7);
#undef HG_KRD
#undef HG_KMM
#pragma unroll
                for (int r = 0; r < 16; ++r) { const int s0_ = crow(r, hi); if (s0_ > t) p0[r] = 0.f; if (s0_ + 32 > t) p1[r] = 0.f; }
#define PK4(P, BASE, OUT) do { unsigned a0 = cvtpk(P[BASE + 0], P[BASE + 1]), a1 = cvtpk(P[BASE + 2], P[BASE + 3]);   \
    unsigned b0 = cvtpk(P[BASE + 4], P[BASE + 5]), b1 = cvtpk(P[BASE + 6], P[BASE + 7]);                              \
    auto r0 = __builtin_amdgcn_permlane32_swap(a0, b0, false, false); auto r1 = __builtin_amdgcn_permlane32_swap(a1, b1, false, false); \
    u32x4 w = {r0[0], r1[0], r0[1], r1[1]}; OUT = *reinterpret_cast<bf16x8*>(&w); } while (0)
                PK4(p0, 0, pa0); PK4(p0, 8, pa1); PK4(p1, 0, pa2); PK4(p1, 8, pa3);
#undef PK4
            }
            if (c < 7) HG_LOAD(c + 1);
            const int vbI = (int)(unsigned long)(lds + H_TI) + v_rd_base(lane) + db * 512;
            bf16x8 bI[4];
            {
                const s16x4 l0 = tr_read<v_rd_off(0, 0, 0)>(vbI), h0 = tr_read<v_rd_off(0, 0, 1)>(vbI), l1 = tr_read<v_rd_off(0, 1, 0)>(vbI), h1 = tr_read<v_rd_off(0, 1, 1)>(vbI);
                const s16x4 l2 = tr_read<v_rd_off(0, 2, 0)>(vbI), h2 = tr_read<v_rd_off(0, 2, 1)>(vbI), l3 = tr_read<v_rd_off(0, 3, 0)>(vbI), h3 = tr_read<v_rd_off(0, 3, 1)>(vbI);
                asm volatile("s_waitcnt lgkmcnt(0)" ::: "memory"); SBAR();
                bI[0] = PK(l0, h0); bI[1] = PK(l1, h1); bI[2] = PK(l2, h2); bI[3] = PK(l3, h3);
            }
            if (PASS_B) {
                f32x16 od = {};
                od = __builtin_amdgcn_mfma_f32_32x32x16_bf16(pa0, bI[0], od, 0, 0, 0);
                od = __builtin_amdgcn_mfma_f32_32x32x16_bf16(pa1, bI[1], od, 0, 0, 0);
                od = __builtin_amdgcn_mfma_f32_32x32x16_bf16(pa2, bI[2], od, 0, 0, 0);
                od = __builtin_amdgcn_mfma_f32_32x32x16_bf16(pa3, bI[3], od, 0, 0, 0);
#if HG_NEW_SIMG
#pragma unroll
                for (int ks = 0; ks < 8; ++ks) {
                    const bf16x8 bs = *(const LAS bf16x8*)(lds + H_SIMG + KSWZ(32 * db + r32, (16 * ks + 8 * hi) * 2));
                    od = __builtin_amdgcn_mfma_f32_32x32x16_bf16(qr[ks], bs, od, 0, 0, 0);
                }
#else
#pragma unroll
                for (int hf = 0; hf < 2; ++hf) {
                    const int vbS = (int)(unsigned long)(lds + H_SIMG) + hf * 16384 + v_rd_base(lane) + db * 512;
                    const s16x4 l0 = tr_read<v_rd_off(0, 0, 0)>(vbS), h0 = tr_read<v_rd_off(0, 0, 1)>(vbS), l1 = tr_read<v_rd_off(0, 1, 0)>(vbS), h1 = tr_read<v_rd_off(0, 1, 1)>(vbS);
                    const s16x4 l2 = tr_read<v_rd_off(0, 2, 0)>(vbS), h2 = tr_read<v_rd_off(0, 2, 1)>(vbS), l3 = tr_read<v_rd_off(0, 3, 0)>(vbS), h3 = tr_read<v_rd_off(0, 3, 1)>(vbS);
                    asm volatile("s_waitcnt lgkmcnt(0)" ::: "memory"); SBAR();
                    od = __builtin_amdgcn_mfma_f32_32x32x16_bf16(qr[hf * 4 + 0], PK(l0, h0), od, 0, 0, 0);
                    od = __builtin_amdgcn_mfma_f32_32x32x16_bf16(qr[hf * 4 + 1], PK(l1, h1), od, 0, 0, 0);
                    od = __builtin_amdgcn_mfma_f32_32x32x16_bf16(qr[hf * 4 + 2], PK(l2, h2), od, 0, 0, 0);
                    od = __builtin_amdgcn_mfma_f32_32x32x16_bf16(qr[hf * 4 + 3], PK(l3, h3), od, 0, 0, 0);
                }
#endif
#undef PK
                LAS float* ost = (LAS float*)(lds + H_OST);
#pragma unroll
                for (int r = 0; r < 16; ++r) ost[(32 * tb + crow(r, hi)) * OST_LD + 32 * db + r32] = od[r];
            }
            const LAS float* el = (const LAS float*)(lds + H_EL);
#pragma unroll
            for (int i = 0; i < 2; ++i) { const int nb = 2 * tb + i;
#pragma unroll
                for (int r = 0; r < 16; ++r) Sacc[i][r] *= el[32 * nb + crow(r, hi)];
#pragma unroll
                for (int ks = 0; ks < 4; ++ks) {
                    const bf16x8 af = *(const LAS bf16x8*)(lds + H_TKT + kt_off(32 * nb + r32, 16 * ks + 8 * hi));
                    Sacc[i] = __builtin_amdgcn_mfma_f32_32x32x16_bf16(af, bI[ks], Sacc[i], 0, 0, 0);
                } }
        }
        HS_E(3); HS_B(4);
        __syncthreads();
        if (PASS_B) {
            HG_SIMG_WRITE();
            const int t = pt, seg = pseg; const size_t go = (m0 + t) * D + h * 128 + 16 * seg;
            const LAS float* orow = (const LAS float*)(lds + H_OST) + t * OST_LD + 16 * seg;
            const unsigned gw[8] = {g0.x, g0.y, g0.z, g0.w, g1.x, g1.y, g1.z, g1.w};
            float ssq = 0.f; unsigned ow[8];
#pragma unroll
            for (int e = 0; e < 8; ++e) { const float o0 = orow[2 * e], o1 = orow[2 * e + 1]; ssq = fmaf(o0, o0, ssq); ssq = fmaf(o1, o1, ssq);
                ow[e] = pk2(o0 * __uint_as_float(gw[e] << 16), o1 * __uint_as_float(gw[e] & 0xffff0000u)); }
            *(u32x4*)(OGATED + go) = (u32x4){ow[0], ow[1], ow[2], ow[3]}; *(u32x4*)(OGATED + go + 8) = (u32x4){ow[4], ow[5], ow[6], ow[7]};
            ssq += __shfl_xor(ssq, 1); ssq += __shfl_xor(ssq, 2); ssq += __shfl_xor(ssq, 4);
            if (seg == 0) SSQH[(m0 + t) * 8 + h] = ssq;
        }
        HS_E(4);
    }
    if (!PASS_B) {
        int lo_ = (wid * 8 * 64 + lane) * 4; asm volatile("" : "+v"(lo_));
        float* tg = TG + (size_t)u * 16384 + lo_;
#pragma unroll
        for (int i = 0; i < 2; ++i)
#pragma unroll
            for (int q4 = 0; q4 < 4; ++q4) *(f32x4*)(tg + (i * 4 + q4) * 256) = (f32x4){Sacc[i][4 * q4], Sacc[i][4 * q4 + 1], Sacc[i][4 * q4 + 2], Sacc[i][4 * q4 + 3]};
        if (tq == 0) DG[(size_t)u * 128 + npre] = dg;
    }
    __syncthreads();
#undef HG_LOAD
#undef HG_SIMG_WRITE
}
}

#define XB_TMO      128
#define XB_XCNT(j)  (256  + 64 * (j))
#define XB_XSUB(j)  (1280 + 64 * (j))
#define XB_XGEN(j)  (2304 + 64 * (j))
#define XB_TOP      3328
#define XB_TOPGEN   3392
#define XCD_BAR_WORDS 3456
#define XB_SPIN_CAP (1u << 18)

__device__ __forceinline__ unsigned xb_ld(unsigned* p)              { return __hip_atomic_load(p, __ATOMIC_RELAXED, __HIP_MEMORY_SCOPE_AGENT); }
__device__ __forceinline__ unsigned xb_add(unsigned* p, unsigned v) { return __hip_atomic_fetch_add(p, v, __ATOMIC_RELAXED, __HIP_MEMORY_SCOPE_AGENT); }
__device__ __forceinline__ unsigned xb_xcc_id() { return (unsigned)__builtin_amdgcn_s_getreg((3 << 11) | 20) & 0xFu; }
#define XB_SPIN(cond, bar) do { unsigned _sp = 0; while (cond) { __builtin_amdgcn_s_sleep(1); \
    if ((++_sp & 255u) == 0u) { if (xb_ld(&(bar)[XB_TMO])) break; if (_sp > XB_SPIN_CAP) { atomicAdd(&(bar)[XB_TMO], 1u); break; } } } } while (0)

struct XcdBarrier {
    unsigned* bar; unsigned x;
    volatile LAS unsigned* st;
};

__device__ __forceinline__ XcdBarrier xcd_barrier_post(unsigned* bar, volatile LAS unsigned* st) {
    XcdBarrier b; b.bar = bar; b.x = xb_xcc_id(); b.st = st;
    if (threadIdx.x == 0) (void)xb_add(&bar[XB_XCNT(b.x)], 1u);
    return b;
}
__device__ __forceinline__ void xcd_barrier_complete(unsigned* bar, unsigned x, unsigned& nloc, unsigned& nx) {
    const unsigned G = gridDim.x * gridDim.y * gridDim.z;
    unsigned sum, cnt, mine, sp = 0u;
    for (;;) {
        sum = 0u; cnt = 0u; mine = 0u;
#pragma unroll
        for (unsigned j = 0; j < 16; ++j) { const unsigned c = xb_ld(&bar[XB_XCNT(j)]); sum += c; cnt += (c > 0u) ? 1u : 0u; mine = (j == x) ? c : mine; }
        if (sum == G) break;
        __builtin_amdgcn_s_sleep(1);
        if ((++sp & 255u) == 0u) { if (xb_ld(&bar[XB_TMO])) break; if (sp > XB_SPIN_CAP) { atomicAdd(&bar[XB_TMO], 1u); break; } }
    }
    nloc = mine > 0u ? mine : 1u; nx = cnt > 0u ? cnt : 1u;
}

__device__ __forceinline__ void xcd_barrier(const XcdBarrier& b) {
    asm volatile("s_waitcnt vmcnt(0)" ::: "memory");
    __syncthreads();
    if (threadIdx.x == 0) {
        unsigned* bar = b.bar;
        __builtin_amdgcn_s_waitcnt(0);
        unsigned nloc = b.st[0], nx = b.st[1];
        if (nloc == 0u) { xcd_barrier_complete(bar, b.x, nloc, nx); b.st[0] = nloc; b.st[1] = nx; }
        const unsigned old = xb_add(&bar[XB_XSUB(b.x)], 1u);
        const unsigned gen = old / nloc;
        if (old + 1u == (gen + 1u) * nloc) {
            __builtin_amdgcn_fence(__ATOMIC_RELEASE, "agent");
            asm volatile("s_waitcnt vmcnt(0)" ::: "memory");
            const unsigned og = xb_add(&bar[XB_TOP], 1u);
            const unsigned tg = og / nx;
            if (og + 1u == (tg + 1u) * nx) xb_add(&bar[XB_TOPGEN], 1u);
            else XB_SPIN(xb_ld(&bar[XB_TOPGEN]) == tg, bar);
            __builtin_amdgcn_fence(__ATOMIC_ACQUIRE, "agent");
            xb_add(&bar[XB_XGEN(b.x)], 1u);
            asm volatile("s_waitcnt vmcnt(0)" ::: "memory");
        } else {
            XB_SPIN(xb_ld(&bar[XB_XGEN(b.x)]) == gen, bar);
            __builtin_amdgcn_fence(__ATOMIC_ACQUIRE, "agent");
            asm volatile("s_waitcnt vmcnt(0)" ::: "memory");
        }
    }
    __syncthreads();
}

__global__ void __launch_bounds__(NWAVES * 64, 2) mk(Args a) {
    extern __shared__ __attribute__((aligned(16))) unsigned char lds_raw[];
    LAS unsigned char* lds = (LAS unsigned char*)lds_raw;
    const int tid = threadIdx.x, lane = tid & 63, wave = __builtin_amdgcn_readfirstlane(tid >> 6);
    unsigned char* ws = a.ws;
    const int lo = a.ph_lo, hi = a.ph_hi;
    const int G = gridDim.x;
    cg::grid_group grid = cg::this_grid();
#ifdef PROBE_SEAMS
#define SEAM_PS_B() do { __builtin_amdgcn_sched_barrier(0); psec -= __builtin_amdgcn_s_memrealtime(); __builtin_amdgcn_sched_barrier(0); } while (0)
#define SEAM_PS_E() do { __builtin_amdgcn_sched_barrier(0); psec += __builtin_amdgcn_s_memrealtime(); __builtin_amdgcn_sched_barrier(0); } while (0)
#else
#define SEAM_PS_B() do { } while (0)
#define SEAM_PS_E() do { } while (0)
#endif
#define IN(k) (lo <= (k) && (k) < hi)
#if CG_SEAM0
#define SEAM(k) do { if (IN(k) && IN((k) + 1)) { if ((k) == 0) { grid.sync(); bar = xcd_barrier_post((unsigned*)(ws + WS_BAR), MISC); } else { SEAM_PS_B(); xcd_barrier(bar); SEAM_PS_E(); } } } while (0)
#else
#define SEAM(k) do { if (IN(k) && IN((k) + 1)) { SEAM_PS_B(); xcd_barrier(bar); SEAM_PS_E(); } } while (0)
#endif
    float* SSQ = (float*)(ws + WS_SSQ);
    volatile LAS unsigned* MISC = (volatile LAS unsigned*)(lds + LDS_MISC);
    if (tid < 2) MISC[tid] = 0u;
    __syncthreads();
    XcdBarrier bar; bar.bar = (unsigned*)(ws + WS_BAR); bar.x = 0; bar.st = MISC;
#if !CG_SEAM0
    if (a.ph_lo < 0) grid.sync();
    bar = xcd_barrier_post((unsigned*)(ws + WS_BAR), MISC);
#endif
    int ph = 0;
    unsigned long long psec = 0ull, pdummy = 0ull;
#ifdef PROBE_GEMM_EPI
#define PSE_SEL(k) (((k) == PROBE_GEMM_EPI) ? psec : pdummy)
#else
#define PSE_SEL(k) pdummy
#endif
#ifdef PROBE_LO
    unsigned long long pt0 = 0, pt1 = 0;
#define PMARK(k) do { if (blockIdx.x == PROBE_BLK) { if ((k) == PROBE_LO) pt0 = __builtin_amdgcn_s_memrealtime(); if ((k) == PROBE_HI + 1) pt1 = __builtin_amdgcn_s_memrealtime(); } } while (0)
#else
#define PMARK(k) do { } while (0)
#endif
    PMARK(ph);
    if (IN(ph)) { prologue(a, lds, tid, lane, wave); }
    SEAM(ph); ++ph; PMARK(ph);
    if (IN(ph)) {
        pg8::Gemm g{(const bf16*)(ws + WS_A0), (const bf16*)(ws + WS_WIN0), M, 4096, D}; pg8::StaticOrder S; S.init(M, 4096, G, (int)blockIdx.x);
        pg8::EpiHgrnIn E{(bf16*)(ws + WS_A1), (float*)(ws + WS_A2), (bf16*)(ws + WS_A3), (bf16*)(ws + WS_A4), (const float*)(ws + WS_LB)};
        pg8::gemm_phase<pg8::EpiHgrnIn, pg8::StaticOrder, true, true>(lds, g, S, E, PSE_SEL(ph));
    }
    SEAM(ph); ++ph; PMARK(ph);
    if (IN(ph)) { for (int v = blockIdx.x; v < 256; v += G) { const int u = (G == 256) ? (((v & 7) * 2 + (v >> 7)) * 16 + ((v >> 3) & 15)) : v; hg::hgrn_unit<false>(a, lds, u, tid, lane, wave, psec); } }
    SEAM(ph); ++ph; PMARK(ph);
    if (IN(ph)) { for (int v = blockIdx.x; v < 256; v += G) { const int u = (G == 256) ? (((v & 7) * 2 + (v >> 7)) * 16 + ((v >> 3) & 15)) : v; hg::hgrn_unit<true>(a, lds, u, tid, lane, wave, psec); } }
    SEAM(ph); ++ph; PMARK(ph);
    if (IN(ph)) {
        pg8::Gemm g{(const bf16*)(ws + WS_A0), (const bf16*)(ws + WS_WOUT0), M, D, D}; pg8::StaticOrder S; S.init(M, D, G, (int)blockIdx.x);
        pg8::EpiResid<1, true> E{a.x, (bf16*)(ws + WS_A1), SSQ, (const float*)(ws + WS_SSQH)};
        pg8::gemm_phase<pg8::EpiResid<1, true>, pg8::StaticOrder, true, true>(lds, g, S, E, PSE_SEL(ph));
    }
    SEAM(ph); ++ph; PMARK(ph);
    if (IN(ph)) {
        pg8::Gemm g{(const bf16*)(ws + WS_A1), (const bf16*)(ws + WS_W13_0), M, 2 * DFF, D}; pg8::StaticOrder S; S.init(M, 2 * DFF, G, (int)blockIdx.x);
        pg8::EpiSwiglu E{(bf16*)(ws + WS_A2), DFF, SSQ};
        pg8::gemm_phase<pg8::EpiSwiglu, pg8::StaticOrder, true, true>(lds, g, S, E, PSE_SEL(ph));
        { const int nun = (M / 256) * (2 * DFF / 256), rem = nun % G; const int idle0 = rem ? rem : 0, nidle = rem ? G - rem : G;
          if ((int)blockIdx.x >= idle0) { __syncthreads(); convert_l1_weights(a, lds, lane, wave, (int)blockIdx.x - idle0, nidle); } }
    }
    SEAM(ph); ++ph; PMARK(ph);
    if (IN(ph)) {
        pg8::Gemm g{(const bf16*)(ws + WS_A2), (const bf16*)(ws + WS_W2_0), M, D, DFF}; pg8::StaticOrder S; S.init(M, D, G, (int)blockIdx.x);
        pg8::EpiResid<0, false> E{(const void*)(ws + WS_A1), (bf16*)(ws + WS_A1), SSQ, nullptr};
        pg8::gemm_phase<pg8::EpiResid<0, false>, pg8::StaticOrder, true, true>(lds, g, S, E, PSE_SEL(ph));
    }
    SEAM(ph); ++ph; PMARK(ph);
    if (IN(ph)) {
        pg8::Gemm g{(const bf16*)(ws + WS_A1), (const bf16*)(ws + WS_WQKV), M, 3072, D}; pg8::StaticOrder S; S.init(M, 3072, G, (int)blockIdx.x);
        pg8::EpiQKV E{(bf16*)(ws + WS_A2), (size_t)M * D, SSQ, (float*)(ws + WS_KMEAN)};
        pg8::gemm_phase<pg8::EpiQKV, pg8::StaticOrder, true, true>(lds, g, S, E, PSE_SEL(ph));
    }
    SEAM(ph); ++ph; PMARK(ph);
    if (IN(ph)) topk_phase(a, lds, tid, lane, wave);
    SEAM(ph); ++ph; PMARK(ph);
    if (IN(ph)) { if (ATT_RESIDENT) attn_resident<false>(a, lds, tid, lane, wave); else attn_engine<false>(a, lds, tid, lane, wave, psec); }
    SEAM(ph); ++ph; PMARK(ph);
    if (IN(ph)) { if (ATT_RESIDENT_OWN) attn_resident<true>(a, lds, tid, lane, wave); else attn_engine<true>(a, lds, tid, lane, wave, psec); }
    SEAM(ph); ++ph; PMARK(ph);
    if (IN(ph)) {
        pg8::Gemm g{(const bf16*)(ws + WS_A2), (const bf16*)(ws + WS_WOUT1), M, D, D}; pg8::StaticOrder S; S.init(M, D, G, (int)blockIdx.x);
        pg8::EpiResid<0, false> E{(const void*)(ws + WS_A1), (bf16*)(ws + WS_A1), SSQ, nullptr};
        pg8::gemm_phase<pg8::EpiResid<0, false>, pg8::StaticOrder, true, true>(lds, g, S, E, PSE_SEL(ph));
    }
    SEAM(ph); ++ph; PMARK(ph);
    if (IN(ph)) {
        pg8::Gemm g{(const bf16*)(ws + WS_A1), (const bf16*)(ws + WS_W13_1), M, 2 * DFF, D}; pg8::StaticOrder S; S.init(M, 2 * DFF, G, (int)blockIdx.x);
        pg8::EpiSwiglu E{(bf16*)(ws + WS_A2), DFF, SSQ};
        pg8::gemm_phase<pg8::EpiSwiglu, pg8::StaticOrder, true, true>(lds, g, S, E, PSE_SEL(ph));
    }
    SEAM(ph); ++ph; PMARK(ph);
    if (IN(ph)) {
        pg8::Gemm g{(const bf16*)(ws + WS_A2), (const bf16*)(ws + WS_W2_1), M, D, DFF}; pg8::StaticOrder S; S.init(M, D, G, (int)blockIdx.x);
        pg8::EpiResid<0, false> E{(const void*)(ws + WS_A1), (bf16*)(ws + WS_A1), SSQ, nullptr};
        pg8::gemm_phase<pg8::EpiResid<0, false>, pg8::StaticOrder, true, true>(lds, g, S, E, PSE_SEL(ph));
    }
    SEAM(ph); ++ph; PMARK(ph);
    if (IN(ph)) final_norm_phase(a, lane, wave);
    ++ph; PMARK(ph);
#ifdef PROBE_LO
    if (blockIdx.x == PROBE_BLK) { const unsigned long long te = __builtin_amdgcn_s_memrealtime(); unsigned long long w = 4ull * (pt1 - pt0);
#if defined(PROBE_SEC_ATT) || defined(PROBE_HG) || defined(PROBE_GEMM_EPI) || defined(PROBE_SEAMS)
        w = 4ull * psec;
#endif
        while (__builtin_amdgcn_s_memrealtime() - te < w) __builtin_amdgcn_s_sleep(8); }
#endif
#undef IN
#undef SEAM
#undef GEMM_PHASE
}

extern "C" void kernel_launch(void* const* d_in, const int* in_sizes, int n_in, void* d_out, int out_size, void* d_ws, size_t ws_size, hipStream_t stream) {
    static int grid = 0;
    if (grid == 0) {
        if (n_in != 13 || out_size != M * D || ws_size < WS_END) { fprintf(stderr, "kernel_launch: unexpected problem (n_in %d out %d ws %zu)\n", n_in, out_size, ws_size); grid = -1; return; }
        int dev = 0, cus = 0, per_cu = 0;
        (void)hipGetDevice(&dev); (void)hipDeviceGetAttribute(&cus, hipDeviceAttributeMultiprocessorCount, dev);
        if (hipFuncSetAttribute((const void*)mk, hipFuncAttributeMaxDynamicSharedMemorySize, LDS_BYTES) != hipSuccess) { fprintf(stderr, "kernel_launch: hipFuncSetAttribute failed\n"); grid = -1; return; }
        if (hipOccupancyMaxActiveBlocksPerMultiprocessor(&per_cu, (const void*)mk, NWAVES * 64, LDS_BYTES) != hipSuccess || per_cu < 1) { fprintf(stderr, "kernel_launch: occupancy query says %d\n", per_cu); (void)hipGetLastError(); grid = -1; return; }
        grid = cus;
        if (grid != 256) fprintf(stderr, "kernel_launch: note: %d CUs\n", grid);
    }
    if (grid < 0) return;
    Args a{};
    a.x = (const float*)d_in[0]; a.norm_mix = (const float*)d_in[1]; a.norm_ffn = (const float*)d_in[2]; a.hgrn_w_in = (const float*)d_in[3]; a.lb_logits = (const float*)d_in[4];
    a.hgrn_out_norm = (const float*)d_in[5]; a.hgrn_w_out = (const float*)d_in[6]; a.moba_w_in = (const float*)d_in[7]; a.moba_w_out = (const float*)d_in[8]; a.rel_table = (const float*)d_in[9];
    a.ffn_w13 = (const float*)d_in[10]; a.ffn_w2 = (const float*)d_in[11]; a.final_norm = (const float*)d_in[12];
    a.out = (float*)d_out; a.ws = (unsigned char*)d_ws;
    a.ph_lo = 0; a.ph_hi = 15;
    void* args[] = {&a};
#if !CG_SEAM0
    if (hipMemsetAsync((char*)d_ws + WS_BAR, 0, 3456 * 4, stream) != hipSuccess) { fprintf(stderr, "kernel_launch: hipMemsetAsync of the barrier words failed\n"); return; }
#endif
    hipError_t e = hipLaunchCooperativeKernel((const void*)mk, dim3(grid), dim3(NWAVES * 64), args, LDS_BYTES, stream);
    if (e != hipSuccess) fprintf(stderr, "kernel_launch: cooperative launch failed: %s (grid %d)\n", hipGetErrorString(e), grid);
}
```
